# Optimizing an MI355X kernel written in HIP

```python
import jax, jax.numpy as jnp
from jax import lax
import numpy as np

D_MODEL = 2048
BATCH = 4
SEQ = 2048
DEPTH = 2

PLE_DIM = 256
N_EVEN = (DEPTH + 1) // 2
N_ODD = DEPTH // 2
CHUNK = 64
CONV_W = 4
EPS = 1e-6
A_DK = 128
A_WIDTH = D_MODEL // 2
A_HEADS = A_WIDTH // A_DK
A_DV = A_WIDTH // A_HEADS
A_QK = A_HEADS * A_DK
B_WIDTH = D_MODEL // 2
B_BLOCK = 128
B_BLOCKS = B_WIDTH // B_BLOCK
LRU_C = 8.0
C_DK = 128
C_DV = 256
C_WIDTH = D_MODEL
C_HEADS = C_WIDTH // C_DV
C_QK = C_HEADS * C_DK
EVEN_IN = 2 * A_QK + 2 * A_WIDTH + 2 * B_WIDTH
EVEN_MIX = A_WIDTH + B_WIDTH
ODD_IN = 2 * C_QK + 3 * C_WIDTH + 2 * C_HEADS
ODD_MIX = C_WIDTH

kernel_name = "hybrid_hgrn2_rglru_mlstm_trunk"


def rmsnorm(x, g):
    xf = x.astype(jnp.float32)
    y = xf * lax.rsqrt(jnp.mean(xf * xf, axis=-1, keepdims=True) + EPS)
    return (y * g.astype(jnp.float32)).astype(x.dtype)


def head_rmsnorm(y, g):
    b, s, h, d = y.shape
    yn = y * lax.rsqrt(jnp.mean(y * y, axis=-1, keepdims=True) + EPS)
    return (yn * g.astype(jnp.float32).reshape(h, d)).reshape(b, s, h * d)


def causal_conv(u, w, bias):
    k_w = w.shape[0]
    s = u.shape[1]
    up = jnp.pad(u, ((0, 0), (k_w - 1, 0), (0, 0)))
    out = bias
    for k in range(k_w):
        out = out + up[:, k:k + s, :] * w[k]
    return out


def to_chunks(t):
    b, s = t.shape[:2]
    t = t.reshape((b, s // CHUNK, CHUNK) + t.shape[2:])
    return jnp.moveaxis(t, (1, 3), (0, 2))


def from_chunks(t):
    nc, b, h, c, d = t.shape
    return t.transpose(1, 0, 3, 2, 4).reshape(b, nc * c, h, d)


def hgrn2(q_pre, f_pre, v, lb):
    bsz, s, h, dk = q_pre.shape
    dv = v.shape[-1]
    lb = lb.reshape(h, dk)
    fp = f_pre.astype(jnp.float32)
    q = jax.nn.silu(q_pre.astype(jnp.float32))
    f = lb + (1.0 - lb) * jax.nn.sigmoid(fp)
    log_f = jnp.log(f)
    k = (1.0 - lb) * jax.nn.sigmoid(-fp)
    causal = jnp.tril(jnp.ones((CHUNK, CHUNK), dtype=bool))

    def step(state, inp):
        qc, kc, vc, gc = inp
        b = jnp.cumsum(gc, axis=2)
        diff = b[:, :, :, None, :] - b[:, :, None, :, :]
        w = jnp.exp(jnp.where(causal[:, :, None], diff, -jnp.inf))
        attn = jnp.einsum('bhtd,bhsd,bhtsd->bhts', qc, kc, w)
        o = (jnp.einsum('bhtd,bhde->bhte', qc * jnp.exp(b), state)
             + jnp.einsum('bhts,bhse->bhte', attn, vc))
        b_last = b[:, :, -1:, :]
        new_state = (jnp.exp(b_last[:, :, 0, :, None]) * state
                     + jnp.einsum('bhsd,bhse->bhde', kc * jnp.exp(b_last - b), vc))
        return new_state, o

    s0 = jnp.zeros((bsz, h, dk, dv), jnp.float32)
    xs = (to_chunks(q), to_chunks(k), to_chunks(v.astype(jnp.float32)), to_chunks(log_f))
    _, o = lax.scan(step, s0, xs)
    return from_chunks(o)


def rg_lru(xc, w_r, b_r, w_i, b_i, lam):
    bsz, s, wdt = xc.shape
    xf = xc.astype(jnp.float32)
    xh = xf.reshape(bsz, s, B_BLOCKS, B_BLOCK)
    r = jax.nn.sigmoid(jnp.einsum('bsnc,ncd->bsnd', xh, w_r.astype(jnp.float32)).reshape(bsz, s, wdt)
                       + b_r.astype(jnp.float32))
    ig = jax.nn.sigmoid(jnp.einsum('bsnc,ncd->bsnd', xh, w_i.astype(jnp.float32)).reshape(bsz, s, wdt)
                        + b_i.astype(jnp.float32))
    log_a = -LRU_C * r * jax.nn.softplus(-lam.astype(jnp.float32))
    a = jnp.exp(log_a)
    u = jnp.sqrt(-jnp.expm1(2.0 * log_a)) * (ig * xf)

    def combine(left, right):
        a1, b1 = left
        a2, b2 = right
        return a1 * a2, a2 * b1 + b2

    _, hs = lax.associative_scan(combine, (a, u), axis=1)
    return hs


def mlstm(q, k, v, li, lf):
    bsz, s, h, dk = q.shape
    dv = v.shape[-1]
    q = q.astype(jnp.float32) * (dk ** -0.5)
    causal = jnp.tril(jnp.ones((CHUNK, CHUNK), dtype=bool))

    def step(carry, inp):
        c_st, n_st, m_st = carry
        qc, kc, vc, lic, lfc = inp
        b = jnp.cumsum(lfc, axis=-1)
        dmat = jnp.where(causal, b[..., :, None] - b[..., None, :] + lic[..., None, :], -jnp.inf)
        inter = b + m_st[..., None]
        m_t = jnp.maximum(jnp.max(dmat, axis=-1), inter)
        wts = jnp.exp(dmat - m_t[..., None])
        g_inter = jnp.exp(inter - m_t)
        sc = jnp.einsum('bhtd,bhsd->bhts', qc, kc) * wts
        num = (g_inter[..., None] * jnp.einsum('bhtd,bhde->bhte', qc, c_st)
               + jnp.einsum('bhts,bhse->bhte', sc, vc))
        den = g_inter * jnp.einsum('bhtd,bhd->bht', qc, n_st) + jnp.sum(sc, axis=-1)
        hout = num / jnp.maximum(jnp.abs(den), jnp.exp(-m_t))[..., None]
        b_last = b[..., -1]
        logw = b_last[..., None] - b + lic
        m_new = jnp.maximum(b_last + m_st, jnp.max(logw, axis=-1))
        decay = jnp.exp(b_last + m_st - m_new)
        kw = kc * jnp.exp(logw - m_new[..., None])[..., None]
        c_new = decay[..., None, None] * c_st + jnp.einsum('bhsd,bhse->bhde', kw, vc)
        n_new = decay[..., None] * n_st + jnp.sum(kw, axis=2)
        return (c_new, n_new, m_new), hout

    init = (jnp.zeros((bsz, h, dk, dv), jnp.float32),
            jnp.zeros((bsz, h, dk), jnp.float32),
            jnp.zeros((bsz, h), jnp.float32))
    xs = (to_chunks(q), to_chunks(k.astype(jnp.float32)), to_chunks(v.astype(jnp.float32)),
          to_chunks(li), to_chunks(lf))
    _, hs = lax.scan(step, init, xs)
    return from_chunks(hs)


def setup_inputs(seed: int = 0) -> dict:
    key = jax.random.key(seed)
    ks = jax.random.split(key, 32)

    def nrm(k, shape, scale):
        return jax.random.normal(k, shape, jnp.float32) * scale

    u = jax.random.uniform(ks[12], (N_EVEN, B_WIDTH), jnp.float32, minval=0.9, maxval=0.999)
    a0 = u ** (1.0 / LRU_C)
    return {
        "x": nrm(ks[0], (BATCH, SEQ, D_MODEL), 1.0),
        "p": nrm(ks[1], (DEPTH, BATCH, SEQ, PLE_DIM), 1.0),
        "e_norm": 1.0 + nrm(ks[2], (N_EVEN, D_MODEL), 0.02),
        "e_w_in": nrm(ks[3], (N_EVEN, D_MODEL, EVEN_IN), D_MODEL ** -0.5),
        "a_lb_logits": nrm(ks[4], (N_EVEN + 1, A_QK), 0.1),
        "a_norm": 1.0 + nrm(ks[5], (N_EVEN, A_WIDTH), 0.02),
        "b_conv_w": nrm(ks[6], (N_EVEN, CONV_W, B_WIDTH), CONV_W ** -0.5),
        "b_conv_b": nrm(ks[7], (N_EVEN, B_WIDTH), 0.01),
        "b_w_r": nrm(ks[8], (N_EVEN, B_BLOCKS, B_BLOCK, B_BLOCK), B_BLOCK ** -0.5),
        "b_b_r": nrm(ks[9], (N_EVEN, B_WIDTH), 0.1),
        "b_w_i": nrm(ks[10], (N_EVEN, B_BLOCKS, B_BLOCK, B_BLOCK), B_BLOCK ** -0.5),
        "b_b_i": nrm(ks[11], (N_EVEN, B_WIDTH), 0.1),
        "b_lambda": jnp.log(a0) - jnp.log1p(-a0),
        "e_w_out": nrm(ks[13], (N_EVEN, EVEN_MIX, D_MODEL), EVEN_MIX ** -0.5),
        "o_norm": 1.0 + nrm(ks[14], (N_ODD, D_MODEL), 0.02),
        "o_w_in": nrm(ks[15], (N_ODD, D_MODEL, ODD_IN), D_MODEL ** -0.5),
        "c_conv_w": nrm(ks[16], (N_ODD, CONV_W, 2 * C_QK), CONV_W ** -0.5),
        "c_conv_b": nrm(ks[17], (N_ODD, 2 * C_QK), 0.01),
        "c_b_i": nrm(ks[18], (N_ODD, C_HEADS), 0.1),
        "c_b_f": jnp.linspace(3.0, 6.0, C_HEADS, dtype=jnp.float32)[None, :] + nrm(ks[19], (N_ODD, C_HEADS), 0.1),
        "c_norm": 1.0 + nrm(ks[20], (N_ODD, C_WIDTH), 0.02),
        "o_w_out": nrm(ks[21], (N_ODD, ODD_MIX, D_MODEL), ODD_MIX ** -0.5),
        "ple_w": nrm(ks[22], (DEPTH, PLE_DIM, D_MODEL), PLE_DIM ** -0.5),
        "ple_norm": 1.0 + nrm(ks[23], (DEPTH, D_MODEL), 0.02),
        "ple_gate_w": nrm(ks[24], (DEPTH, D_MODEL, D_MODEL), D_MODEL ** -0.5),
        "final_norm": 1.0 + nrm(ks[25], (D_MODEL,), 0.02),
    }


def reference(x, p, e_norm, e_w_in, a_lb_logits, a_norm, b_conv_w, b_conv_b, b_w_r, b_b_r,
              b_w_i, b_b_i, b_lambda, e_w_out, o_norm, o_w_in, c_conv_w, c_conv_b, c_b_i,
              c_b_f, c_norm, o_w_out, ple_w, ple_norm, ple_gate_w, final_norm):
    bsz, s, _ = x.shape
    lbs = jnp.cumsum(jax.nn.softmax(a_lb_logits.astype(jnp.float32), axis=0), axis=0)
    h = x
    for i in range(DEPTH):
        j = i // 2
        hn = rmsnorm(h, e_norm[j] if i % 2 == 0 else o_norm[j])
        if i % 2 == 0:
            u = hn @ e_w_in[j]
            o0 = 0
            qa = u[..., o0:o0 + A_QK]; o0 += A_QK
            fa = u[..., o0:o0 + A_QK]; o0 += A_QK
            ia = u[..., o0:o0 + A_WIDTH]; o0 += A_WIDTH
            za = u[..., o0:o0 + A_WIDTH]; o0 += A_WIDTH
            xb = u[..., o0:o0 + B_WIDTH]; o0 += B_WIDTH
            zb = u[..., o0:o0 + B_WIDTH]
            ya = hgrn2(qa.reshape(bsz, s, A_HEADS, A_DK), fa.reshape(bsz, s, A_HEADS, A_DK),
                       ia.reshape(bsz, s, A_HEADS, A_DV), lbs[j])
            ya = head_rmsnorm(ya, a_norm[j]) * jax.nn.silu(za.astype(jnp.float32))
            xc = causal_conv(xb, b_conv_w[j], b_conv_b[j])
            yb = rg_lru(xc, b_w_r[j], b_b_r[j], b_w_i[j], b_b_i[j], b_lambda[j])
            yb = yb * jax.nn.silu(zb.astype(jnp.float32))
            y = jnp.concatenate([ya, yb], axis=-1).astype(h.dtype)
            mix = y @ e_w_out[j]
        else:
            u = hn @ o_w_in[j]
            o0 = 0
            qk = u[..., o0:o0 + 2 * C_QK]; o0 += 2 * C_QK
            v = u[..., o0:o0 + C_WIDTH]; o0 += C_WIDTH
            og = u[..., o0:o0 + C_WIDTH]; o0 += C_WIDTH
            z = u[..., o0:o0 + C_WIDTH]; o0 += C_WIDTH
            ig = u[..., o0:o0 + C_HEADS]; o0 += C_HEADS
            fg = u[..., o0:o0 + C_HEADS]
            qk = jax.nn.silu(causal_conv(qk, c_conv_w[j], c_conv_b[j]))
            q = qk[..., :C_QK].reshape(bsz, s, C_HEADS, C_DK)
            k = qk[..., C_QK:].reshape(bsz, s, C_HEADS, C_DK)
            li = ig.astype(jnp.float32) + c_b_i[j].astype(jnp.float32)
            lf = jax.nn.log_sigmoid(fg.astype(jnp.float32) + c_b_f[j].astype(jnp.float32))
            yc = mlstm(q, k, v.reshape(bsz, s, C_HEADS, C_DV), li, lf)
            yc = (head_rmsnorm(yc, c_norm[j]) * jax.nn.sigmoid(og.astype(jnp.float32))
                  * jax.nn.silu(z.astype(jnp.float32)))
            mix = yc.astype(h.dtype) @ o_w_out[j]
        h = h + mix
        pl = rmsnorm(p[i].astype(h.dtype) @ ple_w[i], ple_norm[i])
        h = h + jax.nn.sigmoid(h @ ple_gate_w[i]) * pl
    return rmsnorm(h, final_norm)
```

```cpp
#include <hip/hip_runtime.h>
#include <cstdio>
#include <cstdint>

namespace {
constexpr int NB = 4, S = 2048, D = 2048, M = NB * S, PLE = 256;
constexpr float EPS = 1e-6f;
typedef unsigned short bf16_t;

constexpr size_t MiB = 1u << 20;
constexpr size_t OFF_CTL = 0;
constexpr size_t OFF_WIN0 = 1 * MiB;
constexpr size_t OFF_WOUT0 = 25 * MiB;
constexpr size_t OFF_WG0 = 33 * MiB;
constexpr size_t OFF_WIN1 = 41 * MiB;
constexpr size_t OFF_WOUT1 = 73 * MiB;
constexpr size_t OFF_WG1 = 81 * MiB;
constexpr size_t OFF_PLEW = 89 * MiB;
constexpr size_t OFF_WGATE1 = 91 * MiB;
constexpr size_t OFF_SMALL = 91 * MiB + 65536;
constexpr size_t OFF_GATES1 = 92 * MiB;
constexpr size_t OFF_STATS = 92 * MiB + 524288;
constexpr size_t OFF_A = 94 * MiB;
constexpr size_t OFF_B = 126 * MiB;
constexpr size_t OFF_U = 158 * MiB;
constexpr size_t WS_END = 254 * MiB;

__device__ __forceinline__ float bf2f(bf16_t b) { return __uint_as_float(((unsigned)b) << 16); }
__device__ __forceinline__ bf16_t f2bf(float f) { unsigned u = __float_as_uint(f); u += 0x7fffu + ((u >> 16) & 1u); return (bf16_t)(u >> 16); }
__device__ __forceinline__ float sigmoidf_(float x) { return 1.f / (1.f + __expf(-x)); }
__device__ __forceinline__ float siluf_(float x) { return x / (1.f + __expf(-x)); }
__device__ __forceinline__ float wave_sum(float v) {
#pragma unroll
    for (int o = 1; o < 64; o <<= 1) v += __shfl_xor(v, o);
    return v;
}

__device__ __forceinline__ int srccol(int mode, int n) {
    if (mode == 0) return n;
    if (n < 4096) return n;
    const int r = n - 4096, j = r >> 8, i = r & 255;
    return i < 128 ? 4096 + 128 * j + i : 6144 + 128 * j + (i - 128);
}
__global__ void __launch_bounds__(256) k_wt(const float* __restrict__ W, int K, int N, bf16_t* __restrict__ WT, const float* __restrict__ gain, int mode) {
    __shared__ float t[32][33];
    const int n0 = blockIdx.x * 32, k0 = blockIdx.y * 32, tx = threadIdx.x & 31, ty = threadIdx.x >> 5;
    const int src0 = srccol(mode, n0);
    for (int i = ty; i < 32; i += 8) { const float g = gain ? gain[k0 + i] : 1.f; t[i][tx] = W[(size_t)(k0 + i) * N + src0 + tx] * g; }
    __syncthreads();
    for (int i = ty; i < 32; i += 8) WT[(size_t)(n0 + i) * K + k0 + tx] = f2bf(t[tx][i]);
}
__global__ void k_wt_gates(const float* __restrict__ W, bf16_t* __restrict__ WT, const float* __restrict__ gain) {
    const int i = blockIdx.x * blockDim.x + threadIdx.x; if (i >= 16 * 2048) return;
    const int j = i >> 11, k = i & 2047;
    WT[i] = f2bf(W[(size_t)k * 8208 + 8192 + j] * gain[k]);
}
__global__ void __launch_bounds__(256) k_x_to_bf16(const float* __restrict__ x, bf16_t* __restrict__ o, float* __restrict__ ss) {
    __shared__ float red[4];
    const int row = blockIdx.x, tid = threadIdx.x;
    const float4* xr = (const float4*)(x + (size_t)row * D) + tid * 2;
    const float4 a = xr[0], b = xr[1];
    float s = a.x * a.x + a.y * a.y + a.z * a.z + a.w * a.w + b.x * b.x + b.y * b.y + b.z * b.z + b.w * b.w;
    bf16_t* op = o + (size_t)row * D + tid * 8;
    op[0] = f2bf(a.x); op[1] = f2bf(a.y); op[2] = f2bf(a.z); op[3] = f2bf(a.w); op[4] = f2bf(b.x); op[5] = f2bf(b.y); op[6] = f2bf(b.z); op[7] = f2bf(b.w);
    s = wave_sum(s); if ((tid & 63) == 0) red[tid >> 6] = s; __syncthreads();
    if (tid == 0) ss[row] = red[0] + red[1] + red[2] + red[3];
}
__global__ void k_f32_to_bf16(const float* __restrict__ x, bf16_t* __restrict__ o, size_t n) {
    for (size_t i = (size_t)blockIdx.x * blockDim.x + threadIdx.x; i < n; i += (size_t)gridDim.x * blockDim.x) o[i] = f2bf(x[i]);
}
__global__ void k_lbs(const float* __restrict__ logits, float* __restrict__ lb) {
    const int c = blockIdx.x * blockDim.x + threadIdx.x; if (c >= 1024) return;
    lb[c] = 1.f / (1.f + expf(logits[1024 + c] - logits[c]));
}
__global__ void __launch_bounds__(256) k_row_ss_f32(const float* __restrict__ x, float* __restrict__ ss) {
    __shared__ float red[4];
    const int row = blockIdx.x, tid = threadIdx.x;
    const float4* xr = (const float4*)(x + (size_t)row * D) + tid * 2;
    const float4 a = xr[0], b = xr[1];
    float s = a.x * a.x + a.y * a.y + a.z * a.z + a.w * a.w + b.x * b.x + b.y * b.y + b.z * b.z + b.w * b.w;
    s = wave_sum(s); if ((tid & 63) == 0) red[tid >> 6] = s; __syncthreads();
    if (tid == 0) ss[row] = red[0] + red[1] + red[2] + red[3];
}
__global__ void __launch_bounds__(256) k_row_ss_bf16(const bf16_t* __restrict__ x, int ld, float* __restrict__ ss) {
    __shared__ float red[4];
    const int row = blockIdx.x, tid = threadIdx.x;
    const bf16_t* xr = x + (size_t)row * ld + tid * 8;
    float s = 0.f;
#pragma unroll
    for (int i = 0; i < 8; ++i) { const float v = bf2f(xr[i]); s += v * v; }
    s = wave_sum(s); if ((tid & 63) == 0) red[tid >> 6] = s; __syncthreads();
    if (tid == 0) ss[row] = red[0] + red[1] + red[2] + red[3];
}

template <class Epi>
__global__ void __launch_bounds__(256) k_gemm_naive(const bf16_t* __restrict__ A, const bf16_t* __restrict__ Bt, int K, Epi epi) {
    __shared__ float As[16][68], B0s[16][68], B1s[16][68];
    const int tid = threadIdx.x, tx = tid & 15, ty = tid >> 4;
    const int row0 = blockIdx.y * 64, c0 = 256 * (blockIdx.x >> 1) + 64 * (blockIdx.x & 1);
    const int lr = tid >> 2, lq = tid & 3;
    float acc0[4][4], acc1[4][4];
#pragma unroll
    for (int i = 0; i < 4; ++i)
#pragma unroll
        for (int j = 0; j < 4; ++j) { acc0[i][j] = 0.f; acc1[i][j] = 0.f; }
    const bf16_t* ap = A + (size_t)(row0 + lr) * K + 4 * lq;
    const bf16_t* b0p = Bt + (size_t)(c0 + lr) * K + 4 * lq;
    const bf16_t* b1p = Bt + (size_t)(c0 + 128 + lr) * K + 4 * lq;
    for (int k0 = 0; k0 < K; k0 += 16) {
        const uint2 a = *(const uint2*)(ap + k0), b0 = *(const uint2*)(b0p + k0), b1 = *(const uint2*)(b1p + k0);
        __syncthreads();
        As[4 * lq + 0][lr] = __uint_as_float(a.x << 16); As[4 * lq + 1][lr] = __uint_as_float(a.x & 0xffff0000u);
        As[4 * lq + 2][lr] = __uint_as_float(a.y << 16); As[4 * lq + 3][lr] = __uint_as_float(a.y & 0xffff0000u);
        B0s[4 * lq + 0][lr] = __uint_as_float(b0.x << 16); B0s[4 * lq + 1][lr] = __uint_as_float(b0.x & 0xffff0000u);
        B0s[4 * lq + 2][lr] = __uint_as_float(b0.y << 16); B0s[4 * lq + 3][lr] = __uint_as_float(b0.y & 0xffff0000u);
        B1s[4 * lq + 0][lr] = __uint_as_float(b1.x << 16); B1s[4 * lq + 1][lr] = __uint_as_float(b1.x & 0xffff0000u);
        B1s[4 * lq + 2][lr] = __uint_as_float(b1.y << 16); B1s[4 * lq + 3][lr] = __uint_as_float(b1.y & 0xffff0000u);
        __syncthreads();
#pragma unroll
        for (int kk = 0; kk < 16; ++kk) {
            const float4 av = *(const float4*)&As[kk][ty * 4], v0 = *(const float4*)&B0s[kk][tx * 4], v1 = *(const float4*)&B1s[kk][tx * 4];
            const float a_[4] = {av.x, av.y, av.z, av.w}, p0[4] = {v0.x, v0.y, v0.z, v0.w}, p1[4] = {v1.x, v1.y, v1.z, v1.w};
#pragma unroll
            for (int i = 0; i < 4; ++i)
#pragma unroll
                for (int j = 0; j < 4; ++j) { acc0[i][j] += a_[i] * p0[j]; acc1[i][j] += a_[i] * p1[j]; }
        }
    }
#pragma unroll
    for (int i = 0; i < 4; ++i)
#pragma unroll
        for (int j = 0; j < 4; ++j) epi(row0 + ty * 4 + i, c0 + tx * 4 + j, acc0[i][j], acc1[i][j]);
}

struct EpiIn0 {
    bf16_t* U; const float* rowss;
    __device__ __forceinline__ void operator()(int row, int col, float a0, float a1) const {
        const float sc = rsqrtf(rowss[row] * (1.f / D) + EPS);
        U[(size_t)row * 6144 + col] = f2bf(a0 * sc); U[(size_t)row * 6144 + col + 128] = f2bf(a1 * sc);
    }
};
struct EpiIn1 {
    bf16_t* U; const float* rowss;
    __device__ __forceinline__ void operator()(int row, int col, float a0, float a1) const {
        const float sc = rsqrtf(rowss[row] * (1.f / D) + EPS);
        if (col < 4096) { U[(size_t)row * 6144 + col] = f2bf(a0 * sc); U[(size_t)row * 6144 + col + 128] = f2bf(a1 * sc); }
        else { const int r = col - 4096, j = r >> 8, i = r & 255;
            U[(size_t)row * 6144 + 4096 + 128 * j + i] = f2bf(sigmoidf_(a0 * sc) * siluf_(a1 * sc)); }
    }
};
struct EpiOut {
    const float* base; float* out; bf16_t* h16;
    __device__ __forceinline__ void operator()(int row, int col, float a0, float a1) const {
        const size_t o = (size_t)row * D + col;
        const float h0 = base[o] + a0, h1 = base[o + 128] + a1;
        out[o] = h0; out[o + 128] = h1; h16[o] = f2bf(h0); h16[o + 128] = f2bf(h1);
    }
};
struct EpiPle {
    bf16_t* P;
    __device__ __forceinline__ void operator()(int row, int col, float a0, float a1) const {
        const size_t o = (size_t)row * D + col; P[o] = f2bf(a0); P[o + 128] = f2bf(a1);
    }
};
struct EpiGate {
    float* out; bf16_t* h16; const bf16_t* P; const float* plss; const float* ple_norm;
    __device__ __forceinline__ void operator()(int row, int col, float a0, float a1) const {
        const size_t o = (size_t)row * D + col;
        const float rs = rsqrtf(plss[row] * (1.f / D) + EPS);
        const float h0 = out[o] + sigmoidf_(a0) * (bf2f(P[o]) * rs * ple_norm[col]);
        const float h1 = out[o + 128] + sigmoidf_(a1) * (bf2f(P[o + 128]) * rs * ple_norm[col + 128]);
        out[o] = h0; out[o + 128] = h1;
        if (h16) { h16[o] = f2bf(h0); h16[o + 128] = f2bf(h1); }
    }
};
__global__ void __launch_bounds__(256) k_gates1(const bf16_t* __restrict__ A, const bf16_t* __restrict__ WG, const float* __restrict__ rowss, float* __restrict__ gates) {
    const int row = blockIdx.x * 4 + (threadIdx.x >> 6), lane = threadIdx.x & 63;
    const float sc = rsqrtf(rowss[row] * (1.f / D) + EPS);
    float a[32];
#pragma unroll
    for (int i = 0; i < 32; ++i) a[i] = bf2f(A[(size_t)row * D + lane + 64 * i]);
    for (int j = 0; j < 16; ++j) {
        float s = 0.f;
#pragma unroll
        for (int i = 0; i < 32; ++i) s += a[i] * bf2f(WG[(size_t)j * D + lane + 64 * i]);
        s = wave_sum(s);
        if (lane == 0) gates[(size_t)row * 16 + j] = s * sc;
    }
}

__global__ void __launch_bounds__(256) k_hgrn2_naive(const bf16_t* __restrict__ U, const float* __restrict__ lb, const float* __restrict__ a_norm, bf16_t* __restrict__ Y) {
    __shared__ float sq[128], sf[128], sk[128], part[2][128], red[4];
    const int b = blockIdx.x >> 3, h = blockIdx.x & 7, tid = threadIdx.x, e = tid & 127, half = tid >> 7;
    float Sr[64];
#pragma unroll
    for (int i = 0; i < 64; ++i) Sr[i] = 0.f;
    const float lbv = lb[h * 128 + e], an = a_norm[h * 128 + e];
    const bf16_t* up = U + (size_t)b * S * 6144 + h * 128 + e;
    bf16_t nqa = up[0], nfa = up[1024], nv = up[2048], nza = up[3072];
    for (int t = 0; t < S; ++t) {
        const float qa = bf2f(nqa), fa = bf2f(nfa), v = bf2f(nv), za = bf2f(nza);
        if (t + 1 < S) { const bf16_t* np = up + (size_t)(t + 1) * 6144; nqa = np[0]; nfa = np[1024]; nv = np[2048]; nza = np[3072]; }
        if (half == 0) { sq[e] = siluf_(qa); sf[e] = lbv + (1.f - lbv) * sigmoidf_(fa); sk[e] = (1.f - lbv) * sigmoidf_(-fa); }
        __syncthreads();
        float acc = 0.f;
#pragma unroll
        for (int i = 0; i < 64; ++i) { const int d = half * 64 + i; Sr[i] = sf[d] * Sr[i] + sk[d] * v; acc += Sr[i] * sq[d]; }
        part[half][e] = acc;
        __syncthreads();
        const float o = part[0][e] + part[1][e];
        float s2 = wave_sum(o * o);
        if ((tid & 63) == 0) red[tid >> 6] = s2;
        __syncthreads();
        const float tot = red[0] + red[1];
        if (half == 0) Y[((size_t)b * S + t) * D + h * 128 + e] = f2bf(o * rsqrtf(tot * (1.f / 128) + EPS) * an * siluf_(za));
    }
}
__global__ void __launch_bounds__(128) k_rglru_naive(const bf16_t* __restrict__ U, const float* __restrict__ conv_w, const float* __restrict__ conv_b, const float* __restrict__ w_r,
                                                     const float* __restrict__ b_r, const float* __restrict__ w_i, const float* __restrict__ b_i, const float* __restrict__ lam, bf16_t* __restrict__ Y) {
    extern __shared__ float sm[];
    float* wr = sm; float* wi = sm + 16384; float* xcs = sm + 32768;
    const int b = blockIdx.x >> 3, n = blockIdx.x & 7, d = threadIdx.x, ch = n * 128 + d;
    for (int i = d; i < 16384; i += 128) { wr[i] = w_r[n * 16384 + i]; wi[i] = w_i[n * 16384 + i]; }
    const float cw0 = conv_w[ch], cw1 = conv_w[1024 + ch], cw2 = conv_w[2048 + ch], cw3 = conv_w[3072 + ch], cb = conv_b[ch], br = b_r[ch], bi = b_i[ch];
    const float sp = log1pf(expf(-lam[ch]));
    float x1 = 0.f, x2 = 0.f, x3 = 0.f, hst = 0.f;
    const bf16_t* up = U + (size_t)b * S * 6144 + 4096 + ch;
    bf16_t nx = up[0], nz = up[1024];
    __syncthreads();
    for (int t = 0; t < S; ++t) {
        const float xb = bf2f(nx), zb = bf2f(nz);
        if (t + 1 < S) { const bf16_t* np = up + (size_t)(t + 1) * 6144; nx = np[0]; nz = np[1024]; }
        const float xc = cb + cw0 * x3 + cw1 * x2 + cw2 * x1 + cw3 * xb;
        x3 = x2; x2 = x1; x1 = xb;
        xcs[d] = xc;
        __syncthreads();
        float ar = br, ai = bi;
#pragma unroll 8
        for (int c = 0; c < 128; ++c) { const float xv = xcs[c]; ar += xv * wr[c * 128 + d]; ai += xv * wi[c * 128 + d]; }
        const float r = sigmoidf_(ar), ig = sigmoidf_(ai), log_a = -8.f * r * sp, a = expf(log_a);
        const float u = sqrtf(-expm1f(2.f * log_a)) * ig * xc;
        hst = a * hst + u;
        Y[((size_t)b * S + t) * D + 1024 + ch] = f2bf(hst * siluf_(zb));
        __syncthreads();
    }
}
__global__ void k_qkconv(const bf16_t* __restrict__ U, const float* __restrict__ cw, const float* __restrict__ cb, bf16_t* __restrict__ QK) {
    const size_t i = (size_t)blockIdx.x * blockDim.x + threadIdx.x; if (i >= (size_t)M * 2048) return;
    const int row = (int)(i >> 11), c = (int)(i & 2047), t = row & (S - 1);
    float acc = cb[c];
#pragma unroll
    for (int k = 0; k < 4; ++k) { const int tt = t - 3 + k; if (tt >= 0) acc += cw[k * 2048 + c] * bf2f(U[(size_t)(row - 3 + k) * 6144 + c]); }
    QK[i] = f2bf(siluf_(acc));
}
__global__ void __launch_bounds__(256) k_mlstm_naive(const bf16_t* __restrict__ U, const bf16_t* __restrict__ QK, const float* __restrict__ gates, const float* __restrict__ c_b_i, const float* __restrict__ c_b_f,
                                                     const float* __restrict__ c_norm, bf16_t* __restrict__ Y) {
    __shared__ float sq[128], sk[128], sn[128], red[4];
    const int b = blockIdx.x >> 3, h = blockIdx.x & 7, tid = threadIdx.x;
    float C[128];
#pragma unroll
    for (int i = 0; i < 128; ++i) C[i] = 0.f;
    if (tid < 128) sn[tid] = 0.f;
    float m = 0.f;
    const float bi = c_b_i[h], bf = c_b_f[h], cn = c_norm[h * 256 + tid];
    const size_t row0 = (size_t)b * S;
    for (int t = 0; t < S; ++t) {
        const size_t row = row0 + t;
        if (tid < 128) sq[tid] = bf2f(QK[row * 2048 + h * 128 + tid]) * 0.08838834764831845f;
        else sk[tid - 128] = bf2f(QK[row * 2048 + 1024 + h * 128 + (tid - 128)]);
        const float li = gates[row * 16 + h] + bi, xf = gates[row * 16 + 8 + h] + bf;
        const float lf = fminf(xf, 0.f) - log1pf(expf(-fabsf(xf)));
        const float mn = fmaxf(lf + m, li), ip = expf(li - mn), fp = expf(lf + m - mn);
        m = mn;
        const float v = bf2f(U[row * 6144 + 2048 + h * 256 + tid]), g = bf2f(U[row * 6144 + 4096 + h * 256 + tid]);
        __syncthreads();
        float num = 0.f;
#pragma unroll
        for (int d = 0; d < 128; ++d) { C[d] = fp * C[d] + (ip * sk[d]) * v; num += C[d] * sq[d]; }
        if (tid < 128) sn[tid] = fp * sn[tid] + ip * sk[tid];
        __syncthreads();
        float den = 0.f;
#pragma unroll 8
        for (int d = 0; d < 128; ++d) den += sn[d] * sq[d];
        const float hv = num / fmaxf(fabsf(den), expf(-m));
        const float s2 = wave_sum(hv * hv);
        if ((tid & 63) == 0) red[tid >> 6] = s2;
        __syncthreads();
        const float tot = red[0] + red[1] + red[2] + red[3];
        Y[row * D + h * 256 + tid] = f2bf(hv * rsqrtf(tot * (1.f / 256) + EPS) * cn * g);
    }
}
__global__ void __launch_bounds__(256) k_final_norm(float* __restrict__ out, const float* __restrict__ g) {
    __shared__ float red[4];
    const int row = blockIdx.x, tid = threadIdx.x;
    float4* xr = (float4*)(out + (size_t)row * D) + tid * 2;
    float4 a = xr[0], b = xr[1];
    float s = a.x * a.x + a.y * a.y + a.z * a.z + a.w * a.w + b.x * b.x + b.y * b.y + b.z * b.z + b.w * b.w;
    s = wave_sum(s); if ((tid & 63) == 0) red[tid >> 6] = s; __syncthreads();
    const float rs = rsqrtf((red[0] + red[1] + red[2] + red[3]) * (1.f / D) + EPS);
    const float4 g0 = ((const float4*)g)[tid * 2], g1 = ((const float4*)g)[tid * 2 + 1];
    a.x *= rs * g0.x; a.y *= rs * g0.y; a.z *= rs * g0.z; a.w *= rs * g0.w; b.x *= rs * g1.x; b.y *= rs * g1.y; b.z *= rs * g1.z; b.w *= rs * g1.w;
    xr[0] = a; xr[1] = b;
}
}

extern "C" void kernel_launch(void* const* d_in, const int* in_sizes, int n_in, void* d_out, int out_size, void* d_ws, size_t ws_size, hipStream_t stream) {
    if (n_in != 26 || ws_size < WS_END || out_size != M * D) { fprintf(stderr, "kernel_launch: unexpected problem shape (n_in %d, ws %zu, out %d)\n", n_in, ws_size, out_size); return; }
    const float* x = (const float*)d_in[0]; const float* p = (const float*)d_in[1]; const float* e_norm = (const float*)d_in[2]; const float* e_w_in = (const float*)d_in[3];
    const float* a_lb = (const float*)d_in[4]; const float* a_norm = (const float*)d_in[5]; const float* b_conv_w = (const float*)d_in[6]; const float* b_conv_b = (const float*)d_in[7];
    const float* b_w_r = (const float*)d_in[8]; const float* b_b_r = (const float*)d_in[9]; const float* b_w_i = (const float*)d_in[10]; const float* b_b_i = (const float*)d_in[11];
    const float* b_lambda = (const float*)d_in[12]; const float* e_w_out = (const float*)d_in[13]; const float* o_norm = (const float*)d_in[14]; const float* o_w_in = (const float*)d_in[15];
    const float* c_conv_w = (const float*)d_in[16]; const float* c_conv_b = (const float*)d_in[17]; const float* c_b_i = (const float*)d_in[18]; const float* c_b_f = (const float*)d_in[19];
    const float* c_norm = (const float*)d_in[20]; const float* o_w_out = (const float*)d_in[21]; const float* ple_w = (const float*)d_in[22]; const float* ple_norm = (const float*)d_in[23];
    const float* ple_gate_w = (const float*)d_in[24]; const float* final_norm = (const float*)d_in[25];
    float* out = (float*)d_out; char* ws = (char*)d_ws;
    bf16_t* WIN0 = (bf16_t*)(ws + OFF_WIN0); bf16_t* WOUT0 = (bf16_t*)(ws + OFF_WOUT0); bf16_t* WG0 = (bf16_t*)(ws + OFF_WG0); bf16_t* WIN1 = (bf16_t*)(ws + OFF_WIN1);
    bf16_t* WOUT1 = (bf16_t*)(ws + OFF_WOUT1); bf16_t* WG1 = (bf16_t*)(ws + OFF_WG1); bf16_t* PLEW = (bf16_t*)(ws + OFF_PLEW); bf16_t* WGATE1 = (bf16_t*)(ws + OFF_WGATE1);
    float* lb = (float*)(ws + OFF_SMALL); float* gates1 = (float*)(ws + OFF_GATES1);
    float* rowss0 = (float*)(ws + OFF_STATS); float* plss = rowss0 + M; float* rowss1 = plss + M;
    bf16_t* A = (bf16_t*)(ws + OFF_A); bf16_t* B = (bf16_t*)(ws + OFF_B); bf16_t* U = (bf16_t*)(ws + OFF_U); bf16_t* P16 = (bf16_t*)(ws + OFF_WIN0);
    bf16_t* PL = U;

    static bool attr_done = false;
    if (!attr_done) { (void)hipFuncSetAttribute((const void*)k_rglru_naive, hipFuncAttributeMaxDynamicSharedMemorySize, (32768 + 128) * 4); attr_done = true; }

    k_wt<<<dim3(6144 / 32, 2048 / 32), 256, 0, stream>>>(e_w_in, 2048, 6144, WIN0, e_norm, 0);
    k_wt<<<dim3(2048 / 32, 2048 / 32), 256, 0, stream>>>(e_w_out, 2048, 2048, WOUT0, nullptr, 0);
    k_wt<<<dim3(2048 / 32, 2048 / 32), 256, 0, stream>>>(ple_gate_w, 2048, 2048, WG0, nullptr, 0);
    k_wt<<<dim3(2048 / 32, 2048 / 32), 256, 0, stream>>>(ple_gate_w + (size_t)2048 * 2048, 2048, 2048, WG1, nullptr, 0);
    k_wt<<<dim3(8192 / 32, 2048 / 32), 256, 0, stream>>>(o_w_in, 2048, 8208, WIN1, o_norm, 1);
    k_wt_gates<<<(16 * 2048) / 256, 256, 0, stream>>>(o_w_in, WGATE1, o_norm);
    k_wt<<<dim3(2048 / 32, 2048 / 32), 256, 0, stream>>>(o_w_out, 2048, 2048, WOUT1, nullptr, 0);
    k_wt<<<dim3(2048 / 32, 256 / 32), 256, 0, stream>>>(ple_w, 256, 2048, PLEW, nullptr, 0);
    k_wt<<<dim3(2048 / 32, 256 / 32), 256, 0, stream>>>(ple_w + (size_t)256 * 2048, 256, 2048, PLEW + (size_t)2048 * 256, nullptr, 0);
    k_x_to_bf16<<<M, 256, 0, stream>>>(x, A, rowss0);
    k_lbs<<<4, 256, 0, stream>>>(a_lb, lb);
    k_gemm_naive<EpiIn0><<<dim3((6144 / 256) * 2, M / 64), 256, 0, stream>>>(A, WIN0, 2048, EpiIn0{U, rowss0});
    k_f32_to_bf16<<<2048, 256, 0, stream>>>(p, P16, (size_t)2 * M * PLE);
    k_hgrn2_naive<<<32, 256, 0, stream>>>(U, lb, a_norm, A);
    k_rglru_naive<<<32, 128, (32768 + 128) * 4, stream>>>(U, b_conv_w, b_conv_b, b_w_r, b_b_r, b_w_i, b_b_i, b_lambda, A);
    k_gemm_naive<EpiOut><<<dim3((2048 / 256) * 2, M / 64), 256, 0, stream>>>(A, WOUT0, 2048, EpiOut{x, out, B});
    k_gemm_naive<EpiPle><<<dim3((2048 / 256) * 2, M / 64), 256, 0, stream>>>(P16, PLEW, 256, EpiPle{PL});
    k_row_ss_bf16<<<M, 256, 0, stream>>>(PL, D, plss);
    k_gemm_naive<EpiGate><<<dim3((2048 / 256) * 2, M / 64), 256, 0, stream>>>(B, WG0, 2048, EpiGate{out, A, PL, plss, ple_norm});
    k_row_ss_f32<<<M, 256, 0, stream>>>(out, rowss1);
    k_gemm_naive<EpiIn1><<<dim3((8192 / 256) * 2, M / 64), 256, 0, stream>>>(A, WIN1, 2048, EpiIn1{U, rowss1});
    k_gates1<<<M / 4, 256, 0, stream>>>(A, WGATE1, rowss1, gates1);
    k_qkconv<<<(M * 2048) / 256, 256, 0, stream>>>(U, c_conv_w, c_conv_b, A);
    k_mlstm_naive<<<32, 256, 0, stream>>>(U, A, gates1, c_b_i, c_b_f, c_norm, B);
    k_gemm_naive<EpiOut><<<dim3((2048 / 256) * 2, M / 64), 256, 0, stream>>>(B, WOUT1, 2048, EpiOut{out, out, A});
    k_gemm_naive<EpiPle><<<dim3((2048 / 256) * 2, M / 64), 256, 0, stream>>>(P16 + (size_t)M * PLE, PLEW + (size_t)2048 * 256, 256, EpiPle{PL});
    k_row_ss_bf16<<<M, 256, 0, stream>>>(PL, D, plss);
    k_gemm_naive<EpiGate><<<dim3((2048 / 256) * 2, M / 64), 256, 0, stream>>>(A, WG1, 2048, EpiGate{out, nullptr, PL, plss, ple_norm + D});
    k_final_norm<<<M, 256, 0, stream>>>(out, final_norm);
}
```

```cpp
#include <hip/hip_runtime.h>
#include <cstdio>
#include <cstdint>

namespace pg8 {
#define PG8_LAS __attribute__((address_space(3)))
typedef unsigned short bf16_t;
typedef short bf16x8 __attribute__((ext_vector_type(8)));
typedef float f32x4 __attribute__((ext_vector_type(4)));
typedef unsigned u32x4 __attribute__((ext_vector_type(4)));
constexpr int BM = 256, BK = 64, HALF = 128, HTB = HALF * BK * 2  , STAGE_BYTES = 8 * HTB, NXCD = 8, WGM = 8;

__host__ __device__ __forceinline__ int lds_byte(int r, int c) { const int st = (r >> 4) * 2 + (c >> 5), rr = r & 15, cc = c & 31, ob = rr * 64 + cc * 2; return st * 1024 + (ob ^ (((ob >> 9) & 1) << 5)); }
__host__ __device__ __forceinline__ void stage_rc(int b, int& R, int& C) { const int st = b / 1024, sb = b % 1024, swz = sb ^ (((sb >> 9) & 1) << 5); R = (st >> 1) * 16 + swz / 64; C = (st & 1) * 32 + (swz % 64) / 2; }
__host__ __device__ __forceinline__ int perm32(int rho) { const int n = rho >> 4, i = rho & 15; return 8 * (i >> 2) + 4 * n + (i & 3); }

struct Unit { int pm, pn; };
struct Gemm { const bf16_t* A; const bf16_t* Bt; int M, N, K; };

struct StaticOrder {
    int nM, nN, nwg, G, c;
    __host__ __device__ void init(int M, int N, int G_, int c_) { nM = M / BM; nN = N / BM; nwg = nM * nN; G = G_; c = c_; }
    __host__ __device__ bool next(int i, Unit& u) const {
        const long L = (long)i * G + c; if (L >= nwg) return false;
        int wgid = (int)L; { const int q = nwg / NXCD, r = nwg % NXCD, xcd = wgid % NXCD, off = wgid / NXCD; wgid = (xcd < r ? xcd * (q + 1) : r * (q + 1) + (xcd - r) * q) + off; }
        const int nig = WGM * nN, gid = wgid / nig, fm = gid * WGM, gsz = (nM - fm) < WGM ? (nM - fm) : WGM;
        u.pm = fm + ((wgid % nig) % gsz); u.pn = (wgid % nig) / gsz; return true;
    }
    __device__ __forceinline__ void a_ready(const Unit&) const {}
    __device__ __forceinline__ void done(const Unit&) const {}
};

__device__ __forceinline__ unsigned cvt_pk_bf16(float lo, float hi) { unsigned r; asm volatile("v_cvt_pk_bf16_f32 %0, %1, %2" : "=v"(r) : "v"(lo), "v"(hi)); return r; }
typedef float f32x2 __attribute__((ext_vector_type(2)));
template <class Epi, class Sched, bool ALIGN_EPI = false, bool SP2 = false>
__device__ __forceinline__ void gemm_phase(PG8_LAS unsigned char* lds, const Gemm g, const Sched& S, const Epi& E) {
    const int tid = threadIdx.x, wid = __builtin_amdgcn_readfirstlane(tid >> 6), lane = tid & 63, wr = wid >> 2, wc = wid & 3, fr = lane & 15, fq = lane >> 4;
    const int K = g.K, nt = K / BK;
    unsigned voffA[2], voffB[2];
#pragma unroll
    for (int i = 0; i < 2; ++i) { int R, C; stage_rc(tid * 16 + i * 8192, R, C); const int Rb = Epi::PERM ? ((R & ~31) + perm32(R & 31)) : R;
        voffA[i] = (unsigned)(R * K + C) * 2u; voffB[i] = (unsigned)(Rb * K + C) * 2u; }
    const size_t kstep = (size_t)(BK * 2);
    const size_t hstep = (size_t)HALF * K * 2;
    const size_t tstep = 2 * hstep;
    const unsigned ldsw = (unsigned)wid * 1024u;
    const int aoff = lds_byte(wr * 64 + fr, fq * 8), boff = lds_byte(wc * 32 + fr, fq * 8);
#define PG8_SA(b, h) (((b) * 2 + (h)) * HTB)
#define PG8_SB(b, h) ((4 + (b) * 2 + (h)) * HTB)
#define PG8_STAGE(bufoff, gbase, voff) do { _Pragma("unroll") for (int _i = 0; _i < 2; ++_i) \
        __builtin_amdgcn_global_load_lds((const unsigned*)((const char*)(gbase) + (voff)[_i]), (PG8_LAS unsigned*)(lds + (bufoff) + ldsw + _i * 8192), 16, 0, 0); } while (0)
#define PG8_LDA(dst, b, h) do { _Pragma("unroll") for (int m = 0; m < 4; ++m) _Pragma("unroll") for (int k = 0; k < 2; ++k) dst[m][k] = *(const PG8_LAS bf16x8*)(lds + PG8_SA(b, h) + aoff + m * 2048 + k * 1024); } while (0)
#define PG8_LDB(dst, b, h) do { _Pragma("unroll") for (int n = 0; n < 2; ++n) _Pragma("unroll") for (int k = 0; k < 2; ++k) dst[n][k] = *(const PG8_LAS bf16x8*)(lds + PG8_SB(b, h) + boff + n * 2048 + k * 1024); } while (0)
#define PG8_MMA(ai, bj, At, Bt) do { __builtin_amdgcn_s_setprio(1); _Pragma("unroll") for (int m = 0; m < 4; ++m) _Pragma("unroll") for (int n = 0; n < 2; ++n) _Pragma("unroll") for (int k = 0; k < 2; ++k) \
        acc[ai][bj][m][n] = __builtin_amdgcn_mfma_f32_16x16x32_bf16(Bt[n][k], At[m][k], acc[ai][bj][m][n], 0, 0, 0); __builtin_amdgcn_s_setprio(0); } while (0)
#define PG8_WAIT_V(n) asm volatile("s_waitcnt vmcnt(" #n ")" ::: "memory")
#define PG8_WAIT_L(n) asm volatile("s_waitcnt lgkmcnt(" #n ")" ::: "memory")
#define PG8_BAR __builtin_amdgcn_s_barrier()
#define PG8_SCHED __builtin_amdgcn_sched_barrier(0)
    Unit cur, nxt; int ui = 0;
    if (!S.next(0, cur)) return;
    f32x4 acc[2][2][4][2];
#pragma unroll
    for (int a = 0; a < 2; ++a)
#pragma unroll
        for (int b = 0; b < 2; ++b)
#pragma unroll
            for (int m = 0; m < 4; ++m)
#pragma unroll
                for (int n = 0; n < 2; ++n) acc[a][b][m][n] = (f32x4){0.f, 0.f, 0.f, 0.f};
    bf16x8 At[4][2], B0[2][2], B1[2][2];
    const char* cA = (const char*)g.A + (size_t)cur.pm * tstep; const char* cB = (const char*)g.Bt + (size_t)cur.pn * tstep;
    S.a_ready(cur);
    if constexpr (SP2) {
        PG8_STAGE(PG8_SB(0, 0), cB, voffB); PG8_STAGE(PG8_SB(0, 1), cB + hstep, voffB); PG8_STAGE(PG8_SA(0, 0), cA, voffA); PG8_STAGE(PG8_SA(0, 1), cA + hstep, voffA);
        if (wr == 1) PG8_BAR;
        PG8_WAIT_V(2); PG8_BAR;
        PG8_STAGE(PG8_SB(1, 0), cB + kstep, voffB); PG8_STAGE(PG8_SA(1, 0), cA + kstep, voffA); PG8_STAGE(PG8_SB(1, 1), cB + hstep + kstep, voffB);
        PG8_WAIT_V(6); PG8_BAR;
    } else {
        PG8_STAGE(PG8_SB(0, 0), cB, voffB); PG8_STAGE(PG8_SA(0, 0), cA, voffA); PG8_STAGE(PG8_SB(0, 1), cB + hstep, voffB); PG8_STAGE(PG8_SA(0, 1), cA + hstep, voffA);
        if (wr == 1) PG8_BAR;
        PG8_WAIT_V(4); PG8_BAR;
        PG8_STAGE(PG8_SB(1, 0), cB + kstep, voffB); PG8_STAGE(PG8_SA(1, 0), cA + kstep, voffA); PG8_STAGE(PG8_SB(1, 1), cB + hstep + kstep, voffB);
        PG8_WAIT_V(6); PG8_BAR;
    }
    for (;;) {
        const bool has_next = S.next(ui + 1, nxt);
        const char* nA = has_next ? (const char*)g.A + (size_t)nxt.pm * tstep : cA; const char* nB = has_next ? (const char*)g.Bt + (size_t)nxt.pn * tstep : cB;
        for (int t = 0; t < nt; t += 2) {
            const bool last = (t == nt - 2);
            const char* a1 = cA + (size_t)(t + 1) * kstep;
            const char* a2 = last ? nA : cA + (size_t)(t + 2) * kstep; const char* b2 = last ? nB : cB + (size_t)(t + 2) * kstep;
            const char* a3 = a2 + kstep; const char* b3 = b2 + kstep;
            if (last && has_next) S.a_ready(nxt);
            if constexpr (SP2) {
            PG8_LDB(B0, 0, 0); PG8_LDB(B1, 0, 1); PG8_SCHED; PG8_LDA(At, 0, 0); PG8_STAGE(PG8_SA(1, 1), a1 + hstep, voffA);
            PG8_WAIT_V(8); PG8_WAIT_L(0); PG8_BAR; PG8_MMA(0, 0, At, B0); PG8_MMA(0, 1, At, B1); PG8_BAR; PG8_SCHED;
            PG8_LDA(At, 0, 1); PG8_STAGE(PG8_SB(0, 0), b2, voffB); PG8_STAGE(PG8_SB(0, 1), b2 + hstep, voffB); PG8_STAGE(PG8_SA(0, 0), a2, voffA);
            PG8_WAIT_V(8); PG8_WAIT_L(0); PG8_BAR; PG8_MMA(1, 0, At, B0); PG8_MMA(1, 1, At, B1); PG8_BAR; PG8_SCHED;
            PG8_LDB(B0, 1, 0); PG8_LDB(B1, 1, 1); PG8_SCHED; PG8_LDA(At, 1, 0); PG8_STAGE(PG8_SA(0, 1), a2 + hstep, voffA);
            PG8_WAIT_V(8); PG8_WAIT_L(0); PG8_BAR; PG8_MMA(0, 0, At, B0); PG8_MMA(0, 1, At, B1); PG8_BAR; PG8_SCHED;
            PG8_LDA(At, 1, 1); PG8_STAGE(PG8_SB(1, 0), b3, voffB); PG8_STAGE(PG8_SB(1, 1), b3 + hstep, voffB); PG8_STAGE(PG8_SA(1, 0), a3, voffA);
            PG8_WAIT_V(8); PG8_WAIT_L(0); PG8_BAR; PG8_MMA(1, 0, At, B0); PG8_MMA(1, 1, At, B1); PG8_BAR; PG8_SCHED;
            } else {
            PG8_LDB(B0, 0, 0); PG8_SCHED; PG8_LDA(At, 0, 0); PG8_STAGE(PG8_SA(1, 1), a1 + hstep, voffA);
            PG8_WAIT_L(8); PG8_BAR; PG8_WAIT_L(0); PG8_MMA(0, 0, At, B0); PG8_BAR; PG8_SCHED;
            PG8_LDB(B1, 0, 1); PG8_STAGE(PG8_SB(0, 0), b2, voffB);
            PG8_BAR; PG8_WAIT_L(0); PG8_MMA(0, 1, At, B1); PG8_BAR;
            PG8_LDA(At, 0, 1); PG8_STAGE(PG8_SA(0, 0), a2, voffA);
            PG8_BAR; PG8_WAIT_L(0); PG8_MMA(1, 0, At, B0); PG8_BAR; PG8_SCHED;
            PG8_STAGE(PG8_SB(0, 1), b2 + hstep, voffB);
            PG8_WAIT_V(6); PG8_BAR; PG8_MMA(1, 1, At, B1); PG8_BAR;
            PG8_LDB(B0, 1, 0); PG8_SCHED; PG8_LDA(At, 1, 0); PG8_STAGE(PG8_SA(0, 1), a2 + hstep, voffA);
            PG8_WAIT_L(8); PG8_BAR; PG8_WAIT_L(0); PG8_MMA(0, 0, At, B0); PG8_BAR; PG8_SCHED;
            PG8_LDB(B1, 1, 1); PG8_STAGE(PG8_SB(1, 0), b3, voffB);
            PG8_BAR; PG8_WAIT_L(0); PG8_MMA(0, 1, At, B1); PG8_BAR;
            PG8_LDA(At, 1, 1); PG8_STAGE(PG8_SA(1, 0), a3, voffA);
            PG8_BAR; PG8_WAIT_L(0); PG8_MMA(1, 0, At, B0); PG8_BAR; PG8_SCHED;
            PG8_STAGE(PG8_SB(1, 1), b3 + hstep, voffB);
            PG8_WAIT_V(6); PG8_BAR; PG8_MMA(1, 1, At, B1); PG8_BAR;
            }
        }
        if constexpr (ALIGN_EPI) { if (wr == 0) PG8_BAR; }
        if constexpr (!Epi::AFTER_DRAIN) { E(acc, cur, wr, wc, fr, fq); S.done(cur); }
        if (!has_next) break;
#pragma unroll
        for (int a = 0; a < 2; ++a)
#pragma unroll
            for (int b = 0; b < 2; ++b)
#pragma unroll
                for (int m = 0; m < 4; ++m)
#pragma unroll
                    for (int n = 0; n < 2; ++n) acc[a][b][m][n] = (f32x4){0.f, 0.f, 0.f, 0.f};
        cur = nxt; cA = nA; cB = nB; ++ui;
        if constexpr (ALIGN_EPI) { if (wr == 1) PG8_BAR; }
    }
    PG8_WAIT_V(0);
    if constexpr (!ALIGN_EPI) { if (wr == 0) PG8_BAR; }
    PG8_BAR;
    if constexpr (Epi::AFTER_DRAIN) { E.fused(acc, cur, wr, wc, fr, fq, lds, wid, lane); S.done(cur); }
#undef PG8_SA
#undef PG8_SB
#undef PG8_STAGE
#undef PG8_LDA
#undef PG8_LDB
#undef PG8_MMA
#undef PG8_WAIT_V
#undef PG8_WAIT_L
#undef PG8_BAR
#undef PG8_SCHED
}
}

namespace pg8 {
constexpr float EPSN = 1e-6f;
__device__ __forceinline__ float fsigmoid(float x) { return __builtin_amdgcn_rcpf(1.f + __expf(-x)); }
__device__ __forceinline__ float fsilu(float x) { return x * __builtin_amdgcn_rcpf(1.f + __expf(-x)); }
__device__ __forceinline__ float row_stat32(const float* part, int row, int fq) {
    const f32x4 a = *(const f32x4*)(part + (size_t)row * 32 + 8 * fq), b = *(const f32x4*)(part + (size_t)row * 32 + 8 * fq + 4);
    float s = ((a.x + a.y) + (a.z + a.w)) + ((b.x + b.y) + (b.z + b.w));
    s += __shfl_xor(s, 16); s += __shfl_xor(s, 32); return s;
}
__device__ __forceinline__ u32x4 pack8(const f32x4 v0, const f32x4 v1) { u32x4 w; w.x = cvt_pk_bf16(v0[0], v0[1]); w.y = cvt_pk_bf16(v0[2], v0[3]); w.z = cvt_pk_bf16(v1[0], v1[1]); w.w = cvt_pk_bf16(v1[2], v1[3]); return w; }
__device__ __forceinline__ float bflo(unsigned w) { return __uint_as_float(w << 16); }
__device__ __forceinline__ float bfhi(unsigned w) { return __uint_as_float(w & 0xffff0000u); }

struct EpiIn0 {
    static constexpr bool PERM = true, AFTER_DRAIN = false;
    bf16_t* U; const float* rstd;
    __device__ __forceinline__ void operator()(const f32x4 (&acc)[2][2][4][2], const Unit& u, int wr, int wc, int fr, int fq) const {
        const int row0 = u.pm * BM + wr * 64 + fr, col0 = u.pn * BM + wc * 32 + 8 * fq;
#pragma unroll
        for (int ai = 0; ai < 2; ++ai)
#pragma unroll
            for (int m = 0; m < 4; ++m) { const int row = row0 + ai * HALF + m * 16; const float sc = rstd[row]; bf16_t* rowp = U + (size_t)row * 6144 + col0;
#pragma unroll
                for (int bj = 0; bj < 2; ++bj) *(u32x4*)(rowp + bj * HALF) = pack8(acc[ai][bj][m][0] * sc, acc[ai][bj][m][1] * sc); }
    }
};
struct EpiIn1 {
    static constexpr bool PERM = true, AFTER_DRAIN = false;
    bf16_t* U; const float* hpart;
    __device__ __forceinline__ void operator()(const f32x4 (&acc)[2][2][4][2], const Unit& u, int wr, int wc, int fr, int fq) const {
        const int row0 = u.pm * BM + wr * 64 + fr;
        if (u.pn < 16) {
            const int col0 = u.pn * BM + wc * 32 + 8 * fq;
#pragma unroll
            for (int ai = 0; ai < 2; ++ai)
#pragma unroll
                for (int m = 0; m < 4; ++m) { const int row = row0 + ai * HALF + m * 16; const float sc = rsqrtf(row_stat32(hpart, row, fq) * (1.f / 2048.f) + EPSN); bf16_t* rowp = U + (size_t)row * 6144 + col0;
#pragma unroll
                    for (int bj = 0; bj < 2; ++bj) *(u32x4*)(rowp + bj * HALF) = pack8(acc[ai][bj][m][0] * sc, acc[ai][bj][m][1] * sc); }
        } else {
            const int col0 = 4096 + 128 * (u.pn - 16) + wc * 32 + 8 * fq;
#pragma unroll
            for (int ai = 0; ai < 2; ++ai)
#pragma unroll
                for (int m = 0; m < 4; ++m) { const int row = row0 + ai * HALF + m * 16; const float sc = rsqrtf(row_stat32(hpart, row, fq) * (1.f / 2048.f) + EPSN);
                    f32x4 g0, g1;
#pragma unroll
                    for (int j = 0; j < 4; ++j) { g0[j] = fsigmoid(acc[ai][0][m][0][j] * sc) * fsilu(acc[ai][1][m][0][j] * sc); g1[j] = fsigmoid(acc[ai][0][m][1][j] * sc) * fsilu(acc[ai][1][m][1][j] * sc); }
                    *(u32x4*)(U + (size_t)row * 6144 + col0) = pack8(g0, g1); }
        }
    }
};
struct EpiOut {
    static constexpr bool PERM = true, AFTER_DRAIN = false;
    const float* base; float* out; bf16_t* h16;
    __device__ __forceinline__ void operator()(const f32x4 (&acc)[2][2][4][2], const Unit& u, int wr, int wc, int fr, int fq) const {
        const int row0 = u.pm * BM + wr * 64 + fr, col0 = u.pn * BM + wc * 32 + 8 * fq;
#pragma unroll
        for (int ai = 0; ai < 2; ++ai)
#pragma unroll
            for (int m = 0; m < 4; ++m) { const size_t off = (size_t)(row0 + ai * HALF + m * 16) * 2048 + col0;
#pragma unroll
                for (int bj = 0; bj < 2; ++bj) { const f32x4 h0 = *(const f32x4*)(base + off + bj * HALF) + acc[ai][bj][m][0], h1 = *(const f32x4*)(base + off + bj * HALF + 4) + acc[ai][bj][m][1];
                    *(f32x4*)(out + off + bj * HALF) = h0; *(f32x4*)(out + off + bj * HALF + 4) = h1; *(u32x4*)(h16 + off + bj * HALF) = pack8(h0, h1); }
                asm volatile("" ::: "memory"); }
    }
};
struct EpiPle {
    static constexpr bool PERM = true, AFTER_DRAIN = false;
    bf16_t* PL; float* plpart;
    __device__ __forceinline__ void operator()(const f32x4 (&acc)[2][2][4][2], const Unit& u, int wr, int wc, int fr, int fq) const {
        const int row0 = u.pm * BM + wr * 64 + fr, col0 = u.pn * BM + wc * 32 + 8 * fq;
#pragma unroll
        for (int ai = 0; ai < 2; ++ai)
#pragma unroll
            for (int m = 0; m < 4; ++m) { const int row = row0 + ai * HALF + m * 16; float s = 0.f;
#pragma unroll
                for (int bj = 0; bj < 2; ++bj) { const f32x4 v0 = acc[ai][bj][m][0], v1 = acc[ai][bj][m][1];
                    s += ((v0[0] * v0[0] + v0[1] * v0[1]) + (v0[2] * v0[2] + v0[3] * v0[3])) + ((v1[0] * v1[0] + v1[1] * v1[1]) + (v1[2] * v1[2] + v1[3] * v1[3]));
                    *(u32x4*)(PL + (size_t)row * 2048 + col0 + bj * HALF) = pack8(v0, v1); }
                s += __shfl_xor(s, 16); s += __shfl_xor(s, 32);
                if (fq == 0) plpart[(size_t)row * 32 + u.pn * 4 + wc] = s; }
    }
};
struct EpiGate {
    static constexpr bool PERM = true, AFTER_DRAIN = false;
    float* out; bf16_t* h16; const bf16_t* PL; const float* plpart; const float* ple_norm; float* hpart;
    __device__ __forceinline__ void operator()(const f32x4 (&acc)[2][2][4][2], const Unit& u, int wr, int wc, int fr, int fq) const {
        const int row0 = u.pm * BM + wr * 64 + fr, col0 = u.pn * BM + wc * 32 + 8 * fq;
        f32x4 pn[2][2];
#pragma unroll
        for (int bj = 0; bj < 2; ++bj) { pn[bj][0] = *(const f32x4*)(ple_norm + col0 + bj * HALF); pn[bj][1] = *(const f32x4*)(ple_norm + col0 + bj * HALF + 4); }
#pragma unroll
        for (int ai = 0; ai < 2; ++ai)
#pragma unroll
            for (int m = 0; m < 4; ++m) { const int row = row0 + ai * HALF + m * 16; const size_t off = (size_t)row * 2048 + col0;
                const float rs = rsqrtf(row_stat32(plpart, row, fq) * (1.f / 2048.f) + EPSN); float s = 0.f;
#pragma unroll
                for (int bj = 0; bj < 2; ++bj) { const u32x4 pw = *(const u32x4*)(PL + off + bj * HALF);
                    const f32x4 p0 = (f32x4){bflo(pw.x), bfhi(pw.x), bflo(pw.y), bfhi(pw.y)} * pn[bj][0] * rs, p1 = (f32x4){bflo(pw.z), bfhi(pw.z), bflo(pw.w), bfhi(pw.w)} * pn[bj][1] * rs;
                    f32x4 h0 = *(const f32x4*)(out + off + bj * HALF), h1 = *(const f32x4*)(out + off + bj * HALF + 4);
#pragma unroll
                    for (int j = 0; j < 4; ++j) { h0[j] += fsigmoid(acc[ai][bj][m][0][j]) * p0[j]; h1[j] += fsigmoid(acc[ai][bj][m][1][j]) * p1[j]; }
                    *(f32x4*)(out + off + bj * HALF) = h0; *(f32x4*)(out + off + bj * HALF + 4) = h1;
                    if (h16) *(u32x4*)(h16 + off + bj * HALF) = pack8(h0, h1);
                    s += ((h0[0] * h0[0] + h0[1] * h0[1]) + (h0[2] * h0[2] + h0[3] * h0[3])) + ((h1[0] * h1[0] + h1[1] * h1[1]) + (h1[2] * h1[2] + h1[3] * h1[3])); }
                s += __shfl_xor(s, 16); s += __shfl_xor(s, 32);
                if (fq == 0) hpart[(size_t)row * 32 + u.pn * 4 + wc] = s;
                asm volatile("" ::: "memory"); }
    }
};
}

constexpr int NWAVES = 8;
constexpr int NB = 4, S = 2048, D = 2048, M = NB * S, PLE = 256;
constexpr float EPS = 1e-6f;
typedef unsigned short bf16_t;
typedef float f32x4 __attribute__((ext_vector_type(4)));
typedef unsigned v4u __attribute__((ext_vector_type(4)));
typedef unsigned v2u __attribute__((ext_vector_type(2)));

constexpr size_t MiB = 1u << 20;
constexpr size_t OFF_CTL = 0, CTL_ZERO_BYTES = 1 * MiB;
constexpr size_t OFF_WIN0 = 1 * MiB;
constexpr size_t OFF_WOUT0 = 25 * MiB;
constexpr size_t OFF_WG0 = 33 * MiB;
constexpr size_t OFF_WIN1 = 41 * MiB;
constexpr size_t OFF_WOUT1 = 73 * MiB;
constexpr size_t OFF_WG1 = 81 * MiB;
constexpr size_t OFF_PLEW = 89 * MiB;
constexpr size_t OFF_WGATE1 = 91 * MiB;
constexpr size_t OFF_SMALL = 91 * MiB + 65536;
constexpr size_t OFF_GATES1 = 92 * MiB;
constexpr size_t OFF_PART = 92 * MiB + 524288;
constexpr size_t OFF_A = 95 * MiB;
constexpr size_t OFF_B = 127 * MiB;
constexpr size_t OFF_U = 159 * MiB;
constexpr size_t WS_END = 255 * MiB;
constexpr int CW_BAR = 4096;

constexpr int RING_BYTES = 131072;
constexpr int MISC_OFF = RING_BYTES + 320;
constexpr int LDS_BYTES = 147456;

#define LAS __attribute__((address_space(3)))
#define GAS __attribute__((address_space(1)))
__device__ __forceinline__ float bf2f(bf16_t b) { return __uint_as_float(((unsigned)b) << 16); }
__device__ __forceinline__ unsigned f2bf(float f) { unsigned u = __float_as_uint(f); return (u + 0x7fffu + ((u >> 16) & 1u)) >> 16; }
__device__ __forceinline__ unsigned pk2(float lo, float hi) { return f2bf(lo) | (f2bf(hi) << 16); }
__device__ __forceinline__ float sigmoidf_(float x) { return 1.f / (1.f + __expf(-x)); }
__device__ __forceinline__ float siluf_(float x) { return x / (1.f + __expf(-x)); }
__device__ __forceinline__ float wave_sum(float v) {
#pragma unroll
    for (int o = 1; o < 64; o <<= 1) v += __shfl_xor(v, o);
    return v;
}
#define LDS_WAIT() asm volatile("s_waitcnt lgkmcnt(0)" ::: "memory")
#define XB_TMO      128
#define XB_XCNT(j)  (256  + 64 * (j))
#define XB_XSUB(j)  (1280 + 64 * (j))
#define XB_XGEN(j)  (2304 + 64 * (j))
#define XB_TOP      3328
#define XB_TOPGEN   3392
#define XCD_BAR_WORDS 3456
#define XB_SPIN_CAP (1u << 26)

__device__ __forceinline__ unsigned xb_ld(unsigned* p)              { return __hip_atomic_load(p, __ATOMIC_RELAXED, __HIP_MEMORY_SCOPE_AGENT); }
__device__ __forceinline__ unsigned xb_add(unsigned* p, unsigned v) { return __hip_atomic_fetch_add(p, v, __ATOMIC_RELAXED, __HIP_MEMORY_SCOPE_AGENT); }
__device__ __forceinline__ unsigned xb_xcc_id() { return (unsigned)__builtin_amdgcn_s_getreg((3 << 11) | 20) & 0xFu; }
#define XB_SPIN(cond, bar) do { unsigned _sp = 0; while (cond) { __builtin_amdgcn_s_sleep(1); \
    if ((++_sp & 255u) == 0u) { if (xb_ld(&(bar)[XB_TMO])) break; if (_sp > XB_SPIN_CAP) { atomicAdd(&(bar)[XB_TMO], 1u); break; } } } } while (0)

struct XcdBarrier {
    unsigned* bar; unsigned x;
    volatile LAS unsigned* st;
};

__device__ __forceinline__ XcdBarrier xcd_barrier_post(unsigned* bar, volatile LAS unsigned* st) {
    XcdBarrier b; b.bar = bar; b.x = xb_xcc_id(); b.st = st;
    if (threadIdx.x == 0) (void)xb_add(&bar[XB_XCNT(b.x)], 1u);
    return b;
}
__device__ __forceinline__ void xcd_barrier_complete(unsigned* bar, unsigned x, unsigned& nloc, unsigned& nx) {
    const unsigned G = gridDim.x * gridDim.y * gridDim.z;
    unsigned sum, cnt, mine, sp = 0u;
    for (;;) {
        sum = 0u; cnt = 0u; mine = 0u;
#pragma unroll
        for (unsigned j = 0; j < 16; ++j) { const unsigned c = xb_ld(&bar[XB_XCNT(j)]); sum += c; cnt += (c > 0u) ? 1u : 0u; mine = (j == x) ? c : mine; }
        if (sum == G) break;
        __builtin_amdgcn_s_sleep(1);
        if ((++sp & 255u) == 0u) { if (xb_ld(&bar[XB_TMO])) break; if (sp > XB_SPIN_CAP) { atomicAdd(&bar[XB_TMO], 1u); break; } }
    }
    nloc = mine > 0u ? mine : 1u; nx = cnt > 0u ? cnt : 1u;
}

__device__ __forceinline__ void xcd_barrier(const XcdBarrier& b) {
    asm volatile("s_waitcnt vmcnt(0)" ::: "memory");
    __syncthreads();
    if (threadIdx.x == 0) {
        unsigned* bar = b.bar;
        __builtin_amdgcn_s_waitcnt(0);
        unsigned nloc = b.st[0], nx = b.st[1];
        if (nloc == 0u) { xcd_barrier_complete(bar, b.x, nloc, nx); b.st[0] = nloc; b.st[1] = nx; }
        const unsigned old = xb_add(&bar[XB_XSUB(b.x)], 1u);
        const unsigned gen = old / nloc;
        if (old + 1u == (gen + 1u) * nloc) {
            __builtin_amdgcn_fence(__ATOMIC_RELEASE, "agent");
            asm volatile("s_waitcnt vmcnt(0)" ::: "memory");
            const unsigned og = xb_add(&bar[XB_TOP], 1u);
            const unsigned tg = og / nx;
            if (og + 1u == (tg + 1u) * nx) xb_add(&bar[XB_TOPGEN], 1u);
            else XB_SPIN(xb_ld(&bar[XB_TOPGEN]) == tg, bar);
            __builtin_amdgcn_fence(__ATOMIC_ACQUIRE, "agent");
            xb_add(&bar[XB_XGEN(b.x)], 1u);
            asm volatile("s_waitcnt vmcnt(0)" ::: "memory");
        } else {
            XB_SPIN(xb_ld(&bar[XB_XGEN(b.x)]) == gen, bar);
            __builtin_amdgcn_fence(__ATOMIC_ACQUIRE, "agent");
            asm volatile("s_waitcnt vmcnt(0)" ::: "memory");
        }
    }
    __syncthreads();
}

struct Ptrs {
    const float* in[26]; float* out; unsigned char* ws; int ph_lo, ph_hi, li, pad;
};
__device__ __forceinline__ int srccol_in1(int n) {
    if (n < 4096) return n;
    const int r = n - 4096, j = r >> 8, i = r & 255;
    return i < 128 ? 4096 + 128 * j + i : 6144 + 128 * j + (i - 128);
}
__device__ __forceinline__ void p0_transpose_item(const float* __restrict__ W, int K, int ldw, bf16_t* __restrict__ WT, const float* __restrict__ gain, bool map1, int nblk, LAS float* scr, int item, int lane) {
    const int kb = item / nblk, nb = item % nblk, k0 = 64 * kb, n0 = 32 * nb, s0 = map1 ? srccol_in1(n0) : n0;
#pragma unroll 8
    for (int i = 0; i < 32; ++i) { const int kk = 2 * i + (lane >> 5); const float g = gain ? gain[k0 + kk] : 1.f; scr[kk * 33 + (lane & 31)] = W[(size_t)(k0 + kk) * ldw + s0 + (lane & 31)] * g; }
    LDS_WAIT(); asm volatile("" ::: "memory");
    const int c = lane & 7;
#pragma unroll
    for (int j = 0; j < 4; ++j) { const int n = (lane >> 3) + 8 * j; const LAS float* s = scr + (8 * c) * 33 + n;
        v4u o; o.x = pk2(s[0 * 33], s[1 * 33]); o.y = pk2(s[2 * 33], s[3 * 33]); o.z = pk2(s[4 * 33], s[5 * 33]); o.w = pk2(s[6 * 33], s[7 * 33]);
        *(v4u*)(WT + (size_t)(n0 + n) * K + k0 + 8 * c) = o; }
    LDS_WAIT(); asm volatile("" ::: "memory");
}
struct Frame {
    LAS unsigned char* lds; int tid, lane, wave, G, bid;
    const float* const* in; float* out; unsigned char* ws;
};
__device__ __forceinline__ void p0_prologue(const Frame& F) {
    LAS float* scr = (LAS float*)(F.lds + F.wave * 16384);
    const int gw = F.bid * NWAVES + F.wave, NGW = F.G * NWAVES;
    unsigned char* ws = F.ws;
    const float* e_norm = F.in[2]; const float* e_w_in = F.in[3]; const float* e_w_out = F.in[13]; const float* o_norm = F.in[14]; const float* o_w_in = F.in[15];
    const float* o_w_out = F.in[21]; const float* ple_w = F.in[22]; const float* ple_gate_w = F.in[24];
    constexpr int I_IN0 = 32 * 192, I_SQ = 32 * 64, I_IN1 = 32 * 256, I_PLE = 4 * 64;
    constexpr int NITEMS = I_IN0 + 4 * I_SQ + I_IN1 + 2 * I_PLE;
    for (int it = gw; it < NITEMS; it += NGW) {
        int r = it;
        if (r < I_IN0) { p0_transpose_item(e_w_in, 2048, 6144, (bf16_t*)(ws + OFF_WIN0), e_norm, false, 192, scr, r, F.lane); continue; } r -= I_IN0;
        if (r < I_IN1) { p0_transpose_item(o_w_in, 2048, 8208, (bf16_t*)(ws + OFF_WIN1), o_norm, true, 256, scr, r, F.lane); continue; } r -= I_IN1;
        if (r < I_SQ) { p0_transpose_item(e_w_out, 2048, 2048, (bf16_t*)(ws + OFF_WOUT0), nullptr, false, 64, scr, r, F.lane); continue; } r -= I_SQ;
        if (r < I_SQ) { p0_transpose_item(ple_gate_w, 2048, 2048, (bf16_t*)(ws + OFF_WG0), nullptr, false, 64, scr, r, F.lane); continue; } r -= I_SQ;
        if (r < I_SQ) { p0_transpose_item(o_w_out, 2048, 2048, (bf16_t*)(ws + OFF_WOUT1), nullptr, false, 64, scr, r, F.lane); continue; } r -= I_SQ;
        if (r < I_SQ) { p0_transpose_item(ple_gate_w + (size_t)2048 * 2048, 2048, 2048, (bf16_t*)(ws + OFF_WG1), nullptr, false, 64, scr, r, F.lane); continue; } r -= I_SQ;
        if (r < I_PLE) { p0_transpose_item(ple_w, 256, 2048, (bf16_t*)(ws + OFF_PLEW), nullptr, false, 64, scr, r, F.lane); continue; } r -= I_PLE;
        p0_transpose_item(ple_w + (size_t)256 * 2048, 256, 2048, (bf16_t*)(ws + OFF_PLEW) + (size_t)2048 * 256, nullptr, false, 64, scr, r, F.lane);
    }
    const float* x = F.in[0]; bf16_t* A = (bf16_t*)(ws + OFF_A); float* rstd0 = (float*)(ws + OFF_SMALL) + 1024;
    for (int m = gw; m < M; m += NGW) {
        const f32x4* xr = (const f32x4*)(x + (size_t)m * D) + F.lane; f32x4 v[8]; float s = 0.f;
#pragma unroll
        for (int j = 0; j < 8; ++j) { v[j] = xr[64 * j]; s += (v[j].x * v[j].x + v[j].y * v[j].y) + (v[j].z * v[j].z + v[j].w * v[j].w); }
        s = wave_sum(s);
        v2u* o8 = (v2u*)(A + (size_t)m * D) + F.lane;
#pragma unroll
        for (int j = 0; j < 8; ++j) { v2u w; w.x = pk2(v[j].x, v[j].y); w.y = pk2(v[j].z, v[j].w); o8[64 * j] = w; }
        if (F.lane == 0) rstd0[m] = rsqrtf(s * (1.f / D) + EPS);
    }
    const int gt = F.bid * (NWAVES * 64) + F.tid, NGT = F.G * NWAVES * 64;
    bf16_t* WGATE1 = (bf16_t*)(ws + OFF_WGATE1);
    for (int i = gt; i < 16 * 2048; i += NGT) { const int j = i >> 11, k = i & 2047; WGATE1[i] = (bf16_t)f2bf(o_w_in[(size_t)k * 8208 + 8192 + j] * o_norm[k]); }
    float* lb = (float*)(ws + OFF_SMALL); const float* logits = F.in[4];
    for (int c = gt; c < 1024; c += NGT) lb[c] = 1.f / (1.f + expf(logits[1024 + c] - logits[c]));
}
__device__ __forceinline__ void gates1_phase(const Frame& F) {
    const bf16_t* A = (const bf16_t*)(F.ws + OFF_A); const bf16_t* WG = (const bf16_t*)(F.ws + OFF_WGATE1);
    const float* hpart = (const float*)(F.ws + OFF_PART) + (size_t)M * 32; float* gates = (float*)(F.ws + OFF_GATES1);
    const int gw = F.bid * NWAVES + F.wave, NGW = F.G * NWAVES;
    for (int row = gw; row < M; row += NGW) {
        float ss = (F.lane < 32) ? hpart[(size_t)row * 32 + F.lane] : 0.f; ss = wave_sum(ss);
        const float sc = rsqrtf(ss * (1.f / D) + EPS);
        float a[32];
        const v4u* ar = (const v4u*)(A + (size_t)row * D) + F.lane;
#pragma unroll
        for (int j = 0; j < 4; ++j) { const v4u w = ar[64 * j]; a[8 * j + 0] = pg8::bflo(w.x); a[8 * j + 1] = pg8::bfhi(w.x); a[8 * j + 2] = pg8::bflo(w.y); a[8 * j + 3] = pg8::bfhi(w.y);
            a[8 * j + 4] = pg8::bflo(w.z); a[8 * j + 5] = pg8::bfhi(w.z); a[8 * j + 6] = pg8::bflo(w.w); a[8 * j + 7] = pg8::bfhi(w.w); }
        float res = 0.f;
        for (int g = 0; g < 16; ++g) {
            const v4u* wr = (const v4u*)(WG + (size_t)g * D) + F.lane; float s = 0.f;
#pragma unroll
            for (int j = 0; j < 4; ++j) { const v4u w = wr[64 * j];
                s += a[8 * j + 0] * pg8::bflo(w.x) + a[8 * j + 1] * pg8::bfhi(w.x) + a[8 * j + 2] * pg8::bflo(w.y) + a[8 * j + 3] * pg8::bfhi(w.y)
                   + a[8 * j + 4] * pg8::bflo(w.z) + a[8 * j + 5] * pg8::bfhi(w.z) + a[8 * j + 6] * pg8::bflo(w.w) + a[8 * j + 7] * pg8::bfhi(w.w); }
            s = wave_sum(s);
            res = (F.lane == g) ? s * sc : res;
        }
        if (F.lane < 16) gates[(size_t)row * 16 + F.lane] = res;
    }
}
__device__ __forceinline__ void final_norm_phase(const Frame& F) {
    const float* hpart = (const float*)(F.ws + OFF_PART) + (size_t)M * 32; const float* g = F.in[25];
    const int gw = F.bid * NWAVES + F.wave, NGW = F.G * NWAVES;
    f32x4 gv[8];
#pragma unroll
    for (int j = 0; j < 8; ++j) gv[j] = ((const f32x4*)g)[F.lane + 64 * j];
    for (int row = gw; row < M; row += NGW) {
        float ss = (F.lane < 32) ? hpart[(size_t)row * 32 + F.lane] : 0.f; ss = wave_sum(ss);
        const float rs = rsqrtf(ss * (1.f / D) + EPS);
        f32x4* xr = (f32x4*)(F.out + (size_t)row * D) + F.lane;
#pragma unroll
        for (int j = 0; j < 8; ++j) { f32x4 v = xr[64 * j]; v = v * gv[j] * rs; xr[64 * j] = v; }
    }
}

__device__ __forceinline__ void cvt_p_phase(const Frame& F) {
    const float* p = F.in[1]; bf16_t* P16 = (bf16_t*)(F.ws + OFF_WIN0);
    const size_t n4 = (size_t)2 * M * PLE / 4, gt = (size_t)F.bid * (NWAVES * 64) + F.tid, NGT = (size_t)F.G * NWAVES * 64;
    for (size_t i = gt; i < n4; i += NGT) { const f32x4 v = ((const f32x4*)p)[i]; v2u w; w.x = pk2(v.x, v.y); w.y = pk2(v.z, v.w); ((v2u*)P16)[i] = w; }
}
__device__ __forceinline__ void hgrn2_naive_phase(const Frame& F, int b, int h) {
    LAS float* sq = (LAS float*)F.lds; LAS float* sf = sq + 128; LAS float* sk = sf + 128; LAS float* part = sk + 128; LAS float* red = part + 512;
    const bf16_t* U = (const bf16_t*)(F.ws + OFF_U); bf16_t* Y = (bf16_t*)(F.ws + OFF_A);
    const float* lb = (const float*)(F.ws + OFF_SMALL); const float* a_norm = F.in[5];
    const int tid = F.tid, e = tid & 127, qt = tid >> 7;
    float Sr[32];
#pragma unroll
    for (int i = 0; i < 32; ++i) Sr[i] = 0.f;
    const float lbv = lb[h * 128 + e], an = a_norm[h * 128 + e];
    const bf16_t* up = U + (size_t)b * S * 6144 + h * 128 + e;
    bf16_t nqa = up[0], nfa = up[1024], nv = up[2048], nza = up[3072];
    for (int t = 0; t < S; ++t) {
        const float qa = bf2f(nqa), fa = bf2f(nfa), v = bf2f(nv), za = bf2f(nza);
        if (t + 1 < S) { const bf16_t* np = up + (size_t)(t + 1) * 6144; nqa = np[0]; nfa = np[1024]; nv = np[2048]; nza = np[3072]; }
        if (qt == 0) { sq[e] = siluf_(qa); sf[e] = lbv + (1.f - lbv) * sigmoidf_(fa); sk[e] = (1.f - lbv) * sigmoidf_(-fa); }
        __syncthreads();
        float acc = 0.f;
#pragma unroll
        for (int i = 0; i < 32; ++i) { const int d = qt * 32 + i; Sr[i] = sf[d] * Sr[i] + sk[d] * v; acc += Sr[i] * sq[d]; }
        part[qt * 128 + e] = acc;
        __syncthreads();
        const float o = (part[e] + part[128 + e]) + (part[256 + e] + part[384 + e]);
        const float s2 = wave_sum(o * o);
        if ((tid & 63) == 0) red[tid >> 6] = s2;
        __syncthreads();
        const float tot = red[0] + red[1];
        if (qt == 0) Y[((size_t)b * S + t) * D + h * 128 + e] = (bf16_t)f2bf(o * rsqrtf(tot * (1.f / 128) + EPS) * an * siluf_(za));
    }
    __syncthreads();
}
__device__ __forceinline__ void rglru_naive_phase(const Frame& F, int b, int n) {
    LAS float* wr = (LAS float*)F.lds; LAS float* wi = wr + 16384; LAS float* xcs = (LAS float*)(F.lds + MISC_OFF + 256);
    const bf16_t* U = (const bf16_t*)(F.ws + OFF_U); bf16_t* Y = (bf16_t*)(F.ws + OFF_A);
    const float* conv_w = F.in[6]; const float* conv_b = F.in[7]; const float* w_r = F.in[8]; const float* b_r = F.in[9]; const float* w_i = F.in[10]; const float* b_i = F.in[11]; const float* lam = F.in[12];
    const int tid = F.tid, d = tid & 127, ch = n * 128 + d; const bool act = tid < 128;
    for (int i = tid; i < 16384; i += NWAVES * 64) { wr[i] = w_r[n * 16384 + i]; wi[i] = w_i[n * 16384 + i]; }
    const float cw0 = conv_w[ch], cw1 = conv_w[1024 + ch], cw2 = conv_w[2048 + ch], cw3 = conv_w[3072 + ch], cb = conv_b[ch], br = b_r[ch], bi = b_i[ch];
    const float sp = log1pf(expf(-lam[ch]));
    float x1 = 0.f, x2 = 0.f, x3 = 0.f, hst = 0.f;
    const bf16_t* up = U + (size_t)b * S * 6144 + 4096 + ch;
    bf16_t nx = up[0], nz = up[1024];
    __syncthreads();
    for (int t = 0; t < S; ++t) {
        const float xb = bf2f(nx), zb = bf2f(nz);
        if (t + 1 < S) { const bf16_t* np = up + (size_t)(t + 1) * 6144; nx = np[0]; nz = np[1024]; }
        const float xc = cb + cw0 * x3 + cw1 * x2 + cw2 * x1 + cw3 * xb;
        x3 = x2; x2 = x1; x1 = xb;
        if (act) xcs[d] = xc;
        __syncthreads();
        if (act) {
            float ar = br, ai = bi;
#pragma unroll 8
            for (int c = 0; c < 128; ++c) { const float xv = xcs[c]; ar += xv * wr[c * 128 + d]; ai += xv * wi[c * 128 + d]; }
            const float r = sigmoidf_(ar), ig = sigmoidf_(ai), log_a = -8.f * r * sp, a = expf(log_a);
            const float u = sqrtf(-expm1f(2.f * log_a)) * ig * xc;
            hst = a * hst + u;
            Y[((size_t)b * S + t) * D + 1024 + ch] = (bf16_t)f2bf(hst * siluf_(zb));
        }
        __syncthreads();
    }
}
__device__ __forceinline__ void qkconv_phase(const Frame& F) {
    const bf16_t* U = (const bf16_t*)(F.ws + OFF_U); bf16_t* QK = (bf16_t*)(F.ws + OFF_A); const float* cw = F.in[16]; const float* cb = F.in[17];
    const size_t gt = (size_t)F.bid * (NWAVES * 64) + F.tid, NGT = (size_t)F.G * NWAVES * 64;
    for (size_t i = gt; i < (size_t)M * 2048; i += NGT) {
        const int row = (int)(i >> 11), c = (int)(i & 2047), t = row & (S - 1);
        float acc = cb[c];
#pragma unroll
        for (int k = 0; k < 4; ++k) { const int tt = t - 3 + k; if (tt >= 0) acc += cw[k * 2048 + c] * bf2f(U[(size_t)(row - 3 + k) * 6144 + c]); }
        QK[i] = (bf16_t)f2bf(siluf_(acc));
    }
}
__device__ __forceinline__ void mlstm_naive_phase(const Frame& F, int b, int h) {
    LAS float* sq = (LAS float*)F.lds; LAS float* sk = sq + 128; LAS float* sn = sk + 128; LAS float* part = sn + 128; LAS float* red = part + 512;
    const bf16_t* U = (const bf16_t*)(F.ws + OFF_U); const bf16_t* QK = (const bf16_t*)(F.ws + OFF_A); bf16_t* Y = (bf16_t*)(F.ws + OFF_B);
    const float* gates = (const float*)(F.ws + OFF_GATES1); const float* c_norm = F.in[20];
    const int tid = F.tid, e = tid & 255, hf = tid >> 8;
    float C[64];
#pragma unroll
    for (int i = 0; i < 64; ++i) C[i] = 0.f;
    if (tid < 128) sn[tid] = 0.f;
    float m = 0.f;
    const float bi = F.in[18][h], bf = F.in[19][h], cn = c_norm[h * 256 + e];
    const size_t row0 = (size_t)b * S;
    __syncthreads();
    for (int t = 0; t < S; ++t) {
        const size_t row = row0 + t;
        if (tid < 128) sq[tid] = bf2f(QK[row * 2048 + h * 128 + tid]) * 0.08838834764831845f;
        else if (tid < 256) sk[tid - 128] = bf2f(QK[row * 2048 + 1024 + h * 128 + (tid - 128)]);
        const float li = gates[row * 16 + h] + bi, xf = gates[row * 16 + 8 + h] + bf;
        const float lf = fminf(xf, 0.f) - log1pf(expf(-fabsf(xf)));
        const float mn = fmaxf(lf + m, li), ip = expf(li - mn), fp = expf(lf + m - mn);
        m = mn;
        const float v = bf2f(U[row * 6144 + 2048 + h * 256 + e]), g = bf2f(U[row * 6144 + 4096 + h * 256 + e]);
        __syncthreads();
        float num = 0.f;
#pragma unroll
        for (int i = 0; i < 64; ++i) { const int d = hf * 64 + i; C[i] = fp * C[i] + (ip * sk[d]) * v; num += C[i] * sq[d]; }
        part[hf * 256 + e] = num;
        if (tid < 128) sn[tid] = fp * sn[tid] + ip * sk[tid];
        __syncthreads();
        float den = 0.f;
#pragma unroll 8
        for (int d = 0; d < 128; ++d) den += sn[d] * sq[d];
        const float hv = (part[e] + part[256 + e]) / fmaxf(fabsf(den), expf(-m));
        const float s2 = wave_sum(hv * hv);
        if ((tid & 63) == 0) red[tid >> 6] = s2;
        __syncthreads();
        const float tot = (red[0] + red[1]) + (red[2] + red[3]);
        if (hf == 0) Y[row * D + h * 256 + e] = (bf16_t)f2bf(hv * rsqrtf(tot * (1.f / 256) + EPS) * cn * g);
    }
    __syncthreads();
}

enum { PH_P0 = 0, PH_IN0, PH_MIX0A, PH_MIX0B, PH_OUT0, PH_GATE0, PH_IN1, PH_MIX1A, PH_MIX1B, PH_OUT1, PH_GATE1, PH_FINAL, PH_END };

__global__ void __launch_bounds__(NWAVES * 64, 2) mk_fwd(Ptrs args) {
    extern __shared__ __attribute__((aligned(16))) unsigned char lds_raw[];
    Frame F;
    F.lds = (LAS unsigned char*)lds_raw;
    F.tid = threadIdx.x; F.lane = F.tid & 63; F.wave = __builtin_amdgcn_readfirstlane(F.tid >> 6);
    F.G = gridDim.x; F.bid = blockIdx.x; F.in = args.in; F.out = args.out; F.ws = args.ws;
    volatile LAS unsigned* MISC = (volatile LAS unsigned*)(F.lds + MISC_OFF);
    if (F.tid < 32) MISC[F.tid] = 0u;
    __syncthreads();
    XcdBarrier bar = xcd_barrier_post((unsigned*)(F.ws + OFF_CTL) + CW_BAR + args.li * XCD_BAR_WORDS, MISC + 8);
    const int lo = args.ph_lo, hi = args.ph_hi;
#define IN_(k) (lo <= (k) && (k) < hi)
#define SEAM(k) do { if (IN_(k) && IN_((k) + 1)) xcd_barrier(bar); } while (0)
    unsigned char* ws = F.ws;
    bf16_t* A = (bf16_t*)(ws + OFF_A); bf16_t* B = (bf16_t*)(ws + OFF_B); bf16_t* U = (bf16_t*)(ws + OFF_U);
    float* plpart = (float*)(ws + OFF_PART); float* hpart = plpart + (size_t)M * 32;
    const bf16_t* P16 = (const bf16_t*)(ws + OFF_WIN0); bf16_t* PL = U;
    const bf16_t* PLEW = (const bf16_t*)(ws + OFF_PLEW);

    if (IN_(PH_P0)) { p0_prologue(F); } SEAM(PH_P0);
    if (IN_(PH_IN0)) {
        pg8::Gemm g{A, (const bf16_t*)(ws + OFF_WIN0), M, 6144, 2048}; pg8::StaticOrder So; So.init(M, 6144, F.G, F.bid);
        pg8::EpiIn0 E{U, (const float*)(ws + OFF_SMALL) + 1024};
        pg8::gemm_phase<pg8::EpiIn0, pg8::StaticOrder, true, true>(F.lds, g, So, E);
    } SEAM(PH_IN0);
    if (IN_(PH_MIX0A)) cvt_p_phase(F);
    SEAM(PH_MIX0A);
    if (IN_(PH_MIX0B)) { if (F.bid < 32) hgrn2_naive_phase(F, F.bid >> 3, F.bid & 7); else if (F.bid < 64) rglru_naive_phase(F, (F.bid - 32) >> 3, (F.bid - 32) & 7); }
    SEAM(PH_MIX0B);
    if (IN_(PH_OUT0)) {
        { pg8::Gemm g{A, (const bf16_t*)(ws + OFF_WOUT0), M, 2048, 2048}; pg8::StaticOrder So; So.init(M, 2048, F.G, F.bid);
          pg8::EpiOut E{F.in[0], F.out, B};
          pg8::gemm_phase<pg8::EpiOut, pg8::StaticOrder, true, true>(F.lds, g, So, E); }
        { pg8::Gemm g{P16, PLEW, M, 2048, 256}; pg8::StaticOrder So; So.init(M, 2048, F.G, F.bid);
          pg8::EpiPle E{PL, plpart};
          pg8::gemm_phase<pg8::EpiPle, pg8::StaticOrder, true, true>(F.lds, g, So, E); }
    } SEAM(PH_OUT0);
    if (IN_(PH_GATE0)) {
        pg8::Gemm g{B, (const bf16_t*)(ws + OFF_WG0), M, 2048, 2048}; pg8::StaticOrder So; So.init(M, 2048, F.G, F.bid);
        pg8::EpiGate E{F.out, A, PL, plpart, F.in[23], hpart};
        pg8::gemm_phase<pg8::EpiGate, pg8::StaticOrder, true, true>(F.lds, g, So, E);
    } SEAM(PH_GATE0);
    if (IN_(PH_IN1)) {
        pg8::Gemm g{A, (const bf16_t*)(ws + OFF_WIN1), M, 8192, 2048}; pg8::StaticOrder So; So.init(M, 8192, F.G, F.bid);
        pg8::EpiIn1 E{U, hpart};
        pg8::gemm_phase<pg8::EpiIn1, pg8::StaticOrder, true, true>(F.lds, g, So, E);
        gates1_phase(F);
    } SEAM(PH_IN1);
    if (IN_(PH_MIX1A)) qkconv_phase(F);
    SEAM(PH_MIX1A);
    if (IN_(PH_MIX1B)) { if (F.bid < 32) mlstm_naive_phase(F, F.bid >> 3, F.bid & 7); }
    SEAM(PH_MIX1B);
    if (IN_(PH_OUT1)) {
        { pg8::Gemm g{B, (const bf16_t*)(ws + OFF_WOUT1), M, 2048, 2048}; pg8::StaticOrder So; So.init(M, 2048, F.G, F.bid);
          pg8::EpiOut E{F.out, F.out, A};
          pg8::gemm_phase<pg8::EpiOut, pg8::StaticOrder, true, true>(F.lds, g, So, E); }
        { pg8::Gemm g{P16 + (size_t)M * PLE, PLEW + (size_t)2048 * 256, M, 2048, 256}; pg8::StaticOrder So; So.init(M, 2048, F.G, F.bid);
          pg8::EpiPle E{PL, plpart};
          pg8::gemm_phase<pg8::EpiPle, pg8::StaticOrder, true, true>(F.lds, g, So, E); }
    } SEAM(PH_OUT1);
    if (IN_(PH_GATE1)) {
        pg8::Gemm g{A, (const bf16_t*)(ws + OFF_WG1), M, 2048, 2048}; pg8::StaticOrder So; So.init(M, 2048, F.G, F.bid);
        pg8::EpiGate E{F.out, nullptr, PL, plpart, F.in[23] + D, hpart};
        pg8::gemm_phase<pg8::EpiGate, pg8::StaticOrder, true, true>(F.lds, g, So, E);
    } SEAM(PH_GATE1);
    if (IN_(PH_FINAL)) final_norm_phase(F);
#undef IN_
#undef SEAM
}

extern "C" void kernel_launch(void* const* d_in, const int* in_sizes, int n_in, void* d_out, int out_size, void* d_ws, size_t ws_size, hipStream_t stream) {
    static int grid = 0;
    if (grid == 0) {
        if (n_in != 26 || ws_size < WS_END || out_size != M * D) { fprintf(stderr, "kernel_launch: unexpected problem (n_in %d, ws %zu, out %d)\n", n_in, ws_size, out_size); grid = -1; return; }
        int dev = 0, cus = 0, per_cu = 0;
        if (hipGetDevice(&dev) != hipSuccess || hipDeviceGetAttribute(&cus, hipDeviceAttributeMultiprocessorCount, dev) != hipSuccess) { grid = -1; return; }
        if (hipFuncSetAttribute((const void*)mk_fwd, hipFuncAttributeMaxDynamicSharedMemorySize, LDS_BYTES) != hipSuccess) { fprintf(stderr, "kernel_launch: hipFuncSetAttribute failed\n"); grid = -1; return; }
        if (hipOccupancyMaxActiveBlocksPerMultiprocessor(&per_cu, (const void*)mk_fwd, NWAVES * 64, LDS_BYTES) != hipSuccess || per_cu < 1) { fprintf(stderr, "kernel_launch: occupancy query says %d blocks per CU\n", per_cu); (void)hipGetLastError(); grid = -1; return; }
        grid = cus;
    }
    if (grid < 0) return;
    (void)hipMemsetAsync((char*)d_ws + OFF_CTL, 0, CTL_ZERO_BYTES, stream);
    Ptrs a{};
    for (int i = 0; i < 26; ++i) a.in[i] = (const float*)d_in[i];
    a.out = (float*)d_out; a.ws = (unsigned char*)d_ws; a.ph_lo = PH_P0; a.ph_hi = PH_END; a.li = 0;
    void* kargs[] = {&a};
    const hipError_t e = hipLaunchCooperativeKernel((const void*)mk_fwd, dim3(grid), dim3(NWAVES * 64), kargs, LDS_BYTES, stream);
    if (e != hipSuccess) fprintf(stderr, "kernel_launch: cooperative launch failed: %s (grid %d)\n", hipGetErrorString(e), grid);
}
```

```cpp
#include <hip/hip_runtime.h>
#include <cstdio>
#include <cstdint>

namespace pg8 {
#define PG8_LAS __attribute__((address_space(3)))
typedef unsigned short bf16_t;
typedef short bf16x8 __attribute__((ext_vector_type(8)));
typedef float f32x4 __attribute__((ext_vector_type(4)));
typedef unsigned u32x4 __attribute__((ext_vector_type(4)));
constexpr int BM = 256, BK = 64, HALF = 128, HTB = HALF * BK * 2  , STAGE_BYTES = 8 * HTB, NXCD = 8, WGM = 8;

__host__ __device__ __forceinline__ int lds_byte(int r, int c) { const int st = (r >> 4) * 2 + (c >> 5), rr = r & 15, cc = c & 31, ob = rr * 64 + cc * 2; return st * 1024 + (ob ^ (((ob >> 9) & 1) << 5)); }
__host__ __device__ __forceinline__ void stage_rc(int b, int& R, int& C) { const int st = b / 1024, sb = b % 1024, swz = sb ^ (((sb >> 9) & 1) << 5); R = (st >> 1) * 16 + swz / 64; C = (st & 1) * 32 + (swz % 64) / 2; }
__host__ __device__ __forceinline__ int perm32(int rho) { const int n = rho >> 4, i = rho & 15; return 8 * (i >> 2) + 4 * n + (i & 3); }

struct Unit { int pm, pn; };
struct Gemm { const bf16_t* A; const bf16_t* Bt; int M, N, K; };

struct StaticOrder {
    int nM, nN, nwg, G, c;
    __host__ __device__ void init(int M, int N, int G_, int c_) { nM = M / BM; nN = N / BM; nwg = nM * nN; G = G_; c = c_; }
    __host__ __device__ bool next(int i, Unit& u) const {
        const long L = (long)i * G + c; if (L >= nwg) return false;
        int wgid = (int)L; { const int q = nwg / NXCD, r = nwg % NXCD, xcd = wgid % NXCD, off = wgid / NXCD; wgid = (xcd < r ? xcd * (q + 1) : r * (q + 1) + (xcd - r) * q) + off; }
        const int nig = WGM * nN, gid = wgid / nig, fm = gid * WGM, gsz = (nM - fm) < WGM ? (nM - fm) : WGM;
        u.pm = fm + ((wgid % nig) % gsz); u.pn = (wgid % nig) / gsz; return true;
    }
    __device__ __forceinline__ void a_ready(const Unit&) const {}
    __device__ __forceinline__ void done(const Unit&) const {}
};

__device__ __forceinline__ unsigned cvt_pk_bf16(float lo, float hi) { unsigned r; asm volatile("v_cvt_pk_bf16_f32 %0, %1, %2" : "=v"(r) : "v"(lo), "v"(hi)); return r; }
typedef float f32x2 __attribute__((ext_vector_type(2)));
template <class Epi, class Sched, bool ALIGN_EPI = false, bool SP2 = false>
__device__ __forceinline__ void gemm_phase(PG8_LAS unsigned char* lds, const Gemm g, const Sched& S, const Epi& E) {
    const int tid = threadIdx.x, wid = __builtin_amdgcn_readfirstlane(tid >> 6), lane = tid & 63, wr = wid >> 2, wc = wid & 3, fr = lane & 15, fq = lane >> 4;
    const int K = g.K, nt = K / BK;
    unsigned voffA[2], voffB[2];
#pragma unroll
    for (int i = 0; i < 2; ++i) { int R, C; stage_rc(tid * 16 + i * 8192, R, C); const int Rb = Epi::PERM ? ((R & ~31) + perm32(R & 31)) : R;
        voffA[i] = (unsigned)(R * K + C) * 2u; voffB[i] = (unsigned)(Rb * K + C) * 2u; }
    const size_t kstep = (size_t)(BK * 2);
    const size_t hstep = (size_t)HALF * K * 2;
    const size_t tstep = 2 * hstep;
    const unsigned ldsw = (unsigned)wid * 1024u;
    const int aoff = lds_byte(wr * 64 + fr, fq * 8), boff = lds_byte(wc * 32 + fr, fq * 8);
#define PG8_SA(b, h) (((b) * 2 + (h)) * HTB)
#define PG8_SB(b, h) ((4 + (b) * 2 + (h)) * HTB)
#define PG8_STAGE(bufoff, gbase, voff) do { _Pragma("unroll") for (int _i = 0; _i < 2; ++_i) \
        __builtin_amdgcn_global_load_lds((const unsigned*)((const char*)(gbase) + (voff)[_i]), (PG8_LAS unsigned*)(lds + (bufoff) + ldsw + _i * 8192), 16, 0, 0); } while (0)
#define PG8_LDA(dst, b, h) do { _Pragma("unroll") for (int m = 0; m < 4; ++m) _Pragma("unroll") for (int k = 0; k < 2; ++k) dst[m][k] = *(const PG8_LAS bf16x8*)(lds + PG8_SA(b, h) + aoff + m * 2048 + k * 1024); } while (0)
#define PG8_LDB(dst, b, h) do { _Pragma("unroll") for (int n = 0; n < 2; ++n) _Pragma("unroll") for (int k = 0; k < 2; ++k) dst[n][k] = *(const PG8_LAS bf16x8*)(lds + PG8_SB(b, h) + boff + n * 2048 + k * 1024); } while (0)
#define PG8_MMA(ai, bj, At, Bt) do { __builtin_amdgcn_s_setprio(1); _Pragma("unroll") for (int m = 0; m < 4; ++m) _Pragma("unroll") for (int n = 0; n < 2; ++n) _Pragma("unroll") for (int k = 0; k < 2; ++k) \
        acc[ai][bj][m][n] = __builtin_amdgcn_mfma_f32_16x16x32_bf16(Bt[n][k], At[m][k], acc[ai][bj][m][n], 0, 0, 0); __builtin_amdgcn_s_setprio(0); } while (0)
#define PG8_WAIT_V(n) asm volatile("s_waitcnt vmcnt(" #n ")" ::: "memory")
#define PG8_WAIT_L(n) asm volatile("s_waitcnt lgkmcnt(" #n ")" ::: "memory")
#define PG8_BAR __builtin_amdgcn_s_barrier()
#define PG8_SCHED __builtin_amdgcn_sched_barrier(0)
    Unit cur, nxt; int ui = 0;
    if (!S.next(0, cur)) return;
    f32x4 acc[2][2][4][2];
#pragma unroll
    for (int a = 0; a < 2; ++a)
#pragma unroll
        for (int b = 0; b < 2; ++b)
#pragma unroll
            for (int m = 0; m < 4; ++m)
#pragma unroll
                for (int n = 0; n < 2; ++n) acc[a][b][m][n] = (f32x4){0.f, 0.f, 0.f, 0.f};
    bf16x8 At[4][2], B0[2][2], B1[2][2];
    const char* cA = (const char*)g.A + (size_t)cur.pm * tstep; const char* cB = (const char*)g.Bt + (size_t)cur.pn * tstep;
    S.a_ready(cur);
    if constexpr (SP2) {
        PG8_STAGE(PG8_SB(0, 0), cB, voffB); PG8_STAGE(PG8_SB(0, 1), cB + hstep, voffB); PG8_STAGE(PG8_SA(0, 0), cA, voffA); PG8_STAGE(PG8_SA(0, 1), cA + hstep, voffA);
        if (wr == 1) PG8_BAR;
        PG8_WAIT_V(2); PG8_BAR;
        PG8_STAGE(PG8_SB(1, 0), cB + kstep, voffB); PG8_STAGE(PG8_SA(1, 0), cA + kstep, voffA); PG8_STAGE(PG8_SB(1, 1), cB + hstep + kstep, voffB);
        PG8_WAIT_V(6); PG8_BAR;
    } else {
        PG8_STAGE(PG8_SB(0, 0), cB, voffB); PG8_STAGE(PG8_SA(0, 0), cA, voffA); PG8_STAGE(PG8_SB(0, 1), cB + hstep, voffB); PG8_STAGE(PG8_SA(0, 1), cA + hstep, voffA);
        if (wr == 1) PG8_BAR;
        PG8_WAIT_V(4); PG8_BAR;
        PG8_STAGE(PG8_SB(1, 0), cB + kstep, voffB); PG8_STAGE(PG8_SA(1, 0), cA + kstep, voffA); PG8_STAGE(PG8_SB(1, 1), cB + hstep + kstep, voffB);
        PG8_WAIT_V(6); PG8_BAR;
    }
    for (;;) {
        const bool has_next = S.next(ui + 1, nxt);
        const char* nA = has_next ? (const char*)g.A + (size_t)nxt.pm * tstep : cA; const char* nB = has_next ? (const char*)g.Bt + (size_t)nxt.pn * tstep : cB;
        for (int t = 0; t < nt; t += 2) {
            const bool last = (t == nt - 2);
            const char* a1 = cA + (size_t)(t + 1) * kstep;
            const char* a2 = last ? nA : cA + (size_t)(t + 2) * kstep; const char* b2 = last ? nB : cB + (size_t)(t + 2) * kstep;
            const char* a3 = a2 + kstep; const char* b3 = b2 + kstep;
            if (last && has_next) S.a_ready(nxt);
            if constexpr (SP2) {
            PG8_LDB(B0, 0, 0); PG8_LDB(B1, 0, 1); PG8_SCHED; PG8_LDA(At, 0, 0); PG8_STAGE(PG8_SA(1, 1), a1 + hstep, voffA);
            PG8_WAIT_V(8); PG8_WAIT_L(0); PG8_BAR; PG8_MMA(0, 0, At, B0); PG8_MMA(0, 1, At, B1); PG8_BAR; PG8_SCHED;
            PG8_LDA(At, 0, 1); PG8_STAGE(PG8_SB(0, 0), b2, voffB); PG8_STAGE(PG8_SB(0, 1), b2 + hstep, voffB); PG8_STAGE(PG8_SA(0, 0), a2, voffA);
            PG8_WAIT_V(8); PG8_WAIT_L(0); PG8_BAR; PG8_MMA(1, 0, At, B0); PG8_MMA(1, 1, At, B1); PG8_BAR; PG8_SCHED;
            PG8_LDB(B0, 1, 0); PG8_LDB(B1, 1, 1); PG8_SCHED; PG8_LDA(At, 1, 0); PG8_STAGE(PG8_SA(0, 1), a2 + hstep, voffA);
            PG8_WAIT_V(8); PG8_WAIT_L(0); PG8_BAR; PG8_MMA(0, 0, At, B0); PG8_MMA(0, 1, At, B1); PG8_BAR; PG8_SCHED;
            PG8_LDA(At, 1, 1); PG8_STAGE(PG8_SB(1, 0), b3, voffB); PG8_STAGE(PG8_SB(1, 1), b3 + hstep, voffB); PG8_STAGE(PG8_SA(1, 0), a3, voffA);
            PG8_WAIT_V(8); PG8_WAIT_L(0); PG8_BAR; PG8_MMA(1, 0, At, B0); PG8_MMA(1, 1, At, B1); PG8_BAR; PG8_SCHED;
            } else {
            PG8_LDB(B0, 0, 0); PG8_SCHED; PG8_LDA(At, 0, 0); PG8_STAGE(PG8_SA(1, 1), a1 + hstep, voffA);
            PG8_WAIT_L(8); PG8_BAR; PG8_WAIT_L(0); PG8_MMA(0, 0, At, B0); PG8_BAR; PG8_SCHED;
            PG8_LDB(B1, 0, 1); PG8_STAGE(PG8_SB(0, 0), b2, voffB);
            PG8_BAR; PG8_WAIT_L(0); PG8_MMA(0, 1, At, B1); PG8_BAR;
            PG8_LDA(At, 0, 1); PG8_STAGE(PG8_SA(0, 0), a2, voffA);
            PG8_BAR; PG8_WAIT_L(0); PG8_MMA(1, 0, At, B0); PG8_BAR; PG8_SCHED;
            PG8_STAGE(PG8_SB(0, 1), b2 + hstep, voffB);
            PG8_WAIT_V(6); PG8_BAR; PG8_MMA(1, 1, At, B1); PG8_BAR;
            PG8_LDB(B0, 1, 0); PG8_SCHED; PG8_LDA(At, 1, 0); PG8_STAGE(PG8_SA(0, 1), a2 + hstep, voffA);
            PG8_WAIT_L(8); PG8_BAR; PG8_WAIT_L(0); PG8_MMA(0, 0, At, B0); PG8_BAR; PG8_SCHED;
            PG8_LDB(B1, 1, 1); PG8_STAGE(PG8_SB(1, 0), b3, voffB);
            PG8_BAR; PG8_WAIT_L(0); PG8_MMA(0, 1, At, B1); PG8_BAR;
            PG8_LDA(At, 1, 1); PG8_STAGE(PG8_SA(1, 0), a3, voffA);
            PG8_BAR; PG8_WAIT_L(0); PG8_MMA(1, 0, At, B0); PG8_BAR; PG8_SCHED;
            PG8_STAGE(PG8_SB(1, 1), b3 + hstep, voffB);
            PG8_WAIT_V(6); PG8_BAR; PG8_MMA(1, 1, At, B1); PG8_BAR;
            }
        }
        if constexpr (ALIGN_EPI) { if (wr == 0) PG8_BAR; }
        if constexpr (!Epi::AFTER_DRAIN) { E(acc, cur, wr, wc, fr, fq); S.done(cur); }
        if (!has_next) break;
#pragma unroll
        for (int a = 0; a < 2; ++a)
#pragma unroll
            for (int b = 0; b < 2; ++b)
#pragma unroll
                for (int m = 0; m < 4; ++m)
#pragma unroll
                    for (int n = 0; n < 2; ++n) acc[a][b][m][n] = (f32x4){0.f, 0.f, 0.f, 0.f};
        cur = nxt; cA = nA; cB = nB; ++ui;
        if constexpr (ALIGN_EPI) { if (wr == 1) PG8_BAR; }
    }
    PG8_WAIT_V(0);
    if constexpr (!ALIGN_EPI) { if (wr == 0) PG8_BAR; }
    PG8_BAR;
    if constexpr (Epi::AFTER_DRAIN) { E.fused(acc, cur, wr, wc, fr, fq, lds, wid, lane); S.done(cur); }
#undef PG8_SA
#undef PG8_SB
#undef PG8_STAGE
#undef PG8_LDA
#undef PG8_LDB
#undef PG8_MMA
#undef PG8_WAIT_V
#undef PG8_WAIT_L
#undef PG8_BAR
#undef PG8_SCHED
}
}

namespace pg8 {
constexpr float EPSN = 1e-6f;
__device__ __forceinline__ float fsigmoid(float x) { return __builtin_amdgcn_rcpf(1.f + __expf(-x)); }
__device__ __forceinline__ float fsilu(float x) { return x * __builtin_amdgcn_rcpf(1.f + __expf(-x)); }
__device__ __forceinline__ float row_stat32(const float* part, int row, int fq) {
    const f32x4 a = *(const f32x4*)(part + (size_t)row * 32 + 8 * fq), b = *(const f32x4*)(part + (size_t)row * 32 + 8 * fq + 4);
    float s = ((a.x + a.y) + (a.z + a.w)) + ((b.x + b.y) + (b.z + b.w));
    s += __shfl_xor(s, 16); s += __shfl_xor(s, 32); return s;
}
__device__ __forceinline__ u32x4 pack8(const f32x4 v0, const f32x4 v1) { u32x4 w; w.x = cvt_pk_bf16(v0[0], v0[1]); w.y = cvt_pk_bf16(v0[2], v0[3]); w.z = cvt_pk_bf16(v1[0], v1[1]); w.w = cvt_pk_bf16(v1[2], v1[3]); return w; }
__device__ __forceinline__ float bflo(unsigned w) { return __uint_as_float(w << 16); }
__device__ __forceinline__ float bfhi(unsigned w) { return __uint_as_float(w & 0xffff0000u); }

struct EpiIn0 {
    static constexpr bool PERM = true, AFTER_DRAIN = false;
    bf16_t* U; const float* rstd;
    __device__ __forceinline__ void operator()(const f32x4 (&acc)[2][2][4][2], const Unit& u, int wr, int wc, int fr, int fq) const {
        const int row0 = u.pm * BM + wr * 64 + fr, col0 = u.pn * BM + wc * 32 + 8 * fq;
#pragma unroll
        for (int ai = 0; ai < 2; ++ai)
#pragma unroll
            for (int m = 0; m < 4; ++m) { const int row = row0 + ai * HALF + m * 16; const float sc = rstd[row]; bf16_t* rowp = U + (size_t)row * 6144 + col0;
#pragma unroll
                for (int bj = 0; bj < 2; ++bj) *(u32x4*)(rowp + bj * HALF) = pack8(acc[ai][bj][m][0] * sc, acc[ai][bj][m][1] * sc); }
    }
};
struct EpiIn1 {
    static constexpr bool PERM = true, AFTER_DRAIN = false;
    bf16_t* U; const float* hpart;
    __device__ __forceinline__ void operator()(const f32x4 (&acc)[2][2][4][2], const Unit& u, int wr, int wc, int fr, int fq) const {
        const int row0 = u.pm * BM + wr * 64 + fr;
        if (u.pn < 16) {
            const int col0 = u.pn * BM + wc * 32 + 8 * fq;
#pragma unroll
            for (int ai = 0; ai < 2; ++ai)
#pragma unroll
                for (int m = 0; m < 4; ++m) { const int row = row0 + ai * HALF + m * 16; const float sc = rsqrtf(row_stat32(hpart, row, fq) * (1.f / 2048.f) + EPSN); bf16_t* rowp = U + (size_t)row * 6144 + col0;
#pragma unroll
                    for (int bj = 0; bj < 2; ++bj) *(u32x4*)(rowp + bj * HALF) = pack8(acc[ai][bj][m][0] * sc, acc[ai][bj][m][1] * sc); }
        } else {
            const int col0 = 4096 + 128 * (u.pn - 16) + wc * 32 + 8 * fq;
#pragma unroll
            for (int ai = 0; ai < 2; ++ai)
#pragma unroll
                for (int m = 0; m < 4; ++m) { const int row = row0 + ai * HALF + m * 16; const float sc = rsqrtf(row_stat32(hpart, row, fq) * (1.f / 2048.f) + EPSN);
                    f32x4 g0, g1;
#pragma unroll
                    for (int j = 0; j < 4; ++j) { g0[j] = fsigmoid(acc[ai][0][m][0][j] * sc) * fsilu(acc[ai][1][m][0][j] * sc); g1[j] = fsigmoid(acc[ai][0][m][1][j] * sc) * fsilu(acc[ai][1][m][1][j] * sc); }
                    *(u32x4*)(U + (size_t)row * 6144 + col0) = pack8(g0, g1); }
        }
    }
};
struct EpiOut {
    static constexpr bool PERM = true, AFTER_DRAIN = false;
    const float* base; float* out; bf16_t* h16;
    __device__ __forceinline__ void operator()(const f32x4 (&acc)[2][2][4][2], const Unit& u, int wr, int wc, int fr, int fq) const {
        const int row0 = u.pm * BM + wr * 64 + fr, col0 = u.pn * BM + wc * 32 + 8 * fq;
#pragma unroll
        for (int ai = 0; ai < 2; ++ai)
#pragma unroll
            for (int m = 0; m < 4; ++m) { const size_t off = (size_t)(row0 + ai * HALF + m * 16) * 2048 + col0;
#pragma unroll
                for (int bj = 0; bj < 2; ++bj) { const f32x4 h0 = *(const f32x4*)(base + off + bj * HALF) + acc[ai][bj][m][0], h1 = *(const f32x4*)(base + off + bj * HALF + 4) + acc[ai][bj][m][1];
                    *(f32x4*)(out + off + bj * HALF) = h0; *(f32x4*)(out + off + bj * HALF + 4) = h1; *(u32x4*)(h16 + off + bj * HALF) = pack8(h0, h1); }
                asm volatile("" ::: "memory"); }
    }
};
struct EpiPle {
    static constexpr bool PERM = true, AFTER_DRAIN = false;
    bf16_t* PL; float* plpart;
    __device__ __forceinline__ void operator()(const f32x4 (&acc)[2][2][4][2], const Unit& u, int wr, int wc, int fr, int fq) const {
        const int row0 = u.pm * BM + wr * 64 + fr, col0 = u.pn * BM + wc * 32 + 8 * fq;
#pragma unroll
        for (int ai = 0; ai < 2; ++ai)
#pragma unroll
            for (int m = 0; m < 4; ++m) { const int row = row0 + ai * HALF + m * 16; float s = 0.f;
#pragma unroll
                for (int bj = 0; bj < 2; ++bj) { const f32x4 v0 = acc[ai][bj][m][0], v1 = acc[ai][bj][m][1];
                    s += ((v0[0] * v0[0] + v0[1] * v0[1]) + (v0[2] * v0[2] + v0[3] * v0[3])) + ((v1[0] * v1[0] + v1[1] * v1[1]) + (v1[2] * v1[2] + v1[3] * v1[3]));
                    *(u32x4*)(PL + (size_t)row * 2048 + col0 + bj * HALF) = pack8(v0, v1); }
                s += __shfl_xor(s, 16); s += __shfl_xor(s, 32);
                if (fq == 0) plpart[(size_t)row * 32 + u.pn * 4 + wc] = s; }
    }
};
struct EpiGate {
    static constexpr bool PERM = true, AFTER_DRAIN = false;
    float* out; bf16_t* h16; const bf16_t* PL; const float* plpart; const float* ple_norm; float* hpart;
    __device__ __forceinline__ void operator()(const f32x4 (&acc)[2][2][4][2], const Unit& u, int wr, int wc, int fr, int fq) const {
        const int row0 = u.pm * BM + wr * 64 + fr, col0 = u.pn * BM + wc * 32 + 8 * fq;
        f32x4 pn[2][2];
#pragma unroll
        for (int bj = 0; bj < 2; ++bj) { pn[bj][0] = *(const f32x4*)(ple_norm + col0 + bj * HALF); pn[bj][1] = *(const f32x4*)(ple_norm + col0 + bj * HALF + 4); }
#pragma unroll
        for (int ai = 0; ai < 2; ++ai)
#pragma unroll
            for (int m = 0; m < 4; ++m) { const int row = row0 + ai * HALF + m * 16; const size_t off = (size_t)row * 2048 + col0;
                const float rs = rsqrtf(row_stat32(plpart, row, fq) * (1.f / 2048.f) + EPSN); float s = 0.f;
#pragma unroll
                for (int bj = 0; bj < 2; ++bj) { const u32x4 pw = *(const u32x4*)(PL + off + bj * HALF);
                    const f32x4 p0 = (f32x4){bflo(pw.x), bfhi(pw.x), bflo(pw.y), bfhi(pw.y)} * pn[bj][0] * rs, p1 = (f32x4){bflo(pw.z), bfhi(pw.z), bflo(pw.w), bfhi(pw.w)} * pn[bj][1] * rs;
                    f32x4 h0 = *(const f32x4*)(out + off + bj * HALF), h1 = *(const f32x4*)(out + off + bj * HALF + 4);
#pragma unroll
                    for (int j = 0; j < 4; ++j) { h0[j] += fsigmoid(acc[ai][bj][m][0][j]) * p0[j]; h1[j] += fsigmoid(acc[ai][bj][m][1][j]) * p1[j]; }
                    *(f32x4*)(out + off + bj * HALF) = h0; *(f32x4*)(out + off + bj * HALF + 4) = h1;
                    if (h16) *(u32x4*)(h16 + off + bj * HALF) = pack8(h0, h1);
                    s += ((h0[0] * h0[0] + h0[1] * h0[1]) + (h0[2] * h0[2] + h0[3] * h0[3])) + ((h1[0] * h1[0] + h1[1] * h1[1]) + (h1[2] * h1[2] + h1[3] * h1[3])); }
                s += __shfl_xor(s, 16); s += __shfl_xor(s, 32);
                if (fq == 0) hpart[(size_t)row * 32 + u.pn * 4 + wc] = s;
                asm volatile("" ::: "memory"); }
    }
};
}

constexpr int NWAVES = 8;
constexpr int NB = 4, S = 2048, D = 2048, M = NB * S, PLE = 256;
constexpr float EPS = 1e-6f;
typedef unsigned short bf16_t;
typedef float f32x4 __attribute__((ext_vector_type(4)));
typedef unsigned v4u __attribute__((ext_vector_type(4)));
typedef unsigned v2u __attribute__((ext_vector_type(2)));

constexpr size_t MiB = 1u << 20;
constexpr size_t OFF_CTL = 0, CTL_ZERO_BYTES = 1 * MiB;
constexpr size_t OFF_WIN0 = 1 * MiB;
constexpr size_t OFF_WOUT0 = 25 * MiB;
constexpr size_t OFF_WG0 = 33 * MiB;
constexpr size_t OFF_WIN1 = 41 * MiB;
constexpr size_t OFF_WOUT1 = 73 * MiB;
constexpr size_t OFF_WG1 = 81 * MiB;
constexpr size_t OFF_PLEW = 89 * MiB;
constexpr size_t OFF_WGATE1 = 91 * MiB;
constexpr size_t OFF_SMALL = 91 * MiB + 65536;
constexpr size_t OFF_GATES1 = 92 * MiB;
constexpr size_t OFF_PART = 92 * MiB + 524288;
constexpr size_t OFF_A = 95 * MiB;
constexpr size_t OFF_B = 127 * MiB;
constexpr size_t OFF_U = 159 * MiB;
constexpr size_t WS_END = 255 * MiB;
constexpr size_t OFF_ACUM = OFF_B;
constexpr size_t OFF_CARRY = OFF_B + 17 * MiB;
constexpr size_t OFF_DECAY = OFF_B + 18 * MiB;
constexpr size_t OFF_WRT = OFF_SMALL + 65536;
constexpr int CW_BAR = 4096;

constexpr int RING_BYTES = 131072;
constexpr int MISC_OFF = RING_BYTES + 320;
constexpr int LDS_BYTES = 147456;

#define LAS __attribute__((address_space(3)))
#define GAS __attribute__((address_space(1)))
__device__ __forceinline__ float bf2f(bf16_t b) { return __uint_as_float(((unsigned)b) << 16); }
__device__ __forceinline__ unsigned f2bf(float f) { unsigned u = __float_as_uint(f); return (u + 0x7fffu + ((u >> 16) & 1u)) >> 16; }
__device__ __forceinline__ unsigned pk2(float lo, float hi) { return f2bf(lo) | (f2bf(hi) << 16); }
__device__ __forceinline__ float sigmoidf_(float x) { return 1.f / (1.f + __expf(-x)); }
__device__ __forceinline__ float siluf_(float x) { return x / (1.f + __expf(-x)); }
__device__ __forceinline__ float wave_sum(float v) {
#pragma unroll
    for (int o = 1; o < 64; o <<= 1) v += __shfl_xor(v, o);
    return v;
}
#define LDS_WAIT() asm volatile("s_waitcnt lgkmcnt(0)" ::: "memory")
#define XB_TMO      128
#define XB_XCNT(j)  (256  + 64 * (j))
#define XB_XSUB(j)  (1280 + 64 * (j))
#define XB_XGEN(j)  (2304 + 64 * (j))
#define XB_TOP      3328
#define XB_TOPGEN   3392
#define XCD_BAR_WORDS 3456
#define XB_SPIN_CAP (1u << 26)

__device__ __forceinline__ unsigned xb_ld(unsigned* p)              { return __hip_atomic_load(p, __ATOMIC_RELAXED, __HIP_MEMORY_SCOPE_AGENT); }
__device__ __forceinline__ unsigned xb_add(unsigned* p, unsigned v) { return __hip_atomic_fetch_add(p, v, __ATOMIC_RELAXED, __HIP_MEMORY_SCOPE_AGENT); }
__device__ __forceinline__ unsigned xb_xcc_id() { return (unsigned)__builtin_amdgcn_s_getreg((3 << 11) | 20) & 0xFu; }
#define XB_SPIN(cond, bar) do { unsigned _sp = 0; while (cond) { __builtin_amdgcn_s_sleep(1); \
    if ((++_sp & 255u) == 0u) { if (xb_ld(&(bar)[XB_TMO])) break; if (_sp > XB_SPIN_CAP) { atomicAdd(&(bar)[XB_TMO], 1u); break; } } } } while (0)

struct XcdBarrier {
    unsigned* bar; unsigned x;
    volatile LAS unsigned* st;
};

__device__ __forceinline__ XcdBarrier xcd_barrier_post(unsigned* bar, volatile LAS unsigned* st) {
    XcdBarrier b; b.bar = bar; b.x = xb_xcc_id(); b.st = st;
    if (threadIdx.x == 0) (void)xb_add(&bar[XB_XCNT(b.x)], 1u);
    return b;
}
__device__ __forceinline__ void xcd_barrier_complete(unsigned* bar, unsigned x, unsigned& nloc, unsigned& nx) {
    const unsigned G = gridDim.x * gridDim.y * gridDim.z;
    unsigned sum, cnt, mine, sp = 0u;
    for (;;) {
        sum = 0u; cnt = 0u; mine = 0u;
#pragma unroll
        for (unsigned j = 0; j < 16; ++j) { const unsigned c = xb_ld(&bar[XB_XCNT(j)]); sum += c; cnt += (c > 0u) ? 1u : 0u; mine = (j == x) ? c : mine; }
        if (sum == G) break;
        __builtin_amdgcn_s_sleep(1);
        if ((++sp & 255u) == 0u) { if (xb_ld(&bar[XB_TMO])) break; if (sp > XB_SPIN_CAP) { atomicAdd(&bar[XB_TMO], 1u); break; } }
    }
    nloc = mine > 0u ? mine : 1u; nx = cnt > 0u ? cnt : 1u;
}

__device__ __forceinline__ void xcd_barrier(const XcdBarrier& b) {
    asm volatile("s_waitcnt vmcnt(0)" ::: "memory");
    __syncthreads();
    if (threadIdx.x == 0) {
        unsigned* bar = b.bar;
        __builtin_amdgcn_s_waitcnt(0);
        unsigned nloc = b.st[0], nx = b.st[1];
        if (nloc == 0u) { xcd_barrier_complete(bar, b.x, nloc, nx); b.st[0] = nloc; b.st[1] = nx; }
        const unsigned old = xb_add(&bar[XB_XSUB(b.x)], 1u);
        const unsigned gen = old / nloc;
        if (old + 1u == (gen + 1u) * nloc) {
            __builtin_amdgcn_fence(__ATOMIC_RELEASE, "agent");
            asm volatile("s_waitcnt vmcnt(0)" ::: "memory");
            const unsigned og = xb_add(&bar[XB_TOP], 1u);
            const unsigned tg = og / nx;
            if (og + 1u == (tg + 1u) * nx) xb_add(&bar[XB_TOPGEN], 1u);
            else XB_SPIN(xb_ld(&bar[XB_TOPGEN]) == tg, bar);
            __builtin_amdgcn_fence(__ATOMIC_ACQUIRE, "agent");
            xb_add(&bar[XB_XGEN(b.x)], 1u);
            asm volatile("s_waitcnt vmcnt(0)" ::: "memory");
        } else {
            XB_SPIN(xb_ld(&bar[XB_XGEN(b.x)]) == gen, bar);
            __builtin_amdgcn_fence(__ATOMIC_ACQUIRE, "agent");
            asm volatile("s_waitcnt vmcnt(0)" ::: "memory");
        }
    }
    __syncthreads();
}

struct Ptrs {
    const float* in[26]; float* out; unsigned char* ws; int ph_lo, ph_hi, li, pad;
};
__device__ __forceinline__ int srccol_in1(int n) {
    if (n < 4096) return n;
    const int r = n - 4096, j = r >> 8, i = r & 255;
    return i < 128 ? 4096 + 128 * j + i : 6144 + 128 * j + (i - 128);
}
__device__ __forceinline__ void p0_transpose_item(const float* __restrict__ W, int K, int ldw, bf16_t* __restrict__ WT, const float* __restrict__ gain, bool map1, int nblk, LAS float* scr, int item, int lane) {
    const int kb = item / nblk, nb = item % nblk, k0 = 64 * kb, n0 = 32 * nb, s0 = map1 ? srccol_in1(n0) : n0;
#pragma unroll 8
    for (int i = 0; i < 32; ++i) { const int kk = 2 * i + (lane >> 5); const float g = gain ? gain[k0 + kk] : 1.f; scr[kk * 33 + (lane & 31)] = W[(size_t)(k0 + kk) * ldw + s0 + (lane & 31)] * g; }
    LDS_WAIT(); asm volatile("" ::: "memory");
    const int c = lane & 7;
#pragma unroll
    for (int j = 0; j < 4; ++j) { const int n = (lane >> 3) + 8 * j; const LAS float* s = scr + (8 * c) * 33 + n;
        v4u o; o.x = pk2(s[0 * 33], s[1 * 33]); o.y = pk2(s[2 * 33], s[3 * 33]); o.z = pk2(s[4 * 33], s[5 * 33]); o.w = pk2(s[6 * 33], s[7 * 33]);
        *(v4u*)(WT + (size_t)(n0 + n) * K + k0 + 8 * c) = o; }
    LDS_WAIT(); asm volatile("" ::: "memory");
}
struct Frame {
    LAS unsigned char* lds; int tid, lane, wave, G, bid;
    const float* const* in; float* out; unsigned char* ws;
};
__device__ __forceinline__ void p0_prologue(const Frame& F) {
    LAS float* scr = (LAS float*)(F.lds + F.wave * 16384);
    const int gw = F.bid * NWAVES + F.wave, NGW = F.G * NWAVES;
    unsigned char* ws = F.ws;
    const float* e_norm = F.in[2]; const float* e_w_in = F.in[3]; const float* e_w_out = F.in[13]; const float* o_norm = F.in[14]; const float* o_w_in = F.in[15];
    const float* o_w_out = F.in[21]; const float* ple_w = F.in[22]; const float* ple_gate_w = F.in[24];
    constexpr int I_IN0 = 32 * 192, I_SQ = 32 * 64, I_IN1 = 32 * 256, I_PLE = 4 * 64;
    constexpr int NITEMS = I_IN0 + 4 * I_SQ + I_IN1 + 2 * I_PLE;
    for (int it = gw; it < NITEMS; it += NGW) {
        int r = it;
        if (r < I_IN0) { p0_transpose_item(e_w_in, 2048, 6144, (bf16_t*)(ws + OFF_WIN0), e_norm, false, 192, scr, r, F.lane); continue; } r -= I_IN0;
        if (r < I_IN1) { p0_transpose_item(o_w_in, 2048, 8208, (bf16_t*)(ws + OFF_WIN1), o_norm, true, 256, scr, r, F.lane); continue; } r -= I_IN1;
        if (r < I_SQ) { p0_transpose_item(e_w_out, 2048, 2048, (bf16_t*)(ws + OFF_WOUT0), nullptr, false, 64, scr, r, F.lane); continue; } r -= I_SQ;
        if (r < I_SQ) { p0_transpose_item(ple_gate_w, 2048, 2048, (bf16_t*)(ws + OFF_WG0), nullptr, false, 64, scr, r, F.lane); continue; } r -= I_SQ;
        if (r < I_SQ) { p0_transpose_item(o_w_out, 2048, 2048, (bf16_t*)(ws + OFF_WOUT1), nullptr, false, 64, scr, r, F.lane); continue; } r -= I_SQ;
        if (r < I_SQ) { p0_transpose_item(ple_gate_w + (size_t)2048 * 2048, 2048, 2048, (bf16_t*)(ws + OFF_WG1), nullptr, false, 64, scr, r, F.lane); continue; } r -= I_SQ;
        if (r < I_PLE) { p0_transpose_item(ple_w, 256, 2048, (bf16_t*)(ws + OFF_PLEW), nullptr, false, 64, scr, r, F.lane); continue; } r -= I_PLE;
        p0_transpose_item(ple_w + (size_t)256 * 2048, 256, 2048, (bf16_t*)(ws + OFF_PLEW) + (size_t)2048 * 256, nullptr, false, 64, scr, r, F.lane);
    }
    const float* x = F.in[0]; bf16_t* A = (bf16_t*)(ws + OFF_A); float* rstd0 = (float*)(ws + OFF_SMALL) + 1024;
    for (int m = gw; m < M; m += NGW) {
        const f32x4* xr = (const f32x4*)(x + (size_t)m * D) + F.lane; f32x4 v[8]; float s = 0.f;
#pragma unroll
        for (int j = 0; j < 8; ++j) { v[j] = xr[64 * j]; s += (v[j].x * v[j].x + v[j].y * v[j].y) + (v[j].z * v[j].z + v[j].w * v[j].w); }
        s = wave_sum(s);
        v2u* o8 = (v2u*)(A + (size_t)m * D) + F.lane;
#pragma unroll
        for (int j = 0; j < 8; ++j) { v2u w; w.x = pk2(v[j].x, v[j].y); w.y = pk2(v[j].z, v[j].w); o8[64 * j] = w; }
        if (F.lane == 0) rstd0[m] = rsqrtf(s * (1.f / D) + EPS);
    }
    const int gt = F.bid * (NWAVES * 64) + F.tid, NGT = F.G * NWAVES * 64;
    bf16_t* WGATE1 = (bf16_t*)(ws + OFF_WGATE1);
    for (int i = gt; i < 16 * 2048; i += NGT) { const int j = i >> 11, k = i & 2047; WGATE1[i] = (bf16_t)f2bf(o_w_in[(size_t)k * 8208 + 8192 + j] * o_norm[k]); }
    bf16_t* WRT = (bf16_t*)(ws + OFF_WRT); const float* w_r = F.in[8]; const float* w_i = F.in[10];
    for (int i = gt; i < 2 * 131072; i += NGT) { const int j = i & 131071, n = j >> 14, d = (j >> 7) & 127, cc = j & 127; WRT[i] = (bf16_t)f2bf(((i >> 17) ? w_i : w_r)[n * 16384 + cc * 128 + d]); }
    float* lb = (float*)(ws + OFF_SMALL); const float* logits = F.in[4];
    for (int c = gt; c < 1024; c += NGT) lb[c] = 1.f / (1.f + expf(logits[1024 + c] - logits[c]));
}
__device__ __forceinline__ void gates1_phase(const Frame& F) {
    const bf16_t* A = (const bf16_t*)(F.ws + OFF_A); const bf16_t* WG = (const bf16_t*)(F.ws + OFF_WGATE1);
    const float* hpart = (const float*)(F.ws + OFF_PART) + (size_t)M * 32; float* gates = (float*)(F.ws + OFF_GATES1);
    const int gw = F.bid * NWAVES + F.wave, NGW = F.G * NWAVES;
    for (int row = gw; row < M; row += NGW) {
        float ss = (F.lane < 32) ? hpart[(size_t)row * 32 + F.lane] : 0.f; ss = wave_sum(ss);
        const float sc = rsqrtf(ss * (1.f / D) + EPS);
        float a[32];
        const v4u* ar = (const v4u*)(A + (size_t)row * D) + F.lane;
#pragma unroll
        for (int j = 0; j < 4; ++j) { const v4u w = ar[64 * j]; a[8 * j + 0] = pg8::bflo(w.x); a[8 * j + 1] = pg8::bfhi(w.x); a[8 * j + 2] = pg8::bflo(w.y); a[8 * j + 3] = pg8::bfhi(w.y);
            a[8 * j + 4] = pg8::bflo(w.z); a[8 * j + 5] = pg8::bfhi(w.z); a[8 * j + 6] = pg8::bflo(w.w); a[8 * j + 7] = pg8::bfhi(w.w); }
        float res = 0.f;
        for (int g = 0; g < 16; ++g) {
            const v4u* wr = (const v4u*)(WG + (size_t)g * D) + F.lane; float s = 0.f;
#pragma unroll
            for (int j = 0; j < 4; ++j) { const v4u w = wr[64 * j];
                s += a[8 * j + 0] * pg8::bflo(w.x) + a[8 * j + 1] * pg8::bfhi(w.x) + a[8 * j + 2] * pg8::bflo(w.y) + a[8 * j + 3] * pg8::bfhi(w.y)
                   + a[8 * j + 4] * pg8::bflo(w.z) + a[8 * j + 5] * pg8::bfhi(w.z) + a[8 * j + 6] * pg8::bflo(w.w) + a[8 * j + 7] * pg8::bfhi(w.w); }
            s = wave_sum(s);
            res = (F.lane == g) ? s * sc : res;
        }
        if (F.lane < 16) gates[(size_t)row * 16 + F.lane] = res;
    }
}
__device__ __forceinline__ void final_norm_phase(const Frame& F) {
    const float* hpart = (const float*)(F.ws + OFF_PART) + (size_t)M * 32; const float* g = F.in[25];
    const int gw = F.bid * NWAVES + F.wave, NGW = F.G * NWAVES;
    f32x4 gv[8];
#pragma unroll
    for (int j = 0; j < 8; ++j) gv[j] = ((const f32x4*)g)[F.lane + 64 * j];
    for (int row = gw; row < M; row += NGW) {
        float ss = (F.lane < 32) ? hpart[(size_t)row * 32 + F.lane] : 0.f; ss = wave_sum(ss);
        const float rs = rsqrtf(ss * (1.f / D) + EPS);
        f32x4* xr = (f32x4*)(F.out + (size_t)row * D) + F.lane;
#pragma unroll
        for (int j = 0; j < 8; ++j) { f32x4 v = xr[64 * j]; v = v * gv[j] * rs; xr[64 * j] = v; }
    }
}

__device__ __forceinline__ void cvt_p_phase(const Frame& F) {
    const float* p = F.in[1]; bf16_t* P16 = (bf16_t*)(F.ws + OFF_WIN0);
    const size_t n4 = (size_t)2 * M * PLE / 4, gt = (size_t)F.bid * (NWAVES * 64) + F.tid, NGT = (size_t)F.G * NWAVES * 64;
    for (size_t i = gt; i < n4; i += NGT) { const f32x4 v = ((const f32x4*)p)[i]; v2u w; w.x = pk2(v.x, v.y); w.y = pk2(v.z, v.w); ((v2u*)P16)[i] = w; }
}
__device__ __forceinline__ void hgrn2_naive_phase(const Frame& F, int b, int h) {
    LAS float* sq = (LAS float*)F.lds; LAS float* sf = sq + 128; LAS float* sk = sf + 128; LAS float* part = sk + 128; LAS float* red = part + 512;
    const bf16_t* U = (const bf16_t*)(F.ws + OFF_U); bf16_t* Y = (bf16_t*)(F.ws + OFF_A);
    const float* lb = (const float*)(F.ws + OFF_SMALL); const float* a_norm = F.in[5];
    const int tid = F.tid, e = tid & 127, qt = tid >> 7;
    float Sr[32];
#pragma unroll
    for (int i = 0; i < 32; ++i) Sr[i] = 0.f;
    const float lbv = lb[h * 128 + e], an = a_norm[h * 128 + e];
    const bf16_t* up = U + (size_t)b * S * 6144 + h * 128 + e;
    bf16_t nqa = up[0], nfa = up[1024], nv = up[2048], nza = up[3072];
    for (int t = 0; t < S; ++t) {
        const float qa = bf2f(nqa), fa = bf2f(nfa), v = bf2f(nv), za = bf2f(nza);
        if (t + 1 < S) { const bf16_t* np = up + (size_t)(t + 1) * 6144; nqa = np[0]; nfa = np[1024]; nv = np[2048]; nza = np[3072]; }
        if (qt == 0) { sq[e] = siluf_(qa); sf[e] = lbv + (1.f - lbv) * sigmoidf_(fa); sk[e] = (1.f - lbv) * sigmoidf_(-fa); }
        __syncthreads();
        float acc = 0.f;
#pragma unroll
        for (int i = 0; i < 32; ++i) { const int d = qt * 32 + i; Sr[i] = sf[d] * Sr[i] + sk[d] * v; acc += Sr[i] * sq[d]; }
        part[qt * 128 + e] = acc;
        __syncthreads();
        const float o = (part[e] + part[128 + e]) + (part[256 + e] + part[384 + e]);
        const float s2 = wave_sum(o * o);
        if ((tid & 63) == 0) red[tid >> 6] = s2;
        __syncthreads();
        const float tot = red[0] + red[1];
        if (qt == 0) Y[((size_t)b * S + t) * D + h * 128 + e] = (bf16_t)f2bf(o * rsqrtf(tot * (1.f / 128) + EPS) * an * siluf_(za));
    }
    __syncthreads();
}
__device__ __forceinline__ void rglru_naive_phase(const Frame& F, int b, int n) {
    LAS float* wr = (LAS float*)F.lds; LAS float* wi = wr + 16384; LAS float* xcs = (LAS float*)(F.lds + MISC_OFF + 256);
    const bf16_t* U = (const bf16_t*)(F.ws + OFF_U); bf16_t* Y = (bf16_t*)(F.ws + OFF_A);
    const float* conv_w = F.in[6]; const float* conv_b = F.in[7]; const float* w_r = F.in[8]; const float* b_r = F.in[9]; const float* w_i = F.in[10]; const float* b_i = F.in[11]; const float* lam = F.in[12];
    const int tid = F.tid, d = tid & 127, ch = n * 128 + d; const bool act = tid < 128;
    for (int i = tid; i < 16384; i += NWAVES * 64) { wr[i] = w_r[n * 16384 + i]; wi[i] = w_i[n * 16384 + i]; }
    const float cw0 = conv_w[ch], cw1 = conv_w[1024 + ch], cw2 = conv_w[2048 + ch], cw3 = conv_w[3072 + ch], cb = conv_b[ch], br = b_r[ch], bi = b_i[ch];
    const float sp = log1pf(expf(-lam[ch]));
    float x1 = 0.f, x2 = 0.f, x3 = 0.f, hst = 0.f;
    const bf16_t* up = U + (size_t)b * S * 6144 + 4096 + ch;
    bf16_t nx = up[0], nz = up[1024];
    __syncthreads();
    for (int t = 0; t < S; ++t) {
        const float xb = bf2f(nx), zb = bf2f(nz);
        if (t + 1 < S) { const bf16_t* np = up + (size_t)(t + 1) * 6144; nx = np[0]; nz = np[1024]; }
        const float xc = cb + cw0 * x3 + cw1 * x2 + cw2 * x1 + cw3 * xb;
        x3 = x2; x2 = x1; x1 = xb;
        if (act) xcs[d] = xc;
        __syncthreads();
        if (act) {
            float ar = br, ai = bi;
#pragma unroll 8
            for (int c = 0; c < 128; ++c) { const float xv = xcs[c]; ar += xv * wr[c * 128 + d]; ai += xv * wi[c * 128 + d]; }
            const float r = sigmoidf_(ar), ig = sigmoidf_(ai), log_a = -8.f * r * sp, a = expf(log_a);
            const float u = sqrtf(-expm1f(2.f * log_a)) * ig * xc;
            hst = a * hst + u;
            Y[((size_t)b * S + t) * D + 1024 + ch] = (bf16_t)f2bf(hst * siluf_(zb));
        }
        __syncthreads();
    }
}
__device__ __forceinline__ void qkconv_phase(const Frame& F) {
    const bf16_t* U = (const bf16_t*)(F.ws + OFF_U); bf16_t* QK = (bf16_t*)(F.ws + OFF_A); const float* cw = F.in[16]; const float* cb = F.in[17];
    const size_t gt = (size_t)F.bid * (NWAVES * 64) + F.tid, NGT = (size_t)F.G * NWAVES * 64;
    for (size_t i = gt; i < (size_t)M * 2048; i += NGT) {
        const int row = (int)(i >> 11), c = (int)(i & 2047), t = row & (S - 1);
        float acc = cb[c];
#pragma unroll
        for (int k = 0; k < 4; ++k) { const int tt = t - 3 + k; if (tt >= 0) acc += cw[k * 2048 + c] * bf2f(U[(size_t)(row - 3 + k) * 6144 + c]); }
        QK[i] = (bf16_t)f2bf(siluf_(acc));
    }
}
__device__ __forceinline__ void mlstm_naive_phase(const Frame& F, int b, int h) {
    LAS float* sq = (LAS float*)F.lds; LAS float* sk = sq + 128; LAS float* sn = sk + 128; LAS float* part = sn + 128; LAS float* red = part + 512;
    const bf16_t* U = (const bf16_t*)(F.ws + OFF_U); const bf16_t* QK = (const bf16_t*)(F.ws + OFF_A); bf16_t* Y = (bf16_t*)(F.ws + OFF_B);
    const float* gates = (const float*)(F.ws + OFF_GATES1); const float* c_norm = F.in[20];
    const int tid = F.tid, e = tid & 255, hf = tid >> 8;
    float C[64];
#pragma unroll
    for (int i = 0; i < 64; ++i) C[i] = 0.f;
    if (tid < 128) sn[tid] = 0.f;
    float m = 0.f;
    const float bi = F.in[18][h], bf = F.in[19][h], cn = c_norm[h * 256 + e];
    const size_t row0 = (size_t)b * S;
    __syncthreads();
    for (int t = 0; t < S; ++t) {
        const size_t row = row0 + t;
        if (tid < 128) sq[tid] = bf2f(QK[row * 2048 + h * 128 + tid]) * 0.08838834764831845f;
        else if (tid < 256) sk[tid - 128] = bf2f(QK[row * 2048 + 1024 + h * 128 + (tid - 128)]);
        const float li = gates[row * 16 + h] + bi, xf = gates[row * 16 + 8 + h] + bf;
        const float lf = fminf(xf, 0.f) - log1pf(expf(-fabsf(xf)));
        const float mn = fmaxf(lf + m, li), ip = expf(li - mn), fp = expf(lf + m - mn);
        m = mn;
        const float v = bf2f(U[row * 6144 + 2048 + h * 256 + e]), g = bf2f(U[row * 6144 + 4096 + h * 256 + e]);
        __syncthreads();
        float num = 0.f;
#pragma unroll
        for (int i = 0; i < 64; ++i) { const int d = hf * 64 + i; C[i] = fp * C[i] + (ip * sk[d]) * v; num += C[i] * sq[d]; }
        part[hf * 256 + e] = num;
        if (tid < 128) sn[tid] = fp * sn[tid] + ip * sk[tid];
        __syncthreads();
        float den = 0.f;
#pragma unroll 8
        for (int d = 0; d < 128; ++d) den += sn[d] * sq[d];
        const float hv = (part[e] + part[256 + e]) / fmaxf(fabsf(den), expf(-m));
        const float s2 = wave_sum(hv * hv);
        if ((tid & 63) == 0) red[tid >> 6] = s2;
        __syncthreads();
        const float tot = (red[0] + red[1]) + (red[2] + red[3]);
        if (hf == 0) Y[row * D + h * 256 + e] = (bf16_t)f2bf(hv * rsqrtf(tot * (1.f / 256) + EPS) * cn * g);
    }
    __syncthreads();
}

typedef short bf16x8_t __attribute__((ext_vector_type(8)));
typedef float f32x16 __attribute__((ext_vector_type(16)));

__device__ __forceinline__ void rglru_a_item(const Frame& F, int b, int c, int n) {
    constexpr int XS = 136;
    LAS bf16_t* XT = (LAS bf16_t*)F.lds;
    LAS float* AL = (LAS float*)(F.lds + 17408);
    LAS float* ML = AL + 8192;
    LAS float* AGG = ML + 8192;
    const bf16_t* U = (const bf16_t*)(F.ws + OFF_U); bf16_t* HL = (bf16_t*)(F.ws + OFF_A); bf16_t* AC = (bf16_t*)(F.ws + OFF_ACUM); float* carry = (float*)(F.ws + OFF_CARRY);
    const bf16_t* WRT = (const bf16_t*)(F.ws + OFF_WRT) + (size_t)n * 16384; const bf16_t* WIT = WRT + 8 * 16384;
    const float* conv_w = F.in[6]; const float* conv_b = F.in[7]; const float* b_r = F.in[9]; const float* b_i = F.in[11]; const float* lam = F.in[12];
    const int tid = F.tid, d = tid & 127, q = tid >> 7, ch = n * 128 + d, t0 = c * 64;
    const size_t row0 = (size_t)b * S + t0;
    float xc[16];
    {
        float xv[19];
#pragma unroll
        for (int i = 0; i < 19; ++i) { const int t = t0 + 16 * q - 3 + i; xv[i] = (t >= 0) ? bf2f(U[((size_t)b * S + t) * 6144 + 4096 + ch]) : 0.f; }
        const float cw0 = conv_w[ch], cw1 = conv_w[1024 + ch], cw2 = conv_w[2048 + ch], cw3 = conv_w[3072 + ch], cb = conv_b[ch];
#pragma unroll
        for (int i = 0; i < 16; ++i) { xc[i] = cb + cw0 * xv[i] + cw1 * xv[i + 1] + cw2 * xv[i + 2] + cw3 * xv[i + 3]; XT[(16 * q + i) * XS + d] = (bf16_t)f2bf(xc[i]); }
    }
    __syncthreads();
    {
        const int w = F.wave, tt = w >> 2, db = w & 3, l31 = F.lane & 31, hh = F.lane >> 5;
        f32x16 accR, accI;
#pragma unroll
        for (int r = 0; r < 16; ++r) { accR[r] = 0.f; accI[r] = 0.f; }
        const LAS bf16_t* ap = XT + (32 * tt + l31) * XS + 8 * hh;
        const bf16_t* rp = WRT + (size_t)(32 * db + l31) * 128 + 8 * hh; const bf16_t* ip = WIT + (size_t)(32 * db + l31) * 128 + 8 * hh;
#pragma unroll
        for (int ks = 0; ks < 8; ++ks) {
            const bf16x8_t a = *(const LAS bf16x8_t*)(ap + 16 * ks), br_ = *(const bf16x8_t*)(rp + 16 * ks), bi_ = *(const bf16x8_t*)(ip + 16 * ks);
            accR = __builtin_amdgcn_mfma_f32_32x32x16_bf16(a, br_, accR, 0, 0, 0);
            accI = __builtin_amdgcn_mfma_f32_32x32x16_bf16(a, bi_, accI, 0, 0, 0);
        }
        const int dc = 32 * db + l31, chc = n * 128 + dc;
        const float brv = b_r[chc], biv = b_i[chc], sp = log1pf(expf(-lam[chc]));
#pragma unroll
        for (int r = 0; r < 16; ++r) {
            const int t = 32 * tt + (r & 3) + 8 * (r >> 2) + 4 * hh;
            const float rr = sigmoidf_(accR[r] + brv), ii = sigmoidf_(accI[r] + biv), la = -8.f * rr * sp;
            AL[t * 128 + dc] = __expf(la); ML[t * 128 + dc] = sqrtf(-expm1f(2.f * la)) * ii;
        }
    }
    __syncthreads();
    float hl[16], ac[16];
    {
        float h = 0.f, Ac = 1.f;
#pragma unroll
        for (int i = 0; i < 16; ++i) { const int t = 16 * q + i; const float a = AL[t * 128 + d], u = ML[t * 128 + d] * xc[i]; h = a * h + u; Ac *= a; hl[i] = h; ac[i] = Ac; }
        AGG[(q * 2 + 0) * 128 + d] = Ac; AGG[(q * 2 + 1) * 128 + d] = h;
    }
    __syncthreads();
    {
        float Hp = 0.f, Ap = 1.f;
#pragma unroll
        for (int qq = 0; qq < 3; ++qq) if (qq < q) { const float a = AGG[(qq * 2 + 0) * 128 + d], hh_ = AGG[(qq * 2 + 1) * 128 + d]; Hp = a * Hp + hh_; Ap *= a; }
#pragma unroll
        for (int i = 0; i < 16; ++i) { const size_t row = row0 + 16 * q + i; const float hv = hl[i] + ac[i] * Hp, av = ac[i] * Ap;
            HL[row * D + 1024 + ch] = (bf16_t)f2bf(hv); AC[row * 1024 + ch] = (bf16_t)f2bf(av);
            if (q == 3 && i == 15) { float* cp = carry + ((size_t)((b * 32 + c) * 8 + n)) * 256; cp[d] = av; cp[128 + d] = hv; } }
    }
    __syncthreads();
}
__device__ __forceinline__ void rglru_b_item(const Frame& F, int b, int c, int n) {
    const bf16_t* U = (const bf16_t*)(F.ws + OFF_U); bf16_t* Y = (bf16_t*)(F.ws + OFF_A); const bf16_t* AC = (const bf16_t*)(F.ws + OFF_ACUM); const float* carry = (const float*)(F.ws + OFF_CARRY);
    const int tid = F.tid, d = tid & 127, q = tid >> 7, ch = n * 128 + d;
    float H = 0.f;
    for (int cc = 0; cc < c; ++cc) { const float* cp = carry + ((size_t)((b * 32 + cc) * 8 + n)) * 256; H = cp[d] * H + cp[128 + d]; }
    const size_t row0 = (size_t)b * S + c * 64 + 16 * q;
#pragma unroll 4
    for (int i = 0; i < 16; ++i) { const size_t row = row0 + i;
        const float hl = bf2f(Y[row * D + 1024 + ch]), av = bf2f(AC[row * 1024 + ch]), zb = bf2f(U[row * 6144 + 5120 + ch]);
        Y[row * D + 1024 + ch] = (bf16_t)f2bf((hl + av * H) * siluf_(zb)); }
}

typedef float f32x4_t __attribute__((ext_vector_type(4)));
typedef short bf16x4_t __attribute__((ext_vector_type(4)));
__device__ __forceinline__ bf16x8_t pack_bf16x8(float a0, float a1, float a2, float a3, float a4, float a5, float a6, float a7) {
    v4u w; w.x = pg8::cvt_pk_bf16(a0, a1); w.y = pg8::cvt_pk_bf16(a2, a3); w.z = pg8::cvt_pk_bf16(a4, a5); w.w = pg8::cvt_pk_bf16(a6, a7);
    return __builtin_bit_cast(bf16x8_t, w);
}
__device__ __forceinline__ bf16x8_t cat_bf16x4(v2u lo, v2u hi) { v4u w; w.x = lo.x; w.y = lo.y; w.z = hi.x; w.w = hi.y; return __builtin_bit_cast(bf16x8_t, w); }

__device__ __forceinline__ void hgrn2_a_item(const Frame& F, int b, int c, int h) {
    constexpr int QS = 136, VS = 72;
    LAS bf16_t* QT = (LAS bf16_t*)F.lds;
    LAS bf16_t* KT = QT + 64 * QS;
    LAS bf16_t* VT = KT + 64 * QS;
    LAS bf16_t* AT = VT + 128 * VS;
    LAS float* CS = (LAS float*)(AT + 64 * VS);
    bf16_t* U = (bf16_t*)(F.ws + OFF_U); bf16_t* OI = (bf16_t*)(F.ws + OFF_A); float* decay = (float*)(F.ws + OFF_DECAY);
    const float* lb = (const float*)(F.ws + OFF_SMALL);
    const int tid = F.tid, d = tid & 127, q = tid >> 7, t0 = c * 64;
    const size_t row0 = (size_t)b * S + t0;
    {
        const float lbv = lb[h * 128 + d];
        float qa[16], fa[16], vv[16];
        const bf16_t* up = U + (row0 + 16 * q) * 6144 + h * 128 + d;
#pragma unroll
        for (int i = 0; i < 16; ++i) { qa[i] = bf2f(up[(size_t)i * 6144]); fa[i] = bf2f(up[(size_t)i * 6144 + 1024]); vv[i] = bf2f(up[(size_t)i * 6144 + 2048]); }
        float cs[16]; float run = 0.f;
#pragma unroll
        for (int i = 0; i < 16; ++i) { const float f = lbv + (1.f - lbv) * sigmoidf_(fa[i]); run += __logf(f); cs[i] = run; }
        CS[q * 128 + d] = run;
        __syncthreads();
        float off = 0.f, tot = 0.f;
#pragma unroll
        for (int qq = 0; qq < 4; ++qq) { const float v_ = CS[qq * 128 + d]; off += (qq < q) ? v_ : 0.f; tot += v_; }
        float kd[16];
#pragma unroll
        for (int i = 0; i < 16; ++i) { const float bt = off + cs[i], k = (1.f - lbv) * sigmoidf_(-fa[i]);
            QT[(16 * q + i) * QS + d] = (bf16_t)f2bf(siluf_(qa[i]) * __expf(bt)); KT[(16 * q + i) * QS + d] = (bf16_t)f2bf(k * __expf(-bt)); kd[i] = k * __expf(tot - bt); }
        const bf16x8_t k0 = pack_bf16x8(kd[0], kd[1], kd[2], kd[3], kd[4], kd[5], kd[6], kd[7]), k1 = pack_bf16x8(kd[8], kd[9], kd[10], kd[11], kd[12], kd[13], kd[14], kd[15]);
        const bf16x8_t v0 = pack_bf16x8(vv[0], vv[1], vv[2], vv[3], vv[4], vv[5], vv[6], vv[7]), v1 = pack_bf16x8(vv[8], vv[9], vv[10], vv[11], vv[12], vv[13], vv[14], vv[15]);
        *(LAS bf16x8_t*)(VT + d * VS + 16 * q) = v0; *(LAS bf16x8_t*)(VT + d * VS + 16 * q + 8) = v1;
        __syncthreads();
        bf16_t* tp = U + (row0 + (d >> 1)) * 6144 + h * 128 + (d & 1) * 64 + 16 * q;
        *(bf16x8_t*)(tp + 1024) = k0; *(bf16x8_t*)(tp + 1024 + 8) = k1;
        *(bf16x8_t*)(tp + 2048) = v0; *(bf16x8_t*)(tp + 2048 + 8) = v1;
        if (q == 0) decay[((size_t)((b * 32 + c) * 8 + h)) * 128 + d] = __expf(tot);
    }
    {
        const int w = F.wave, tb = w >> 1, r = F.lane & 15, g = F.lane >> 4;
#pragma unroll
        for (int k2 = 0; k2 < 2; ++k2) {
            const int sb = 2 * (w & 1) + k2;
            f32x4_t acc = {0.f, 0.f, 0.f, 0.f};
            if (sb <= tb) {
#pragma unroll
                for (int ks = 0; ks < 4; ++ks) {
                    const bf16x8_t a = *(const LAS bf16x8_t*)(QT + (16 * tb + r) * QS + 32 * ks + 8 * g), bb = *(const LAS bf16x8_t*)(KT + (16 * sb + r) * QS + 32 * ks + 8 * g);
                    acc = __builtin_amdgcn_mfma_f32_16x16x32_bf16(a, bb, acc, 0, 0, 0);
                }
            }
#pragma unroll
            for (int j = 0; j < 4; ++j) { const int t = 16 * tb + 4 * g + j, s = 16 * sb + r; AT[t * VS + s] = (bf16_t)f2bf(s <= t ? acc[j] : 0.f); }
        }
    }
    __syncthreads();
    {
        const int w = F.wave, th = w >> 2, eb = w & 3, l31 = F.lane & 31, hh = F.lane >> 5;
        f32x16 acc;
#pragma unroll
        for (int r = 0; r < 16; ++r) acc[r] = 0.f;
#pragma unroll
        for (int ks = 0; ks < 4; ++ks) {
            const bf16x8_t a = *(const LAS bf16x8_t*)(AT + (32 * th + l31) * VS + 16 * ks + 8 * hh), bb = *(const LAS bf16x8_t*)(VT + (32 * eb + l31) * VS + 16 * ks + 8 * hh);
            acc = __builtin_amdgcn_mfma_f32_32x32x16_bf16(a, bb, acc, 0, 0, 0);
        }
#pragma unroll
        for (int r = 0; r < 16; ++r) { const int t = 32 * th + (r & 3) + 8 * (r >> 2) + 4 * hh; OI[(row0 + t) * D + h * 128 + 32 * eb + l31] = (bf16_t)f2bf(acc[r]); }
#pragma unroll
        for (int j = 0; j < 2; ++j) { const int p = tid + 512 * j, row = p >> 4, c16 = p & 15; *(bf16x8_t*)(U + (row0 + row) * 6144 + h * 128 + c16 * 8) = *(const LAS bf16x8_t*)(QT + row * QS + c16 * 8); }
    }
    __syncthreads();
}

__device__ __forceinline__ void hgrn2_b_phase(const Frame& F, int b, int h) {
    constexpr int QS = 132, VS = 72;
    LAS bf16_t* QB = (LAS bf16_t*)F.lds;
    LAS bf16_t* KB = QB + 64 * QS;
    LAS bf16_t* VB = KB + 128 * VS;
    LAS float* DEC = (LAS float*)(VB + 128 * VS);
    LAS float* XB = DEC + 128;
    LAS float* SSQ = XB + 8 * 1024;
    const bf16_t* U = (const bf16_t*)(F.ws + OFF_U); bf16_t* Y = (bf16_t*)(F.ws + OFF_A); const float* decay = (const float*)(F.ws + OFF_DECAY);
    const float* a_norm = F.in[5];
    const int tid = F.tid, w = F.wave, eb = w & 3, dh = w >> 2, l31 = F.lane & 31, hh = F.lane >> 5;
    f32x16 X[2];
#pragma unroll
    for (int xi = 0; xi < 2; ++xi)
#pragma unroll
        for (int r = 0; r < 16; ++r) X[xi][r] = 0.f;
    float an[16];
#pragma unroll
    for (int r = 0; r < 16; ++r) an[r] = a_norm[h * 128 + 32 * eb + (r & 3) + 8 * (r >> 2) + 4 * hh];
    bf16x8_t pq[2], pk[2], pv[2]; float pdec = 0.f;
    {
        const size_t row0 = (size_t)b * S;
#pragma unroll
        for (int j = 0; j < 2; ++j) { const int p = tid + 512 * j; const bf16_t* up = U + (row0 + (p >> 4)) * 6144 + h * 128 + (p & 15) * 8;
            pq[j] = *(const bf16x8_t*)up; pk[j] = *(const bf16x8_t*)(up + 1024); pv[j] = *(const bf16x8_t*)(up + 2048); }
        if (tid < 128) pdec = decay[((size_t)((b * 32 + 0) * 8 + h)) * 128 + tid];
    }
    for (int c = 0; c < 32; ++c) {
        const size_t row0 = (size_t)b * S + c * 64;
#pragma unroll
        for (int j = 0; j < 2; ++j) { const int p = tid + 512 * j, ur = p >> 4, c16 = p & 15;
            { const v4u w4 = __builtin_bit_cast(v4u, pq[j]); v2u lo, hi; lo.x = w4.x; lo.y = w4.y; hi.x = w4.z; hi.y = w4.w; *(LAS v2u*)(QB + ur * QS + c16 * 8) = lo; *(LAS v2u*)(QB + ur * QS + c16 * 8 + 4) = hi; }
            *(LAS bf16x8_t*)(KB + (2 * ur + (c16 >> 3)) * VS + (c16 & 7) * 8) = pk[j];
            *(LAS bf16x8_t*)(VB + (2 * ur + (c16 >> 3)) * VS + (c16 & 7) * 8) = pv[j]; }
        if (tid < 128) DEC[tid] = pdec;
        __syncthreads();
        if (c + 1 < 32) {
            const size_t rn = row0 + 64;
#pragma unroll
            for (int j = 0; j < 2; ++j) { const int p = tid + 512 * j; const bf16_t* up = U + (rn + (p >> 4)) * 6144 + h * 128 + (p & 15) * 8;
                pq[j] = *(const bf16x8_t*)up; pk[j] = *(const bf16x8_t*)(up + 1024); pv[j] = *(const bf16x8_t*)(up + 2048); }
            if (tid < 128) pdec = decay[((size_t)((b * 32 + c + 1) * 8 + h)) * 128 + tid];
        }
        const int tf = 32 * dh + l31;
        v2u oi[4], zz[4];
#pragma unroll
        for (int g4 = 0; g4 < 4; ++g4) { const int e0 = h * 128 + 32 * eb + 8 * g4 + 4 * hh;
            oi[g4] = *(const v2u*)(Y + (row0 + tf) * D + e0); zz[g4] = *(const v2u*)(U + (row0 + tf) * 6144 + 3072 + e0); }
        f32x16 accT[2];
#pragma unroll
        for (int tt = 0; tt < 2; ++tt)
#pragma unroll
            for (int r = 0; r < 16; ++r) accT[tt][r] = 0.f;
#pragma unroll
        for (int xi = 0; xi < 2; ++xi)
#pragma unroll
            for (int s = 0; s < 2; ++s) {
                const bf16x8_t a = pack_bf16x8(X[xi][8 * s + 0], X[xi][8 * s + 1], X[xi][8 * s + 2], X[xi][8 * s + 3], X[xi][8 * s + 4], X[xi][8 * s + 5], X[xi][8 * s + 6], X[xi][8 * s + 7]);
#pragma unroll
                for (int tt = 0; tt < 2; ++tt) {
                    const LAS bf16_t* qp = QB + (32 * tt + l31) * QS + 64 * dh + 32 * xi + 16 * s + 4 * hh;
                    const bf16x8_t bq = cat_bf16x4(*(const LAS v2u*)qp, *(const LAS v2u*)(qp + 8));
                    accT[tt] = __builtin_amdgcn_mfma_f32_32x32x16_bf16(a, bq, accT[tt], 0, 0, 0);
                }
            }
#pragma unroll
        for (int xi = 0; xi < 2; ++xi) {
#pragma unroll
            for (int g4 = 0; g4 < 4; ++g4) { const f32x4_t dv = *(const LAS f32x4_t*)(DEC + 64 * dh + 32 * xi + 8 * g4 + 4 * hh);
                X[xi][4 * g4 + 0] *= dv[0]; X[xi][4 * g4 + 1] *= dv[1]; X[xi][4 * g4 + 2] *= dv[2]; X[xi][4 * g4 + 3] *= dv[3]; }
#pragma unroll
            for (int ks = 0; ks < 4; ++ks) {
                const bf16x8_t a = *(const LAS bf16x8_t*)(KB + (64 * dh + 32 * xi + l31) * VS + 16 * ks + 8 * hh), bv = *(const LAS bf16x8_t*)(VB + (32 * eb + l31) * VS + 16 * ks + 8 * hh);
                X[xi] = __builtin_amdgcn_mfma_f32_32x32x16_bf16(a, bv, X[xi], 0, 0, 0);
            }
        }
        {
            LAS float* xo = XB + w * 1024 + F.lane;
            if (dh == 0) {
#pragma unroll
                for (int r = 0; r < 16; ++r) xo[r * 64] = accT[1][r];
            } else {
#pragma unroll
                for (int r = 0; r < 16; ++r) xo[r * 64] = accT[0][r];
            }
        }
        __syncthreads();
        float o[16];
        {
            const LAS float* xi_ = XB + (w ^ 4) * 1024 + F.lane;
            if (dh == 0) {
#pragma unroll
                for (int r = 0; r < 16; ++r) o[r] = accT[0][r] + xi_[r * 64];
            } else {
#pragma unroll
                for (int r = 0; r < 16; ++r) o[r] = accT[1][r] + xi_[r * 64];
            }
        }
        float ss = 0.f;
#pragma unroll
        for (int g4 = 0; g4 < 4; ++g4) {
            o[4 * g4 + 0] += pg8::bflo(oi[g4].x); o[4 * g4 + 1] += pg8::bfhi(oi[g4].x); o[4 * g4 + 2] += pg8::bflo(oi[g4].y); o[4 * g4 + 3] += pg8::bfhi(oi[g4].y);
            ss += (o[4 * g4 + 0] * o[4 * g4 + 0] + o[4 * g4 + 1] * o[4 * g4 + 1]) + (o[4 * g4 + 2] * o[4 * g4 + 2] + o[4 * g4 + 3] * o[4 * g4 + 3]);
        }
        ss += __shfl_xor(ss, 32);
        if (hh == 0) SSQ[eb * 64 + tf] = ss;
        __syncthreads();
        const float rs = rsqrtf(((SSQ[tf] + SSQ[64 + tf]) + (SSQ[128 + tf] + SSQ[192 + tf])) * (1.f / 128.f) + EPS);
#pragma unroll
        for (int g4 = 0; g4 < 4; ++g4) {
            const float y0 = o[4 * g4 + 0] * rs * an[4 * g4 + 0] * siluf_(pg8::bflo(zz[g4].x)), y1 = o[4 * g4 + 1] * rs * an[4 * g4 + 1] * siluf_(pg8::bfhi(zz[g4].x));
            const float y2 = o[4 * g4 + 2] * rs * an[4 * g4 + 2] * siluf_(pg8::bflo(zz[g4].y)), y3 = o[4 * g4 + 3] * rs * an[4 * g4 + 3] * siluf_(pg8::bfhi(zz[g4].y));
            v2u yw; yw.x = pg8::cvt_pk_bf16(y0, y1); yw.y = pg8::cvt_pk_bf16(y2, y3);
            *(v2u*)(Y + (row0 + tf) * D + h * 128 + 32 * eb + 8 * g4 + 4 * hh) = yw;
        }
    }
    __syncthreads();
}

constexpr size_t OFF_MS = OFF_PART;
constexpr size_t OFF_ITEM1 = OFF_PART + 1 * MiB;

__device__ __forceinline__ void mlstm_a_item(const Frame& F, int b, int c, int h) {
    constexpr int QS = 136, VS = 72;
    LAS bf16_t* QT = (LAS bf16_t*)F.lds;
    LAS bf16_t* KT = QT + 64 * QS;
    LAS bf16_t* VT = KT + 64 * QS;
    LAS bf16_t* AT = VT + 256 * VS;
    LAS float* BCS = (LAS float*)(AT + 64 * VS);
    LAS float* A2 = BCS + 64; LAS float* PM = A2 + 64; LAS float* KWS = PM + 64;
    LAS float* NL = KWS + 64;
    LAS float* DL = NL + 512;
    bf16_t* U = (bf16_t*)(F.ws + OFF_U); bf16_t* QA = (bf16_t*)(F.ws + OFF_A); bf16_t* NUM = (bf16_t*)(F.ws + OFF_B);
    const float* gates = (const float*)(F.ws + OFF_GATES1); float* MS = (float*)(F.ws + OFF_MS); float* ITEM = (float*)(F.ws + OFF_ITEM1) + (size_t)((b * 32 + c) * 8 + h) * 256;
    const float* cw = F.in[16]; const float* cb = F.in[17];
    const int tid = F.tid, w = F.wave, lane = F.lane, d = tid & 127, qq = tid >> 7, t0 = c * 64;
    const size_t row0 = (size_t)b * S + t0;
    if (w == 0) {
        const size_t row = row0 + lane;
        const float li = gates[row * 16 + h] + F.in[18][h], xf = gates[row * 16 + 8 + h] + F.in[19][h];
        const float lf = fminf(xf, 0.f) - log1pf(expf(-fabsf(xf)));
        float bc = lf;
#pragma unroll
        for (int o = 1; o < 64; o <<= 1) { const float v_ = __shfl_up(bc, o); bc += (lane >= o) ? v_ : 0.f; }
        const float a2 = li - bc; float pm = a2;
#pragma unroll
        for (int o = 1; o < 64; o <<= 1) { const float v_ = __shfl_up(pm, o); pm = (lane >= o) ? fmaxf(pm, v_) : pm; }
        const float pml = __shfl(pm, 63), bl = __shfl(bc, 63);
        BCS[lane] = bc; A2[lane] = a2; PM[lane] = pm; KWS[lane] = __expf(a2 - pml);
        MS[(row * 8 + h) * 4 + 0] = bc; MS[(row * 8 + h) * 4 + 1] = bc + pm;
        if (lane == 0) { ITEM[128] = bl + pml; ITEM[129] = bl; }
    }
    float kp[16];
    {
        float xq[19], xk[19];
#pragma unroll
        for (int i = 0; i < 19; ++i) { const int t = t0 + 16 * qq - 3 + i; const bool ok = t >= 0; const bf16_t* up = U + ((size_t)b * S + (ok ? t : 0)) * 6144 + h * 128 + d;
            xq[i] = ok ? bf2f(up[0]) : 0.f; xk[i] = ok ? bf2f(up[1024]) : 0.f; }
        const int cq = h * 128 + d, ck = 1024 + h * 128 + d;
        const float q0 = cw[cq], q1 = cw[2048 + cq], q2 = cw[4096 + cq], q3 = cw[6144 + cq], qb = cb[cq];
        const float k0 = cw[ck], k1 = cw[2048 + ck], k2 = cw[4096 + ck], k3 = cw[6144 + ck], kb = cb[ck];
#pragma unroll
        for (int i = 0; i < 16; ++i) {
            const float qv = siluf_(qb + q0 * xq[i] + q1 * xq[i + 1] + q2 * xq[i + 2] + q3 * xq[i + 3]) * 0.08838834764831845f;
            kp[i] = siluf_(kb + k0 * xk[i] + k1 * xk[i + 1] + k2 * xk[i + 2] + k3 * xk[i + 3]);
            QT[(16 * qq + i) * QS + d] = (bf16_t)f2bf(qv); KT[(16 * qq + i) * QS + d] = (bf16_t)f2bf(kp[i]);
        }
    }
    bf16x8_t vt[4];
    {
        const int e = tid & 255, hf = tid >> 8;
        const bf16_t* vp = U + (row0 + 32 * hf) * 6144 + 2048 + h * 256 + e;
        unsigned short vv[32];
#pragma unroll
        for (int i = 0; i < 32; ++i) vv[i] = vp[(size_t)i * 6144];
#pragma unroll
        for (int j = 0; j < 4; ++j) { v4u w4; w4.x = vv[8 * j] | ((unsigned)vv[8 * j + 1] << 16); w4.y = vv[8 * j + 2] | ((unsigned)vv[8 * j + 3] << 16); w4.z = vv[8 * j + 4] | ((unsigned)vv[8 * j + 5] << 16); w4.w = vv[8 * j + 6] | ((unsigned)vv[8 * j + 7] << 16);
            vt[j] = __builtin_bit_cast(bf16x8_t, w4); *(LAS bf16x8_t*)(VT + e * VS + 32 * hf + 8 * j) = vt[j]; }
    }
    __syncthreads();
    {
        const int e = tid & 255, hf = tid >> 8;
        bf16_t* tp = U + (row0 + (e >> 2)) * 6144 + 2048 + h * 256 + (e & 3) * 64 + 32 * hf;
#pragma unroll
        for (int j = 0; j < 4; ++j) *(bf16x8_t*)(tp + 8 * j) = vt[j];
        float kw[16], ns = 0.f;
#pragma unroll
        for (int i = 0; i < 16; ++i) { kw[i] = kp[i] * KWS[16 * qq + i]; ns += kw[i]; }
        NL[qq * 128 + d] = ns;
        bf16_t* kp_ = QA + (row0 + (d >> 1)) * D + 1024 + h * 128 + (d & 1) * 64 + 16 * qq;
        *(bf16x8_t*)kp_ = pack_bf16x8(kw[0], kw[1], kw[2], kw[3], kw[4], kw[5], kw[6], kw[7]); *(bf16x8_t*)(kp_ + 8) = pack_bf16x8(kw[8], kw[9], kw[10], kw[11], kw[12], kw[13], kw[14], kw[15]);
#pragma unroll
        for (int j = 0; j < 2; ++j) { const int p = tid + 512 * j, row = p >> 4, c16 = p & 15; *(bf16x8_t*)(QA + (row0 + row) * D + h * 128 + c16 * 8) = *(const LAS bf16x8_t*)(QT + row * QS + c16 * 8); }
    }
    {
        const int tb = w >> 1, r = lane & 15, g = lane >> 4;
#pragma unroll
        for (int k2 = 0; k2 < 2; ++k2) {
            const int sb = 2 * (w & 1) + k2;
            f32x4_t acc = {0.f, 0.f, 0.f, 0.f};
            if (sb <= tb) {
#pragma unroll
                for (int ks = 0; ks < 4; ++ks) {
                    const bf16x8_t a = *(const LAS bf16x8_t*)(KT + (16 * sb + r) * QS + 32 * ks + 8 * g), bb = *(const LAS bf16x8_t*)(QT + (16 * tb + r) * QS + 32 * ks + 8 * g);
                    acc = __builtin_amdgcn_mfma_f32_16x16x32_bf16(a, bb, acc, 0, 0, 0);
                }
            }
            const int t = 16 * tb + r, s0 = 16 * sb + 4 * g; const float pmt = PM[t];
            float sc[4], ds = 0.f;
#pragma unroll
            for (int j = 0; j < 4; ++j) { sc[j] = (s0 + j <= t) ? acc[j] * __expf(A2[s0 + j] - pmt) : 0.f; ds += sc[j]; }
            v2u pw; pw.x = pg8::cvt_pk_bf16(sc[0], sc[1]); pw.y = pg8::cvt_pk_bf16(sc[2], sc[3]);
            *(LAS v2u*)(AT + t * VS + s0) = pw;
            ds += __shfl_xor(ds, 16); ds += __shfl_xor(ds, 32);
            if (g == 0) DL[sb * 64 + t] = ds;
        }
    }
    __syncthreads();
    {
        const int l31 = lane & 31, hh = lane >> 5;
#pragma unroll
        for (int th = 0; th < 2; ++th) {
            f32x16 acc;
#pragma unroll
            for (int r = 0; r < 16; ++r) acc[r] = 0.f;
#pragma unroll
            for (int ks = 0; ks < 4; ++ks) {
                const bf16x8_t a = *(const LAS bf16x8_t*)(AT + (32 * th + l31) * VS + 16 * ks + 8 * hh), bb = *(const LAS bf16x8_t*)(VT + (32 * w + l31) * VS + 16 * ks + 8 * hh);
                acc = __builtin_amdgcn_mfma_f32_32x32x16_bf16(a, bb, acc, 0, 0, 0);
            }
#pragma unroll
            for (int r = 0; r < 16; ++r) { const int t = 32 * th + (r & 3) + 8 * (r >> 2) + 4 * hh; NUM[(row0 + t) * D + h * 256 + 32 * w + l31] = (bf16_t)f2bf(acc[r]); }
        }
        if (tid < 64) MS[((row0 + tid) * 8 + h) * 4 + 2] = (DL[tid] + DL[64 + tid]) + (DL[128 + tid] + DL[192 + tid]);
        if (tid >= 128 && tid < 256) { const int dd = tid - 128; ITEM[dd] = (NL[dd] + NL[128 + dd]) + (NL[256 + dd] + NL[384 + dd]); }
    }
    __syncthreads();
}

__device__ __forceinline__ void mlstm_b_phase(const Frame& F, int b, int h) {
    constexpr int QS = 132, VS = 72;
    LAS bf16_t* QB = (LAS bf16_t*)F.lds;
    LAS bf16_t* KB = QB + 64 * QS;
    LAS bf16_t* VB = KB + 128 * VS;
    LAS float* NS = (LAS float*)(VB + 256 * VS);
    LAS float* DI = NS + 128;
    LAS float* SSQ = DI + 64;
    LAS float* MST = SSQ + 512;
    LAS float* DECC = MST + 40;
    LAS float* SLOC = DECC + 32;
    bf16_t* U = (bf16_t*)(F.ws + OFF_U); const bf16_t* QA = (const bf16_t*)(F.ws + OFF_A); bf16_t* Y = (bf16_t*)(F.ws + OFF_B);
    const float* MS = (const float*)(F.ws + OFF_MS); const float* ITEM0 = (const float*)(F.ws + OFF_ITEM1) + (size_t)((b * 32) * 8 + h) * 256;
    const float* c_norm = F.in[20];
    const int tid = F.tid, w = F.wave, lane = F.lane, l31 = lane & 31, hh = lane >> 5;
    if (tid == 0) {
        float m = 0.f;
        for (int c = 0; c < 32; ++c) { const float Mc = ITEM0[(size_t)c * 2048 + 128], bl = ITEM0[(size_t)c * 2048 + 129]; const float mn = fmaxf(bl + m, Mc);
            MST[c] = m; DECC[c] = __expf(bl + m - mn); SLOC[c] = __expf(Mc - mn); m = mn; }
        MST[32] = m;
    }
    if (tid < 128) NS[tid] = 0.f;
    f32x16 X[4];
#pragma unroll
    for (int xi = 0; xi < 4; ++xi)
#pragma unroll
        for (int r = 0; r < 16; ++r) X[xi][r] = 0.f;
    bf16x8_t pq[2], pk[2], pv[4]; float pnl = 0.f;
    {
        const size_t row0 = (size_t)b * S;
#pragma unroll
        for (int j = 0; j < 2; ++j) { const int p = tid + 512 * j; const bf16_t* ap = QA + (row0 + (p >> 4)) * D + h * 128 + (p & 15) * 8; pq[j] = *(const bf16x8_t*)ap; pk[j] = *(const bf16x8_t*)(ap + 1024); }
#pragma unroll
        for (int j = 0; j < 4; ++j) { const int p = tid + 512 * j; pv[j] = *(const bf16x8_t*)(U + (row0 + (p >> 5)) * 6144 + 2048 + h * 256 + (p & 31) * 8); }
        if (tid < 128) pnl = ITEM0[tid];
    }
    __syncthreads();
    for (int c = 0; c < 32; ++c) {
        const size_t row0 = (size_t)b * S + c * 64;
        const float m_st = MST[c], dec = DECC[c], sloc = SLOC[c];
#pragma unroll
        for (int j = 0; j < 2; ++j) { const int p = tid + 512 * j, ur = p >> 4, c16 = p & 15;
            { const v4u w4 = __builtin_bit_cast(v4u, pq[j]); v2u lo, hi; lo.x = w4.x; lo.y = w4.y; hi.x = w4.z; hi.y = w4.w; *(LAS v2u*)(QB + ur * QS + c16 * 8) = lo; *(LAS v2u*)(QB + ur * QS + c16 * 8 + 4) = hi; }
            { const v4u w4 = __builtin_bit_cast(v4u, pk[j]);
              const bf16x8_t ks_ = pack_bf16x8(pg8::bflo(w4.x) * sloc, pg8::bfhi(w4.x) * sloc, pg8::bflo(w4.y) * sloc, pg8::bfhi(w4.y) * sloc, pg8::bflo(w4.z) * sloc, pg8::bfhi(w4.z) * sloc, pg8::bflo(w4.w) * sloc, pg8::bfhi(w4.w) * sloc);
              *(LAS bf16x8_t*)(KB + (2 * ur + (c16 >> 3)) * VS + (c16 & 7) * 8) = ks_; } }
#pragma unroll
        for (int j = 0; j < 4; ++j) { const int p = tid + 512 * j, ur = p >> 5, c32 = p & 31; *(LAS bf16x8_t*)(VB + (4 * ur + (c32 >> 3)) * VS + (c32 & 7) * 8) = pv[j]; }
        const float nl_cur = pnl;
        __syncthreads();
        if (c + 1 < 32) {
            const size_t rn = row0 + 64;
#pragma unroll
            for (int j = 0; j < 2; ++j) { const int p = tid + 512 * j; const bf16_t* ap = QA + (rn + (p >> 4)) * D + h * 128 + (p & 15) * 8; pq[j] = *(const bf16x8_t*)ap; pk[j] = *(const bf16x8_t*)(ap + 1024); }
#pragma unroll
            for (int j = 0; j < 4; ++j) { const int p = tid + 512 * j; pv[j] = *(const bf16x8_t*)(U + (rn + (p >> 5)) * 6144 + 2048 + h * 256 + (p & 31) * 8); }
            if (tid < 128) pnl = ITEM0[(size_t)(c + 1) * 2048 + tid];
        }
        v2u nm[2][4]; f32x4_t st[2];
#pragma unroll
        for (int tt = 0; tt < 2; ++tt) { const size_t row = row0 + 32 * tt + l31;
            st[tt] = *(const f32x4_t*)(MS + (row * 8 + h) * 4);
#pragma unroll
            for (int g4 = 0; g4 < 4; ++g4) { const int e0 = h * 256 + 32 * w + 8 * g4 + 4 * hh; nm[tt][g4] = *(const v2u*)(Y + row * D + e0); } }
        {
            const int tq = 8 * w + (lane >> 3), d0 = (lane & 7) * 16; float s = 0.f;
#pragma unroll
            for (int j = 0; j < 4; ++j) { const v2u qv = *(const LAS v2u*)(QB + tq * QS + d0 + 4 * j); const f32x4_t nv = *(const LAS f32x4_t*)(NS + d0 + 4 * j);
                s += (pg8::bflo(qv.x) * nv[0] + pg8::bfhi(qv.x) * nv[1]) + (pg8::bflo(qv.y) * nv[2] + pg8::bfhi(qv.y) * nv[3]); }
            s += __shfl_xor(s, 1); s += __shfl_xor(s, 2); s += __shfl_xor(s, 4);
            if ((lane & 7) == 0) DI[tq] = s;
        }
        f32x16 accT[2];
#pragma unroll
        for (int tt = 0; tt < 2; ++tt)
#pragma unroll
            for (int r = 0; r < 16; ++r) accT[tt][r] = 0.f;
#pragma unroll
        for (int xi = 0; xi < 4; ++xi)
#pragma unroll
            for (int s = 0; s < 2; ++s) {
                const bf16x8_t a = pack_bf16x8(X[xi][8 * s + 0], X[xi][8 * s + 1], X[xi][8 * s + 2], X[xi][8 * s + 3], X[xi][8 * s + 4], X[xi][8 * s + 5], X[xi][8 * s + 6], X[xi][8 * s + 7]);
#pragma unroll
                for (int tt = 0; tt < 2; ++tt) {
                    const LAS bf16_t* qp = QB + (32 * tt + l31) * QS + 32 * xi + 16 * s + 4 * hh;
                    const bf16x8_t bq = cat_bf16x4(*(const LAS v2u*)qp, *(const LAS v2u*)(qp + 8));
                    accT[tt] = __builtin_amdgcn_mfma_f32_32x32x16_bf16(a, bq, accT[tt], 0, 0, 0);
                }
            }
#pragma unroll
        for (int xi = 0; xi < 4; ++xi) {
#pragma unroll
            for (int r = 0; r < 16; ++r) X[xi][r] *= dec;
#pragma unroll
            for (int ks = 0; ks < 4; ++ks) {
                const bf16x8_t a = *(const LAS bf16x8_t*)(KB + (32 * xi + l31) * VS + 16 * ks + 8 * hh), bv = *(const LAS bf16x8_t*)(VB + (32 * w + l31) * VS + 16 * ks + 8 * hh);
                X[xi] = __builtin_amdgcn_mfma_f32_32x32x16_bf16(a, bv, X[xi], 0, 0, 0);
            }
        }
        __syncthreads();
        if (tid < 128) NS[tid] = dec * NS[tid] + sloc * nl_cur;
        v2u gg[2][4];
#pragma unroll
        for (int tt = 0; tt < 2; ++tt)
#pragma unroll
            for (int g4 = 0; g4 < 4; ++g4) gg[tt][g4] = *(const v2u*)(U + (row0 + 32 * tt + l31) * 6144 + 4096 + h * 256 + 32 * w + 8 * g4 + 4 * hh);
        float hv[2][16], rsn[2];
#pragma unroll
        for (int tt = 0; tt < 2; ++tt) {
            const int t = 32 * tt + l31;
            const float bcs = st[tt][0], mloc = st[tt][1], dloc = st[tt][2];
            const float mt = fmaxf(mloc, bcs + m_st), gi = __expf(bcs + m_st - mt), gl = __expf(mloc - mt);
            const float den = gi * DI[t] + gl * dloc, inv = 1.f / fmaxf(fabsf(den), __expf(-mt));
            float ss = 0.f;
#pragma unroll
            for (int g4 = 0; g4 < 4; ++g4) {
                const float n0 = pg8::bflo(nm[tt][g4].x), n1 = pg8::bfhi(nm[tt][g4].x), n2 = pg8::bflo(nm[tt][g4].y), n3 = pg8::bfhi(nm[tt][g4].y);
                hv[tt][4 * g4 + 0] = (gi * accT[tt][4 * g4 + 0] + gl * n0) * inv; hv[tt][4 * g4 + 1] = (gi * accT[tt][4 * g4 + 1] + gl * n1) * inv;
                hv[tt][4 * g4 + 2] = (gi * accT[tt][4 * g4 + 2] + gl * n2) * inv; hv[tt][4 * g4 + 3] = (gi * accT[tt][4 * g4 + 3] + gl * n3) * inv;
                ss += (hv[tt][4 * g4 + 0] * hv[tt][4 * g4 + 0] + hv[tt][4 * g4 + 1] * hv[tt][4 * g4 + 1]) + (hv[tt][4 * g4 + 2] * hv[tt][4 * g4 + 2] + hv[tt][4 * g4 + 3] * hv[tt][4 * g4 + 3]);
            }
            ss += __shfl_xor(ss, 32);
            if (hh == 0) SSQ[w * 64 + t] = ss;
        }
        __syncthreads();
#pragma unroll
        for (int tt = 0; tt < 2; ++tt) {
            const int t = 32 * tt + l31; float tot = 0.f;
#pragma unroll
            for (int ww = 0; ww < 8; ++ww) tot += SSQ[ww * 64 + t];
            rsn[tt] = rsqrtf(tot * (1.f / 256.f) + EPS);
#pragma unroll
            for (int g4 = 0; g4 < 4; ++g4) {
                const f32x4_t cn = *(const f32x4_t*)(c_norm + h * 256 + 32 * w + 8 * g4 + 4 * hh);
                const float y0 = hv[tt][4 * g4 + 0] * rsn[tt] * cn[0] * pg8::bflo(gg[tt][g4].x), y1 = hv[tt][4 * g4 + 1] * rsn[tt] * cn[1] * pg8::bfhi(gg[tt][g4].x);
                const float y2 = hv[tt][4 * g4 + 2] * rsn[tt] * cn[2] * pg8::bflo(gg[tt][g4].y), y3 = hv[tt][4 * g4 + 3] * rsn[tt] * cn[3] * pg8::bfhi(gg[tt][g4].y);
                v2u yw; yw.x = pg8::cvt_pk_bf16(y0, y1); yw.y = pg8::cvt_pk_bf16(y2, y3);
                *(v2u*)(Y + (row0 + t) * D + h * 256 + 32 * w + 8 * g4 + 4 * hh) = yw;
            }
        }
    }
    __syncthreads();
}

enum { PH_P0 = 0, PH_IN0, PH_MIX0A, PH_MIX0B, PH_OUT0, PH_GATE0, PH_IN1, PH_MIX1A, PH_MIX1B, PH_OUT1, PH_GATE1, PH_FINAL, PH_END };

__global__ void __launch_bounds__(NWAVES * 64, 2) mk_fwd(Ptrs args) {
    extern __shared__ __attribute__((aligned(16))) unsigned char lds_raw[];
    Frame F;
    F.lds = (LAS unsigned char*)lds_raw;
    F.tid = threadIdx.x; F.lane = F.tid & 63; F.wave = __builtin_amdgcn_readfirstlane(F.tid >> 6);
    F.G = gridDim.x; F.bid = blockIdx.x; F.in = args.in; F.out = args.out; F.ws = args.ws;
    volatile LAS unsigned* MISC = (volatile LAS unsigned*)(F.lds + MISC_OFF);
    if (F.tid < 32) MISC[F.tid] = 0u;
    __syncthreads();
    XcdBarrier bar = xcd_barrier_post((unsigned*)(F.ws + OFF_CTL) + CW_BAR + args.li * XCD_BAR_WORDS, MISC + 8);
    const int lo = args.ph_lo, hi = args.ph_hi;
#define IN_(k) (lo <= (k) && (k) < hi)
#define SEAM(k) do { if (IN_(k) && IN_((k) + 1)) xcd_barrier(bar); } while (0)
    unsigned char* ws = F.ws;
    bf16_t* A = (bf16_t*)(ws + OFF_A); bf16_t* B = (bf16_t*)(ws + OFF_B); bf16_t* U = (bf16_t*)(ws + OFF_U);
    float* plpart = (float*)(ws + OFF_PART); float* hpart = plpart + (size_t)M * 32;
    const bf16_t* P16 = (const bf16_t*)(ws + OFF_WIN0); bf16_t* PL = U;
    const bf16_t* PLEW = (const bf16_t*)(ws + OFF_PLEW);

    if (IN_(PH_P0)) { p0_prologue(F); } SEAM(PH_P0);
    if (IN_(PH_IN0)) {
        pg8::Gemm g{A, (const bf16_t*)(ws + OFF_WIN0), M, 6144, 2048}; pg8::StaticOrder So; So.init(M, 6144, F.G, F.bid);
        pg8::EpiIn0 E{U, (const float*)(ws + OFF_SMALL) + 1024};
        pg8::gemm_phase<pg8::EpiIn0, pg8::StaticOrder, true, true>(F.lds, g, So, E);
    } SEAM(PH_IN0);
    if (IN_(PH_MIX0A)) { cvt_p_phase(F);
        for (int it = F.bid; it < 1024; it += F.G) hgrn2_a_item(F, it >> 8, (it >> 3) & 31, it & 7);
        for (int it = F.bid; it < 1024; it += F.G) rglru_a_item(F, it >> 8, (it >> 3) & 31, it & 7); }
    SEAM(PH_MIX0A);
    if (IN_(PH_MIX0B)) { if (F.bid < 32) hgrn2_b_phase(F, F.bid >> 3, F.bid & 7); else for (int it = F.bid - 32; it < 1024; it += F.G - 32) rglru_b_item(F, it >> 8, (it >> 3) & 31, it & 7); }
    SEAM(PH_MIX0B);
    if (IN_(PH_OUT0)) {
        { pg8::Gemm g{A, (const bf16_t*)(ws + OFF_WOUT0), M, 2048, 2048}; pg8::StaticOrder So; So.init(M, 2048, F.G, F.bid);
          pg8::EpiOut E{F.in[0], F.out, B};
          pg8::gemm_phase<pg8::EpiOut, pg8::StaticOrder, true, true>(F.lds, g, So, E); }
        { pg8::Gemm g{P16, PLEW, M, 2048, 256}; pg8::StaticOrder So; So.init(M, 2048, F.G, F.bid);
          pg8::EpiPle E{PL, plpart};
          pg8::gemm_phase<pg8::EpiPle, pg8::StaticOrder, true, true>(F.lds, g, So, E); }
    } SEAM(PH_OUT0);
    if (IN_(PH_GATE0)) {
        pg8::Gemm g{B, (const bf16_t*)(ws + OFF_WG0), M, 2048, 2048}; pg8::StaticOrder So; So.init(M, 2048, F.G, F.bid);
        pg8::EpiGate E{F.out, A, PL, plpart, F.in[23], hpart};
        pg8::gemm_phase<pg8::EpiGate, pg8::StaticOrder, true, true>(F.lds, g, So, E);
    } SEAM(PH_GATE0);
    if (IN_(PH_IN1)) {
        pg8::Gemm g{A, (const bf16_t*)(ws + OFF_WIN1), M, 8192, 2048}; pg8::StaticOrder So; So.init(M, 8192, F.G, F.bid);
        pg8::EpiIn1 E{U, hpart};
        pg8::gemm_phase<pg8::EpiIn1, pg8::StaticOrder, true, true>(F.lds, g, So, E);
        gates1_phase(F);
    } SEAM(PH_IN1);
    if (IN_(PH_MIX1A)) { for (int it = F.bid; it < 1024; it += F.G) mlstm_a_item(F, it >> 8, (it >> 3) & 31, it & 7); }
    SEAM(PH_MIX1A);
    if (IN_(PH_MIX1B)) { if (F.bid < 32) mlstm_b_phase(F, F.bid >> 3, F.bid & 7); }
    SEAM(PH_MIX1B);
    if (IN_(PH_OUT1)) {
        { pg8::Gemm g{B, (const bf16_t*)(ws + OFF_WOUT1), M, 2048, 2048}; pg8::StaticOrder So; So.init(M, 2048, F.G, F.bid);
          pg8::EpiOut E{F.out, F.out, A};
          pg8::gemm_phase<pg8::EpiOut, pg8::StaticOrder, true, true>(F.lds, g, So, E); }
        { pg8::Gemm g{P16 + (size_t)M * PLE, PLEW + (size_t)2048 * 256, M, 2048, 256}; pg8::StaticOrder So; So.init(M, 2048, F.G, F.bid);
          pg8::EpiPle E{PL, plpart};
          pg8::gemm_phase<pg8::EpiPle, pg8::StaticOrder, true, true>(F.lds, g, So, E); }
    } SEAM(PH_OUT1);
    if (IN_(PH_GATE1)) {
        pg8::Gemm g{A, (const bf16_t*)(ws + OFF_WG1), M, 2048, 2048}; pg8::StaticOrder So; So.init(M, 2048, F.G, F.bid);
        pg8::EpiGate E{F.out, nullptr, PL, plpart, F.in[23] + D, hpart};
        pg8::gemm_phase<pg8::EpiGate, pg8::StaticOrder, true, true>(F.lds, g, So, E);
    } SEAM(PH_GATE1);
    if (IN_(PH_FINAL)) final_norm_phase(F);
#undef IN_
#undef SEAM
}

extern "C" void kernel_launch(void* const* d_in, const int* in_sizes, int n_in, void* d_out, int out_size, void* d_ws, size_t ws_size, hipStream_t stream) {
    static int grid = 0;
    if (grid == 0) {
        if (n_in != 26 || ws_size < WS_END || out_size != M * D) { fprintf(stderr, "kernel_launch: unexpected problem (n_in %d, ws %zu, out %d)\n", n_in, ws_size, out_size); grid = -1; return; }
        int dev = 0, cus = 0, per_cu = 0;
        if (hipGetDevice(&dev) != hipSuccess || hipDeviceGetAttribute(&cus, hipDeviceAttributeMultiprocessorCount, dev) != hipSuccess) { grid = -1; return; }
        if (hipFuncSetAttribute((const void*)mk_fwd, hipFuncAttributeMaxDynamicSharedMemorySize, LDS_BYTES) != hipSuccess) { fprintf(stderr, "kernel_launch: hipFuncSetAttribute failed\n"); grid = -1; return; }
        if (hipOccupancyMaxActiveBlocksPerMultiprocessor(&per_cu, (const void*)mk_fwd, NWAVES * 64, LDS_BYTES) != hipSuccess || per_cu < 1) { fprintf(stderr, "kernel_launch: occupancy query says %d blocks per CU\n", per_cu); (void)hipGetLastError(); grid = -1; return; }
        grid = cus;
    }
    if (grid < 0) return;
    (void)hipMemsetAsync((char*)d_ws + OFF_CTL, 0, CTL_ZERO_BYTES, stream);
    Ptrs a{};
    for (int i = 0; i < 26; ++i) a.in[i] = (const float*)d_in[i];
    a.out = (float*)d_out; a.ws = (unsigned char*)d_ws; a.ph_lo = PH_P0; a.ph_hi = PH_END; a.li = 0;
    void* kargs[] = {&a};
    const hipError_t e = hipLaunchCooperativeKernel((const void*)mk_fwd, dim3(grid), dim3(NWAVES * 64), kargs, LDS_BYTES, stream);
    if (e != hipSuccess) fprintf(stderr, "kernel_launch: cooperative launch failed: %s (grid %d)\n", hipGetErrorString(e), grid);
}
```

```cpp
#include <hip/hip_runtime.h>
#include <cstdio>
#include <cstdint>

namespace pg8 {
#define PG8_LAS __attribute__((address_space(3)))
typedef unsigned short bf16_t;
typedef short bf16x8 __attribute__((ext_vector_type(8)));
typedef float f32x4 __attribute__((ext_vector_type(4)));
typedef unsigned u32x4 __attribute__((ext_vector_type(4)));
constexpr int BM = 256, BK = 64, HALF = 128, HTB = HALF * BK * 2  , STAGE_BYTES = 8 * HTB, NXCD = 8, WGM = 8;

__host__ __device__ __forceinline__ int lds_byte(int r, int c) { const int st = (r >> 4) * 2 + (c >> 5), rr = r & 15, cc = c & 31, ob = rr * 64 + cc * 2; return st * 1024 + (ob ^ (((ob >> 9) & 1) << 5)); }
__host__ __device__ __forceinline__ void stage_rc(int b, int& R, int& C) { const int st = b / 1024, sb = b % 1024, swz = sb ^ (((sb >> 9) & 1) << 5); R = (st >> 1) * 16 + swz / 64; C = (st & 1) * 32 + (swz % 64) / 2; }
__host__ __device__ __forceinline__ int perm32(int rho) { const int n = rho >> 4, i = rho & 15; return 8 * (i >> 2) + 4 * n + (i & 3); }

struct Unit { int pm, pn; };
struct Gemm { const bf16_t* A; const bf16_t* Bt; int M, N, K; };

struct StaticOrder {
    int nM, nN, nwg, G, c;
    __host__ __device__ void init(int M, int N, int G_, int c_) { nM = M / BM; nN = N / BM; nwg = nM * nN; G = G_; c = c_; }
    __host__ __device__ bool next(int i, Unit& u) const {
        const long L = (long)i * G + c; if (L >= nwg) return false;
        int wgid = (int)L; { const int q = nwg / NXCD, r = nwg % NXCD, xcd = wgid % NXCD, off = wgid / NXCD; wgid = (xcd < r ? xcd * (q + 1) : r * (q + 1) + (xcd - r) * q) + off; }
        const int nig = WGM * nN, gid = wgid / nig, fm = gid * WGM, gsz = (nM - fm) < WGM ? (nM - fm) : WGM;
        u.pm = fm + ((wgid % nig) % gsz); u.pn = (wgid % nig) / gsz; return true;
    }
    __device__ __forceinline__ void a_ready(const Unit&) const {}
    __device__ __forceinline__ void done(const Unit&) const {}
};

typedef __bf16 bf16v2_t __attribute__((ext_vector_type(2)));
typedef float f32v2_t __attribute__((ext_vector_type(2)));
__device__ __forceinline__ unsigned cvt_pk_bf16(float lo, float hi) { const f32v2_t v = {lo, hi}; return __builtin_bit_cast(unsigned, __builtin_convertvector(v, bf16v2_t)); }
typedef float f32x2 __attribute__((ext_vector_type(2)));
template <class Epi, class Sched, bool ALIGN_EPI = false, bool SP2 = false>
__device__ __forceinline__ void gemm_phase(PG8_LAS unsigned char* lds, const Gemm g, const Sched& S, const Epi& E) {
    const int tid = threadIdx.x, wid = __builtin_amdgcn_readfirstlane(tid >> 6), lane = tid & 63, wr = wid >> 2, wc = wid & 3, fr = lane & 15, fq = lane >> 4;
    const int K = g.K, nt = K / BK;
    unsigned voffA[2], voffB[2];
#pragma unroll
    for (int i = 0; i < 2; ++i) { int R, C; stage_rc(tid * 16 + i * 8192, R, C); const int Rb = Epi::PERM ? ((R & ~31) + perm32(R & 31)) : R;
        voffA[i] = (unsigned)(R * K + C) * 2u; voffB[i] = (unsigned)(Rb * K + C) * 2u; }
    const size_t kstep = (size_t)(BK * 2);
    const size_t hstep = (size_t)HALF * K * 2;
    const size_t tstep = 2 * hstep;
    const unsigned ldsw = (unsigned)wid * 1024u;
    const int aoff = lds_byte(wr * 64 + fr, fq * 8), boff = lds_byte(wc * 32 + fr, fq * 8);
#define PG8_SA(b, h) (((b) * 2 + (h)) * HTB)
#define PG8_SB(b, h) ((4 + (b) * 2 + (h)) * HTB)
#define PG8_STAGE(bufoff, gbase, voff) do { _Pragma("unroll") for (int _i = 0; _i < 2; ++_i) \
        __builtin_amdgcn_global_load_lds((const unsigned*)((const char*)(gbase) + (voff)[_i]), (PG8_LAS unsigned*)(lds + (bufoff) + ldsw + _i * 8192), 16, 0, 0); } while (0)
#define PG8_LDA(dst, b, h) do { _Pragma("unroll") for (int m = 0; m < 4; ++m) _Pragma("unroll") for (int k = 0; k < 2; ++k) dst[m][k] = *(const PG8_LAS bf16x8*)(lds + PG8_SA(b, h) + aoff + m * 2048 + k * 1024); } while (0)
#define PG8_LDB(dst, b, h) do { _Pragma("unroll") for (int n = 0; n < 2; ++n) _Pragma("unroll") for (int k = 0; k < 2; ++k) dst[n][k] = *(const PG8_LAS bf16x8*)(lds + PG8_SB(b, h) + boff + n * 2048 + k * 1024); } while (0)
#define PG8_MMA(ai, bj, At, Bt) do { __builtin_amdgcn_s_setprio(1); _Pragma("unroll") for (int m = 0; m < 4; ++m) _Pragma("unroll") for (int n = 0; n < 2; ++n) _Pragma("unroll") for (int k = 0; k < 2; ++k) \
        acc[ai][bj][m][n] = __builtin_amdgcn_mfma_f32_16x16x32_bf16(Bt[n][k], At[m][k], acc[ai][bj][m][n], 0, 0, 0); __builtin_amdgcn_s_setprio(0); } while (0)
#define PG8_WAIT_V(n) asm volatile("s_waitcnt vmcnt(" #n ")" ::: "memory")
#define PG8_WAIT_L(n) asm volatile("s_waitcnt lgkmcnt(" #n ")" ::: "memory")
#define PG8_BAR __builtin_amdgcn_s_barrier()
#define PG8_SCHED __builtin_amdgcn_sched_barrier(0)
    Unit cur, nxt; int ui = 0;
    if (!S.next(0, cur)) return;
    f32x4 acc[2][2][4][2];
#pragma unroll
    for (int a = 0; a < 2; ++a)
#pragma unroll
        for (int b = 0; b < 2; ++b)
#pragma unroll
            for (int m = 0; m < 4; ++m)
#pragma unroll
                for (int n = 0; n < 2; ++n) acc[a][b][m][n] = (f32x4){0.f, 0.f, 0.f, 0.f};
    bf16x8 At[4][2], B0[2][2], B1[2][2];
    const char* cA = (const char*)g.A + (size_t)cur.pm * tstep; const char* cB = (const char*)g.Bt + (size_t)cur.pn * tstep;
    S.a_ready(cur);
    if constexpr (SP2) {
        PG8_STAGE(PG8_SB(0, 0), cB, voffB); PG8_STAGE(PG8_SB(0, 1), cB + hstep, voffB); PG8_STAGE(PG8_SA(0, 0), cA, voffA); PG8_STAGE(PG8_SA(0, 1), cA + hstep, voffA);
        if (wr == 1) PG8_BAR;
        PG8_WAIT_V(2); PG8_BAR;
        PG8_STAGE(PG8_SB(1, 0), cB + kstep, voffB); PG8_STAGE(PG8_SA(1, 0), cA + kstep, voffA); PG8_STAGE(PG8_SB(1, 1), cB + hstep + kstep, voffB);
        PG8_WAIT_V(6); PG8_BAR;
    } else {
        PG8_STAGE(PG8_SB(0, 0), cB, voffB); PG8_STAGE(PG8_SA(0, 0), cA, voffA); PG8_STAGE(PG8_SB(0, 1), cB + hstep, voffB); PG8_STAGE(PG8_SA(0, 1), cA + hstep, voffA);
        if (wr == 1) PG8_BAR;
        PG8_WAIT_V(4); PG8_BAR;
        PG8_STAGE(PG8_SB(1, 0), cB + kstep, voffB); PG8_STAGE(PG8_SA(1, 0), cA + kstep, voffA); PG8_STAGE(PG8_SB(1, 1), cB + hstep + kstep, voffB);
        PG8_WAIT_V(6); PG8_BAR;
    }
    for (;;) {
        const bool has_next = S.next(ui + 1, nxt);
        const char* nA = has_next ? (const char*)g.A + (size_t)nxt.pm * tstep : cA; const char* nB = has_next ? (const char*)g.Bt + (size_t)nxt.pn * tstep : cB;
        for (int t = 0; t < nt; t += 2) {
            const bool last = (t == nt - 2);
            const char* a1 = cA + (size_t)(t + 1) * kstep;
            const char* a2 = last ? nA : cA + (size_t)(t + 2) * kstep; const char* b2 = last ? nB : cB + (size_t)(t + 2) * kstep;
            const char* a3 = a2 + kstep; const char* b3 = b2 + kstep;
            if (last && has_next) S.a_ready(nxt);
            if constexpr (SP2) {
            PG8_LDB(B0, 0, 0); PG8_LDB(B1, 0, 1); PG8_SCHED; PG8_LDA(At, 0, 0); PG8_STAGE(PG8_SA(1, 1), a1 + hstep, voffA);
            PG8_WAIT_V(8); PG8_WAIT_L(0); PG8_BAR; PG8_MMA(0, 0, At, B0); PG8_MMA(0, 1, At, B1); PG8_BAR; PG8_SCHED;
            PG8_LDA(At, 0, 1); PG8_STAGE(PG8_SB(0, 0), b2, voffB); PG8_STAGE(PG8_SB(0, 1), b2 + hstep, voffB); PG8_STAGE(PG8_SA(0, 0), a2, voffA);
            PG8_WAIT_V(8); PG8_WAIT_L(0); PG8_BAR; PG8_MMA(1, 0, At, B0); PG8_MMA(1, 1, At, B1); PG8_BAR; PG8_SCHED;
            PG8_LDB(B0, 1, 0); PG8_LDB(B1, 1, 1); PG8_SCHED; PG8_LDA(At, 1, 0); PG8_STAGE(PG8_SA(0, 1), a2 + hstep, voffA);
            PG8_WAIT_V(8); PG8_WAIT_L(0); PG8_BAR; PG8_MMA(0, 0, At, B0); PG8_MMA(0, 1, At, B1); PG8_BAR; PG8_SCHED;
            PG8_LDA(At, 1, 1); PG8_STAGE(PG8_SB(1, 0), b3, voffB); PG8_STAGE(PG8_SB(1, 1), b3 + hstep, voffB); PG8_STAGE(PG8_SA(1, 0), a3, voffA);
            PG8_WAIT_V(8); PG8_WAIT_L(0); PG8_BAR; PG8_MMA(1, 0, At, B0); PG8_MMA(1, 1, At, B1); PG8_BAR; PG8_SCHED;
            } else {
            PG8_LDB(B0, 0, 0); PG8_SCHED; PG8_LDA(At, 0, 0); PG8_STAGE(PG8_SA(1, 1), a1 + hstep, voffA);
            PG8_WAIT_L(8); PG8_BAR; PG8_WAIT_L(0); PG8_MMA(0, 0, At, B0); PG8_BAR; PG8_SCHED;
            PG8_LDB(B1, 0, 1); PG8_STAGE(PG8_SB(0, 0), b2, voffB);
            PG8_BAR; PG8_WAIT_L(0); PG8_MMA(0, 1, At, B1); PG8_BAR;
            PG8_LDA(At, 0, 1); PG8_STAGE(PG8_SA(0, 0), a2, voffA);
            PG8_BAR; PG8_WAIT_L(0); PG8_MMA(1, 0, At, B0); PG8_BAR; PG8_SCHED;
            PG8_STAGE(PG8_SB(0, 1), b2 + hstep, voffB);
            PG8_WAIT_V(6); PG8_BAR; PG8_MMA(1, 1, At, B1); PG8_BAR;
            PG8_LDB(B0, 1, 0); PG8_SCHED; PG8_LDA(At, 1, 0); PG8_STAGE(PG8_SA(0, 1), a2 + hstep, voffA);
            PG8_WAIT_L(8); PG8_BAR; PG8_WAIT_L(0); PG8_MMA(0, 0, At, B0); PG8_BAR; PG8_SCHED;
            PG8_LDB(B1, 1, 1); PG8_STAGE(PG8_SB(1, 0), b3, voffB);
            PG8_BAR; PG8_WAIT_L(0); PG8_MMA(0, 1, At, B1); PG8_BAR;
            PG8_LDA(At, 1, 1); PG8_STAGE(PG8_SA(1, 0), a3, voffA);
            PG8_BAR; PG8_WAIT_L(0); PG8_MMA(1, 0, At, B0); PG8_BAR; PG8_SCHED;
            PG8_STAGE(PG8_SB(1, 1), b3 + hstep, voffB);
            PG8_WAIT_V(6); PG8_BAR; PG8_MMA(1, 1, At, B1); PG8_BAR;
            }
        }
        if constexpr (ALIGN_EPI) { if (wr == 0) PG8_BAR; }
        if constexpr (!Epi::AFTER_DRAIN) { E(acc, cur, wr, wc, fr, fq); S.done(cur); }
        if (!has_next) break;
#pragma unroll
        for (int a = 0; a < 2; ++a)
#pragma unroll
            for (int b = 0; b < 2; ++b)
#pragma unroll
                for (int m = 0; m < 4; ++m)
#pragma unroll
                    for (int n = 0; n < 2; ++n) acc[a][b][m][n] = (f32x4){0.f, 0.f, 0.f, 0.f};
        cur = nxt; cA = nA; cB = nB; ++ui;
        if constexpr (ALIGN_EPI) { if (wr == 1) PG8_BAR; }
    }
    PG8_WAIT_V(0);
    if constexpr (!ALIGN_EPI) { if (wr == 0) PG8_BAR; }
    PG8_BAR;
    if constexpr (Epi::AFTER_DRAIN) { E.fused(acc, cur, wr, wc, fr, fq, lds, wid, lane); S.done(cur); }
#undef PG8_SA
#undef PG8_SB
#undef PG8_STAGE
#undef PG8_LDA
#undef PG8_LDB
#undef PG8_MMA
#undef PG8_WAIT_V
#undef PG8_WAIT_L
#undef PG8_BAR
#undef PG8_SCHED
}
}

namespace pg8 {
constexpr float EPSN = 1e-6f;
__device__ __forceinline__ float fsigmoid(float x) { return __builtin_amdgcn_rcpf(1.f + __expf(-x)); }
__device__ __forceinline__ float fsilu(float x) { return x * __builtin_amdgcn_rcpf(1.f + __expf(-x)); }
__device__ __forceinline__ float row_stat32(const float* part, int row, int fq) {
    const f32x4 a = *(const f32x4*)(part + (size_t)row * 32 + 8 * fq), b = *(const f32x4*)(part + (size_t)row * 32 + 8 * fq + 4);
    float s = ((a.x + a.y) + (a.z + a.w)) + ((b.x + b.y) + (b.z + b.w));
    s += __shfl_xor(s, 16); s += __shfl_xor(s, 32); return s;
}
__device__ __forceinline__ u32x4 pack8(const f32x4 v0, const f32x4 v1) { u32x4 w; w.x = cvt_pk_bf16(v0[0], v0[1]); w.y = cvt_pk_bf16(v0[2], v0[3]); w.z = cvt_pk_bf16(v1[0], v1[1]); w.w = cvt_pk_bf16(v1[2], v1[3]); return w; }
__device__ __forceinline__ float bflo(unsigned w) { return __uint_as_float(w << 16); }
__device__ __forceinline__ float bfhi(unsigned w) { return __uint_as_float(w & 0xffff0000u); }

struct EpiIn0 {
    static constexpr bool PERM = true, AFTER_DRAIN = false;
    bf16_t* U; const float* rstd; int dry;
    __device__ __forceinline__ void operator()(const f32x4 (&acc)[2][2][4][2], const Unit& u, int wr, int wc, int fr, int fq) const {
        if (dry) return;
        const int row0 = u.pm * BM + wr * 64 + fr, col0 = u.pn * BM + wc * 32 + 8 * fq;
#pragma unroll
        for (int ai = 0; ai < 2; ++ai)
#pragma unroll
            for (int m = 0; m < 4; ++m) { const int row = row0 + ai * HALF + m * 16; const float sc = rstd[row]; bf16_t* rowp = U + (size_t)row * 6144 + col0;
#pragma unroll
                for (int bj = 0; bj < 2; ++bj) *(u32x4*)(rowp + bj * HALF) = pack8(acc[ai][bj][m][0] * sc, acc[ai][bj][m][1] * sc); }
    }
};
struct EpiIn1 {
    static constexpr bool PERM = true, AFTER_DRAIN = false;
    bf16_t* U; const float* hpart; int dry;
    __device__ __forceinline__ void operator()(const f32x4 (&acc)[2][2][4][2], const Unit& u, int wr, int wc, int fr, int fq) const {
        if (dry) return;
        const int row0 = u.pm * BM + wr * 64 + fr;
        if (u.pn < 16) {
            const int col0 = u.pn * BM + wc * 32 + 8 * fq;
#pragma unroll
            for (int ai = 0; ai < 2; ++ai)
#pragma unroll
                for (int m = 0; m < 4; ++m) { const int row = row0 + ai * HALF + m * 16; const float sc = rsqrtf(row_stat32(hpart, row, fq) * (1.f / 2048.f) + EPSN); bf16_t* rowp = U + (size_t)row * 6144 + col0;
#pragma unroll
                    for (int bj = 0; bj < 2; ++bj) *(u32x4*)(rowp + bj * HALF) = pack8(acc[ai][bj][m][0] * sc, acc[ai][bj][m][1] * sc); }
        } else {
            const int col0 = 4096 + 128 * (u.pn - 16) + wc * 32 + 8 * fq;
#pragma unroll
            for (int ai = 0; ai < 2; ++ai)
#pragma unroll
                for (int m = 0; m < 4; ++m) { const int row = row0 + ai * HALF + m * 16; const float sc = rsqrtf(row_stat32(hpart, row, fq) * (1.f / 2048.f) + EPSN);
                    f32x4 g0, g1;
#pragma unroll
                    for (int j = 0; j < 4; ++j) { g0[j] = fsigmoid(acc[ai][0][m][0][j] * sc) * fsilu(acc[ai][1][m][0][j] * sc); g1[j] = fsigmoid(acc[ai][0][m][1][j] * sc) * fsilu(acc[ai][1][m][1][j] * sc); }
                    *(u32x4*)(U + (size_t)row * 6144 + col0) = pack8(g0, g1); }
        }
    }
};
struct EpiOut {
    static constexpr bool PERM = true, AFTER_DRAIN = false;
    const float* base; float* out; bf16_t* h16; int dry;
    __device__ __forceinline__ void operator()(const f32x4 (&acc)[2][2][4][2], const Unit& u, int wr, int wc, int fr, int fq) const {
        if (dry) return;
        const int row0 = u.pm * BM + wr * 64 + fr, col0 = u.pn * BM + wc * 32 + 8 * fq;
#pragma unroll
        for (int ai = 0; ai < 2; ++ai)
#pragma unroll
            for (int m = 0; m < 4; ++m) { const size_t off = (size_t)(row0 + ai * HALF + m * 16) * 2048 + col0;
#pragma unroll
                for (int bj = 0; bj < 2; ++bj) { const f32x4 h0 = *(const f32x4*)(base + off + bj * HALF) + acc[ai][bj][m][0], h1 = *(const f32x4*)(base + off + bj * HALF + 4) + acc[ai][bj][m][1];
                    *(f32x4*)(out + off + bj * HALF) = h0; *(f32x4*)(out + off + bj * HALF + 4) = h1; *(u32x4*)(h16 + off + bj * HALF) = pack8(h0, h1); }
                asm volatile("" ::: "memory"); }
    }
};
struct EpiPle {
    static constexpr bool PERM = true, AFTER_DRAIN = false;
    bf16_t* PL; float* plpart; int dry;
    __device__ __forceinline__ void operator()(const f32x4 (&acc)[2][2][4][2], const Unit& u, int wr, int wc, int fr, int fq) const {
        if (dry) return;
        const int row0 = u.pm * BM + wr * 64 + fr, col0 = u.pn * BM + wc * 32 + 8 * fq;
#pragma unroll
        for (int ai = 0; ai < 2; ++ai)
#pragma unroll
            for (int m = 0; m < 4; ++m) { const int row = row0 + ai * HALF + m * 16; float s = 0.f;
#pragma unroll
                for (int bj = 0; bj < 2; ++bj) { const f32x4 v0 = acc[ai][bj][m][0], v1 = acc[ai][bj][m][1];
                    s += ((v0[0] * v0[0] + v0[1] * v0[1]) + (v0[2] * v0[2] + v0[3] * v0[3])) + ((v1[0] * v1[0] + v1[1] * v1[1]) + (v1[2] * v1[2] + v1[3] * v1[3]));
                    *(u32x4*)(PL + (size_t)row * 2048 + col0 + bj * HALF) = pack8(v0, v1); }
                s += __shfl_xor(s, 16); s += __shfl_xor(s, 32);
                if (fq == 0) plpart[(size_t)row * 32 + u.pn * 4 + wc] = s; }
    }
};
struct EpiGate {
    static constexpr bool PERM = true, AFTER_DRAIN = false;
    float* out; bf16_t* h16; const bf16_t* PL; const float* plpart; const float* ple_norm; float* hpart; int dry;
    __device__ __forceinline__ void operator()(const f32x4 (&acc)[2][2][4][2], const Unit& u, int wr, int wc, int fr, int fq) const {
        if (dry) return;
        const int row0 = u.pm * BM + wr * 64 + fr, col0 = u.pn * BM + wc * 32 + 8 * fq;
        f32x4 pn[2][2];
#pragma unroll
        for (int bj = 0; bj < 2; ++bj) { pn[bj][0] = *(const f32x4*)(ple_norm + col0 + bj * HALF); pn[bj][1] = *(const f32x4*)(ple_norm + col0 + bj * HALF + 4); }
#pragma unroll
        for (int ai = 0; ai < 2; ++ai)
#pragma unroll
            for (int m = 0; m < 4; ++m) { const int row = row0 + ai * HALF + m * 16; const size_t off = (size_t)row * 2048 + col0;
                const float rs = rsqrtf(row_stat32(plpart, row, fq) * (1.f / 2048.f) + EPSN); float s = 0.f;
#pragma unroll
                for (int bj = 0; bj < 2; ++bj) { const u32x4 pw = *(const u32x4*)(PL + off + bj * HALF);
                    const f32x4 p0 = (f32x4){bflo(pw.x), bfhi(pw.x), bflo(pw.y), bfhi(pw.y)} * pn[bj][0] * rs, p1 = (f32x4){bflo(pw.z), bfhi(pw.z), bflo(pw.w), bfhi(pw.w)} * pn[bj][1] * rs;
                    f32x4 h0 = *(const f32x4*)(out + off + bj * HALF), h1 = *(const f32x4*)(out + off + bj * HALF + 4);
#pragma unroll
                    for (int j = 0; j < 4; ++j) { h0[j] += fsigmoid(acc[ai][bj][m][0][j]) * p0[j]; h1[j] += fsigmoid(acc[ai][bj][m][1][j]) * p1[j]; }
                    *(f32x4*)(out + off + bj * HALF) = h0; *(f32x4*)(out + off + bj * HALF + 4) = h1;
                    if (h16) *(u32x4*)(h16 + off + bj * HALF) = pack8(h0, h1);
                    s += ((h0[0] * h0[0] + h0[1] * h0[1]) + (h0[2] * h0[2] + h0[3] * h0[3])) + ((h1[0] * h1[0] + h1[1] * h1[1]) + (h1[2] * h1[2] + h1[3] * h1[3])); }
                s += __shfl_xor(s, 16); s += __shfl_xor(s, 32);
                if (fq == 0) hpart[(size_t)row * 32 + u.pn * 4 + wc] = s;
                asm volatile("" ::: "memory"); }
    }
};
}

constexpr int NWAVES = 8;
constexpr int NB = 4, S = 2048, D = 2048, M = NB * S, PLE = 256;
constexpr float EPS = 1e-6f;
typedef unsigned short bf16_t;
typedef float f32x4 __attribute__((ext_vector_type(4)));
typedef unsigned v4u __attribute__((ext_vector_type(4)));
typedef unsigned v2u __attribute__((ext_vector_type(2)));

constexpr size_t MiB = 1u << 20;
constexpr size_t OFF_CTL = 0, CTL_ZERO_BYTES = 1 * MiB;
constexpr size_t OFF_WIN0 = 1 * MiB;
constexpr size_t OFF_WOUT0 = 25 * MiB;
constexpr size_t OFF_WG0 = 33 * MiB;
constexpr size_t OFF_WIN1 = 41 * MiB;
constexpr size_t OFF_WOUT1 = 73 * MiB;
constexpr size_t OFF_WG1 = 81 * MiB;
constexpr size_t OFF_PLEW = 89 * MiB;
constexpr size_t OFF_WGATE1 = 91 * MiB;
constexpr size_t OFF_SMALL = 91 * MiB + 65536;
constexpr size_t OFF_GATES1 = 92 * MiB;
constexpr size_t OFF_PART = 92 * MiB + 524288;
constexpr size_t OFF_A = 95 * MiB;
constexpr size_t OFF_B = 127 * MiB;
constexpr size_t OFF_U = 159 * MiB;
constexpr size_t WS_END = 255 * MiB;
constexpr size_t OFF_ACUM = OFF_B;
constexpr size_t OFF_CARRY = OFF_B + 17 * MiB;
constexpr size_t OFF_DECAY = OFF_B + 18 * MiB;
constexpr size_t OFF_WRT = OFF_SMALL + 65536;
constexpr int CW_BAR = 4096;

constexpr int RING_BYTES = 131072;
constexpr int MISC_OFF = RING_BYTES + 320;
constexpr int LDS_BYTES = 147456;

#define LAS __attribute__((address_space(3)))
#define GAS __attribute__((address_space(1)))
__device__ __forceinline__ float bf2f(bf16_t b) { return __uint_as_float(((unsigned)b) << 16); }
__device__ __forceinline__ unsigned f2bf(float f) { unsigned u = __float_as_uint(f); return (u + 0x7fffu + ((u >> 16) & 1u)) >> 16; }
__device__ __forceinline__ unsigned pk2(float lo, float hi) { return f2bf(lo) | (f2bf(hi) << 16); }
__device__ __forceinline__ float sigmoidf_(float x) { return 1.f / (1.f + __expf(-x)); }
__device__ __forceinline__ float siluf_(float x) { return x / (1.f + __expf(-x)); }
__device__ __forceinline__ float wave_sum(float v) {
#pragma unroll
    for (int o = 1; o < 64; o <<= 1) v += __shfl_xor(v, o);
    return v;
}
#define LDS_WAIT() asm volatile("s_waitcnt lgkmcnt(0)" ::: "memory")
#define WG_BAR() asm volatile("s_waitcnt lgkmcnt(0)\n\ts_barrier" ::: "memory")
#define XB_TMO      128
#define XB_XCNT(j)  (256  + 64 * (j))
#define XB_XSUB(j)  (1280 + 64 * (j))
#define XB_XGEN(j)  (2304 + 64 * (j))
#define XB_TOP      3328
#define XB_TOPGEN   3392
#define XCD_BAR_WORDS 3456
#define XB_SPIN_CAP (1u << 26)

__device__ __forceinline__ unsigned xb_ld(unsigned* p)              { return __hip_atomic_load(p, __ATOMIC_RELAXED, __HIP_MEMORY_SCOPE_AGENT); }
__device__ __forceinline__ unsigned xb_add(unsigned* p, unsigned v) { return __hip_atomic_fetch_add(p, v, __ATOMIC_RELAXED, __HIP_MEMORY_SCOPE_AGENT); }
__device__ __forceinline__ unsigned xb_xcc_id() { return (unsigned)__builtin_amdgcn_s_getreg((3 << 11) | 20) & 0xFu; }
#define XB_SPIN(cond, bar) do { unsigned _sp = 0; while (cond) { __builtin_amdgcn_s_sleep(1); \
    if ((++_sp & 255u) == 0u) { if (xb_ld(&(bar)[XB_TMO])) break; if (_sp > XB_SPIN_CAP) { atomicAdd(&(bar)[XB_TMO], 1u); break; } } } } while (0)

struct XcdBarrier {
    unsigned* bar; unsigned x;
    volatile LAS unsigned* st;
};

__device__ __forceinline__ XcdBarrier xcd_barrier_post(unsigned* bar, volatile LAS unsigned* st) {
    XcdBarrier b; b.bar = bar; b.x = xb_xcc_id(); b.st = st;
    if (threadIdx.x == 0) (void)xb_add(&bar[XB_XCNT(b.x)], 1u);
    return b;
}
__device__ __forceinline__ void xcd_barrier_complete(unsigned* bar, unsigned x, unsigned& nloc, unsigned& nx) {
    const unsigned G = gridDim.x * gridDim.y * gridDim.z;
    unsigned sum, cnt, mine, sp = 0u;
    for (;;) {
        sum = 0u; cnt = 0u; mine = 0u;
#pragma unroll
        for (unsigned j = 0; j < 16; ++j) { const unsigned c = xb_ld(&bar[XB_XCNT(j)]); sum += c; cnt += (c > 0u) ? 1u : 0u; mine = (j == x) ? c : mine; }
        if (sum == G) break;
        __builtin_amdgcn_s_sleep(1);
        if ((++sp & 255u) == 0u) { if (xb_ld(&bar[XB_TMO])) break; if (sp > XB_SPIN_CAP) { atomicAdd(&bar[XB_TMO], 1u); break; } }
    }
    nloc = mine > 0u ? mine : 1u; nx = cnt > 0u ? cnt : 1u;
}

__device__ __forceinline__ void xcd_barrier(const XcdBarrier& b) {
    asm volatile("s_waitcnt vmcnt(0)" ::: "memory");
    __syncthreads();
    if (threadIdx.x == 0) {
        unsigned* bar = b.bar;
        __builtin_amdgcn_s_waitcnt(0);
        unsigned nloc = b.st[0], nx = b.st[1];
        if (nloc == 0u) { xcd_barrier_complete(bar, b.x, nloc, nx); b.st[0] = nloc; b.st[1] = nx; }
        const unsigned old = xb_add(&bar[XB_XSUB(b.x)], 1u);
        const unsigned gen = old / nloc;
        if (old + 1u == (gen + 1u) * nloc) {
            __builtin_amdgcn_fence(__ATOMIC_RELEASE, "agent");
            asm volatile("s_waitcnt vmcnt(0)" ::: "memory");
            const unsigned og = xb_add(&bar[XB_TOP], 1u);
            const unsigned tg = og / nx;
            if (og + 1u == (tg + 1u) * nx) xb_add(&bar[XB_TOPGEN], 1u);
            else XB_SPIN(xb_ld(&bar[XB_TOPGEN]) == tg, bar);
            __builtin_amdgcn_fence(__ATOMIC_ACQUIRE, "agent");
            xb_add(&bar[XB_XGEN(b.x)], 1u);
            asm volatile("s_waitcnt vmcnt(0)" ::: "memory");
        } else {
            XB_SPIN(xb_ld(&bar[XB_XGEN(b.x)]) == gen, bar);
            __builtin_amdgcn_fence(__ATOMIC_ACQUIRE, "agent");
            asm volatile("s_waitcnt vmcnt(0)" ::: "memory");
        }
    }
    __syncthreads();
}

struct Ptrs {
    const float* in[26]; float* out; unsigned char* ws; int ph_lo, ph_hi, li, dup;
};
__device__ __forceinline__ int srccol_in1(int n) {
    if (n < 4096) return n;
    const int r = n - 4096, j = r >> 8, i = r & 255;
    return i < 128 ? 4096 + 128 * j + i : 6144 + 128 * j + (i - 128);
}
__device__ __forceinline__ void p0_transpose_item(const float* __restrict__ W, int K, int ldw, bf16_t* __restrict__ WT, const float* __restrict__ gain, bool map1, int nblk, LAS float* scr, int item, int lane) {
    const int kb = item / nblk, nb = item % nblk, k0 = 64 * kb, n0 = 32 * nb, s0 = map1 ? srccol_in1(n0) : n0;
    float wv[32];
#pragma unroll
    for (int i = 0; i < 32; ++i) wv[i] = W[(size_t)(k0 + 2 * i + (lane >> 5)) * ldw + s0 + (lane & 31)];
    if (gain) {
#pragma unroll
        for (int i = 0; i < 32; ++i) wv[i] *= gain[k0 + 2 * i + (lane >> 5)];
    }
#pragma unroll
    for (int i = 0; i < 32; ++i) scr[(2 * i + (lane >> 5)) * 33 + (lane & 31)] = wv[i];
    LDS_WAIT(); asm volatile("" ::: "memory");
    const int c = lane & 7;
#pragma unroll
    for (int j = 0; j < 4; ++j) { const int n = (lane >> 3) + 8 * j; const LAS float* s = scr + (8 * c) * 33 + n;
        v4u o; o.x = pk2(s[0 * 33], s[1 * 33]); o.y = pk2(s[2 * 33], s[3 * 33]); o.z = pk2(s[4 * 33], s[5 * 33]); o.w = pk2(s[6 * 33], s[7 * 33]);
        *(v4u*)(WT + (size_t)(n0 + n) * K + k0 + 8 * c) = o; }
    LDS_WAIT(); asm volatile("" ::: "memory");
}
struct Frame {
    LAS unsigned char* lds; int tid, lane, wave, G, bid;
    const float* const* in; float* out; unsigned char* ws;
};
__device__ __forceinline__ void p0_layer1_weights(const Frame& F, int gw, int NGW) {
    LAS float* scr = (LAS float*)(F.lds + F.wave * 16384);
    unsigned char* ws = F.ws;
    const float* o_norm = F.in[14]; const float* o_w_in = F.in[15]; const float* o_w_out = F.in[21]; const float* ple_gate_w = F.in[24];
    constexpr int I_SQ = 32 * 64, I_IN1 = 32 * 256;
    for (int it = gw; it < I_IN1 + 2 * I_SQ; it += NGW) {
        int r = it;
        if (r < I_IN1) { p0_transpose_item(o_w_in, 2048, 8208, (bf16_t*)(ws + OFF_WIN1), o_norm, true, 256, scr, r, F.lane); continue; } r -= I_IN1;
        if (r < I_SQ) { p0_transpose_item(o_w_out, 2048, 2048, (bf16_t*)(ws + OFF_WOUT1), nullptr, false, 64, scr, r, F.lane); continue; } r -= I_SQ;
        p0_transpose_item(ple_gate_w + (size_t)2048 * 2048, 2048, 2048, (bf16_t*)(ws + OFF_WG1), nullptr, false, 64, scr, r, F.lane);
    }
    const int gt = gw * 64 + F.lane, NGT = NGW * 64;
    bf16_t* WGATE1 = (bf16_t*)(ws + OFF_WGATE1);
    for (int i = gt; i < 16 * 2048; i += NGT) { const int j = i >> 11, k = i & 2047; WGATE1[i] = (bf16_t)f2bf(o_w_in[(size_t)k * 8208 + 8192 + j] * o_norm[k]); }
}
__device__ __forceinline__ void p0_prologue(const Frame& F) {
    LAS float* scr = (LAS float*)(F.lds + F.wave * 16384);
    const int gw = F.bid * NWAVES + F.wave, NGW = F.G * NWAVES;
    unsigned char* ws = F.ws;
    const float* e_norm = F.in[2]; const float* e_w_in = F.in[3]; const float* e_w_out = F.in[13]; const float* ple_w = F.in[22]; const float* ple_gate_w = F.in[24];
    constexpr int I_IN0 = 32 * 192, I_SQ = 32 * 64, I_PLE = 4 * 64;
    constexpr int NITEMS = I_IN0 + 2 * I_SQ + 2 * I_PLE;
    for (int it = gw; it < NITEMS; it += NGW) {
        int r = it;
        if (r < I_IN0) { p0_transpose_item(e_w_in, 2048, 6144, (bf16_t*)(ws + OFF_WIN0), e_norm, false, 192, scr, r, F.lane); continue; } r -= I_IN0;
        if (r < I_SQ) { p0_transpose_item(e_w_out, 2048, 2048, (bf16_t*)(ws + OFF_WOUT0), nullptr, false, 64, scr, r, F.lane); continue; } r -= I_SQ;
        if (r < I_SQ) { p0_transpose_item(ple_gate_w, 2048, 2048, (bf16_t*)(ws + OFF_WG0), nullptr, false, 64, scr, r, F.lane); continue; } r -= I_SQ;
        if (r < I_PLE) { p0_transpose_item(ple_w, 256, 2048, (bf16_t*)(ws + OFF_PLEW), nullptr, false, 64, scr, r, F.lane); continue; } r -= I_PLE;
        p0_transpose_item(ple_w + (size_t)256 * 2048, 256, 2048, (bf16_t*)(ws + OFF_PLEW) + (size_t)2048 * 256, nullptr, false, 64, scr, r, F.lane);
    }
    const float* x = F.in[0]; bf16_t* A = (bf16_t*)(ws + OFF_A); float* rstd0 = (float*)(ws + OFF_SMALL) + 1024;
    for (int m = gw; m < M; m += NGW) {
        const f32x4* xr = (const f32x4*)(x + (size_t)m * D) + F.lane; f32x4 v[8]; float s = 0.f;
#pragma unroll
        for (int j = 0; j < 8; ++j) { v[j] = xr[64 * j]; s += (v[j].x * v[j].x + v[j].y * v[j].y) + (v[j].z * v[j].z + v[j].w * v[j].w); }
        s = wave_sum(s);
        v2u* o8 = (v2u*)(A + (size_t)m * D) + F.lane;
#pragma unroll
        for (int j = 0; j < 8; ++j) { v2u w; w.x = pk2(v[j].x, v[j].y); w.y = pk2(v[j].z, v[j].w); o8[64 * j] = w; }
        if (F.lane == 0) rstd0[m] = rsqrtf(s * (1.f / D) + EPS);
    }
    const int gt = F.bid * (NWAVES * 64) + F.tid, NGT = F.G * NWAVES * 64;
    bf16_t* WRT = (bf16_t*)(ws + OFF_WRT); const float* w_r = F.in[8]; const float* w_i = F.in[10];
    for (int i = gt; i < 2 * 131072; i += NGT) { const int j = i & 131071, n = j >> 14, d = (j >> 7) & 127, cc = j & 127; WRT[i] = (bf16_t)f2bf(((i >> 17) ? w_i : w_r)[n * 16384 + cc * 128 + d]); }
    float* lb = (float*)(ws + OFF_SMALL); const float* logits = F.in[4];
    for (int c = gt; c < 1024; c += NGT) lb[c] = 1.f / (1.f + expf(logits[1024 + c] - logits[c]));
}
__device__ __forceinline__ void gates1_phase(const Frame& F, const int dry) {
    const bf16_t* A = (const bf16_t*)(F.ws + OFF_A); const bf16_t* WG = (const bf16_t*)(F.ws + OFF_WGATE1);
    const float* hpart = (const float*)(F.ws + OFF_PART) + (size_t)M * 32; float* gates = (float*)(F.ws + OFF_GATES1);
    const int gw = F.bid * NWAVES + F.wave, NGW = F.G * NWAVES;
    for (int row = gw; row < M; row += NGW) {
        float ss = (F.lane < 32) ? hpart[(size_t)row * 32 + F.lane] : 0.f; ss = wave_sum(ss);
        const float sc = rsqrtf(ss * (1.f / D) + EPS);
        float a[32];
        const v4u* ar = (const v4u*)(A + (size_t)row * D) + F.lane;
#pragma unroll
        for (int j = 0; j < 4; ++j) { const v4u w = ar[64 * j]; a[8 * j + 0] = pg8::bflo(w.x); a[8 * j + 1] = pg8::bfhi(w.x); a[8 * j + 2] = pg8::bflo(w.y); a[8 * j + 3] = pg8::bfhi(w.y);
            a[8 * j + 4] = pg8::bflo(w.z); a[8 * j + 5] = pg8::bfhi(w.z); a[8 * j + 6] = pg8::bflo(w.w); a[8 * j + 7] = pg8::bfhi(w.w); }
        float res = 0.f;
        for (int g = 0; g < 16; ++g) {
            const v4u* wr = (const v4u*)(WG + (size_t)g * D) + F.lane; float s = 0.f;
#pragma unroll
            for (int j = 0; j < 4; ++j) { const v4u w = wr[64 * j];
                s += a[8 * j + 0] * pg8::bflo(w.x) + a[8 * j + 1] * pg8::bfhi(w.x) + a[8 * j + 2] * pg8::bflo(w.y) + a[8 * j + 3] * pg8::bfhi(w.y)
                   + a[8 * j + 4] * pg8::bflo(w.z) + a[8 * j + 5] * pg8::bfhi(w.z) + a[8 * j + 6] * pg8::bflo(w.w) + a[8 * j + 7] * pg8::bfhi(w.w); }
            s = wave_sum(s);
            res = (F.lane == g) ? s * sc : res;
        }
        if (F.lane < 16 && !dry) gates[(size_t)row * 16 + F.lane] = res;
    }
}
__device__ __forceinline__ void final_norm_phase(const Frame& F, const int dry) {
    const float* hpart = (const float*)(F.ws + OFF_PART) + (size_t)M * 32; const float* g = F.in[25];
    const int gw = F.bid * NWAVES + F.wave, NGW = F.G * NWAVES;
    f32x4 gv[8];
#pragma unroll
    for (int j = 0; j < 8; ++j) gv[j] = ((const f32x4*)g)[F.lane + 64 * j];
    for (int row = gw; row < M; row += NGW) {
        float ss = (F.lane < 32) ? hpart[(size_t)row * 32 + F.lane] : 0.f; ss = wave_sum(ss);
        const float rs = rsqrtf(ss * (1.f / D) + EPS);
        f32x4* xr = (f32x4*)(F.out + (size_t)row * D) + F.lane;
#pragma unroll
        for (int j = 0; j < 8; ++j) { f32x4 v = xr[64 * j]; v = v * gv[j] * rs; if (!dry) xr[64 * j] = v; }
    }
}

__device__ __forceinline__ void cvt_p_phase(const Frame& F, const int dry) {
    const float* p = F.in[1]; bf16_t* P16 = (bf16_t*)(F.ws + OFF_WIN0);
    const size_t n4 = (size_t)2 * M * PLE / 4, gt = (size_t)F.bid * (NWAVES * 64) + F.tid, NGT = (size_t)F.G * NWAVES * 64;
    for (size_t i = gt; i < n4; i += NGT) { const f32x4 v = ((const f32x4*)p)[i]; v2u w; w.x = pk2(v.x, v.y); w.y = pk2(v.z, v.w); if (!dry) ((v2u*)P16)[i] = w; }
}
__device__ __forceinline__ void hgrn2_naive_phase(const Frame& F, int b, int h) {
    LAS float* sq = (LAS float*)F.lds; LAS float* sf = sq + 128; LAS float* sk = sf + 128; LAS float* part = sk + 128; LAS float* red = part + 512;
    const bf16_t* U = (const bf16_t*)(F.ws + OFF_U); bf16_t* Y = (bf16_t*)(F.ws + OFF_A);
    const float* lb = (const float*)(F.ws + OFF_SMALL); const float* a_norm = F.in[5];
    const int tid = F.tid, e = tid & 127, qt = tid >> 7;
    float Sr[32];
#pragma unroll
    for (int i = 0; i < 32; ++i) Sr[i] = 0.f;
    const float lbv = lb[h * 128 + e], an = a_norm[h * 128 + e];
    const bf16_t* up = U + (size_t)b * S * 6144 + h * 128 + e;
    bf16_t nqa = up[0], nfa = up[1024], nv = up[2048], nza = up[3072];
    for (int t = 0; t < S; ++t) {
        const float qa = bf2f(nqa), fa = bf2f(nfa), v = bf2f(nv), za = bf2f(nza);
        if (t + 1 < S) { const bf16_t* np = up + (size_t)(t + 1) * 6144; nqa = np[0]; nfa = np[1024]; nv = np[2048]; nza = np[3072]; }
        if (qt == 0) { sq[e] = siluf_(qa); sf[e] = lbv + (1.f - lbv) * sigmoidf_(fa); sk[e] = (1.f - lbv) * sigmoidf_(-fa); }
        __syncthreads();
        float acc = 0.f;
#pragma unroll
        for (int i = 0; i < 32; ++i) { const int d = qt * 32 + i; Sr[i] = sf[d] * Sr[i] + sk[d] * v; acc += Sr[i] * sq[d]; }
        part[qt * 128 + e] = acc;
        __syncthreads();
        const float o = (part[e] + part[128 + e]) + (part[256 + e] + part[384 + e]);
        const float s2 = wave_sum(o * o);
        if ((tid & 63) == 0) red[tid >> 6] = s2;
        __syncthreads();
        const float tot = red[0] + red[1];
        if (qt == 0) Y[((size_t)b * S + t) * D + h * 128 + e] = (bf16_t)f2bf(o * rsqrtf(tot * (1.f / 128) + EPS) * an * siluf_(za));
    }
    __syncthreads();
}
__device__ __forceinline__ void rglru_naive_phase(const Frame& F, int b, int n) {
    LAS float* wr = (LAS float*)F.lds; LAS float* wi = wr + 16384; LAS float* xcs = (LAS float*)(F.lds + MISC_OFF + 256);
    const bf16_t* U = (const bf16_t*)(F.ws + OFF_U); bf16_t* Y = (bf16_t*)(F.ws + OFF_A);
    const float* conv_w = F.in[6]; const float* conv_b = F.in[7]; const float* w_r = F.in[8]; const float* b_r = F.in[9]; const float* w_i = F.in[10]; const float* b_i = F.in[11]; const float* lam = F.in[12];
    const int tid = F.tid, d = tid & 127, ch = n * 128 + d; const bool act = tid < 128;
    for (int i = tid; i < 16384; i += NWAVES * 64) { wr[i] = w_r[n * 16384 + i]; wi[i] = w_i[n * 16384 + i]; }
    const float cw0 = conv_w[ch], cw1 = conv_w[1024 + ch], cw2 = conv_w[2048 + ch], cw3 = conv_w[3072 + ch], cb = conv_b[ch], br = b_r[ch], bi = b_i[ch];
    const float sp = log1pf(expf(-lam[ch]));
    float x1 = 0.f, x2 = 0.f, x3 = 0.f, hst = 0.f;
    const bf16_t* up = U + (size_t)b * S * 6144 + 4096 + ch;
    bf16_t nx = up[0], nz = up[1024];
    __syncthreads();
    for (int t = 0; t < S; ++t) {
        const float xb = bf2f(nx), zb = bf2f(nz);
        if (t + 1 < S) { const bf16_t* np = up + (size_t)(t + 1) * 6144; nx = np[0]; nz = np[1024]; }
        const float xc = cb + cw0 * x3 + cw1 * x2 + cw2 * x1 + cw3 * xb;
        x3 = x2; x2 = x1; x1 = xb;
        if (act) xcs[d] = xc;
        __syncthreads();
        if (act) {
            float ar = br, ai = bi;
#pragma unroll 8
            for (int c = 0; c < 128; ++c) { const float xv = xcs[c]; ar += xv * wr[c * 128 + d]; ai += xv * wi[c * 128 + d]; }
            const float r = sigmoidf_(ar), ig = sigmoidf_(ai), log_a = -8.f * r * sp, a = expf(log_a);
            const float u = sqrtf(-expm1f(2.f * log_a)) * ig * xc;
            hst = a * hst + u;
            Y[((size_t)b * S + t) * D + 1024 + ch] = (bf16_t)f2bf(hst * siluf_(zb));
        }
        __syncthreads();
    }
}
__device__ __forceinline__ void qkconv_phase(const Frame& F) {
    const bf16_t* U = (const bf16_t*)(F.ws + OFF_U); bf16_t* QK = (bf16_t*)(F.ws + OFF_A); const float* cw = F.in[16]; const float* cb = F.in[17];
    const size_t gt = (size_t)F.bid * (NWAVES * 64) + F.tid, NGT = (size_t)F.G * NWAVES * 64;
    for (size_t i = gt; i < (size_t)M * 2048; i += NGT) {
        const int row = (int)(i >> 11), c = (int)(i & 2047), t = row & (S - 1);
        float acc = cb[c];
#pragma unroll
        for (int k = 0; k < 4; ++k) { const int tt = t - 3 + k; if (tt >= 0) acc += cw[k * 2048 + c] * bf2f(U[(size_t)(row - 3 + k) * 6144 + c]); }
        QK[i] = (bf16_t)f2bf(siluf_(acc));
    }
}
__device__ __forceinline__ void mlstm_naive_phase(const Frame& F, int b, int h) {
    LAS float* sq = (LAS float*)F.lds; LAS float* sk = sq + 128; LAS float* sn = sk + 128; LAS float* part = sn + 128; LAS float* red = part + 512;
    const bf16_t* U = (const bf16_t*)(F.ws + OFF_U); const bf16_t* QK = (const bf16_t*)(F.ws + OFF_A); bf16_t* Y = (bf16_t*)(F.ws + OFF_B);
    const float* gates = (const float*)(F.ws + OFF_GATES1); const float* c_norm = F.in[20];
    const int tid = F.tid, e = tid & 255, hf = tid >> 8;
    float C[64];
#pragma unroll
    for (int i = 0; i < 64; ++i) C[i] = 0.f;
    if (tid < 128) sn[tid] = 0.f;
    float m = 0.f;
    const float bi = F.in[18][h], bf = F.in[19][h], cn = c_norm[h * 256 + e];
    const size_t row0 = (size_t)b * S;
    __syncthreads();
    for (int t = 0; t < S; ++t) {
        const size_t row = row0 + t;
        if (tid < 128) sq[tid] = bf2f(QK[row * 2048 + h * 128 + tid]) * 0.08838834764831845f;
        else if (tid < 256) sk[tid - 128] = bf2f(QK[row * 2048 + 1024 + h * 128 + (tid - 128)]);
        const float li = gates[row * 16 + h] + bi, xf = gates[row * 16 + 8 + h] + bf;
        const float lf = fminf(xf, 0.f) - log1pf(expf(-fabsf(xf)));
        const float mn = fmaxf(lf + m, li), ip = expf(li - mn), fp = expf(lf + m - mn);
        m = mn;
        const float v = bf2f(U[row * 6144 + 2048 + h * 256 + e]), g = bf2f(U[row * 6144 + 4096 + h * 256 + e]);
        __syncthreads();
        float num = 0.f;
#pragma unroll
        for (int i = 0; i < 64; ++i) { const int d = hf * 64 + i; C[i] = fp * C[i] + (ip * sk[d]) * v; num += C[i] * sq[d]; }
        part[hf * 256 + e] = num;
        if (tid < 128) sn[tid] = fp * sn[tid] + ip * sk[tid];
        __syncthreads();
        float den = 0.f;
#pragma unroll 8
        for (int d = 0; d < 128; ++d) den += sn[d] * sq[d];
        const float hv = (part[e] + part[256 + e]) / fmaxf(fabsf(den), expf(-m));
        const float s2 = wave_sum(hv * hv);
        if ((tid & 63) == 0) red[tid >> 6] = s2;
        __syncthreads();
        const float tot = (red[0] + red[1]) + (red[2] + red[3]);
        if (hf == 0) Y[row * D + h * 256 + e] = (bf16_t)f2bf(hv * rsqrtf(tot * (1.f / 256) + EPS) * cn * g);
    }
    __syncthreads();
}

typedef short bf16x8_t __attribute__((ext_vector_type(8)));
typedef float f32x16 __attribute__((ext_vector_type(16)));

__device__ __forceinline__ void rglru_a_item(const Frame& F, const int dry, int b, int c, int n) {
    constexpr int XS = 136;
    LAS bf16_t* XT = (LAS bf16_t*)F.lds;
    LAS float* AL = (LAS float*)(F.lds + 17408);
    LAS float* ML = AL + 8192;
    LAS float* AGG = ML + 8192;
    const bf16_t* U = (const bf16_t*)(F.ws + OFF_U); bf16_t* HL = (bf16_t*)(F.ws + OFF_A); bf16_t* AC = (bf16_t*)(F.ws + OFF_ACUM); float* carry = (float*)(F.ws + OFF_CARRY);
    const bf16_t* WRT = (const bf16_t*)(F.ws + OFF_WRT) + (size_t)n * 16384; const bf16_t* WIT = WRT + 8 * 16384;
    const float* conv_w = F.in[6]; const float* conv_b = F.in[7]; const float* b_r = F.in[9]; const float* b_i = F.in[11]; const float* lam = F.in[12];
    const int tid = F.tid, d = tid & 127, q = tid >> 7, ch = n * 128 + d, t0 = c * 64;
    const size_t row0 = (size_t)b * S + t0;
    float xc[16];
    {
        float xv[19];
#pragma unroll
        for (int i = 0; i < 19; ++i) { const int t = t0 + 16 * q - 3 + i; xv[i] = (t >= 0) ? bf2f(U[((size_t)b * S + t) * 6144 + 4096 + ch]) : 0.f; }
        const float cw0 = conv_w[ch], cw1 = conv_w[1024 + ch], cw2 = conv_w[2048 + ch], cw3 = conv_w[3072 + ch], cb = conv_b[ch];
#pragma unroll
        for (int i = 0; i < 16; ++i) { xc[i] = cb + cw0 * xv[i] + cw1 * xv[i + 1] + cw2 * xv[i + 2] + cw3 * xv[i + 3]; XT[(16 * q + i) * XS + d] = (bf16_t)f2bf(xc[i]); }
    }
    WG_BAR();
    {
        const int w = F.wave, tt = w >> 2, db = w & 3, l31 = F.lane & 31, hh = F.lane >> 5;
        f32x16 accR, accI;
#pragma unroll
        for (int r = 0; r < 16; ++r) { accR[r] = 0.f; accI[r] = 0.f; }
        const LAS bf16_t* ap = XT + (32 * tt + l31) * XS + 8 * hh;
        const bf16_t* rp = WRT + (size_t)(32 * db + l31) * 128 + 8 * hh; const bf16_t* ip = WIT + (size_t)(32 * db + l31) * 128 + 8 * hh;
#pragma unroll
        for (int ks = 0; ks < 8; ++ks) {
            const bf16x8_t a = *(const LAS bf16x8_t*)(ap + 16 * ks), br_ = *(const bf16x8_t*)(rp + 16 * ks), bi_ = *(const bf16x8_t*)(ip + 16 * ks);
            accR = __builtin_amdgcn_mfma_f32_32x32x16_bf16(a, br_, accR, 0, 0, 0);
            accI = __builtin_amdgcn_mfma_f32_32x32x16_bf16(a, bi_, accI, 0, 0, 0);
        }
        const int dc = 32 * db + l31, chc = n * 128 + dc;
        const float brv = b_r[chc], biv = b_i[chc], sp = log1pf(expf(-lam[chc]));
#pragma unroll
        for (int r = 0; r < 16; ++r) {
            const int t = 32 * tt + (r & 3) + 8 * (r >> 2) + 4 * hh;
            const float rr = sigmoidf_(accR[r] + brv), ii = sigmoidf_(accI[r] + biv), la = -8.f * rr * sp;
            AL[t * 128 + dc] = __expf(la); ML[t * 128 + dc] = sqrtf(-expm1f(2.f * la)) * ii;
        }
    }
    WG_BAR();
    float hl[16], ac[16];
    {
        float h = 0.f, Ac = 1.f;
#pragma unroll
        for (int i = 0; i < 16; ++i) { const int t = 16 * q + i; const float a = AL[t * 128 + d], u = ML[t * 128 + d] * xc[i]; h = a * h + u; Ac *= a; hl[i] = h; ac[i] = Ac; }
        AGG[(q * 2 + 0) * 128 + d] = Ac; AGG[(q * 2 + 1) * 128 + d] = h;
    }
    WG_BAR();
    {
        float Hp = 0.f, Ap = 1.f;
#pragma unroll
        for (int qq = 0; qq < 3; ++qq) if (qq < q) { const float a = AGG[(qq * 2 + 0) * 128 + d], hh_ = AGG[(qq * 2 + 1) * 128 + d]; Hp = a * Hp + hh_; Ap *= a; }
#pragma unroll
        for (int i = 0; i < 16; ++i) { const size_t row = row0 + 16 * q + i; const float hv = hl[i] + ac[i] * Hp, av = ac[i] * Ap;
            if (!dry) { HL[row * D + 1024 + ch] = (bf16_t)f2bf(hv); AC[row * 1024 + ch] = (bf16_t)f2bf(av); }
            if (q == 3 && i == 15 && !dry) { float* cp = carry + ((size_t)((b * 32 + c) * 8 + n)) * 256; cp[d] = av; cp[128 + d] = hv; } }
    }
    WG_BAR();
}
__device__ __forceinline__ void rglru_b_item(const Frame& F, const int dry, int b, int c, int n) {
    const bf16_t* U = (const bf16_t*)(F.ws + OFF_U); bf16_t* Y = (bf16_t*)(F.ws + OFF_A); const bf16_t* AC = (const bf16_t*)(F.ws + OFF_ACUM); const float* carry = (const float*)(F.ws + OFF_CARRY);
    const int tid = F.tid, d = tid & 127, q = tid >> 7, ch = n * 128 + d;
    float H = 0.f;
    for (int cc = 0; cc < c; ++cc) { const float* cp = carry + ((size_t)((b * 32 + cc) * 8 + n)) * 256; H = cp[d] * H + cp[128 + d]; }
    const size_t row0 = (size_t)b * S + c * 64 + 16 * q;
#pragma unroll 4
    for (int i = 0; i < 16; ++i) { const size_t row = row0 + i;
        const float hl = bf2f(Y[row * D + 1024 + ch]), av = bf2f(AC[row * 1024 + ch]), zb = bf2f(U[row * 6144 + 5120 + ch]);
        const bf16_t yv = (bf16_t)f2bf((hl + av * H) * siluf_(zb)); if (!dry) Y[row * D + 1024 + ch] = yv; }
}

typedef float f32x4_t __attribute__((ext_vector_type(4)));
typedef short bf16x4_t __attribute__((ext_vector_type(4)));
__device__ __forceinline__ bf16x8_t pack_bf16x8(float a0, float a1, float a2, float a3, float a4, float a5, float a6, float a7) {
    v4u w; w.x = pg8::cvt_pk_bf16(a0, a1); w.y = pg8::cvt_pk_bf16(a2, a3); w.z = pg8::cvt_pk_bf16(a4, a5); w.w = pg8::cvt_pk_bf16(a6, a7);
    return __builtin_bit_cast(bf16x8_t, w);
}
__device__ __forceinline__ bf16x8_t cat_bf16x4(v2u lo, v2u hi) { v4u w; w.x = lo.x; w.y = lo.y; w.z = hi.x; w.w = hi.y; return __builtin_bit_cast(bf16x8_t, w); }

__device__ __forceinline__ void hgrn2_a_item(const Frame& F, const int dry, int b, int c, int h) {
    constexpr int QS = 136, VS = 72;
    LAS bf16_t* QT = (LAS bf16_t*)F.lds;
    LAS bf16_t* KT = QT + 64 * QS;
    LAS bf16_t* VT = KT + 64 * QS;
    LAS bf16_t* AT = VT + 128 * VS;
    LAS float* CS = (LAS float*)(AT + 64 * VS);
    bf16_t* U = (bf16_t*)(F.ws + OFF_U); bf16_t* OI = (bf16_t*)(F.ws + OFF_A); float* decay = (float*)(F.ws + OFF_DECAY);
    const float* lb = (const float*)(F.ws + OFF_SMALL);
    const int tid = F.tid, d = tid & 127, q = tid >> 7, t0 = c * 64;
    const size_t row0 = (size_t)b * S + t0;
    {
        const float lbv = lb[h * 128 + d];
        float qa[16], fa[16], vv[16];
        const bf16_t* up = U + (row0 + 16 * q) * 6144 + h * 128 + d;
#pragma unroll
        for (int i = 0; i < 16; ++i) { qa[i] = bf2f(up[(size_t)i * 6144]); fa[i] = bf2f(up[(size_t)i * 6144 + 1024]); vv[i] = bf2f(up[(size_t)i * 6144 + 2048]); }
        float cs[16]; float run = 0.f;
#pragma unroll
        for (int i = 0; i < 16; ++i) { const float f = lbv + (1.f - lbv) * sigmoidf_(fa[i]); run += __logf(f); cs[i] = run; }
        CS[q * 128 + d] = run;
        WG_BAR();
        float off = 0.f, tot = 0.f;
#pragma unroll
        for (int qq = 0; qq < 4; ++qq) { const float v_ = CS[qq * 128 + d]; off += (qq < q) ? v_ : 0.f; tot += v_; }
        float kd[16];
#pragma unroll
        for (int i = 0; i < 16; ++i) { const float bt = off + cs[i], k = (1.f - lbv) * sigmoidf_(-fa[i]);
            QT[(16 * q + i) * QS + d] = (bf16_t)f2bf(siluf_(qa[i]) * __expf(bt)); KT[(16 * q + i) * QS + d] = (bf16_t)f2bf(k * __expf(-bt)); kd[i] = k * __expf(tot - bt); }
        const bf16x8_t k0 = pack_bf16x8(kd[0], kd[1], kd[2], kd[3], kd[4], kd[5], kd[6], kd[7]), k1 = pack_bf16x8(kd[8], kd[9], kd[10], kd[11], kd[12], kd[13], kd[14], kd[15]);
        const bf16x8_t v0 = pack_bf16x8(vv[0], vv[1], vv[2], vv[3], vv[4], vv[5], vv[6], vv[7]), v1 = pack_bf16x8(vv[8], vv[9], vv[10], vv[11], vv[12], vv[13], vv[14], vv[15]);
        *(LAS bf16x8_t*)(VT + d * VS + 16 * q) = v0; *(LAS bf16x8_t*)(VT + d * VS + 16 * q + 8) = v1;
        WG_BAR();
        bf16_t* tp = U + (row0 + (d >> 1)) * 6144 + h * 128 + (d & 1) * 64 + 16 * q;
        if (!dry) { *(bf16x8_t*)(tp + 1024) = k0; *(bf16x8_t*)(tp + 1024 + 8) = k1;
        *(bf16x8_t*)(tp + 2048) = v0; *(bf16x8_t*)(tp + 2048 + 8) = v1; }
        if (q == 0 && !dry) decay[((size_t)((b * 32 + c) * 8 + h)) * 128 + d] = __expf(tot);
    }
    {
        const int w = F.wave, tb = w >> 1, r = F.lane & 15, g = F.lane >> 4;
#pragma unroll
        for (int k2 = 0; k2 < 2; ++k2) {
            const int sb = 2 * (w & 1) + k2;
            f32x4_t acc = {0.f, 0.f, 0.f, 0.f};
            if (sb <= tb) {
#pragma unroll
                for (int ks = 0; ks < 4; ++ks) {
                    const bf16x8_t a = *(const LAS bf16x8_t*)(QT + (16 * tb + r) * QS + 32 * ks + 8 * g), bb = *(const LAS bf16x8_t*)(KT + (16 * sb + r) * QS + 32 * ks + 8 * g);
                    acc = __builtin_amdgcn_mfma_f32_16x16x32_bf16(a, bb, acc, 0, 0, 0);
                }
            }
#pragma unroll
            for (int j = 0; j < 4; ++j) { const int t = 16 * tb + 4 * g + j, s = 16 * sb + r; AT[t * VS + s] = (bf16_t)f2bf(s <= t ? acc[j] : 0.f); }
        }
    }
    WG_BAR();
    {
        const int w = F.wave, th = w >> 2, eb = w & 3, l31 = F.lane & 31, hh = F.lane >> 5;
        f32x16 acc;
#pragma unroll
        for (int r = 0; r < 16; ++r) acc[r] = 0.f;
#pragma unroll
        for (int ks = 0; ks < 4; ++ks) {
            const bf16x8_t a = *(const LAS bf16x8_t*)(AT + (32 * th + l31) * VS + 16 * ks + 8 * hh), bb = *(const LAS bf16x8_t*)(VT + (32 * eb + l31) * VS + 16 * ks + 8 * hh);
            acc = __builtin_amdgcn_mfma_f32_32x32x16_bf16(a, bb, acc, 0, 0, 0);
        }
#pragma unroll
        for (int r = 0; r < 16; ++r) { const int t = 32 * th + (r & 3) + 8 * (r >> 2) + 4 * hh; const bf16_t ov = (bf16_t)f2bf(acc[r]); if (!dry) OI[(row0 + t) * D + h * 128 + 32 * eb + l31] = ov; }
#pragma unroll
        for (int j = 0; j < 2; ++j) { const int p = tid + 512 * j, row = p >> 4, c16 = p & 15; const bf16x8_t qv_ = *(const LAS bf16x8_t*)(QT + row * QS + c16 * 8); if (!dry) *(bf16x8_t*)(U + (row0 + row) * 6144 + h * 128 + c16 * 8) = qv_; }
    }
    WG_BAR();
}

__device__ __forceinline__ void hgrn2_b_phase(const Frame& F, const int dry, int b, int h) {
    constexpr int QS = 132, VS = 72;
    LAS bf16_t* QB = (LAS bf16_t*)F.lds;
    LAS bf16_t* KB = QB + 64 * QS;
    LAS bf16_t* VB = KB + 128 * VS;
    LAS float* DEC = (LAS float*)(VB + 128 * VS);
    bf16_t* U = (bf16_t*)(F.ws + OFF_U); const float* decay = (const float*)(F.ws + OFF_DECAY);
    const int tid = F.tid, w = F.wave, eb = w & 3, dh = w >> 2, l31 = F.lane & 31, hh = F.lane >> 5;
    f32x16 X[2];
#pragma unroll
    for (int xi = 0; xi < 2; ++xi)
#pragma unroll
        for (int r = 0; r < 16; ++r) X[xi][r] = 0.f;
    bf16x8_t pq[2], pk[2], pv[2]; float pdec = 0.f;
    {
        const size_t row0 = (size_t)b * S;
#pragma unroll
        for (int j = 0; j < 2; ++j) { const int p = tid + 512 * j; const bf16_t* up = U + (row0 + (p >> 4)) * 6144 + h * 128 + (p & 15) * 8;
            pq[j] = *(const bf16x8_t*)up; pk[j] = *(const bf16x8_t*)(up + 1024); pv[j] = *(const bf16x8_t*)(up + 2048); }
        if (tid < 128) pdec = decay[((size_t)((b * 32 + 0) * 8 + h)) * 128 + tid];
    }
    for (int c = 0; c < 32; ++c) {
        const size_t row0 = (size_t)b * S + c * 64;
#pragma unroll
        for (int j = 0; j < 2; ++j) { const int p = tid + 512 * j, ur = p >> 4, c16 = p & 15;
            { const v4u w4 = __builtin_bit_cast(v4u, pq[j]); v2u lo, hi; lo.x = w4.x; lo.y = w4.y; hi.x = w4.z; hi.y = w4.w; *(LAS v2u*)(QB + ur * QS + c16 * 8) = lo; *(LAS v2u*)(QB + ur * QS + c16 * 8 + 4) = hi; }
            *(LAS bf16x8_t*)(KB + (2 * ur + (c16 >> 3)) * VS + (c16 & 7) * 8) = pk[j];
            *(LAS bf16x8_t*)(VB + (2 * ur + (c16 >> 3)) * VS + (c16 & 7) * 8) = pv[j]; }
        if (tid < 128) DEC[tid] = pdec;
        WG_BAR();
        if (c + 1 < 32) {
            const size_t rn = row0 + 64;
#pragma unroll
            for (int j = 0; j < 2; ++j) { const int p = tid + 512 * j; const bf16_t* up = U + (rn + (p >> 4)) * 6144 + h * 128 + (p & 15) * 8;
                pq[j] = *(const bf16x8_t*)up; pk[j] = *(const bf16x8_t*)(up + 1024); pv[j] = *(const bf16x8_t*)(up + 2048); }
            if (tid < 128) pdec = decay[((size_t)((b * 32 + c + 1) * 8 + h)) * 128 + tid];
        }
        f32x16 accT[2];
#pragma unroll
        for (int tt = 0; tt < 2; ++tt)
#pragma unroll
            for (int r = 0; r < 16; ++r) accT[tt][r] = 0.f;
#pragma unroll
        for (int xi = 0; xi < 2; ++xi)
#pragma unroll
            for (int s = 0; s < 2; ++s) {
                const bf16x8_t a = pack_bf16x8(X[xi][8 * s + 0], X[xi][8 * s + 1], X[xi][8 * s + 2], X[xi][8 * s + 3], X[xi][8 * s + 4], X[xi][8 * s + 5], X[xi][8 * s + 6], X[xi][8 * s + 7]);
#pragma unroll
                for (int tt = 0; tt < 2; ++tt) {
                    const LAS bf16_t* qp = QB + (32 * tt + l31) * QS + 64 * dh + 32 * xi + 16 * s + 4 * hh;
                    const bf16x8_t bq = cat_bf16x4(*(const LAS v2u*)qp, *(const LAS v2u*)(qp + 8));
                    accT[tt] = __builtin_amdgcn_mfma_f32_32x32x16_bf16(a, bq, accT[tt], 0, 0, 0);
                }
            }
#pragma unroll
        for (int xi = 0; xi < 2; ++xi) {
#pragma unroll
            for (int g4 = 0; g4 < 4; ++g4) { const f32x4_t dv = *(const LAS f32x4_t*)(DEC + 64 * dh + 32 * xi + 8 * g4 + 4 * hh);
                X[xi][4 * g4 + 0] *= dv[0]; X[xi][4 * g4 + 1] *= dv[1]; X[xi][4 * g4 + 2] *= dv[2]; X[xi][4 * g4 + 3] *= dv[3]; }
#pragma unroll
            for (int ks = 0; ks < 4; ++ks) {
                const bf16x8_t a = *(const LAS bf16x8_t*)(KB + (64 * dh + 32 * xi + l31) * VS + 16 * ks + 8 * hh), bv = *(const LAS bf16x8_t*)(VB + (32 * eb + l31) * VS + 16 * ks + 8 * hh);
                X[xi] = __builtin_amdgcn_mfma_f32_32x32x16_bf16(a, bv, X[xi], 0, 0, 0);
            }
        }
#pragma unroll
        for (int tt = 0; tt < 2; ++tt)
#pragma unroll
            for (int g4 = 0; g4 < 4; ++g4) { v2u ow; ow.x = pg8::cvt_pk_bf16(accT[tt][4 * g4 + 0], accT[tt][4 * g4 + 1]); ow.y = pg8::cvt_pk_bf16(accT[tt][4 * g4 + 2], accT[tt][4 * g4 + 3]);
                if (!dry) *(v2u*)(U + (row0 + 32 * tt + l31) * 6144 + 1024 * dh + h * 128 + 32 * eb + 8 * g4 + 4 * hh) = ow; }
        WG_BAR();
    }
}

__device__ __forceinline__ void hgrn2_c_item(const Frame& F, const int dry, int b, int c, int h) {
    const bf16_t* U = (const bf16_t*)(F.ws + OFF_U); bf16_t* Y = (bf16_t*)(F.ws + OFF_A); const float* a_norm = F.in[5];
    const int w = F.wave, l31 = F.lane & 31, hh = F.lane >> 5;
    const size_t row0 = (size_t)b * S + c * 64;
    const f32x4_t an = *(const f32x4_t*)(a_norm + h * 128 + 4 * l31);
    v2u oi[4], p0[4], p1[4], zz[4];
#pragma unroll
    for (int i = 0; i < 4; ++i) { const size_t row = row0 + 8 * w + 2 * i + hh;
        oi[i] = *(const v2u*)(Y + row * D + h * 128 + 4 * l31); p0[i] = *(const v2u*)(U + row * 6144 + h * 128 + 4 * l31);
        p1[i] = *(const v2u*)(U + row * 6144 + 1024 + h * 128 + 4 * l31); zz[i] = *(const v2u*)(U + row * 6144 + 3072 + h * 128 + 4 * l31); }
#pragma unroll
    for (int i = 0; i < 4; ++i) { const size_t row = row0 + 8 * w + 2 * i + hh;
        const float o0 = pg8::bflo(oi[i].x) + pg8::bflo(p0[i].x) + pg8::bflo(p1[i].x), o1 = pg8::bfhi(oi[i].x) + pg8::bfhi(p0[i].x) + pg8::bfhi(p1[i].x);
        const float o2 = pg8::bflo(oi[i].y) + pg8::bflo(p0[i].y) + pg8::bflo(p1[i].y), o3 = pg8::bfhi(oi[i].y) + pg8::bfhi(p0[i].y) + pg8::bfhi(p1[i].y);
        float ss = (o0 * o0 + o1 * o1) + (o2 * o2 + o3 * o3);
        ss += __shfl_xor(ss, 1); ss += __shfl_xor(ss, 2); ss += __shfl_xor(ss, 4); ss += __shfl_xor(ss, 8); ss += __shfl_xor(ss, 16);
        const float rs = rsqrtf(ss * (1.f / 128.f) + EPS);
        v2u yw; yw.x = pg8::cvt_pk_bf16(o0 * rs * an[0] * siluf_(pg8::bflo(zz[i].x)), o1 * rs * an[1] * siluf_(pg8::bfhi(zz[i].x)));
        yw.y = pg8::cvt_pk_bf16(o2 * rs * an[2] * siluf_(pg8::bflo(zz[i].y)), o3 * rs * an[3] * siluf_(pg8::bfhi(zz[i].y)));
        if (!dry) *(v2u*)(Y + row * D + h * 128 + 4 * l31) = yw; }
}

constexpr size_t OFF_MS = OFF_PART;
constexpr size_t OFF_ITEM1 = OFF_PART + 1 * MiB;

__device__ __forceinline__ void mlstm_a_item(const Frame& F, const int dry, int b, int c, int h) {
    constexpr int QS = 136, VS = 72;
    LAS bf16_t* QT = (LAS bf16_t*)F.lds;
    LAS bf16_t* KT = QT + 64 * QS;
    LAS bf16_t* VT = KT + 64 * QS;
    LAS bf16_t* AT = VT + 256 * VS;
    LAS float* BCS = (LAS float*)(AT + 64 * VS);
    LAS float* A2 = BCS + 64; LAS float* PM = A2 + 64; LAS float* KWS = PM + 64;
    LAS float* NL = KWS + 64;
    LAS float* DL = NL + 512;
    bf16_t* U = (bf16_t*)(F.ws + OFF_U); bf16_t* QA = (bf16_t*)(F.ws + OFF_A); bf16_t* NUM = (bf16_t*)(F.ws + OFF_B);
    const float* gates = (const float*)(F.ws + OFF_GATES1); float* MS = (float*)(F.ws + OFF_MS); float* ITEM = (float*)(F.ws + OFF_ITEM1) + (size_t)((b * 32 + c) * 8 + h) * 256;
    const float* cw = F.in[16]; const float* cb = F.in[17];
    const int tid = F.tid, w = F.wave, lane = F.lane, d = tid & 127, qq = tid >> 7, t0 = c * 64;
    const size_t row0 = (size_t)b * S + t0;
    if (w == 0) {
        const size_t row = row0 + lane;
        const float li = gates[row * 16 + h] + F.in[18][h], xf = gates[row * 16 + 8 + h] + F.in[19][h];
        const float lf = fminf(xf, 0.f) - log1pf(expf(-fabsf(xf)));
        float bc = lf;
#pragma unroll
        for (int o = 1; o < 64; o <<= 1) { const float v_ = __shfl_up(bc, o); bc += (lane >= o) ? v_ : 0.f; }
        const float a2 = li - bc; float pm = a2;
#pragma unroll
        for (int o = 1; o < 64; o <<= 1) { const float v_ = __shfl_up(pm, o); pm = (lane >= o) ? fmaxf(pm, v_) : pm; }
        const float pml = __shfl(pm, 63), bl = __shfl(bc, 63);
        BCS[lane] = bc; A2[lane] = a2; PM[lane] = pm; KWS[lane] = __expf(a2 - pml);
        if (!dry) { MS[(row * 8 + h) * 4 + 0] = bc; MS[(row * 8 + h) * 4 + 1] = bc + pm; }
        if (lane == 0 && !dry) { ITEM[128] = bl + pml; ITEM[129] = bl; }
    }
    float kp[16];
    {
        float xq[19], xk[19];
#pragma unroll
        for (int i = 0; i < 19; ++i) { const int t = t0 + 16 * qq - 3 + i; const bool ok = t >= 0; const bf16_t* up = U + ((size_t)b * S + (ok ? t : 0)) * 6144 + h * 128 + d;
            xq[i] = ok ? bf2f(up[0]) : 0.f; xk[i] = ok ? bf2f(up[1024]) : 0.f; }
        const int cq = h * 128 + d, ck = 1024 + h * 128 + d;
        const float q0 = cw[cq], q1 = cw[2048 + cq], q2 = cw[4096 + cq], q3 = cw[6144 + cq], qb = cb[cq];
        const float k0 = cw[ck], k1 = cw[2048 + ck], k2 = cw[4096 + ck], k3 = cw[6144 + ck], kb = cb[ck];
#pragma unroll
        for (int i = 0; i < 16; ++i) {
            const float qv = siluf_(qb + q0 * xq[i] + q1 * xq[i + 1] + q2 * xq[i + 2] + q3 * xq[i + 3]) * 0.08838834764831845f;
            kp[i] = siluf_(kb + k0 * xk[i] + k1 * xk[i + 1] + k2 * xk[i + 2] + k3 * xk[i + 3]);
            QT[(16 * qq + i) * QS + d] = (bf16_t)f2bf(qv); KT[(16 * qq + i) * QS + d] = (bf16_t)f2bf(kp[i]);
        }
    }
    bf16x8_t vt[4];
    {
        const int e = tid & 255, hf = tid >> 8;
        const bf16_t* vp = U + (row0 + 32 * hf) * 6144 + 2048 + h * 256 + e;
        unsigned short vv[32];
#pragma unroll
        for (int i = 0; i < 32; ++i) vv[i] = vp[(size_t)i * 6144];
#pragma unroll
        for (int j = 0; j < 4; ++j) { v4u w4; w4.x = vv[8 * j] | ((unsigned)vv[8 * j + 1] << 16); w4.y = vv[8 * j + 2] | ((unsigned)vv[8 * j + 3] << 16); w4.z = vv[8 * j + 4] | ((unsigned)vv[8 * j + 5] << 16); w4.w = vv[8 * j + 6] | ((unsigned)vv[8 * j + 7] << 16);
            vt[j] = __builtin_bit_cast(bf16x8_t, w4); *(LAS bf16x8_t*)(VT + e * VS + 32 * hf + 8 * j) = vt[j]; }
    }
    WG_BAR();
    {
        const int e = tid & 255, hf = tid >> 8;
        bf16_t* tp = U + (row0 + (e >> 2)) * 6144 + 2048 + h * 256 + (e & 3) * 64 + 32 * hf;
#pragma unroll
        for (int j = 0; j < 4; ++j) if (!dry) *(bf16x8_t*)(tp + 8 * j) = vt[j];
        float kw[16], ns = 0.f;
#pragma unroll
        for (int i = 0; i < 16; ++i) { kw[i] = kp[i] * KWS[16 * qq + i]; ns += kw[i]; }
        NL[qq * 128 + d] = ns;
        bf16_t* kp_ = QA + (row0 + (d >> 1)) * D + 1024 + h * 128 + (d & 1) * 64 + 16 * qq;
        { const bf16x8_t ka_ = pack_bf16x8(kw[0], kw[1], kw[2], kw[3], kw[4], kw[5], kw[6], kw[7]), kb_ = pack_bf16x8(kw[8], kw[9], kw[10], kw[11], kw[12], kw[13], kw[14], kw[15]); if (!dry) { *(bf16x8_t*)kp_ = ka_; *(bf16x8_t*)(kp_ + 8) = kb_; } }
#pragma unroll
        for (int j = 0; j < 2; ++j) { const int p = tid + 512 * j, row = p >> 4, c16 = p & 15; const bf16x8_t qv_ = *(const LAS bf16x8_t*)(QT + row * QS + c16 * 8); if (!dry) *(bf16x8_t*)(QA + (row0 + row) * D + h * 128 + c16 * 8) = qv_; }
    }
    {
        const int tb = w >> 1, r = lane & 15, g = lane >> 4;
#pragma unroll
        for (int k2 = 0; k2 < 2; ++k2) {
            const int sb = 2 * (w & 1) + k2;
            f32x4_t acc = {0.f, 0.f, 0.f, 0.f};
            if (sb <= tb) {
#pragma unroll
                for (int ks = 0; ks < 4; ++ks) {
                    const bf16x8_t a = *(const LAS bf16x8_t*)(KT + (16 * sb + r) * QS + 32 * ks + 8 * g), bb = *(const LAS bf16x8_t*)(QT + (16 * tb + r) * QS + 32 * ks + 8 * g);
                    acc = __builtin_amdgcn_mfma_f32_16x16x32_bf16(a, bb, acc, 0, 0, 0);
                }
            }
            const int t = 16 * tb + r, s0 = 16 * sb + 4 * g; const float pmt = PM[t];
            float sc[4], ds = 0.f;
#pragma unroll
            for (int j = 0; j < 4; ++j) { sc[j] = (s0 + j <= t) ? acc[j] * __expf(A2[s0 + j] - pmt) : 0.f; ds += sc[j]; }
            v2u pw; pw.x = pg8::cvt_pk_bf16(sc[0], sc[1]); pw.y = pg8::cvt_pk_bf16(sc[2], sc[3]);
            *(LAS v2u*)(AT + t * VS + s0) = pw;
            ds += __shfl_xor(ds, 16); ds += __shfl_xor(ds, 32);
            if (g == 0) DL[sb * 64 + t] = ds;
        }
    }
    WG_BAR();
    {
        const int l31 = lane & 31, hh = lane >> 5;
#pragma unroll
        for (int th = 0; th < 2; ++th) {
            f32x16 acc;
#pragma unroll
            for (int r = 0; r < 16; ++r) acc[r] = 0.f;
#pragma unroll
            for (int ks = 0; ks < 4; ++ks) {
                const bf16x8_t a = *(const LAS bf16x8_t*)(AT + (32 * th + l31) * VS + 16 * ks + 8 * hh), bb = *(const LAS bf16x8_t*)(VT + (32 * w + l31) * VS + 16 * ks + 8 * hh);
                acc = __builtin_amdgcn_mfma_f32_32x32x16_bf16(a, bb, acc, 0, 0, 0);
            }
#pragma unroll
            for (int r = 0; r < 16; ++r) { const int t = 32 * th + (r & 3) + 8 * (r >> 2) + 4 * hh; const bf16_t nv_ = (bf16_t)f2bf(acc[r]); if (!dry) NUM[(row0 + t) * D + h * 256 + 32 * w + l31] = nv_; }
        }
        if (tid < 64 && !dry) MS[((row0 + tid) * 8 + h) * 4 + 2] = (DL[tid] + DL[64 + tid]) + (DL[128 + tid] + DL[192 + tid]);
        if (tid >= 128 && tid < 256 && !dry) { const int dd = tid - 128; ITEM[dd] = (NL[dd] + NL[128 + dd]) + (NL[256 + dd] + NL[384 + dd]); }
    }
    WG_BAR();
}

__device__ __forceinline__ void mlstm_b_phase(const Frame& F, const int dry, int b, int h) {
    constexpr int QS = 132, VS = 72;
    LAS bf16_t* QB = (LAS bf16_t*)F.lds;
    LAS bf16_t* KB = QB + 64 * QS;
    LAS bf16_t* VB = KB + 128 * VS;
    LAS float* NS = (LAS float*)(VB + 256 * VS);
    LAS float* DECC = NS + 128;
    LAS float* SLOC = DECC + 32;
    bf16_t* U = (bf16_t*)(F.ws + OFF_U); const bf16_t* QA = (const bf16_t*)(F.ws + OFF_A);
    float* MS = (float*)(F.ws + OFF_MS); float* ITEM0 = (float*)(F.ws + OFF_ITEM1) + (size_t)((b * 32) * 8 + h) * 256;
    const int tid = F.tid, w = F.wave, lane = F.lane, l31 = lane & 31, hh = lane >> 5;
    if (w == 0) {
        const float Mc_l = (lane < 32) ? ITEM0[(size_t)lane * 2048 + 128] : 0.f, bl_l = (lane < 32) ? ITEM0[(size_t)lane * 2048 + 129] : 0.f;
        float m = 0.f, mine_m = 0.f, mine_dec = 0.f, mine_sl = 0.f;
        for (int c = 0; c < 32; ++c) { const float Mc = __shfl(Mc_l, c), bl = __shfl(bl_l, c), mn = fmaxf(bl + m, Mc);
            if (lane == c) { mine_m = m; mine_dec = __expf(bl + m - mn); mine_sl = __expf(Mc - mn); }
            m = mn; }
        if (lane < 32) { DECC[lane] = mine_dec; SLOC[lane] = mine_sl; if (!dry) ITEM0[(size_t)lane * 2048 + 130] = mine_m; }
    }
    if (tid < 128) NS[tid] = 0.f;
    f32x16 X[4];
#pragma unroll
    for (int xi = 0; xi < 4; ++xi)
#pragma unroll
        for (int r = 0; r < 16; ++r) X[xi][r] = 0.f;
    bf16x8_t pq[2], pk[2], pv[4]; float pnl = 0.f;
    {
        const size_t row0 = (size_t)b * S;
#pragma unroll
        for (int j = 0; j < 2; ++j) { const int p = tid + 512 * j; const bf16_t* ap = QA + (row0 + (p >> 4)) * D + h * 128 + (p & 15) * 8; pq[j] = *(const bf16x8_t*)ap; pk[j] = *(const bf16x8_t*)(ap + 1024); }
#pragma unroll
        for (int j = 0; j < 4; ++j) { const int p = tid + 512 * j; pv[j] = *(const bf16x8_t*)(U + (row0 + (p >> 5)) * 6144 + 2048 + h * 256 + (p & 31) * 8); }
        if (tid < 128) pnl = ITEM0[tid];
    }
    WG_BAR();
    for (int c = 0; c < 32; ++c) {
        const size_t row0 = (size_t)b * S + c * 64;
        const float dec = DECC[c], sloc = SLOC[c];
#pragma unroll
        for (int j = 0; j < 2; ++j) { const int p = tid + 512 * j, ur = p >> 4, c16 = p & 15;
            { const v4u w4 = __builtin_bit_cast(v4u, pq[j]); v2u lo, hi; lo.x = w4.x; lo.y = w4.y; hi.x = w4.z; hi.y = w4.w; *(LAS v2u*)(QB + ur * QS + c16 * 8) = lo; *(LAS v2u*)(QB + ur * QS + c16 * 8 + 4) = hi; }
            { const v4u w4 = __builtin_bit_cast(v4u, pk[j]);
              const bf16x8_t ks_ = pack_bf16x8(pg8::bflo(w4.x) * sloc, pg8::bfhi(w4.x) * sloc, pg8::bflo(w4.y) * sloc, pg8::bfhi(w4.y) * sloc, pg8::bflo(w4.z) * sloc, pg8::bfhi(w4.z) * sloc, pg8::bflo(w4.w) * sloc, pg8::bfhi(w4.w) * sloc);
              *(LAS bf16x8_t*)(KB + (2 * ur + (c16 >> 3)) * VS + (c16 & 7) * 8) = ks_; } }
#pragma unroll
        for (int j = 0; j < 4; ++j) { const int p = tid + 512 * j, ur = p >> 5, c32 = p & 31; *(LAS bf16x8_t*)(VB + (4 * ur + (c32 >> 3)) * VS + (c32 & 7) * 8) = pv[j]; }
        const float nl_cur = pnl;
        WG_BAR();
        if (c + 1 < 32) {
            const size_t rn = row0 + 64;
#pragma unroll
            for (int j = 0; j < 2; ++j) { const int p = tid + 512 * j; const bf16_t* ap = QA + (rn + (p >> 4)) * D + h * 128 + (p & 15) * 8; pq[j] = *(const bf16x8_t*)ap; pk[j] = *(const bf16x8_t*)(ap + 1024); }
#pragma unroll
            for (int j = 0; j < 4; ++j) { const int p = tid + 512 * j; pv[j] = *(const bf16x8_t*)(U + (rn + (p >> 5)) * 6144 + 2048 + h * 256 + (p & 31) * 8); }
            if (tid < 128) pnl = ITEM0[(size_t)(c + 1) * 2048 + tid];
        }
        {
            const int tq = 8 * w + (lane >> 3), d0 = (lane & 7) * 16; float s = 0.f;
#pragma unroll
            for (int j = 0; j < 4; ++j) { const v2u qv = *(const LAS v2u*)(QB + tq * QS + d0 + 4 * j); const f32x4_t nv = *(const LAS f32x4_t*)(NS + d0 + 4 * j);
                s += (pg8::bflo(qv.x) * nv[0] + pg8::bfhi(qv.x) * nv[1]) + (pg8::bflo(qv.y) * nv[2] + pg8::bfhi(qv.y) * nv[3]); }
            s += __shfl_xor(s, 1); s += __shfl_xor(s, 2); s += __shfl_xor(s, 4);
            if ((lane & 7) == 0 && !dry) MS[((row0 + tq) * 8 + h) * 4 + 3] = s;
        }
        f32x16 accT[2];
#pragma unroll
        for (int tt = 0; tt < 2; ++tt)
#pragma unroll
            for (int r = 0; r < 16; ++r) accT[tt][r] = 0.f;
#pragma unroll
        for (int xi = 0; xi < 4; ++xi)
#pragma unroll
            for (int s = 0; s < 2; ++s) {
                const bf16x8_t a = pack_bf16x8(X[xi][8 * s + 0], X[xi][8 * s + 1], X[xi][8 * s + 2], X[xi][8 * s + 3], X[xi][8 * s + 4], X[xi][8 * s + 5], X[xi][8 * s + 6], X[xi][8 * s + 7]);
#pragma unroll
                for (int tt = 0; tt < 2; ++tt) {
                    const LAS bf16_t* qp = QB + (32 * tt + l31) * QS + 32 * xi + 16 * s + 4 * hh;
                    const bf16x8_t bq = cat_bf16x4(*(const LAS v2u*)qp, *(const LAS v2u*)(qp + 8));
                    accT[tt] = __builtin_amdgcn_mfma_f32_32x32x16_bf16(a, bq, accT[tt], 0, 0, 0);
                }
            }
#pragma unroll
        for (int xi = 0; xi < 4; ++xi) {
#pragma unroll
            for (int r = 0; r < 16; ++r) X[xi][r] *= dec;
#pragma unroll
            for (int ks = 0; ks < 4; ++ks) {
                const bf16x8_t a = *(const LAS bf16x8_t*)(KB + (32 * xi + l31) * VS + 16 * ks + 8 * hh), bv = *(const LAS bf16x8_t*)(VB + (32 * w + l31) * VS + 16 * ks + 8 * hh);
                X[xi] = __builtin_amdgcn_mfma_f32_32x32x16_bf16(a, bv, X[xi], 0, 0, 0);
            }
        }
#pragma unroll
        for (int tt = 0; tt < 2; ++tt)
#pragma unroll
            for (int g4 = 0; g4 < 4; ++g4) { v2u ow; ow.x = pg8::cvt_pk_bf16(accT[tt][4 * g4 + 0], accT[tt][4 * g4 + 1]); ow.y = pg8::cvt_pk_bf16(accT[tt][4 * g4 + 2], accT[tt][4 * g4 + 3]);
                if (!dry) *(v2u*)(U + (row0 + 32 * tt + l31) * 6144 + h * 256 + 32 * w + 8 * g4 + 4 * hh) = ow; }
        WG_BAR();
        if (tid < 128) NS[tid] = dec * NS[tid] + sloc * nl_cur;
    }
    WG_BAR();
}

__device__ __forceinline__ void mlstm_c_item(const Frame& F, const int dry, int b, int c, int h) {
    const bf16_t* U = (const bf16_t*)(F.ws + OFF_U); bf16_t* Y = (bf16_t*)(F.ws + OFF_B);
    const float* MS = (const float*)(F.ws + OFF_MS); const float* ITEM = (const float*)(F.ws + OFF_ITEM1) + (size_t)((b * 32 + c) * 8 + h) * 256;
    const int w = F.wave, lane = F.lane;
    const size_t row0 = (size_t)b * S + c * 64;
    const f32x4_t cn = *(const f32x4_t*)(F.in[20] + h * 256 + 4 * lane);
    const float m_st = ITEM[130];
    v2u oi[8], nm[8], gg[8]; f32x4_t st[8];
#pragma unroll
    for (int i = 0; i < 8; ++i) { const size_t row = row0 + 8 * w + i;
        oi[i] = *(const v2u*)(U + row * 6144 + h * 256 + 4 * lane); nm[i] = *(const v2u*)(Y + row * D + h * 256 + 4 * lane); gg[i] = *(const v2u*)(U + row * 6144 + 4096 + h * 256 + 4 * lane);
        st[i] = *(const f32x4_t*)(MS + (row * 8 + h) * 4); }
#pragma unroll
    for (int i = 0; i < 8; ++i) { const size_t row = row0 + 8 * w + i;
        const float bcs = st[i][0], mloc = st[i][1], dloc = st[i][2], di = st[i][3];
        const float mt = fmaxf(mloc, bcs + m_st), gi = __expf(bcs + m_st - mt), gl = __expf(mloc - mt);
        const float den = gi * di + gl * dloc, inv = 1.f / fmaxf(fabsf(den), __expf(-mt));
        const float h0 = (gi * pg8::bflo(oi[i].x) + gl * pg8::bflo(nm[i].x)) * inv, h1 = (gi * pg8::bfhi(oi[i].x) + gl * pg8::bfhi(nm[i].x)) * inv;
        const float h2 = (gi * pg8::bflo(oi[i].y) + gl * pg8::bflo(nm[i].y)) * inv, h3 = (gi * pg8::bfhi(oi[i].y) + gl * pg8::bfhi(nm[i].y)) * inv;
        const float ss = wave_sum((h0 * h0 + h1 * h1) + (h2 * h2 + h3 * h3));
        const float rs = rsqrtf(ss * (1.f / 256.f) + EPS);
        v2u yw; yw.x = pg8::cvt_pk_bf16(h0 * rs * cn[0] * pg8::bflo(gg[i].x), h1 * rs * cn[1] * pg8::bfhi(gg[i].x)); yw.y = pg8::cvt_pk_bf16(h2 * rs * cn[2] * pg8::bflo(gg[i].y), h3 * rs * cn[3] * pg8::bfhi(gg[i].y));
        if (!dry) *(v2u*)(Y + row * D + h * 256 + 4 * lane) = yw; }
}

#ifndef MK_DUP
#define MK_DUP -1
#endif
enum { PH_P0 = 0, PH_IN0, PH_MIX0A, PH_MIX0B, PH_MIX0C, PH_OUT0, PH_GATE0, PH_IN1, PH_MIX1A, PH_MIX1B, PH_MIX1C, PH_OUT1, PH_GATE1, PH_FINAL, PH_END };

__global__ void __launch_bounds__(NWAVES * 64, 2) mk_fwd(Ptrs args) {
    extern __shared__ __attribute__((aligned(16))) unsigned char lds_raw[];
    Frame F;
    F.lds = (LAS unsigned char*)lds_raw;
    F.tid = threadIdx.x; F.lane = F.tid & 63; F.wave = __builtin_amdgcn_readfirstlane(F.tid >> 6);
    F.G = gridDim.x; F.bid = blockIdx.x; F.in = args.in; F.out = args.out; F.ws = args.ws;
    volatile LAS unsigned* MISC = (volatile LAS unsigned*)(F.lds + MISC_OFF);
    if (F.tid < 32) MISC[F.tid] = 0u;
    __syncthreads();
    XcdBarrier bar = xcd_barrier_post((unsigned*)(F.ws + OFF_CTL) + CW_BAR + args.li * XCD_BAR_WORDS, MISC + 8);
    const int lo = args.ph_lo, hi = args.ph_hi, dryv = args.dup;
#define IN_(k) (lo <= (k) && (k) < hi)
#define RUN(k, BODY) do { if (IN_(k)) { if (MK_DUP == (k)) { BODY(dryv) xcd_barrier(bar); } BODY(0) } } while (0)
#define SEAM(k) do { if (IN_(k) && IN_((k) + 1)) xcd_barrier(bar); } while (0)
    unsigned char* ws = F.ws;
    bf16_t* A = (bf16_t*)(ws + OFF_A); bf16_t* B = (bf16_t*)(ws + OFF_B); bf16_t* U = (bf16_t*)(ws + OFF_U);
    float* plpart = (float*)(ws + OFF_PART); float* hpart = plpart + (size_t)M * 32;
    const bf16_t* P16 = (const bf16_t*)(ws + OFF_WIN0); bf16_t* PL = U;
    const bf16_t* PLEW = (const bf16_t*)(ws + OFF_PLEW); bf16_t* PL1 = (bf16_t*)(ws + OFF_WIN1);
    float* plpart1 = (float*)(ws + OFF_WIN0 + 8 * MiB);

#define BODY_PH_P0(DRY) { p0_prologue(F); }
#define BODY_PH_IN0(DRY) { pg8::Gemm g{A, (const bf16_t*)(ws + OFF_WIN0), M, 6144, 2048}; pg8::StaticOrder So; So.init(M, 6144, F.G, F.bid); \
        pg8::EpiIn0 E{U, (const float*)(ws + OFF_SMALL) + 1024, DRY}; \
        pg8::gemm_phase<pg8::EpiIn0, pg8::StaticOrder, true, true>(F.lds, g, So, E); }
#define BODY_PH_MIX0A(DRY) { cvt_p_phase(F, DRY); \
        for (int it = F.bid; it < 1024; it += F.G) hgrn2_a_item(F, DRY, it >> 8, (it >> 3) & 31, it & 7); \
        for (int it = F.bid; it < 1024; it += F.G) rglru_a_item(F, DRY, it >> 8, (it >> 3) & 31, it & 7); }
#define BODY_PH_MIX0B(DRY) { if (F.bid < 32) hgrn2_b_phase(F, DRY, F.bid >> 3, F.bid & 7); else { for (int it = F.bid - 32; it < 1024; it += F.G - 32) rglru_b_item(F, DRY, it >> 8, (it >> 3) & 31, it & 7); \
        p0_layer1_weights(F, (F.bid - 32) * NWAVES + F.wave, (F.G - 32) * NWAVES); } }
#define BODY_PH_MIX0C(DRY) { for (int it = F.bid; it < 1024; it += F.G) hgrn2_c_item(F, DRY, it >> 8, (it >> 3) & 31, it & 7); }
#define BODY_PH_OUT0(DRY) { { pg8::Gemm g{A, (const bf16_t*)(ws + OFF_WOUT0), M, 2048, 2048}; pg8::StaticOrder So; So.init(M, 2048, F.G, F.bid); \
          pg8::EpiOut E{F.in[0], F.out, B, DRY}; \
          pg8::gemm_phase<pg8::EpiOut, pg8::StaticOrder, true, true>(F.lds, g, So, E); } \
        { unsigned char* ws2 = ws; asm volatile("" : "+s"(ws2));     \
          pg8::Gemm g{(const bf16_t*)(ws2 + OFF_WIN0), (const bf16_t*)(ws2 + OFF_PLEW), M, 2048, 256}; pg8::StaticOrder So; So.init(M, 2048, F.G, F.bid); \
          pg8::EpiPle E{(bf16_t*)(ws2 + OFF_U), (float*)(ws2 + OFF_PART), DRY}; \
          pg8::gemm_phase<pg8::EpiPle, pg8::StaticOrder, true, true>(F.lds, g, So, E); } }
#define BODY_PH_GATE0(DRY) { pg8::Gemm g{B, (const bf16_t*)(ws + OFF_WG0), M, 2048, 2048}; pg8::StaticOrder So; So.init(M, 2048, F.G, F.bid); \
        pg8::EpiGate E{F.out, A, PL, plpart, F.in[23], hpart, DRY}; \
        pg8::gemm_phase<pg8::EpiGate, pg8::StaticOrder, true, true>(F.lds, g, So, E); }
#define BODY_PH_IN1(DRY) { pg8::Gemm g{A, (const bf16_t*)(ws + OFF_WIN1), M, 8192, 2048}; pg8::StaticOrder So; So.init(M, 8192, F.G, F.bid); \
        pg8::EpiIn1 E{U, hpart, DRY}; \
        pg8::gemm_phase<pg8::EpiIn1, pg8::StaticOrder, true, true>(F.lds, g, So, E); \
        gates1_phase(F, DRY); }
#define BODY_PH_MIX1A(DRY) { for (int it = F.bid; it < 1024; it += F.G) mlstm_a_item(F, DRY, it >> 8, (it >> 3) & 31, it & 7); }
#define BODY_PH_MIX1B(DRY) { if (F.bid < 32) mlstm_b_phase(F, DRY, F.bid >> 3, F.bid & 7); else { \
        pg8::Gemm g{P16 + (size_t)M * PLE, PLEW + (size_t)2048 * 256, M, 2048, 256}; pg8::StaticOrder So; So.init(M, 2048, F.G - 32, F.bid - 32); \
        pg8::EpiPle E{PL1, plpart1, DRY}; \
        pg8::gemm_phase<pg8::EpiPle, pg8::StaticOrder, true, true>(F.lds, g, So, E); } }
#define BODY_PH_MIX1C(DRY) { for (int it = F.bid; it < 1024; it += F.G) mlstm_c_item(F, DRY, it >> 8, (it >> 3) & 31, it & 7); }
#define BODY_PH_OUT1(DRY) { pg8::Gemm g{B, (const bf16_t*)(ws + OFF_WOUT1), M, 2048, 2048}; pg8::StaticOrder So; So.init(M, 2048, F.G, F.bid); \
          pg8::EpiOut E{F.out, F.out, A, DRY}; \
          pg8::gemm_phase<pg8::EpiOut, pg8::StaticOrder, true, true>(F.lds, g, So, E); }
#define BODY_PH_GATE1(DRY) { pg8::Gemm g{A, (const bf16_t*)(ws + OFF_WG1), M, 2048, 2048}; pg8::StaticOrder So; So.init(M, 2048, F.G, F.bid); \
        pg8::EpiGate E{F.out, nullptr, PL1, plpart1, F.in[23] + D, hpart, DRY}; \
        pg8::gemm_phase<pg8::EpiGate, pg8::StaticOrder, true, true>(F.lds, g, So, E); }
#define BODY_PH_FINAL(DRY) { final_norm_phase(F, DRY); }

    RUN(PH_P0, BODY_PH_P0);
    SEAM(PH_P0);
    RUN(PH_IN0, BODY_PH_IN0);
    SEAM(PH_IN0);
    RUN(PH_MIX0A, BODY_PH_MIX0A);
    SEAM(PH_MIX0A);
    RUN(PH_MIX0B, BODY_PH_MIX0B);
    SEAM(PH_MIX0B);
    RUN(PH_MIX0C, BODY_PH_MIX0C);
    SEAM(PH_MIX0C);
    RUN(PH_OUT0, BODY_PH_OUT0);
    SEAM(PH_OUT0);
    RUN(PH_GATE0, BODY_PH_GATE0);
    SEAM(PH_GATE0);
    RUN(PH_IN1, BODY_PH_IN1);
    SEAM(PH_IN1);
    RUN(PH_MIX1A, BODY_PH_MIX1A);
    SEAM(PH_MIX1A);
    RUN(PH_MIX1B, BODY_PH_MIX1B);
    SEAM(PH_MIX1B);
    RUN(PH_MIX1C, BODY_PH_MIX1C);
    SEAM(PH_MIX1C);
    RUN(PH_OUT1, BODY_PH_OUT1);
    SEAM(PH_OUT1);
    RUN(PH_GATE1, BODY_PH_GATE1);
    SEAM(PH_GATE1);
    RUN(PH_FINAL, BODY_PH_FINAL);
#undef IN_
#undef SEAM
#undef RUN
}


extern "C" void kernel_launch(void* const* d_in, const int* in_sizes, int n_in, void* d_out, int out_size, void* d_ws, size_t ws_size, hipStream_t stream) {
    static int grid = 0;
    if (grid == 0) {
        if (n_in != 26 || ws_size < WS_END || out_size != M * D) { fprintf(stderr, "kernel_launch: unexpected problem (n_in %d, ws %zu, out %d)\n", n_in, ws_size, out_size); grid = -1; return; }
        int dev = 0, cus = 0, per_cu = 0;
        if (hipGetDevice(&dev) != hipSuccess || hipDeviceGetAttribute(&cus, hipDeviceAttributeMultiprocessorCount, dev) != hipSuccess) { grid = -1; return; }
        if (hipFuncSetAttribute((const void*)mk_fwd, hipFuncAttributeMaxDynamicSharedMemorySize, LDS_BYTES) != hipSuccess) { fprintf(stderr, "kernel_launch: hipFuncSetAttribute failed\n"); grid = -1; return; }
        if (hipOccupancyMaxActiveBlocksPerMultiprocessor(&per_cu, (const void*)mk_fwd, NWAVES * 64, LDS_BYTES) != hipSuccess || per_cu < 1) { fprintf(stderr, "kernel_launch: occupancy query says %d blocks per CU\n", per_cu); (void)hipGetLastError(); grid = -1; return; }
        grid = cus;
    }
    if (grid < 0) return;
    (void)hipMemsetAsync((char*)d_ws + OFF_CTL, 0, CTL_ZERO_BYTES, stream);
    Ptrs a{};
    for (int i = 0; i < 26; ++i) a.in[i] = (const float*)d_in[i];
    a.out = (float*)d_out; a.ws = (unsigned char*)d_ws; a.ph_lo = PH_P0; a.ph_hi = PH_END; a.li = 0; a.dup = 1;
    void* kargs[] = {&a};
    const hipError_t e = hipLaunchCooperativeKernel((const void*)mk_fwd, dim3(grid), dim3(NWAVES * 64), kargs, LDS_BYTES, stream);
    if (e != hipSuccess) fprintf(stderr, "kernel_launch: cooperative launch failed: %s (grid %d)\n", hipGetErrorString(e), grid);
}
```

```cpp
#include <hip/hip_runtime.h>
#include <cstdio>
#include <cstdint>

namespace pg8 {
#define PG8_LAS __attribute__((address_space(3)))
typedef unsigned short bf16_t;
typedef short bf16x8 __attribute__((ext_vector_type(8)));
typedef float f32x4 __attribute__((ext_vector_type(4)));
typedef unsigned u32x4 __attribute__((ext_vector_type(4)));
constexpr int BM = 256, BK = 64, HALF = 128, HTB = HALF * BK * 2  , STAGE_BYTES = 8 * HTB, NXCD = 8, WGM = 8;

__host__ __device__ __forceinline__ int lds_byte(int r, int c) { const int st = (r >> 4) * 2 + (c >> 5), rr = r & 15, cc = c & 31, ob = rr * 64 + cc * 2; return st * 1024 + (ob ^ (((ob >> 9) & 1) << 5)); }
__host__ __device__ __forceinline__ void stage_rc(int b, int& R, int& C) { const int st = b / 1024, sb = b % 1024, swz = sb ^ (((sb >> 9) & 1) << 5); R = (st >> 1) * 16 + swz / 64; C = (st & 1) * 32 + (swz % 64) / 2; }
__host__ __device__ __forceinline__ int perm32(int rho) { const int n = rho >> 4, i = rho & 15; return 8 * (i >> 2) + 4 * n + (i & 3); }

struct Unit { int pm, pn; };
struct Gemm { const bf16_t* A; const bf16_t* Bt; int M, N, K; };

struct StaticOrder {
    int nM, nN, nwg, G, c;
    __host__ __device__ void init(int M, int N, int G_, int c_) { nM = M / BM; nN = N / BM; nwg = nM * nN; G = G_; c = c_; }
    __host__ __device__ bool next(int i, Unit& u) const {
        const long L = (long)i * G + c; if (L >= nwg) return false;
        int wgid = (int)L; { const int q = nwg / NXCD, r = nwg % NXCD, xcd = wgid % NXCD, off = wgid / NXCD; wgid = (xcd < r ? xcd * (q + 1) : r * (q + 1) + (xcd - r) * q) + off; }
        const int nig = WGM * nN, gid = wgid / nig, fm = gid * WGM, gsz = (nM - fm) < WGM ? (nM - fm) : WGM;
        u.pm = fm + ((wgid % nig) % gsz); u.pn = (wgid % nig) / gsz; return true;
    }
    __device__ __forceinline__ void a_ready(const Unit&) const {}
    __device__ __forceinline__ void done(const Unit&) const {}
};

typedef __bf16 bf16v2_t __attribute__((ext_vector_type(2)));
typedef float f32v2_t __attribute__((ext_vector_type(2)));
__device__ __forceinline__ unsigned cvt_pk_bf16(float lo, float hi) { const f32v2_t v = {lo, hi}; return __builtin_bit_cast(unsigned, __builtin_convertvector(v, bf16v2_t)); }
typedef float f32x2 __attribute__((ext_vector_type(2)));
template <class Epi, class Sched, bool ALIGN_EPI = false, bool SP2 = false>
__device__ __forceinline__ void gemm_phase(PG8_LAS unsigned char* lds, const Gemm g, const Sched& S, const Epi& E) {
    const int tid = threadIdx.x, wid = __builtin_amdgcn_readfirstlane(tid >> 6), lane = tid & 63, wr = wid >> 2, wc = wid & 3, fr = lane & 15, fq = lane >> 4;
    const int K = g.K, nt = K / BK;
    unsigned voffA[2], voffB[2];
#pragma unroll
    for (int i = 0; i < 2; ++i) { int R, C; stage_rc(tid * 16 + i * 8192, R, C); const int Rb = Epi::PERM ? ((R & ~31) + perm32(R & 31)) : R;
        voffA[i] = (unsigned)(R * K + C) * 2u; voffB[i] = (unsigned)(Rb * K + C) * 2u; }
    const size_t kstep = (size_t)(BK * 2);
    const size_t hstep = (size_t)HALF * K * 2;
    const size_t tstep = 2 * hstep;
    const unsigned ldsw = (unsigned)wid * 1024u;
    const int aoff = lds_byte(wr * 64 + fr, fq * 8), boff = lds_byte(wc * 32 + fr, fq * 8);
#define PG8_SA(b, h) (((b) * 2 + (h)) * HTB)
#define PG8_SB(b, h) ((4 + (b) * 2 + (h)) * HTB)
#define PG8_STAGE(bufoff, gbase, voff) do { _Pragma("unroll") for (int _i = 0; _i < 2; ++_i) \
        __builtin_amdgcn_global_load_lds((const unsigned*)((const char*)(gbase) + (voff)[_i]), (PG8_LAS unsigned*)(lds + (bufoff) + ldsw + _i * 8192), 16, 0, 0); } while (0)
#define PG8_LDA(dst, b, h) do { _Pragma("unroll") for (int m = 0; m < 4; ++m) _Pragma("unroll") for (int k = 0; k < 2; ++k) dst[m][k] = *(const PG8_LAS bf16x8*)(lds + PG8_SA(b, h) + aoff + m * 2048 + k * 1024); } while (0)
#define PG8_LDB(dst, b, h) do { _Pragma("unroll") for (int n = 0; n < 2; ++n) _Pragma("unroll") for (int k = 0; k < 2; ++k) dst[n][k] = *(const PG8_LAS bf16x8*)(lds + PG8_SB(b, h) + boff + n * 2048 + k * 1024); } while (0)
#define PG8_MMA(ai, bj, At, Bt) do { __builtin_amdgcn_s_setprio(1); _Pragma("unroll") for (int m = 0; m < 4; ++m) _Pragma("unroll") for (int n = 0; n < 2; ++n) _Pragma("unroll") for (int k = 0; k < 2; ++k) \
        acc[ai][bj][m][n] = __builtin_amdgcn_mfma_f32_16x16x32_bf16(Bt[n][k], At[m][k], acc[ai][bj][m][n], 0, 0, 0); __builtin_amdgcn_s_setprio(0); } while (0)
#define PG8_WAIT_V(n) asm volatile("s_waitcnt vmcnt(" #n ")" ::: "memory")
#define PG8_WAIT_L(n) asm volatile("s_waitcnt lgkmcnt(" #n ")" ::: "memory")
#define PG8_BAR __builtin_amdgcn_s_barrier()
#define PG8_SCHED __builtin_amdgcn_sched_barrier(0)
    Unit cur, nxt; int ui = 0;
    if (!S.next(0, cur)) return;
    f32x4 acc[2][2][4][2];
#pragma unroll
    for (int a = 0; a < 2; ++a)
#pragma unroll
        for (int b = 0; b < 2; ++b)
#pragma unroll
            for (int m = 0; m < 4; ++m)
#pragma unroll
                for (int n = 0; n < 2; ++n) acc[a][b][m][n] = (f32x4){0.f, 0.f, 0.f, 0.f};
    bf16x8 At[4][2], B0[2][2], B1[2][2];
    const char* cA = (const char*)g.A + (size_t)cur.pm * tstep; const char* cB = (const char*)g.Bt + (size_t)cur.pn * tstep;
    S.a_ready(cur);
    if constexpr (SP2) {
        PG8_STAGE(PG8_SB(0, 0), cB, voffB); PG8_STAGE(PG8_SB(0, 1), cB + hstep, voffB); PG8_STAGE(PG8_SA(0, 0), cA, voffA); PG8_STAGE(PG8_SA(0, 1), cA + hstep, voffA);
        if (wr == 1) PG8_BAR;
        PG8_WAIT_V(2); PG8_BAR;
        PG8_STAGE(PG8_SB(1, 0), cB + kstep, voffB); PG8_STAGE(PG8_SA(1, 0), cA + kstep, voffA); PG8_STAGE(PG8_SB(1, 1), cB + hstep + kstep, voffB);
        PG8_WAIT_V(6); PG8_BAR;
    } else {
        PG8_STAGE(PG8_SB(0, 0), cB, voffB); PG8_STAGE(PG8_SA(0, 0), cA, voffA); PG8_STAGE(PG8_SB(0, 1), cB + hstep, voffB); PG8_STAGE(PG8_SA(0, 1), cA + hstep, voffA);
        if (wr == 1) PG8_BAR;
        PG8_WAIT_V(4); PG8_BAR;
        PG8_STAGE(PG8_SB(1, 0), cB + kstep, voffB); PG8_STAGE(PG8_SA(1, 0), cA + kstep, voffA); PG8_STAGE(PG8_SB(1, 1), cB + hstep + kstep, voffB);
        PG8_WAIT_V(6); PG8_BAR;
    }
    for (;;) {
        const bool has_next = S.next(ui + 1, nxt);
        const char* nA = has_next ? (const char*)g.A + (size_t)nxt.pm * tstep : cA; const char* nB = has_next ? (const char*)g.Bt + (size_t)nxt.pn * tstep : cB;
        for (int t = 0; t < nt; t += 2) {
            const bool last = (t == nt - 2);
            const char* a1 = cA + (size_t)(t + 1) * kstep;
            const char* a2 = last ? nA : cA + (size_t)(t + 2) * kstep; const char* b2 = last ? nB : cB + (size_t)(t + 2) * kstep;
            const char* a3 = a2 + kstep; const char* b3 = b2 + kstep;
            if (last && has_next) S.a_ready(nxt);
            if constexpr (SP2) {
            PG8_LDB(B0, 0, 0); PG8_LDB(B1, 0, 1); PG8_SCHED; PG8_LDA(At, 0, 0); PG8_STAGE(PG8_SA(1, 1), a1 + hstep, voffA);
            PG8_WAIT_V(8); PG8_WAIT_L(0); PG8_BAR; PG8_MMA(0, 0, At, B0); PG8_MMA(0, 1, At, B1); PG8_BAR; PG8_SCHED;
            PG8_LDA(At, 0, 1); PG8_STAGE(PG8_SB(0, 0), b2, voffB); PG8_STAGE(PG8_SB(0, 1), b2 + hstep, voffB); PG8_STAGE(PG8_SA(0, 0), a2, voffA);
            PG8_WAIT_V(8); PG8_WAIT_L(0); PG8_BAR; PG8_MMA(1, 0, At, B0); PG8_MMA(1, 1, At, B1); PG8_BAR; PG8_SCHED;
            PG8_LDB(B0, 1, 0); PG8_LDB(B1, 1, 1); PG8_SCHED; PG8_LDA(At, 1, 0); PG8_STAGE(PG8_SA(0, 1), a2 + hstep, voffA);
            PG8_WAIT_V(8); PG8_WAIT_L(0); PG8_BAR; PG8_MMA(0, 0, At, B0); PG8_MMA(0, 1, At, B1); PG8_BAR; PG8_SCHED;
            PG8_LDA(At, 1, 1); PG8_STAGE(PG8_SB(1, 0), b3, voffB); PG8_STAGE(PG8_SB(1, 1), b3 + hstep, voffB); PG8_STAGE(PG8_SA(1, 0), a3, voffA);
            PG8_WAIT_V(8); PG8_WAIT_L(0); PG8_BAR; PG8_MMA(1, 0, At, B0); PG8_MMA(1, 1, At, B1); PG8_BAR; PG8_SCHED;
            } else {
            PG8_LDB(B0, 0, 0); PG8_SCHED; PG8_LDA(At, 0, 0); PG8_STAGE(PG8_SA(1, 1), a1 + hstep, voffA);
            PG8_WAIT_L(8); PG8_BAR; PG8_WAIT_L(0); PG8_MMA(0, 0, At, B0); PG8_BAR; PG8_SCHED;
            PG8_LDB(B1, 0, 1); PG8_STAGE(PG8_SB(0, 0), b2, voffB);
            PG8_BAR; PG8_WAIT_L(0); PG8_MMA(0, 1, At, B1); PG8_BAR;
            PG8_LDA(At, 0, 1); PG8_STAGE(PG8_SA(0, 0), a2, voffA);
            PG8_BAR; PG8_WAIT_L(0); PG8_MMA(1, 0, At, B0); PG8_BAR; PG8_SCHED;
            PG8_STAGE(PG8_SB(0, 1), b2 + hstep, voffB);
            PG8_WAIT_V(6); PG8_BAR; PG8_MMA(1, 1, At, B1); PG8_BAR;
            PG8_LDB(B0, 1, 0); PG8_SCHED; PG8_LDA(At, 1, 0); PG8_STAGE(PG8_SA(0, 1), a2 + hstep, voffA);
            PG8_WAIT_L(8); PG8_BAR; PG8_WAIT_L(0); PG8_MMA(0, 0, At, B0); PG8_BAR; PG8_SCHED;
            PG8_LDB(B1, 1, 1); PG8_STAGE(PG8_SB(1, 0), b3, voffB);
            PG8_BAR; PG8_WAIT_L(0); PG8_MMA(0, 1, At, B1); PG8_BAR;
            PG8_LDA(At, 1, 1); PG8_STAGE(PG8_SA(1, 0), a3, voffA);
            PG8_BAR; PG8_WAIT_L(0); PG8_MMA(1, 0, At, B0); PG8_BAR; PG8_SCHED;
            PG8_STAGE(PG8_SB(1, 1), b3 + hstep, voffB);
            PG8_WAIT_V(6); PG8_BAR; PG8_MMA(1, 1, At, B1); PG8_BAR;
            }
        }
        if constexpr (ALIGN_EPI) { if (wr == 0) PG8_BAR; }
        if constexpr (!Epi::AFTER_DRAIN) { E(acc, cur, wr, wc, fr, fq); S.done(cur); }
        if (!has_next) break;
#pragma unroll
        for (int a = 0; a < 2; ++a)
#pragma unroll
            for (int b = 0; b < 2; ++b)
#pragma unroll
                for (int m = 0; m < 4; ++m)
#pragma unroll
                    for (int n = 0; n < 2; ++n) acc[a][b][m][n] = (f32x4){0.f, 0.f, 0.f, 0.f};
        cur = nxt; cA = nA; cB = nB; ++ui;
        if constexpr (ALIGN_EPI) { if (wr == 1) PG8_BAR; }
    }
    PG8_WAIT_V(0);
    if constexpr (!ALIGN_EPI) { if (wr == 0) PG8_BAR; }
    PG8_BAR;
    if constexpr (Epi::AFTER_DRAIN) { E.fused(acc, cur, wr, wc, fr, fq, lds, wid, lane); S.done(cur); }
#undef PG8_SA
#undef PG8_SB
#undef PG8_STAGE
#undef PG8_LDA
#undef PG8_LDB
#undef PG8_MMA
#undef PG8_WAIT_V
#undef PG8_WAIT_L
#undef PG8_BAR
#undef PG8_SCHED
}
}

namespace pg8 {
constexpr float EPSN = 1e-6f;
__device__ __forceinline__ float fsigmoid(float x) { return __builtin_amdgcn_rcpf(1.f + __expf(-x)); }
__device__ __forceinline__ float fsilu(float x) { return x * __builtin_amdgcn_rcpf(1.f + __expf(-x)); }
__device__ __forceinline__ float row_stat32(const float* part, int row, int fq) {
    const f32x4 a = *(const f32x4*)(part + (size_t)row * 32 + 8 * fq), b = *(const f32x4*)(part + (size_t)row * 32 + 8 * fq + 4);
    float s = ((a.x + a.y) + (a.z + a.w)) + ((b.x + b.y) + (b.z + b.w));
    s += __shfl_xor(s, 16); s += __shfl_xor(s, 32); return s;
}
__device__ __forceinline__ u32x4 pack8(const f32x4 v0, const f32x4 v1) { u32x4 w; w.x = cvt_pk_bf16(v0[0], v0[1]); w.y = cvt_pk_bf16(v0[2], v0[3]); w.z = cvt_pk_bf16(v1[0], v1[1]); w.w = cvt_pk_bf16(v1[2], v1[3]); return w; }
__device__ __forceinline__ float bflo(unsigned w) { return __uint_as_float(w << 16); }
__device__ __forceinline__ float bfhi(unsigned w) { return __uint_as_float(w & 0xffff0000u); }

struct EpiIn0 {
    static constexpr bool PERM = true, AFTER_DRAIN = false;
    bf16_t* U; const float* rstd; int dry;
    __device__ __forceinline__ void operator()(const f32x4 (&acc)[2][2][4][2], const Unit& u, int wr, int wc, int fr, int fq) const {
        if (dry) return;
        const int row0 = u.pm * BM + wr * 64 + fr, col0 = u.pn * BM + wc * 32 + 8 * fq;
#pragma unroll
        for (int ai = 0; ai < 2; ++ai)
#pragma unroll
            for (int m = 0; m < 4; ++m) { const int row = row0 + ai * HALF + m * 16; const float sc = rstd[row]; bf16_t* rowp = U + (size_t)row * 6144 + col0;
#pragma unroll
                for (int bj = 0; bj < 2; ++bj) *(u32x4*)(rowp + bj * HALF) = pack8(acc[ai][bj][m][0] * sc, acc[ai][bj][m][1] * sc); }
    }
};
struct EpiIn1 {
    static constexpr bool PERM = true, AFTER_DRAIN = false;
    bf16_t* U; const float* hpart; int dry;
    __device__ __forceinline__ void operator()(const f32x4 (&acc)[2][2][4][2], const Unit& u, int wr, int wc, int fr, int fq) const {
        if (dry) return;
        const int row0 = u.pm * BM + wr * 64 + fr;
        if (u.pn < 16) {
            const int col0 = u.pn * BM + wc * 32 + 8 * fq;
#pragma unroll
            for (int ai = 0; ai < 2; ++ai)
#pragma unroll
                for (int m = 0; m < 4; ++m) { const int row = row0 + ai * HALF + m * 16; const float sc = rsqrtf(row_stat32(hpart, row, fq) * (1.f / 2048.f) + EPSN); bf16_t* rowp = U + (size_t)row * 6144 + col0;
#pragma unroll
                    for (int bj = 0; bj < 2; ++bj) *(u32x4*)(rowp + bj * HALF) = pack8(acc[ai][bj][m][0] * sc, acc[ai][bj][m][1] * sc); }
        } else {
            const int col0 = 4096 + 128 * (u.pn - 16) + wc * 32 + 8 * fq;
#pragma unroll
            for (int ai = 0; ai < 2; ++ai)
#pragma unroll
                for (int m = 0; m < 4; ++m) { const int row = row0 + ai * HALF + m * 16; const float sc = rsqrtf(row_stat32(hpart, row, fq) * (1.f / 2048.f) + EPSN);
                    f32x4 g0, g1;
#pragma unroll
                    for (int j = 0; j < 4; ++j) { g0[j] = fsigmoid(acc[ai][0][m][0][j] * sc) * fsilu(acc[ai][1][m][0][j] * sc); g1[j] = fsigmoid(acc[ai][0][m][1][j] * sc) * fsilu(acc[ai][1][m][1][j] * sc); }
                    *(u32x4*)(U + (size_t)row * 6144 + col0) = pack8(g0, g1); }
        }
    }
};
template <bool BASE_F32> struct EpiOut {
    static constexpr bool PERM = true, AFTER_DRAIN = false;
    const void* base; bf16_t* h16; int dry;
    __device__ __forceinline__ void operator()(const f32x4 (&acc)[2][2][4][2], const Unit& u, int wr, int wc, int fr, int fq) const {
        if (dry) return;
        const int row0 = u.pm * BM + wr * 64 + fr, col0 = u.pn * BM + wc * 32 + 8 * fq;
#pragma unroll
        for (int ai = 0; ai < 2; ++ai)
#pragma unroll
            for (int m = 0; m < 4; ++m) { const size_t off = (size_t)(row0 + ai * HALF + m * 16) * 2048 + col0;
#pragma unroll
                for (int bj = 0; bj < 2; ++bj) { f32x4 b0, b1;
                    if (BASE_F32) { b0 = *(const f32x4*)((const float*)base + off + bj * HALF); b1 = *(const f32x4*)((const float*)base + off + bj * HALF + 4); }
                    else { const u32x4 pw = *(const u32x4*)((const bf16_t*)base + off + bj * HALF); b0 = (f32x4){bflo(pw.x), bfhi(pw.x), bflo(pw.y), bfhi(pw.y)}; b1 = (f32x4){bflo(pw.z), bfhi(pw.z), bflo(pw.w), bfhi(pw.w)}; }
                    *(u32x4*)(h16 + off + bj * HALF) = pack8(b0 + acc[ai][bj][m][0], b1 + acc[ai][bj][m][1]); }
                asm volatile("" ::: "memory"); }
    }
};
struct EpiPle {
    static constexpr bool PERM = true, AFTER_DRAIN = false;
    bf16_t* PL; float* plpart; int dry;
    __device__ __forceinline__ void operator()(const f32x4 (&acc)[2][2][4][2], const Unit& u, int wr, int wc, int fr, int fq) const {
        if (dry) return;
        const int row0 = u.pm * BM + wr * 64 + fr, col0 = u.pn * BM + wc * 32 + 8 * fq;
#pragma unroll
        for (int ai = 0; ai < 2; ++ai)
#pragma unroll
            for (int m = 0; m < 4; ++m) { const int row = row0 + ai * HALF + m * 16; float s = 0.f;
#pragma unroll
                for (int bj = 0; bj < 2; ++bj) { const f32x4 v0 = acc[ai][bj][m][0], v1 = acc[ai][bj][m][1];
                    s += ((v0[0] * v0[0] + v0[1] * v0[1]) + (v0[2] * v0[2] + v0[3] * v0[3])) + ((v1[0] * v1[0] + v1[1] * v1[1]) + (v1[2] * v1[2] + v1[3] * v1[3]));
                    *(u32x4*)(PL + (size_t)row * 2048 + col0 + bj * HALF) = pack8(v0, v1); }
                s += __shfl_xor(s, 16); s += __shfl_xor(s, 32);
                if (fq == 0) plpart[(size_t)row * 32 + u.pn * 4 + wc] = s; }
    }
};
struct EpiGate {
    static constexpr bool PERM = true, AFTER_DRAIN = false;
    const bf16_t* hin; bf16_t* h16out; float* outf; const bf16_t* PL; const float* plpart; const float* ple_norm; float* hpart; int dry;
    __device__ __forceinline__ void operator()(const f32x4 (&acc)[2][2][4][2], const Unit& u, int wr, int wc, int fr, int fq) const {
        if (dry) return;
        const int row0 = u.pm * BM + wr * 64 + fr, col0 = u.pn * BM + wc * 32 + 8 * fq;
        f32x4 pn[2][2];
#pragma unroll
        for (int bj = 0; bj < 2; ++bj) { pn[bj][0] = *(const f32x4*)(ple_norm + col0 + bj * HALF); pn[bj][1] = *(const f32x4*)(ple_norm + col0 + bj * HALF + 4); }
#pragma unroll
        for (int ai = 0; ai < 2; ++ai)
#pragma unroll
            for (int m = 0; m < 4; ++m) { const int row = row0 + ai * HALF + m * 16; const size_t off = (size_t)row * 2048 + col0;
                const float rs = rsqrtf(row_stat32(plpart, row, fq) * (1.f / 2048.f) + EPSN); float s = 0.f;
#pragma unroll
                for (int bj = 0; bj < 2; ++bj) { const u32x4 pw = *(const u32x4*)(PL + off + bj * HALF), hw = *(const u32x4*)(hin + off + bj * HALF);
                    const f32x4 p0 = (f32x4){bflo(pw.x), bfhi(pw.x), bflo(pw.y), bfhi(pw.y)} * pn[bj][0] * rs, p1 = (f32x4){bflo(pw.z), bfhi(pw.z), bflo(pw.w), bfhi(pw.w)} * pn[bj][1] * rs;
                    f32x4 h0 = (f32x4){bflo(hw.x), bfhi(hw.x), bflo(hw.y), bfhi(hw.y)}, h1 = (f32x4){bflo(hw.z), bfhi(hw.z), bflo(hw.w), bfhi(hw.w)};
#pragma unroll
                    for (int j = 0; j < 4; ++j) { h0[j] += fsigmoid(acc[ai][bj][m][0][j]) * p0[j]; h1[j] += fsigmoid(acc[ai][bj][m][1][j]) * p1[j]; }
                    if (outf) { *(f32x4*)(outf + off + bj * HALF) = h0; *(f32x4*)(outf + off + bj * HALF + 4) = h1; }
                    else *(u32x4*)(h16out + off + bj * HALF) = pack8(h0, h1);
                    s += ((h0[0] * h0[0] + h0[1] * h0[1]) + (h0[2] * h0[2] + h0[3] * h0[3])) + ((h1[0] * h1[0] + h1[1] * h1[1]) + (h1[2] * h1[2] + h1[3] * h1[3])); }
                s += __shfl_xor(s, 16); s += __shfl_xor(s, 32);
                if (fq == 0) hpart[(size_t)row * 32 + u.pn * 4 + wc] = s;
                asm volatile("" ::: "memory"); }
    }
};
struct EpiGateFinal {
    static constexpr bool PERM = true, AFTER_DRAIN = true;
    const bf16_t* hin; float* outf; const bf16_t* PL; const float* plpart; const float* ple_norm; const float* fin_norm; float* xbuf; unsigned* cnt; int dry;
    __device__ __forceinline__ void fused(f32x4 (&acc)[2][2][4][2], const Unit& u, int wr, int wc, int fr, int fq, PG8_LAS unsigned char* lds, int wid, int lane) const {
        if (dry) return;
        PG8_LAS float* P = (PG8_LAS float*)lds;
        PG8_LAS float* S = (PG8_LAS float*)(lds + 4096);
        const int row0 = u.pm * BM + wr * 64 + fr, col0 = u.pn * BM + wc * 32 + 8 * fq;
        {
            f32x4 pn[2][2];
#pragma unroll
            for (int bj = 0; bj < 2; ++bj) { pn[bj][0] = *(const f32x4*)(ple_norm + col0 + bj * HALF); pn[bj][1] = *(const f32x4*)(ple_norm + col0 + bj * HALF + 4); }
#pragma unroll
            for (int ai = 0; ai < 2; ++ai)
#pragma unroll
                for (int m = 0; m < 4; ++m) { const int row = row0 + ai * HALF + m * 16; const size_t off = (size_t)row * 2048 + col0;
                    const float rs = rsqrtf(row_stat32(plpart, row, fq) * (1.f / 2048.f) + EPSN); float s = 0.f;
#pragma unroll
                    for (int bj = 0; bj < 2; ++bj) { const u32x4 pw = *(const u32x4*)(PL + off + bj * HALF), hw = *(const u32x4*)(hin + off + bj * HALF);
                        const f32x4 p0 = (f32x4){bflo(pw.x), bfhi(pw.x), bflo(pw.y), bfhi(pw.y)} * pn[bj][0] * rs, p1 = (f32x4){bflo(pw.z), bfhi(pw.z), bflo(pw.w), bfhi(pw.w)} * pn[bj][1] * rs;
                        f32x4 h0 = (f32x4){bflo(hw.x), bfhi(hw.x), bflo(hw.y), bfhi(hw.y)}, h1 = (f32x4){bflo(hw.z), bfhi(hw.z), bflo(hw.w), bfhi(hw.w)};
#pragma unroll
                        for (int j = 0; j < 4; ++j) { h0[j] += fsigmoid(acc[ai][bj][m][0][j]) * p0[j]; h1[j] += fsigmoid(acc[ai][bj][m][1][j]) * p1[j]; }
                        acc[ai][bj][m][0] = h0; acc[ai][bj][m][1] = h1;
                        s += ((h0[0] * h0[0] + h0[1] * h0[1]) + (h0[2] * h0[2] + h0[3] * h0[3])) + ((h1[0] * h1[0] + h1[1] * h1[1]) + (h1[2] * h1[2] + h1[3] * h1[3])); }
                    s += __shfl_xor(s, 16); s += __shfl_xor(s, 32);
                    if (fq == 0) P[(ai * HALF + wr * 64 + m * 16 + fr) * 4 + wc] = s;
                    asm volatile("" ::: "memory"); }
        }
        asm volatile("s_waitcnt lgkmcnt(0)" ::: "memory"); __builtin_amdgcn_s_barrier(); asm volatile("" ::: "memory");
        const int row = wid * 32 + (lane & 31);
        if (lane < 32) { const float s4 = (P[row * 4 + 0] + P[row * 4 + 1]) + (P[row * 4 + 2] + P[row * 4 + 3]);
            __hip_atomic_store(xbuf + (size_t)(u.pm * BM + row) * 8 + u.pn, s4, __ATOMIC_RELAXED, __HIP_MEMORY_SCOPE_AGENT); }
        asm volatile("s_waitcnt vmcnt(0)" ::: "memory");
        if (lane == 0) __hip_atomic_fetch_add(cnt + 64 * u.pm, 1u, __ATOMIC_RELAXED, __HIP_MEMORY_SCOPE_AGENT);
        if (wid == 0) {
            unsigned spins = 0;
            while ((unsigned)__builtin_amdgcn_readfirstlane(__hip_atomic_load(cnt + 64 * u.pm, __ATOMIC_RELAXED, __HIP_MEMORY_SCOPE_AGENT)) < 64u) { __builtin_amdgcn_s_sleep(2); if (++spins > (1u << 24)) break; }
            __builtin_amdgcn_fence(__ATOMIC_ACQUIRE, "agent");
        }
        asm volatile("s_waitcnt vmcnt(0) lgkmcnt(0)" ::: "memory"); __builtin_amdgcn_s_barrier(); asm volatile("" ::: "memory");
        if (lane < 32) { const float* xp = xbuf + (size_t)(u.pm * BM + row) * 8; float t = 0.f;
#pragma unroll
            for (int k = 0; k < 8; ++k) t += __hip_atomic_load(xp + k, __ATOMIC_RELAXED, __HIP_MEMORY_SCOPE_AGENT);
            S[row] = rsqrtf(t * (1.f / 2048.f) + EPSN); }
        asm volatile("s_waitcnt lgkmcnt(0)" ::: "memory"); __builtin_amdgcn_s_barrier(); asm volatile("" ::: "memory");
        f32x4 fn[2][2];
#pragma unroll
        for (int bj = 0; bj < 2; ++bj) { fn[bj][0] = *(const f32x4*)(fin_norm + col0 + bj * HALF); fn[bj][1] = *(const f32x4*)(fin_norm + col0 + bj * HALF + 4); }
#pragma unroll
        for (int ai = 0; ai < 2; ++ai)
#pragma unroll
            for (int m = 0; m < 4; ++m) { const int r = ai * HALF + wr * 64 + m * 16 + fr; const float rs = S[r]; const size_t off = (size_t)(u.pm * BM + r) * 2048 + col0;
#pragma unroll
                for (int bj = 0; bj < 2; ++bj) { *(f32x4*)(outf + off + bj * HALF) = acc[ai][bj][m][0] * fn[bj][0] * rs; *(f32x4*)(outf + off + bj * HALF + 4) = acc[ai][bj][m][1] * fn[bj][1] * rs; } }
    }
};
}

constexpr int NWAVES = 8;
constexpr int NB = 4, S = 2048, D = 2048, M = NB * S, PLE = 256;
constexpr float EPS = 1e-6f;
typedef unsigned short bf16_t;
typedef float f32x4 __attribute__((ext_vector_type(4)));
typedef unsigned v4u __attribute__((ext_vector_type(4)));
typedef unsigned v2u __attribute__((ext_vector_type(2)));

constexpr size_t MiB = 1u << 20;
constexpr size_t OFF_CTL = 0, CTL_ZERO_BYTES = 1 * MiB;
constexpr size_t OFF_WIN0 = 1 * MiB;
constexpr size_t OFF_WOUT0 = 25 * MiB;
constexpr size_t OFF_WG0 = 33 * MiB;
constexpr size_t OFF_WIN1 = 41 * MiB;
constexpr size_t OFF_WOUT1 = 73 * MiB;
constexpr size_t OFF_WG1 = 81 * MiB;
constexpr size_t OFF_PLEW = 89 * MiB;
constexpr size_t OFF_WGATE1 = 91 * MiB;
constexpr size_t OFF_SMALL = 91 * MiB + 65536;
constexpr size_t OFF_GATES1 = 92 * MiB;
constexpr size_t OFF_PART = 92 * MiB + 524288;
constexpr size_t OFF_A = 95 * MiB;
constexpr size_t OFF_B = 127 * MiB;
constexpr size_t OFF_U = 159 * MiB;
constexpr size_t WS_END = 255 * MiB;
constexpr size_t OFF_ACUM = OFF_B;
constexpr size_t OFF_CARRY = OFF_B + 17 * MiB;
constexpr size_t OFF_DECAY = OFF_B + 18 * MiB;
constexpr size_t OFF_WRT = OFF_SMALL + 65536;
constexpr int CW_FIN = 16384;
constexpr int CW_BAR = 4096;

constexpr int RING_BYTES = 131072;
constexpr int MISC_OFF = RING_BYTES + 320;
constexpr int LDS_BYTES = 147456;

#define LAS __attribute__((address_space(3)))
#define GAS __attribute__((address_space(1)))
__device__ __forceinline__ float bf2f(bf16_t b) { return __uint_as_float(((unsigned)b) << 16); }
__device__ __forceinline__ unsigned f2bf(float f) { unsigned u = __float_as_uint(f); return (u + 0x7fffu + ((u >> 16) & 1u)) >> 16; }
__device__ __forceinline__ unsigned pk2(float lo, float hi) { return f2bf(lo) | (f2bf(hi) << 16); }
__device__ __forceinline__ float sigmoidf_(float x) { return __builtin_amdgcn_rcpf(1.f + __expf(-x)); }
__device__ __forceinline__ float siluf_(float x) { return x * __builtin_amdgcn_rcpf(1.f + __expf(-x)); }
__device__ __forceinline__ float one_minus_exp(float x) { return x > -0.03f ? -x * (1.f + x * (0.5f + x * (0.16666667f + x * 0.041666668f))) : 1.f - __expf(x); }
__device__ __forceinline__ float wave_sum(float v) {
#pragma unroll
    for (int o = 1; o < 64; o <<= 1) v += __shfl_xor(v, o);
    return v;
}
#define LDS_WAIT() asm volatile("s_waitcnt lgkmcnt(0)" ::: "memory")
#define WG_BAR() asm volatile("s_waitcnt lgkmcnt(0)\n\ts_barrier" ::: "memory")
#define XB_TMO      128
#define XB_XCNT(j)  (256  + 64 * (j))
#define XB_XSUB(j)  (1280 + 64 * (j))
#define XB_XGEN(j)  (2304 + 64 * (j))
#define XB_TOP      3328
#define XB_TOPGEN   3392
#define XCD_BAR_WORDS 3456
#define XB_SPIN_CAP (1u << 26)

__device__ __forceinline__ unsigned xb_ld(unsigned* p)              { return __hip_atomic_load(p, __ATOMIC_RELAXED, __HIP_MEMORY_SCOPE_AGENT); }
__device__ __forceinline__ unsigned xb_add(unsigned* p, unsigned v) { return __hip_atomic_fetch_add(p, v, __ATOMIC_RELAXED, __HIP_MEMORY_SCOPE_AGENT); }
__device__ __forceinline__ unsigned xb_xcc_id() { return (unsigned)__builtin_amdgcn_s_getreg((3 << 11) | 20) & 0xFu; }
#define XB_SPIN(cond, bar) do { unsigned _sp = 0; while (cond) { __builtin_amdgcn_s_sleep(1); \
    if ((++_sp & 255u) == 0u) { if (xb_ld(&(bar)[XB_TMO])) break; if (_sp > XB_SPIN_CAP) { atomicAdd(&(bar)[XB_TMO], 1u); break; } } } } while (0)

struct XcdBarrier {
    unsigned* bar; unsigned x;
    volatile LAS unsigned* st;
};

__device__ __forceinline__ XcdBarrier xcd_barrier_post(unsigned* bar, volatile LAS unsigned* st) {
    XcdBarrier b; b.bar = bar; b.x = xb_xcc_id(); b.st = st;
    if (threadIdx.x == 0) (void)xb_add(&bar[XB_XCNT(b.x)], 1u);
    return b;
}
__device__ __forceinline__ void xcd_barrier_complete(unsigned* bar, unsigned x, unsigned& nloc, unsigned& nx) {
    const unsigned G = gridDim.x * gridDim.y * gridDim.z;
    unsigned sum, cnt, mine, sp = 0u;
    for (;;) {
        sum = 0u; cnt = 0u; mine = 0u;
#pragma unroll
        for (unsigned j = 0; j < 16; ++j) { const unsigned c = xb_ld(&bar[XB_XCNT(j)]); sum += c; cnt += (c > 0u) ? 1u : 0u; mine = (j == x) ? c : mine; }
        if (sum == G) break;
        __builtin_amdgcn_s_sleep(1);
        if ((++sp & 255u) == 0u) { if (xb_ld(&bar[XB_TMO])) break; if (sp > XB_SPIN_CAP) { atomicAdd(&bar[XB_TMO], 1u); break; } }
    }
    nloc = mine > 0u ? mine : 1u; nx = cnt > 0u ? cnt : 1u;
}

__device__ __forceinline__ void xcd_barrier(const XcdBarrier& b) {
    asm volatile("s_waitcnt vmcnt(0)" ::: "memory");
    __syncthreads();
    if (threadIdx.x == 0) {
        unsigned* bar = b.bar;
        __builtin_amdgcn_s_waitcnt(0);
        unsigned nloc = b.st[0], nx = b.st[1];
        if (nloc == 0u) { xcd_barrier_complete(bar, b.x, nloc, nx); b.st[0] = nloc; b.st[1] = nx; }
        const unsigned old = xb_add(&bar[XB_XSUB(b.x)], 1u);
        const unsigned gen = old / nloc;
        if (old + 1u == (gen + 1u) * nloc) {
            __builtin_amdgcn_fence(__ATOMIC_RELEASE, "agent");
            asm volatile("s_waitcnt vmcnt(0)" ::: "memory");
            const unsigned og = xb_add(&bar[XB_TOP], 1u);
            const unsigned tg = og / nx;
            if (og + 1u == (tg + 1u) * nx) xb_add(&bar[XB_TOPGEN], 1u);
            else XB_SPIN(xb_ld(&bar[XB_TOPGEN]) == tg, bar);
            __builtin_amdgcn_fence(__ATOMIC_ACQUIRE, "agent");
            xb_add(&bar[XB_XGEN(b.x)], 1u);
            asm volatile("s_waitcnt vmcnt(0)" ::: "memory");
        } else {
            XB_SPIN(xb_ld(&bar[XB_XGEN(b.x)]) == gen, bar);
            __builtin_amdgcn_fence(__ATOMIC_ACQUIRE, "agent");
            asm volatile("s_waitcnt vmcnt(0)" ::: "memory");
        }
    }
    __syncthreads();
}

struct Ptrs {
    const float* in[26]; float* out; unsigned char* ws; int ph_lo, ph_hi, li, dup;
};
__device__ __forceinline__ int srccol_in1(int n) {
    if (n < 4096) return n;
    const int r = n - 4096, j = r >> 8, i = r & 255;
    return i < 128 ? 4096 + 128 * j + i : 6144 + 128 * j + (i - 128);
}
__device__ __forceinline__ void p0_transpose_item(const float* __restrict__ W, int K, int ldw, bf16_t* __restrict__ WT, const float* __restrict__ gain, bool map1, int nblk, LAS float* scr, int item, int lane) {
    const int kb = item / nblk, nb = item % nblk, k0 = 64 * kb, n0 = 32 * nb, s0 = map1 ? srccol_in1(n0) : n0;
    float wv[32];
#pragma unroll
    for (int i = 0; i < 32; ++i) wv[i] = W[(size_t)(k0 + 2 * i + (lane >> 5)) * ldw + s0 + (lane & 31)];
    if (gain) {
#pragma unroll
        for (int i = 0; i < 32; ++i) wv[i] *= gain[k0 + 2 * i + (lane >> 5)];
    }
#pragma unroll
    for (int i = 0; i < 32; ++i) scr[(2 * i + (lane >> 5)) * 33 + (lane & 31)] = wv[i];
    LDS_WAIT(); asm volatile("" ::: "memory");
    const int c = lane & 7;
#pragma unroll
    for (int j = 0; j < 4; ++j) { const int n = (lane >> 3) + 8 * j; const LAS float* s = scr + (8 * c) * 33 + n;
        v4u o; o.x = pk2(s[0 * 33], s[1 * 33]); o.y = pk2(s[2 * 33], s[3 * 33]); o.z = pk2(s[4 * 33], s[5 * 33]); o.w = pk2(s[6 * 33], s[7 * 33]);
        *(v4u*)(WT + (size_t)(n0 + n) * K + k0 + 8 * c) = o; }
    LDS_WAIT(); asm volatile("" ::: "memory");
}
struct Frame {
    LAS unsigned char* lds; int tid, lane, wave, G, bid;
    const float* const* in; float* out; unsigned char* ws;
};
__device__ __forceinline__ void p0_layer1_weights(const Frame& F, int gw, int NGW) {
    LAS float* scr = (LAS float*)(F.lds + F.wave * 16384);
    unsigned char* ws = F.ws;
    const float* o_norm = F.in[14]; const float* o_w_in = F.in[15]; const float* o_w_out = F.in[21]; const float* ple_gate_w = F.in[24];
    constexpr int I_SQ = 32 * 64, I_IN1 = 32 * 256;
    for (int it = gw; it < I_IN1 + 2 * I_SQ; it += NGW) {
        int r = it;
        if (r < I_IN1) { p0_transpose_item(o_w_in, 2048, 8208, (bf16_t*)(ws + OFF_WIN1), o_norm, true, 256, scr, r, F.lane); continue; } r -= I_IN1;
        if (r < I_SQ) { p0_transpose_item(o_w_out, 2048, 2048, (bf16_t*)(ws + OFF_WOUT1), nullptr, false, 64, scr, r, F.lane); continue; } r -= I_SQ;
        p0_transpose_item(ple_gate_w + (size_t)2048 * 2048, 2048, 2048, (bf16_t*)(ws + OFF_WG1), nullptr, false, 64, scr, r, F.lane);
    }
    const int gt = gw * 64 + F.lane, NGT = NGW * 64;
    bf16_t* WGATE1 = (bf16_t*)(ws + OFF_WGATE1);
    for (int i = gt; i < 16 * 2048; i += NGT) { const int j = i >> 11, k = i & 2047; WGATE1[i] = (bf16_t)f2bf(o_w_in[(size_t)k * 8208 + 8192 + j] * o_norm[k]); }
}
__device__ __forceinline__ void p0_prologue(const Frame& F) {
    LAS float* scr = (LAS float*)(F.lds + F.wave * 16384);
    const int gw = F.bid * NWAVES + F.wave, NGW = F.G * NWAVES;
    unsigned char* ws = F.ws;
    const float* e_norm = F.in[2]; const float* e_w_in = F.in[3]; const float* e_w_out = F.in[13]; const float* ple_w = F.in[22]; const float* ple_gate_w = F.in[24];
    constexpr int I_IN0 = 32 * 192, I_SQ = 32 * 64, I_PLE = 4 * 64;
    constexpr int NITEMS = I_IN0 + 2 * I_SQ + 2 * I_PLE;
    for (int it = gw; it < NITEMS; it += NGW) {
        int r = it;
        if (r < I_IN0) { p0_transpose_item(e_w_in, 2048, 6144, (bf16_t*)(ws + OFF_WIN0), e_norm, false, 192, scr, r, F.lane); continue; } r -= I_IN0;
        if (r < I_SQ) { p0_transpose_item(e_w_out, 2048, 2048, (bf16_t*)(ws + OFF_WOUT0), nullptr, false, 64, scr, r, F.lane); continue; } r -= I_SQ;
        if (r < I_SQ) { p0_transpose_item(ple_gate_w, 2048, 2048, (bf16_t*)(ws + OFF_WG0), nullptr, false, 64, scr, r, F.lane); continue; } r -= I_SQ;
        if (r < I_PLE) { p0_transpose_item(ple_w, 256, 2048, (bf16_t*)(ws + OFF_PLEW), nullptr, false, 64, scr, r, F.lane); continue; } r -= I_PLE;
        p0_transpose_item(ple_w + (size_t)256 * 2048, 256, 2048, (bf16_t*)(ws + OFF_PLEW) + (size_t)2048 * 256, nullptr, false, 64, scr, r, F.lane);
    }
    const float* x = F.in[0]; bf16_t* A = (bf16_t*)(ws + OFF_A); float* rstd0 = (float*)(ws + OFF_SMALL) + 1024;
    for (int m = gw; m < M; m += NGW) {
        const f32x4* xr = (const f32x4*)(x + (size_t)m * D) + F.lane; f32x4 v[8]; float s = 0.f;
#pragma unroll
        for (int j = 0; j < 8; ++j) { v[j] = xr[64 * j]; s += (v[j].x * v[j].x + v[j].y * v[j].y) + (v[j].z * v[j].z + v[j].w * v[j].w); }
        s = wave_sum(s);
        v2u* o8 = (v2u*)(A + (size_t)m * D) + F.lane;
#pragma unroll
        for (int j = 0; j < 8; ++j) { v2u w; w.x = pk2(v[j].x, v[j].y); w.y = pk2(v[j].z, v[j].w); o8[64 * j] = w; }
        if (F.lane == 0) rstd0[m] = rsqrtf(s * (1.f / D) + EPS);
    }
    const int gt = F.bid * (NWAVES * 64) + F.tid, NGT = F.G * NWAVES * 64;
    bf16_t* WRT = (bf16_t*)(ws + OFF_WRT); const float* w_r = F.in[8]; const float* w_i = F.in[10];
    for (int i = gt; i < 2 * 131072; i += NGT) { const int j = i & 131071, n = j >> 14, d = (j >> 7) & 127, cc = j & 127; WRT[i] = (bf16_t)f2bf(((i >> 17) ? w_i : w_r)[n * 16384 + cc * 128 + d]); }
    float* lb = (float*)(ws + OFF_SMALL); const float* logits = F.in[4];
    for (int c = gt; c < 1024; c += NGT) lb[c] = 1.f / (1.f + expf(logits[1024 + c] - logits[c]));
}
__device__ __forceinline__ void gates1_phase(const Frame& F, const int dry) {
    const bf16_t* A = (const bf16_t*)(F.ws + OFF_A); const bf16_t* WG = (const bf16_t*)(F.ws + OFF_WGATE1);
    const float* hpart = (const float*)(F.ws + OFF_PART) + (size_t)M * 32; float* gates = (float*)(F.ws + OFF_GATES1);
    const int gw = F.bid * NWAVES + F.wave, NGW = F.G * NWAVES;
    for (int row = gw; row < M; row += NGW) {
        float ss = (F.lane < 32) ? hpart[(size_t)row * 32 + F.lane] : 0.f; ss = wave_sum(ss);
        const float sc = rsqrtf(ss * (1.f / D) + EPS);
        float a[32];
        const v4u* ar = (const v4u*)(A + (size_t)row * D) + F.lane;
#pragma unroll
        for (int j = 0; j < 4; ++j) { const v4u w = ar[64 * j]; a[8 * j + 0] = pg8::bflo(w.x); a[8 * j + 1] = pg8::bfhi(w.x); a[8 * j + 2] = pg8::bflo(w.y); a[8 * j + 3] = pg8::bfhi(w.y);
            a[8 * j + 4] = pg8::bflo(w.z); a[8 * j + 5] = pg8::bfhi(w.z); a[8 * j + 6] = pg8::bflo(w.w); a[8 * j + 7] = pg8::bfhi(w.w); }
        float res = 0.f;
        for (int g = 0; g < 16; ++g) {
            const v4u* wr = (const v4u*)(WG + (size_t)g * D) + F.lane; float s = 0.f;
#pragma unroll
            for (int j = 0; j < 4; ++j) { const v4u w = wr[64 * j];
                s += a[8 * j + 0] * pg8::bflo(w.x) + a[8 * j + 1] * pg8::bfhi(w.x) + a[8 * j + 2] * pg8::bflo(w.y) + a[8 * j + 3] * pg8::bfhi(w.y)
                   + a[8 * j + 4] * pg8::bflo(w.z) + a[8 * j + 5] * pg8::bfhi(w.z) + a[8 * j + 6] * pg8::bflo(w.w) + a[8 * j + 7] * pg8::bfhi(w.w); }
            s = wave_sum(s);
            res = (F.lane == g) ? s * sc : res;
        }
        if (F.lane < 16 && !dry) gates[(size_t)row * 16 + F.lane] = res;
    }
}
__device__ __forceinline__ void final_norm_phase(const Frame& F, const int dry) {
    const float* hpart = (const float*)(F.ws + OFF_PART) + (size_t)M * 32; const float* g = F.in[25];
    const int gw = F.bid * NWAVES + F.wave, NGW = F.G * NWAVES;
    f32x4 gv[8];
#pragma unroll
    for (int j = 0; j < 8; ++j) gv[j] = ((const f32x4*)g)[F.lane + 64 * j];
    for (int row = gw; row < M; row += NGW) {
        float ss = (F.lane < 32) ? hpart[(size_t)row * 32 + F.lane] : 0.f; ss = wave_sum(ss);
        const float rs = rsqrtf(ss * (1.f / D) + EPS);
        f32x4* xr = (f32x4*)(F.out + (size_t)row * D) + F.lane;
#pragma unroll
        for (int j = 0; j < 8; ++j) { f32x4 v = xr[64 * j]; v = v * gv[j] * rs; if (!dry) xr[64 * j] = v; }
    }
}

__device__ __forceinline__ void cvt_p_phase(const Frame& F, const int dry) {
    const float* p = F.in[1]; bf16_t* P16 = (bf16_t*)(F.ws + OFF_WIN0);
    const size_t n4 = (size_t)2 * M * PLE / 4, gt = (size_t)F.bid * (NWAVES * 64) + F.tid, NGT = (size_t)F.G * NWAVES * 64;
    for (size_t i = gt; i < n4; i += NGT) { const f32x4 v = ((const f32x4*)p)[i]; v2u w; w.x = pk2(v.x, v.y); w.y = pk2(v.z, v.w); if (!dry) ((v2u*)P16)[i] = w; }
}
__device__ __forceinline__ void hgrn2_naive_phase(const Frame& F, int b, int h) {
    LAS float* sq = (LAS float*)F.lds; LAS float* sf = sq + 128; LAS float* sk = sf + 128; LAS float* part = sk + 128; LAS float* red = part + 512;
    const bf16_t* U = (const bf16_t*)(F.ws + OFF_U); bf16_t* Y = (bf16_t*)(F.ws + OFF_A);
    const float* lb = (const float*)(F.ws + OFF_SMALL); const float* a_norm = F.in[5];
    const int tid = F.tid, e = tid & 127, qt = tid >> 7;
    float Sr[32];
#pragma unroll
    for (int i = 0; i < 32; ++i) Sr[i] = 0.f;
    const float lbv = lb[h * 128 + e], an = a_norm[h * 128 + e];
    const bf16_t* up = U + (size_t)b * S * 6144 + h * 128 + e;
    bf16_t nqa = up[0], nfa = up[1024], nv = up[2048], nza = up[3072];
    for (int t = 0; t < S; ++t) {
        const float qa = bf2f(nqa), fa = bf2f(nfa), v = bf2f(nv), za = bf2f(nza);
        if (t + 1 < S) { const bf16_t* np = up + (size_t)(t + 1) * 6144; nqa = np[0]; nfa = np[1024]; nv = np[2048]; nza = np[3072]; }
        if (qt == 0) { sq[e] = siluf_(qa); sf[e] = lbv + (1.f - lbv) * sigmoidf_(fa); sk[e] = (1.f - lbv) * sigmoidf_(-fa); }
        __syncthreads();
        float acc = 0.f;
#pragma unroll
        for (int i = 0; i < 32; ++i) { const int d = qt * 32 + i; Sr[i] = sf[d] * Sr[i] + sk[d] * v; acc += Sr[i] * sq[d]; }
        part[qt * 128 + e] = acc;
        __syncthreads();
        const float o = (part[e] + part[128 + e]) + (part[256 + e] + part[384 + e]);
        const float s2 = wave_sum(o * o);
        if ((tid & 63) == 0) red[tid >> 6] = s2;
        __syncthreads();
        const float tot = red[0] + red[1];
        if (qt == 0) Y[((size_t)b * S + t) * D + h * 128 + e] = (bf16_t)f2bf(o * rsqrtf(tot * (1.f / 128) + EPS) * an * siluf_(za));
    }
    __syncthreads();
}
__device__ __forceinline__ void rglru_naive_phase(const Frame& F, int b, int n) {
    LAS float* wr = (LAS float*)F.lds; LAS float* wi = wr + 16384; LAS float* xcs = (LAS float*)(F.lds + MISC_OFF + 256);
    const bf16_t* U = (const bf16_t*)(F.ws + OFF_U); bf16_t* Y = (bf16_t*)(F.ws + OFF_A);
    const float* conv_w = F.in[6]; const float* conv_b = F.in[7]; const float* w_r = F.in[8]; const float* b_r = F.in[9]; const float* w_i = F.in[10]; const float* b_i = F.in[11]; const float* lam = F.in[12];
    const int tid = F.tid, d = tid & 127, ch = n * 128 + d; const bool act = tid < 128;
    for (int i = tid; i < 16384; i += NWAVES * 64) { wr[i] = w_r[n * 16384 + i]; wi[i] = w_i[n * 16384 + i]; }
    const float cw0 = conv_w[ch], cw1 = conv_w[1024 + ch], cw2 = conv_w[2048 + ch], cw3 = conv_w[3072 + ch], cb = conv_b[ch], br = b_r[ch], bi = b_i[ch];
    const float sp = log1pf(expf(-lam[ch]));
    float x1 = 0.f, x2 = 0.f, x3 = 0.f, hst = 0.f;
    const bf16_t* up = U + (size_t)b * S * 6144 + 4096 + ch;
    bf16_t nx = up[0], nz = up[1024];
    __syncthreads();
    for (int t = 0; t < S; ++t) {
        const float xb = bf2f(nx), zb = bf2f(nz);
        if (t + 1 < S) { const bf16_t* np = up + (size_t)(t + 1) * 6144; nx = np[0]; nz = np[1024]; }
        const float xc = cb + cw0 * x3 + cw1 * x2 + cw2 * x1 + cw3 * xb;
        x3 = x2; x2 = x1; x1 = xb;
        if (act) xcs[d] = xc;
        __syncthreads();
        if (act) {
            float ar = br, ai = bi;
#pragma unroll 8
            for (int c = 0; c < 128; ++c) { const float xv = xcs[c]; ar += xv * wr[c * 128 + d]; ai += xv * wi[c * 128 + d]; }
            const float r = sigmoidf_(ar), ig = sigmoidf_(ai), log_a = -8.f * r * sp, a = expf(log_a);
            const float u = sqrtf(-expm1f(2.f * log_a)) * ig * xc;
            hst = a * hst + u;
            Y[((size_t)b * S + t) * D + 1024 + ch] = (bf16_t)f2bf(hst * siluf_(zb));
        }
        __syncthreads();
    }
}
__device__ __forceinline__ void qkconv_phase(const Frame& F) {
    const bf16_t* U = (const bf16_t*)(F.ws + OFF_U); bf16_t* QK = (bf16_t*)(F.ws + OFF_A); const float* cw = F.in[16]; const float* cb = F.in[17];
    const size_t gt = (size_t)F.bid * (NWAVES * 64) + F.tid, NGT = (size_t)F.G * NWAVES * 64;
    for (size_t i = gt; i < (size_t)M * 2048; i += NGT) {
        const int row = (int)(i >> 11), c = (int)(i & 2047), t = row & (S - 1);
        float acc = cb[c];
#pragma unroll
        for (int k = 0; k < 4; ++k) { const int tt = t - 3 + k; if (tt >= 0) acc += cw[k * 2048 + c] * bf2f(U[(size_t)(row - 3 + k) * 6144 + c]); }
        QK[i] = (bf16_t)f2bf(siluf_(acc));
    }
}
__device__ __forceinline__ void mlstm_naive_phase(const Frame& F, int b, int h) {
    LAS float* sq = (LAS float*)F.lds; LAS float* sk = sq + 128; LAS float* sn = sk + 128; LAS float* part = sn + 128; LAS float* red = part + 512;
    const bf16_t* U = (const bf16_t*)(F.ws + OFF_U); const bf16_t* QK = (const bf16_t*)(F.ws + OFF_A); bf16_t* Y = (bf16_t*)(F.ws + OFF_B);
    const float* gates = (const float*)(F.ws + OFF_GATES1); const float* c_norm = F.in[20];
    const int tid = F.tid, e = tid & 255, hf = tid >> 8;
    float C[64];
#pragma unroll
    for (int i = 0; i < 64; ++i) C[i] = 0.f;
    if (tid < 128) sn[tid] = 0.f;
    float m = 0.f;
    const float bi = F.in[18][h], bf = F.in[19][h], cn = c_norm[h * 256 + e];
    const size_t row0 = (size_t)b * S;
    __syncthreads();
    for (int t = 0; t < S; ++t) {
        const size_t row = row0 + t;
        if (tid < 128) sq[tid] = bf2f(QK[row * 2048 + h * 128 + tid]) * 0.08838834764831845f;
        else if (tid < 256) sk[tid - 128] = bf2f(QK[row * 2048 + 1024 + h * 128 + (tid - 128)]);
        const float li = gates[row * 16 + h] + bi, xf = gates[row * 16 + 8 + h] + bf;
        const float lf = fminf(xf, 0.f) - log1pf(expf(-fabsf(xf)));
        const float mn = fmaxf(lf + m, li), ip = expf(li - mn), fp = expf(lf + m - mn);
        m = mn;
        const float v = bf2f(U[row * 6144 + 2048 + h * 256 + e]), g = bf2f(U[row * 6144 + 4096 + h * 256 + e]);
        __syncthreads();
        float num = 0.f;
#pragma unroll
        for (int i = 0; i < 64; ++i) { const int d = hf * 64 + i; C[i] = fp * C[i] + (ip * sk[d]) * v; num += C[i] * sq[d]; }
        part[hf * 256 + e] = num;
        if (tid < 128) sn[tid] = fp * sn[tid] + ip * sk[tid];
        __syncthreads();
        float den = 0.f;
#pragma unroll 8
        for (int d = 0; d < 128; ++d) den += sn[d] * sq[d];
        const float hv = (part[e] + part[256 + e]) / fmaxf(fabsf(den), expf(-m));
        const float s2 = wave_sum(hv * hv);
        if ((tid & 63) == 0) red[tid >> 6] = s2;
        __syncthreads();
        const float tot = (red[0] + red[1]) + (red[2] + red[3]);
        if (hf == 0) Y[row * D + h * 256 + e] = (bf16_t)f2bf(hv * rsqrtf(tot * (1.f / 256) + EPS) * cn * g);
    }
    __syncthreads();
}

typedef short bf16x8_t __attribute__((ext_vector_type(8)));
typedef float f32x16 __attribute__((ext_vector_type(16)));

__device__ __forceinline__ void rglru_a_item(const Frame& F, const int dry, int b, int c, int n) {
    constexpr int XS = 136;
    LAS bf16_t* XT = (LAS bf16_t*)F.lds;
    LAS float* AL = (LAS float*)(F.lds + 17408);
    LAS float* ML = AL + 8192;
    LAS float* AGG = ML + 8192;
    const bf16_t* U = (const bf16_t*)(F.ws + OFF_U); bf16_t* HL = (bf16_t*)(F.ws + OFF_A); bf16_t* AC = (bf16_t*)(F.ws + OFF_ACUM); float* carry = (float*)(F.ws + OFF_CARRY);
    const bf16_t* WRT = (const bf16_t*)(F.ws + OFF_WRT) + (size_t)n * 16384; const bf16_t* WIT = WRT + 8 * 16384;
    const float* conv_w = F.in[6]; const float* conv_b = F.in[7]; const float* b_r = F.in[9]; const float* b_i = F.in[11]; const float* lam = F.in[12];
    const int tid = F.tid, d = tid & 127, q = tid >> 7, ch = n * 128 + d, t0 = c * 64;
    const size_t row0 = (size_t)b * S + t0;
    float xc[16];
    {
        float xv[19];
#pragma unroll
        for (int i = 0; i < 19; ++i) { const int t = t0 + 16 * q - 3 + i; xv[i] = (t >= 0) ? bf2f(U[((size_t)b * S + t) * 6144 + 4096 + ch]) : 0.f; }
        const float cw0 = conv_w[ch], cw1 = conv_w[1024 + ch], cw2 = conv_w[2048 + ch], cw3 = conv_w[3072 + ch], cb = conv_b[ch];
#pragma unroll
        for (int i = 0; i < 16; ++i) { xc[i] = cb + cw0 * xv[i] + cw1 * xv[i + 1] + cw2 * xv[i + 2] + cw3 * xv[i + 3]; XT[(16 * q + i) * XS + d] = (bf16_t)f2bf(xc[i]); }
    }
    WG_BAR();
    {
        const int w = F.wave, tt = w >> 2, db = w & 3, l31 = F.lane & 31, hh = F.lane >> 5;
        f32x16 accR, accI;
#pragma unroll
        for (int r = 0; r < 16; ++r) { accR[r] = 0.f; accI[r] = 0.f; }
        const LAS bf16_t* ap = XT + (32 * tt + l31) * XS + 8 * hh;
        const bf16_t* rp = WRT + (size_t)(32 * db + l31) * 128 + 8 * hh; const bf16_t* ip = WIT + (size_t)(32 * db + l31) * 128 + 8 * hh;
#pragma unroll
        for (int ks = 0; ks < 8; ++ks) {
            const bf16x8_t a = *(const LAS bf16x8_t*)(ap + 16 * ks), br_ = *(const bf16x8_t*)(rp + 16 * ks), bi_ = *(const bf16x8_t*)(ip + 16 * ks);
            accR = __builtin_amdgcn_mfma_f32_32x32x16_bf16(a, br_, accR, 0, 0, 0);
            accI = __builtin_amdgcn_mfma_f32_32x32x16_bf16(a, bi_, accI, 0, 0, 0);
        }
        const int dc = 32 * db + l31, chc = n * 128 + dc;
        const float brv = b_r[chc], biv = b_i[chc], sp = log1pf(expf(-lam[chc]));
#pragma unroll
        for (int r = 0; r < 16; ++r) {
            const int t = 32 * tt + (r & 3) + 8 * (r >> 2) + 4 * hh;
            const float rr = sigmoidf_(accR[r] + brv), ii = sigmoidf_(accI[r] + biv), la = -8.f * rr * sp;
            AL[t * 128 + dc] = __expf(la); ML[t * 128 + dc] = __builtin_amdgcn_sqrtf(one_minus_exp(2.f * la)) * ii;
        }
    }
    WG_BAR();
    float hl[16], ac[16];
    {
        float h = 0.f, Ac = 1.f;
#pragma unroll
        for (int i = 0; i < 16; ++i) { const int t = 16 * q + i; const float a = AL[t * 128 + d], u = ML[t * 128 + d] * xc[i]; h = a * h + u; Ac *= a; hl[i] = h; ac[i] = Ac; }
        AGG[(q * 2 + 0) * 128 + d] = Ac; AGG[(q * 2 + 1) * 128 + d] = h;
    }
    WG_BAR();
    {
        float Hp = 0.f, Ap = 1.f;
#pragma unroll
        for (int qq = 0; qq < 3; ++qq) if (qq < q) { const float a = AGG[(qq * 2 + 0) * 128 + d], hh_ = AGG[(qq * 2 + 1) * 128 + d]; Hp = a * Hp + hh_; Ap *= a; }
#pragma unroll
        for (int i = 0; i < 16; ++i) { const size_t row = row0 + 16 * q + i; const float hv = hl[i] + ac[i] * Hp, av = ac[i] * Ap;
            if (!dry) { HL[row * D + 1024 + ch] = (bf16_t)f2bf(hv); AC[row * 1024 + ch] = (bf16_t)f2bf(av); }
            if (q == 3 && i == 15 && !dry) { float* cp = carry + ((size_t)((b * 32 + c) * 8 + n)) * 256; cp[d] = av; cp[128 + d] = hv; } }
    }
    WG_BAR();
}
__device__ __forceinline__ void rglru_b_item(const Frame& F, const int dry, int b, int c, int n) {
    const bf16_t* U = (const bf16_t*)(F.ws + OFF_U); bf16_t* Y = (bf16_t*)(F.ws + OFF_A); const bf16_t* AC = (const bf16_t*)(F.ws + OFF_ACUM); const float* carry = (const float*)(F.ws + OFF_CARRY);
    const int tid = F.tid, d = tid & 127, q = tid >> 7, ch = n * 128 + d;
    float H = 0.f;
    for (int cc = 0; cc < c; ++cc) { const float* cp = carry + ((size_t)((b * 32 + cc) * 8 + n)) * 256; H = cp[d] * H + cp[128 + d]; }
    const size_t row0 = (size_t)b * S + c * 64 + 16 * q;
#pragma unroll 4
    for (int i = 0; i < 16; ++i) { const size_t row = row0 + i;
        const float hl = bf2f(Y[row * D + 1024 + ch]), av = bf2f(AC[row * 1024 + ch]), zb = bf2f(U[row * 6144 + 5120 + ch]);
        const bf16_t yv = (bf16_t)f2bf((hl + av * H) * siluf_(zb)); if (!dry) Y[row * D + 1024 + ch] = yv; }
}

typedef float f32x4_t __attribute__((ext_vector_type(4)));
typedef short bf16x4_t __attribute__((ext_vector_type(4)));
__device__ __forceinline__ bf16x8_t pack_bf16x8(float a0, float a1, float a2, float a3, float a4, float a5, float a6, float a7) {
    v4u w; w.x = pg8::cvt_pk_bf16(a0, a1); w.y = pg8::cvt_pk_bf16(a2, a3); w.z = pg8::cvt_pk_bf16(a4, a5); w.w = pg8::cvt_pk_bf16(a6, a7);
    return __builtin_bit_cast(bf16x8_t, w);
}
__device__ __forceinline__ bf16x8_t cat_bf16x4(v2u lo, v2u hi) { v4u w; w.x = lo.x; w.y = lo.y; w.z = hi.x; w.w = hi.y; return __builtin_bit_cast(bf16x8_t, w); }

__device__ __forceinline__ void hgrn2_a_item(const Frame& F, const int dry, int b, int c, int h) {
    constexpr int QS = 136, VS = 72;
    LAS bf16_t* QT = (LAS bf16_t*)F.lds;
    LAS bf16_t* KT = QT + 64 * QS;
    LAS bf16_t* VT = KT + 64 * QS;
    LAS bf16_t* AT = VT + 128 * VS;
    LAS float* CS = (LAS float*)(AT + 64 * VS);
    bf16_t* U = (bf16_t*)(F.ws + OFF_U); bf16_t* OI = (bf16_t*)(F.ws + OFF_A); float* decay = (float*)(F.ws + OFF_DECAY);
    const float* lb = (const float*)(F.ws + OFF_SMALL);
    const int tid = F.tid, d = tid & 127, q = tid >> 7, t0 = c * 64;
    const size_t row0 = (size_t)b * S + t0;
    {
        const float lbv = lb[h * 128 + d];
        float qa[16], fa[16], vv[16];
        const bf16_t* up = U + (row0 + 16 * q) * 6144 + h * 128 + d;
#pragma unroll
        for (int i = 0; i < 16; ++i) { qa[i] = bf2f(up[(size_t)i * 6144]); fa[i] = bf2f(up[(size_t)i * 6144 + 1024]); vv[i] = bf2f(up[(size_t)i * 6144 + 2048]); }
        float cs[16]; float run = 0.f;
#pragma unroll
        for (int i = 0; i < 16; ++i) { const float e_ = __expf(-fa[i]), sg = __builtin_amdgcn_rcpf(1.f + e_); run += __logf(lbv + (1.f - lbv) * sg); cs[i] = run; fa[i] = (1.f - lbv) * e_ * sg; }
        CS[q * 128 + d] = run;
        WG_BAR();
        float off = 0.f, tot = 0.f;
#pragma unroll
        for (int qq = 0; qq < 4; ++qq) { const float v_ = CS[qq * 128 + d]; off += (qq < q) ? v_ : 0.f; tot += v_; }
        float kd[16];
        const float etot = __expf(tot);
#pragma unroll
        for (int i = 0; i < 16; ++i) { const float bt = off + cs[i], k = fa[i], eb_ = __expf(bt), ei_ = __builtin_amdgcn_rcpf(eb_), kei = k * ei_;
            QT[(16 * q + i) * QS + d] = (bf16_t)f2bf(siluf_(qa[i]) * eb_); KT[(16 * q + i) * QS + d] = (bf16_t)f2bf(kei); kd[i] = kei * etot; }
        const bf16x8_t k0 = pack_bf16x8(kd[0], kd[1], kd[2], kd[3], kd[4], kd[5], kd[6], kd[7]), k1 = pack_bf16x8(kd[8], kd[9], kd[10], kd[11], kd[12], kd[13], kd[14], kd[15]);
        const bf16x8_t v0 = pack_bf16x8(vv[0], vv[1], vv[2], vv[3], vv[4], vv[5], vv[6], vv[7]), v1 = pack_bf16x8(vv[8], vv[9], vv[10], vv[11], vv[12], vv[13], vv[14], vv[15]);
        *(LAS bf16x8_t*)(VT + d * VS + 16 * q) = v0; *(LAS bf16x8_t*)(VT + d * VS + 16 * q + 8) = v1;
        WG_BAR();
        bf16_t* tp = U + (row0 + (d >> 1)) * 6144 + h * 128 + (d & 1) * 64 + 16 * q;
        if (!dry) { *(bf16x8_t*)(tp + 1024) = k0; *(bf16x8_t*)(tp + 1024 + 8) = k1;
        *(bf16x8_t*)(tp + 2048) = v0; *(bf16x8_t*)(tp + 2048 + 8) = v1; }
        if (q == 0 && !dry) decay[((size_t)((b * 32 + c) * 8 + h)) * 128 + d] = __expf(tot);
    }
    {
        const int w = F.wave, tb = w >> 1, r = F.lane & 15, g = F.lane >> 4;
#pragma unroll
        for (int k2 = 0; k2 < 2; ++k2) {
            const int sb = 2 * (w & 1) + k2;
            f32x4_t acc = {0.f, 0.f, 0.f, 0.f};
            if (sb <= tb) {
#pragma unroll
                for (int ks = 0; ks < 4; ++ks) {
                    const bf16x8_t a = *(const LAS bf16x8_t*)(QT + (16 * tb + r) * QS + 32 * ks + 8 * g), bb = *(const LAS bf16x8_t*)(KT + (16 * sb + r) * QS + 32 * ks + 8 * g);
                    acc = __builtin_amdgcn_mfma_f32_16x16x32_bf16(a, bb, acc, 0, 0, 0);
                }
            }
#pragma unroll
            for (int j = 0; j < 4; ++j) { const int t = 16 * tb + 4 * g + j, s = 16 * sb + r; AT[t * VS + s] = (bf16_t)f2bf(s <= t ? acc[j] : 0.f); }
        }
    }
    WG_BAR();
    {
        const int w = F.wave, th = w >> 2, eb = w & 3, l31 = F.lane & 31, hh = F.lane >> 5;
        f32x16 acc;
#pragma unroll
        for (int r = 0; r < 16; ++r) acc[r] = 0.f;
#pragma unroll
        for (int ks = 0; ks < 4; ++ks) {
            const bf16x8_t a = *(const LAS bf16x8_t*)(AT + (32 * th + l31) * VS + 16 * ks + 8 * hh), bb = *(const LAS bf16x8_t*)(VT + (32 * eb + l31) * VS + 16 * ks + 8 * hh);
            acc = __builtin_amdgcn_mfma_f32_32x32x16_bf16(a, bb, acc, 0, 0, 0);
        }
#pragma unroll
        for (int r = 0; r < 16; ++r) { const int t = 32 * th + (r & 3) + 8 * (r >> 2) + 4 * hh; const bf16_t ov = (bf16_t)f2bf(acc[r]); if (!dry) OI[(row0 + t) * D + h * 128 + 32 * eb + l31] = ov; }
#pragma unroll
        for (int j = 0; j < 2; ++j) { const int p = tid + 512 * j, row = p >> 4, c16 = p & 15; const bf16x8_t qv_ = *(const LAS bf16x8_t*)(QT + row * QS + c16 * 8); if (!dry) *(bf16x8_t*)(U + (row0 + row) * 6144 + h * 128 + c16 * 8) = qv_; }
    }
    WG_BAR();
}

__device__ __forceinline__ void hgrn2_b_phase(const Frame& F, const int dry, int b, int h) {
    constexpr int QS = 132, VS = 72;
    LAS bf16_t* QB = (LAS bf16_t*)F.lds;
    LAS bf16_t* KB = QB + 64 * QS;
    LAS bf16_t* VB = KB + 128 * VS;
    LAS float* DEC = (LAS float*)(VB + 128 * VS);
    bf16_t* U = (bf16_t*)(F.ws + OFF_U); const float* decay = (const float*)(F.ws + OFF_DECAY);
    const int tid = F.tid, w = F.wave, eb = w & 3, dh = w >> 2, l31 = F.lane & 31, hh = F.lane >> 5;
    f32x16 X[2];
#pragma unroll
    for (int xi = 0; xi < 2; ++xi)
#pragma unroll
        for (int r = 0; r < 16; ++r) X[xi][r] = 0.f;
    bf16x8_t pq[2], pk[2], pv[2]; float pdec = 0.f;
    {
        const size_t row0 = (size_t)b * S;
#pragma unroll
        for (int j = 0; j < 2; ++j) { const int p = tid + 512 * j; const bf16_t* up = U + (row0 + (p >> 4)) * 6144 + h * 128 + (p & 15) * 8;
            pq[j] = *(const bf16x8_t*)up; pk[j] = *(const bf16x8_t*)(up + 1024); pv[j] = *(const bf16x8_t*)(up + 2048); }
        if (tid < 128) pdec = decay[((size_t)((b * 32 + 0) * 8 + h)) * 128 + tid];
    }
    for (int c = 0; c < 32; ++c) {
        const size_t row0 = (size_t)b * S + c * 64;
#pragma unroll
        for (int j = 0; j < 2; ++j) { const int p = tid + 512 * j, ur = p >> 4, c16 = p & 15;
            { const v4u w4 = __builtin_bit_cast(v4u, pq[j]); v2u lo, hi; lo.x = w4.x; lo.y = w4.y; hi.x = w4.z; hi.y = w4.w; *(LAS v2u*)(QB + ur * QS + c16 * 8) = lo; *(LAS v2u*)(QB + ur * QS + c16 * 8 + 4) = hi; }
            *(LAS bf16x8_t*)(KB + (2 * ur + (c16 >> 3)) * VS + (c16 & 7) * 8) = pk[j];
            *(LAS bf16x8_t*)(VB + (2 * ur + (c16 >> 3)) * VS + (c16 & 7) * 8) = pv[j]; }
        if (tid < 128) DEC[tid] = pdec;
        WG_BAR();
        if (c + 1 < 32) {
            const size_t rn = row0 + 64;
#pragma unroll
            for (int j = 0; j < 2; ++j) { const int p = tid + 512 * j; const bf16_t* up = U + (rn + (p >> 4)) * 6144 + h * 128 + (p & 15) * 8;
                pq[j] = *(const bf16x8_t*)up; pk[j] = *(const bf16x8_t*)(up + 1024); pv[j] = *(const bf16x8_t*)(up + 2048); }
            if (tid < 128) pdec = decay[((size_t)((b * 32 + c + 1) * 8 + h)) * 128 + tid];
        }
        f32x16 accT[2];
#pragma unroll
        for (int tt = 0; tt < 2; ++tt)
#pragma unroll
            for (int r = 0; r < 16; ++r) accT[tt][r] = 0.f;
#pragma unroll
        for (int xi = 0; xi < 2; ++xi)
#pragma unroll
            for (int s = 0; s < 2; ++s) {
                const bf16x8_t a = pack_bf16x8(X[xi][8 * s + 0], X[xi][8 * s + 1], X[xi][8 * s + 2], X[xi][8 * s + 3], X[xi][8 * s + 4], X[xi][8 * s + 5], X[xi][8 * s + 6], X[xi][8 * s + 7]);
#pragma unroll
                for (int tt = 0; tt < 2; ++tt) {
                    const LAS bf16_t* qp = QB + (32 * tt + l31) * QS + 64 * dh + 32 * xi + 16 * s + 4 * hh;
                    const bf16x8_t bq = cat_bf16x4(*(const LAS v2u*)qp, *(const LAS v2u*)(qp + 8));
                    accT[tt] = __builtin_amdgcn_mfma_f32_32x32x16_bf16(a, bq, accT[tt], 0, 0, 0);
                }
            }
#pragma unroll
        for (int xi = 0; xi < 2; ++xi) {
#pragma unroll
            for (int g4 = 0; g4 < 4; ++g4) { const f32x4_t dv = *(const LAS f32x4_t*)(DEC + 64 * dh + 32 * xi + 8 * g4 + 4 * hh);
                X[xi][4 * g4 + 0] *= dv[0]; X[xi][4 * g4 + 1] *= dv[1]; X[xi][4 * g4 + 2] *= dv[2]; X[xi][4 * g4 + 3] *= dv[3]; }
#pragma unroll
            for (int ks = 0; ks < 4; ++ks) {
                const bf16x8_t a = *(const LAS bf16x8_t*)(KB + (64 * dh + 32 * xi + l31) * VS + 16 * ks + 8 * hh), bv = *(const LAS bf16x8_t*)(VB + (32 * eb + l31) * VS + 16 * ks + 8 * hh);
                X[xi] = __builtin_amdgcn_mfma_f32_32x32x16_bf16(a, bv, X[xi], 0, 0, 0);
            }
        }
#pragma unroll
        for (int tt = 0; tt < 2; ++tt)
#pragma unroll
            for (int g4 = 0; g4 < 4; ++g4) { v2u ow; ow.x = pg8::cvt_pk_bf16(accT[tt][4 * g4 + 0], accT[tt][4 * g4 + 1]); ow.y = pg8::cvt_pk_bf16(accT[tt][4 * g4 + 2], accT[tt][4 * g4 + 3]);
                if (!dry) *(v2u*)(U + (row0 + 32 * tt + l31) * 6144 + 1024 * dh + h * 128 + 32 * eb + 8 * g4 + 4 * hh) = ow; }
        WG_BAR();
    }
}

__device__ __forceinline__ void hgrn2_c_item(const Frame& F, const int dry, int b, int c, int h) {
    const bf16_t* U = (const bf16_t*)(F.ws + OFF_U); bf16_t* Y = (bf16_t*)(F.ws + OFF_A); const float* a_norm = F.in[5];
    const int w = F.wave, l31 = F.lane & 31, hh = F.lane >> 5;
    const size_t row0 = (size_t)b * S + c * 64;
    const f32x4_t an = *(const f32x4_t*)(a_norm + h * 128 + 4 * l31);
    v2u oi[4], p0[4], p1[4], zz[4];
#pragma unroll
    for (int i = 0; i < 4; ++i) { const size_t row = row0 + 8 * w + 2 * i + hh;
        oi[i] = *(const v2u*)(Y + row * D + h * 128 + 4 * l31); p0[i] = *(const v2u*)(U + row * 6144 + h * 128 + 4 * l31);
        p1[i] = *(const v2u*)(U + row * 6144 + 1024 + h * 128 + 4 * l31); zz[i] = *(const v2u*)(U + row * 6144 + 3072 + h * 128 + 4 * l31); }
#pragma unroll
    for (int i = 0; i < 4; ++i) { const size_t row = row0 + 8 * w + 2 * i + hh;
        const float o0 = pg8::bflo(oi[i].x) + pg8::bflo(p0[i].x) + pg8::bflo(p1[i].x), o1 = pg8::bfhi(oi[i].x) + pg8::bfhi(p0[i].x) + pg8::bfhi(p1[i].x);
        const float o2 = pg8::bflo(oi[i].y) + pg8::bflo(p0[i].y) + pg8::bflo(p1[i].y), o3 = pg8::bfhi(oi[i].y) + pg8::bfhi(p0[i].y) + pg8::bfhi(p1[i].y);
        float ss = (o0 * o0 + o1 * o1) + (o2 * o2 + o3 * o3);
        ss += __shfl_xor(ss, 1); ss += __shfl_xor(ss, 2); ss += __shfl_xor(ss, 4); ss += __shfl_xor(ss, 8); ss += __shfl_xor(ss, 16);
        const float rs = rsqrtf(ss * (1.f / 128.f) + EPS);
        v2u yw; yw.x = pg8::cvt_pk_bf16(o0 * rs * an[0] * siluf_(pg8::bflo(zz[i].x)), o1 * rs * an[1] * siluf_(pg8::bfhi(zz[i].x)));
        yw.y = pg8::cvt_pk_bf16(o2 * rs * an[2] * siluf_(pg8::bflo(zz[i].y)), o3 * rs * an[3] * siluf_(pg8::bfhi(zz[i].y)));
        if (!dry) *(v2u*)(Y + row * D + h * 128 + 4 * l31) = yw; }
}

constexpr size_t OFF_MS = OFF_PART;
constexpr size_t OFF_ITEM1 = OFF_PART + 1 * MiB;

__device__ __forceinline__ void mlstm_a_item(const Frame& F, const int dry, int b, int c, int h) {
    constexpr int QS = 136, VS = 72;
    LAS bf16_t* QT = (LAS bf16_t*)F.lds;
    LAS bf16_t* KT = QT + 64 * QS;
    LAS bf16_t* VT = KT + 64 * QS;
    LAS bf16_t* AT = VT + 256 * VS;
    LAS float* BCS = (LAS float*)(AT + 64 * VS);
    LAS float* A2 = BCS + 64; LAS float* PM = A2 + 64; LAS float* KWS = PM + 64;
    LAS float* NL = KWS + 64;
    LAS float* DL = NL + 512;
    bf16_t* U = (bf16_t*)(F.ws + OFF_U); bf16_t* QA = (bf16_t*)F.out;     bf16_t* NUM = (bf16_t*)(F.ws + OFF_B);
    const float* gates = (const float*)(F.ws + OFF_GATES1); float* MS = (float*)(F.ws + OFF_MS); float* ITEM = (float*)(F.ws + OFF_ITEM1) + (size_t)((b * 32 + c) * 8 + h) * 256;
    const float* cw = F.in[16]; const float* cb = F.in[17];
    const int tid = F.tid, w = F.wave, lane = F.lane, d = tid & 127, qq = tid >> 7, t0 = c * 64;
    const size_t row0 = (size_t)b * S + t0;
    if (w == 0) {
        const size_t row = row0 + lane;
        const float li = gates[row * 16 + h] + F.in[18][h], xf = gates[row * 16 + 8 + h] + F.in[19][h];
        const float lf = fminf(xf, 0.f) - log1pf(expf(-fabsf(xf)));
        float bc = lf;
#pragma unroll
        for (int o = 1; o < 64; o <<= 1) { const float v_ = __shfl_up(bc, o); bc += (lane >= o) ? v_ : 0.f; }
        const float a2 = li - bc; float pm = a2;
#pragma unroll
        for (int o = 1; o < 64; o <<= 1) { const float v_ = __shfl_up(pm, o); pm = (lane >= o) ? fmaxf(pm, v_) : pm; }
        const float pml = __shfl(pm, 63), bl = __shfl(bc, 63);
        BCS[lane] = bc; A2[lane] = a2; PM[lane] = pm; KWS[lane] = __expf(a2 - pml);
        if (!dry) { MS[(row * 8 + h) * 4 + 0] = bc; MS[(row * 8 + h) * 4 + 1] = bc + pm; }
        if (lane == 0 && !dry) { ITEM[128] = bl + pml; ITEM[129] = bl; }
    }
    float kp[16];
    {
        float xq[19], xk[19];
#pragma unroll
        for (int i = 0; i < 19; ++i) { const int t = t0 + 16 * qq - 3 + i; const bool ok = t >= 0; const bf16_t* up = U + ((size_t)b * S + (ok ? t : 0)) * 6144 + h * 128 + d;
            xq[i] = ok ? bf2f(up[0]) : 0.f; xk[i] = ok ? bf2f(up[1024]) : 0.f; }
        const int cq = h * 128 + d, ck = 1024 + h * 128 + d;
        const float q0 = cw[cq], q1 = cw[2048 + cq], q2 = cw[4096 + cq], q3 = cw[6144 + cq], qb = cb[cq];
        const float k0 = cw[ck], k1 = cw[2048 + ck], k2 = cw[4096 + ck], k3 = cw[6144 + ck], kb = cb[ck];
#pragma unroll
        for (int i = 0; i < 16; ++i) {
            const float qv = siluf_(qb + q0 * xq[i] + q1 * xq[i + 1] + q2 * xq[i + 2] + q3 * xq[i + 3]) * 0.08838834764831845f;
            kp[i] = siluf_(kb + k0 * xk[i] + k1 * xk[i + 1] + k2 * xk[i + 2] + k3 * xk[i + 3]);
            QT[(16 * qq + i) * QS + d] = (bf16_t)f2bf(qv); KT[(16 * qq + i) * QS + d] = (bf16_t)f2bf(kp[i]);
        }
    }
    bf16x8_t vt[4];
    {
        const int e = tid & 255, hf = tid >> 8;
        const bf16_t* vp = U + (row0 + 32 * hf) * 6144 + 2048 + h * 256 + e;
        unsigned short vv[32];
#pragma unroll
        for (int i = 0; i < 32; ++i) vv[i] = vp[(size_t)i * 6144];
#pragma unroll
        for (int j = 0; j < 4; ++j) { v4u w4; w4.x = vv[8 * j] | ((unsigned)vv[8 * j + 1] << 16); w4.y = vv[8 * j + 2] | ((unsigned)vv[8 * j + 3] << 16); w4.z = vv[8 * j + 4] | ((unsigned)vv[8 * j + 5] << 16); w4.w = vv[8 * j + 6] | ((unsigned)vv[8 * j + 7] << 16);
            vt[j] = __builtin_bit_cast(bf16x8_t, w4); *(LAS bf16x8_t*)(VT + e * VS + 32 * hf + 8 * j) = vt[j]; }
    }
    WG_BAR();
    {
        const int e = tid & 255, hf = tid >> 8;
        bf16_t* tp = U + (row0 + (e >> 2)) * 6144 + 2048 + h * 256 + (e & 3) * 64 + 32 * hf;
#pragma unroll
        for (int j = 0; j < 4; ++j) if (!dry) *(bf16x8_t*)(tp + 8 * j) = vt[j];
        float kw[16], ns = 0.f;
#pragma unroll
        for (int i = 0; i < 16; ++i) { kw[i] = kp[i] * KWS[16 * qq + i]; ns += kw[i]; }
        NL[qq * 128 + d] = ns;
        bf16_t* kp_ = QA + (row0 + (d >> 1)) * D + 1024 + h * 128 + (d & 1) * 64 + 16 * qq;
        { const bf16x8_t ka_ = pack_bf16x8(kw[0], kw[1], kw[2], kw[3], kw[4], kw[5], kw[6], kw[7]), kb_ = pack_bf16x8(kw[8], kw[9], kw[10], kw[11], kw[12], kw[13], kw[14], kw[15]); if (!dry) { *(bf16x8_t*)kp_ = ka_; *(bf16x8_t*)(kp_ + 8) = kb_; } }
#pragma unroll
        for (int j = 0; j < 2; ++j) { const int p = tid + 512 * j, row = p >> 4, c16 = p & 15; const bf16x8_t qv_ = *(const LAS bf16x8_t*)(QT + row * QS + c16 * 8); if (!dry) *(bf16x8_t*)(QA + (row0 + row) * D + h * 128 + c16 * 8) = qv_; }
    }
    {
        const int tb = w >> 1, r = lane & 15, g = lane >> 4;
#pragma unroll
        for (int k2 = 0; k2 < 2; ++k2) {
            const int sb = 2 * (w & 1) + k2;
            f32x4_t acc = {0.f, 0.f, 0.f, 0.f};
            if (sb <= tb) {
#pragma unroll
                for (int ks = 0; ks < 4; ++ks) {
                    const bf16x8_t a = *(const LAS bf16x8_t*)(KT + (16 * sb + r) * QS + 32 * ks + 8 * g), bb = *(const LAS bf16x8_t*)(QT + (16 * tb + r) * QS + 32 * ks + 8 * g);
                    acc = __builtin_amdgcn_mfma_f32_16x16x32_bf16(a, bb, acc, 0, 0, 0);
                }
            }
            const int t = 16 * tb + r, s0 = 16 * sb + 4 * g; const float pmt = PM[t];
            float sc[4], ds = 0.f;
#pragma unroll
            for (int j = 0; j < 4; ++j) { sc[j] = (s0 + j <= t) ? acc[j] * __expf(A2[s0 + j] - pmt) : 0.f; ds += sc[j]; }
            v2u pw; pw.x = pg8::cvt_pk_bf16(sc[0], sc[1]); pw.y = pg8::cvt_pk_bf16(sc[2], sc[3]);
            *(LAS v2u*)(AT + t * VS + s0) = pw;
            ds += __shfl_xor(ds, 16); ds += __shfl_xor(ds, 32);
            if (g == 0) DL[sb * 64 + t] = ds;
        }
    }
    WG_BAR();
    {
        const int l31 = lane & 31, hh = lane >> 5;
#pragma unroll
        for (int th = 0; th < 2; ++th) {
            f32x16 acc;
#pragma unroll
            for (int r = 0; r < 16; ++r) acc[r] = 0.f;
#pragma unroll
            for (int ks = 0; ks < 4; ++ks) {
                const bf16x8_t a = *(const LAS bf16x8_t*)(AT + (32 * th + l31) * VS + 16 * ks + 8 * hh), bb = *(const LAS bf16x8_t*)(VT + (32 * w + l31) * VS + 16 * ks + 8 * hh);
                acc = __builtin_amdgcn_mfma_f32_32x32x16_bf16(a, bb, acc, 0, 0, 0);
            }
#pragma unroll
            for (int r = 0; r < 16; ++r) { const int t = 32 * th + (r & 3) + 8 * (r >> 2) + 4 * hh; const bf16_t nv_ = (bf16_t)f2bf(acc[r]); if (!dry) NUM[(row0 + t) * D + h * 256 + 32 * w + l31] = nv_; }
        }
        if (tid < 64 && !dry) MS[((row0 + tid) * 8 + h) * 4 + 2] = (DL[tid] + DL[64 + tid]) + (DL[128 + tid] + DL[192 + tid]);
        if (tid >= 128 && tid < 256 && !dry) { const int dd = tid - 128; ITEM[dd] = (NL[dd] + NL[128 + dd]) + (NL[256 + dd] + NL[384 + dd]); }
    }
    WG_BAR();
}

__device__ __forceinline__ void mlstm_b_phase(const Frame& F, const int dry, int b, int h, int eh) {
    constexpr int QS = 132, VS = 72;
    LAS bf16_t* QB = (LAS bf16_t*)F.lds;
    LAS bf16_t* KB = QB + 64 * QS;
    LAS bf16_t* VB = KB + 128 * VS;
    LAS float* NS = (LAS float*)(VB + 128 * VS);
    LAS float* DECC = NS + 128;
    LAS float* SLOC = DECC + 32;
    bf16_t* U = (bf16_t*)(F.ws + OFF_U); const bf16_t* QA = (const bf16_t*)F.out; bf16_t* P1 = (bf16_t*)F.out + (size_t)M * D;
    float* MS = (float*)(F.ws + OFF_MS); float* ITEM0 = (float*)(F.ws + OFF_ITEM1) + (size_t)((b * 32) * 8 + h) * 256;
    const int tid = F.tid, w = F.wave, lane = F.lane, l31 = lane & 31, hh = lane >> 5, eb = w & 3, dh = w >> 2;
    if (w == 0) {
        const float Mc_l = (lane < 32) ? ITEM0[(size_t)lane * 2048 + 128] : 0.f, bl_l = (lane < 32) ? ITEM0[(size_t)lane * 2048 + 129] : 0.f;
        float m = 0.f, mine_m = 0.f, mine_dec = 0.f, mine_sl = 0.f;
        for (int c = 0; c < 32; ++c) { const float Mc = __shfl(Mc_l, c), bl = __shfl(bl_l, c), mn = fmaxf(bl + m, Mc);
            if (lane == c) { mine_m = m; mine_dec = __expf(bl + m - mn); mine_sl = __expf(Mc - mn); }
            m = mn; }
        if (lane < 32) { DECC[lane] = mine_dec; SLOC[lane] = mine_sl; if (!dry && eh == 0) ITEM0[(size_t)lane * 2048 + 130] = mine_m; }
    }
    if (tid < 128) NS[tid] = 0.f;
    f32x16 X[2];
#pragma unroll
    for (int xi = 0; xi < 2; ++xi)
#pragma unroll
        for (int r = 0; r < 16; ++r) X[xi][r] = 0.f;
    bf16x8_t pqA[2], pkA[2], pvA[2], pqB[2], pkB[2], pvB[2]; float pnlA = 0.f, pnlB = 0.f;
    {
        const size_t row0 = (size_t)b * S;
#pragma unroll
        for (int j = 0; j < 2; ++j) { const int p = tid + 512 * j; const bf16_t* ap = QA + (row0 + (p >> 4)) * D + h * 128 + (p & 15) * 8; pqA[j] = *(const bf16x8_t*)ap; pkA[j] = *(const bf16x8_t*)(ap + 1024);
            pvA[j] = *(const bf16x8_t*)(U + (row0 + 32 * eh + (p >> 5)) * 6144 + 2048 + h * 256 + (p & 31) * 8);
            const bf16_t* bp = ap + (size_t)64 * D; pqB[j] = *(const bf16x8_t*)bp; pkB[j] = *(const bf16x8_t*)(bp + 1024);
            pvB[j] = *(const bf16x8_t*)(U + (row0 + 64 + 32 * eh + (p >> 5)) * 6144 + 2048 + h * 256 + (p & 31) * 8); }
        if (tid < 128) { pnlA = ITEM0[tid]; pnlB = ITEM0[2048 + tid]; }
    }
    WG_BAR();
#define MLSTM_B_CHUNK(CIDX, PQ, PK, PV, PNL) { const int c = (CIDX); \
        const size_t row0 = (size_t)b * S + c * 64; \
        const float dec = DECC[c], sloc = SLOC[c]; \
_Pragma("unroll") \
        for (int j = 0; j < 2; ++j) { const int p = tid + 512 * j, ur = p >> 4, c16 = p & 15; \
            { const v4u w4 = __builtin_bit_cast(v4u, PQ[j]); v2u lo, hi; lo.x = w4.x; lo.y = w4.y; hi.x = w4.z; hi.y = w4.w; *(LAS v2u*)(QB + ur * QS + c16 * 8) = lo; *(LAS v2u*)(QB + ur * QS + c16 * 8 + 4) = hi; } \
            { const v4u w4 = __builtin_bit_cast(v4u, PK[j]); \
              const bf16x8_t ks_ = pack_bf16x8(pg8::bflo(w4.x) * sloc, pg8::bfhi(w4.x) * sloc, pg8::bflo(w4.y) * sloc, pg8::bfhi(w4.y) * sloc, pg8::bflo(w4.z) * sloc, pg8::bfhi(w4.z) * sloc, pg8::bflo(w4.w) * sloc, pg8::bfhi(w4.w) * sloc); \
              *(LAS bf16x8_t*)(KB + (2 * ur + (c16 >> 3)) * VS + (c16 & 7) * 8) = ks_; } \
            { const int vr = p >> 5, c32 = p & 31; *(LAS bf16x8_t*)(VB + (4 * vr + (c32 >> 3)) * VS + (c32 & 7) * 8) = PV[j]; } } \
        const float nl_cur = PNL; \
        WG_BAR(); \
        if (c + 2 < 32) { \
            const size_t rn = row0 + 128; \
_Pragma("unroll") \
            for (int j = 0; j < 2; ++j) { const int p = tid + 512 * j; const bf16_t* ap = QA + (rn + (p >> 4)) * D + h * 128 + (p & 15) * 8; PQ[j] = *(const bf16x8_t*)ap; PK[j] = *(const bf16x8_t*)(ap + 1024); \
                PV[j] = *(const bf16x8_t*)(U + (rn + 32 * eh + (p >> 5)) * 6144 + 2048 + h * 256 + (p & 31) * 8); } \
            if (tid < 128) PNL = ITEM0[(size_t)(c + 2) * 2048 + tid]; \
        } \
 \
        if (eh == 0) { \
            const int tq = 8 * w + (lane >> 3), d0 = (lane & 7) * 16; float s = 0.f; \
_Pragma("unroll") \
            for (int j = 0; j < 4; ++j) { const v2u qv = *(const LAS v2u*)(QB + tq * QS + d0 + 4 * j); const f32x4_t nv = *(const LAS f32x4_t*)(NS + d0 + 4 * j); \
                s += (pg8::bflo(qv.x) * nv[0] + pg8::bfhi(qv.x) * nv[1]) + (pg8::bflo(qv.y) * nv[2] + pg8::bfhi(qv.y) * nv[3]); } \
            s += __shfl_xor(s, 1); s += __shfl_xor(s, 2); s += __shfl_xor(s, 4); \
            if ((lane & 7) == 0 && !dry) MS[((row0 + tq) * 8 + h) * 4 + 3] = s; \
        } \
 \
        f32x16 accT[2]; \
_Pragma("unroll") \
        for (int tt = 0; tt < 2; ++tt) \
_Pragma("unroll") \
            for (int r = 0; r < 16; ++r) accT[tt][r] = 0.f; \
_Pragma("unroll") \
        for (int xi = 0; xi < 2; ++xi) \
_Pragma("unroll") \
            for (int s = 0; s < 2; ++s) { \
                const bf16x8_t a = pack_bf16x8(X[xi][8 * s + 0], X[xi][8 * s + 1], X[xi][8 * s + 2], X[xi][8 * s + 3], X[xi][8 * s + 4], X[xi][8 * s + 5], X[xi][8 * s + 6], X[xi][8 * s + 7]); \
_Pragma("unroll") \
                for (int tt = 0; tt < 2; ++tt) { \
                    const LAS bf16_t* qp = QB + (32 * tt + l31) * QS + 64 * dh + 32 * xi + 16 * s + 4 * hh; \
                    const bf16x8_t bq = cat_bf16x4(*(const LAS v2u*)qp, *(const LAS v2u*)(qp + 8)); \
                    accT[tt] = __builtin_amdgcn_mfma_f32_32x32x16_bf16(a, bq, accT[tt], 0, 0, 0); \
                } \
            } \
 \
_Pragma("unroll") \
        for (int xi = 0; xi < 2; ++xi) { \
_Pragma("unroll") \
            for (int r = 0; r < 16; ++r) X[xi][r] *= dec; \
_Pragma("unroll") \
            for (int ks = 0; ks < 4; ++ks) { \
                const bf16x8_t a = *(const LAS bf16x8_t*)(KB + (64 * dh + 32 * xi + l31) * VS + 16 * ks + 8 * hh), bv = *(const LAS bf16x8_t*)(VB + (32 * eb + l31) * VS + 16 * ks + 8 * hh); \
                X[xi] = __builtin_amdgcn_mfma_f32_32x32x16_bf16(a, bv, X[xi], 0, 0, 0); \
            } \
        } \
 \
_Pragma("unroll") \
        for (int tt = 0; tt < 2; ++tt) \
_Pragma("unroll") \
            for (int g4 = 0; g4 < 4; ++g4) { v2u ow; ow.x = pg8::cvt_pk_bf16(accT[tt][4 * g4 + 0], accT[tt][4 * g4 + 1]); ow.y = pg8::cvt_pk_bf16(accT[tt][4 * g4 + 2], accT[tt][4 * g4 + 3]); \
                const int e0 = h * 256 + 128 * eh + 32 * eb + 8 * g4 + 4 * hh; const size_t row = row0 + 32 * tt + l31; \
                if (!dry) { if (dh == 0) *(v2u*)(U + row * 6144 + e0) = ow; else *(v2u*)(P1 + row * D + e0) = ow; } } \
        WG_BAR(); \
        if (tid < 128) NS[tid] = dec * NS[tid] + sloc * nl_cur; \
    }
    for (int c2 = 0; c2 < 32; c2 += 2) { MLSTM_B_CHUNK(c2, pqA, pkA, pvA, pnlA) MLSTM_B_CHUNK(c2 + 1, pqB, pkB, pvB, pnlB) }
#undef MLSTM_B_CHUNK
    WG_BAR();
}

__device__ __forceinline__ void mlstm_c_item(const Frame& F, const int dry, int b, int c, int h) {
    const bf16_t* U = (const bf16_t*)(F.ws + OFF_U); bf16_t* Y = (bf16_t*)(F.ws + OFF_B); const bf16_t* P1 = (const bf16_t*)F.out + (size_t)M * D;
    const float* MS = (const float*)(F.ws + OFF_MS); const float* ITEM = (const float*)(F.ws + OFF_ITEM1) + (size_t)((b * 32 + c) * 8 + h) * 256;
    const int w = F.wave, lane = F.lane;
    const size_t row0 = (size_t)b * S + c * 64;
    const f32x4_t cn = *(const f32x4_t*)(F.in[20] + h * 256 + 4 * lane);
    const float m_st = ITEM[130];
    v2u oi[8], o2[8], nm[8], gg[8]; f32x4_t st[8];
#pragma unroll
    for (int i = 0; i < 8; ++i) { const size_t row = row0 + 8 * w + i;
        oi[i] = *(const v2u*)(U + row * 6144 + h * 256 + 4 * lane); o2[i] = *(const v2u*)(P1 + row * D + h * 256 + 4 * lane); nm[i] = *(const v2u*)(Y + row * D + h * 256 + 4 * lane); gg[i] = *(const v2u*)(U + row * 6144 + 4096 + h * 256 + 4 * lane);
        st[i] = *(const f32x4_t*)(MS + (row * 8 + h) * 4); }
#pragma unroll
    for (int i = 0; i < 8; ++i) { const size_t row = row0 + 8 * w + i;
        const float bcs = st[i][0], mloc = st[i][1], dloc = st[i][2], di = st[i][3];
        const float mt = fmaxf(mloc, bcs + m_st), gi = __expf(bcs + m_st - mt), gl = __expf(mloc - mt);
        const float den = gi * di + gl * dloc, inv = 1.f / fmaxf(fabsf(den), __expf(-mt));
        const float h0 = (gi * (pg8::bflo(oi[i].x) + pg8::bflo(o2[i].x)) + gl * pg8::bflo(nm[i].x)) * inv, h1 = (gi * (pg8::bfhi(oi[i].x) + pg8::bfhi(o2[i].x)) + gl * pg8::bfhi(nm[i].x)) * inv;
        const float h2 = (gi * (pg8::bflo(oi[i].y) + pg8::bflo(o2[i].y)) + gl * pg8::bflo(nm[i].y)) * inv, h3 = (gi * (pg8::bfhi(oi[i].y) + pg8::bfhi(o2[i].y)) + gl * pg8::bfhi(nm[i].y)) * inv;
        const float ss = wave_sum((h0 * h0 + h1 * h1) + (h2 * h2 + h3 * h3));
        const float rs = rsqrtf(ss * (1.f / 256.f) + EPS);
        v2u yw; yw.x = pg8::cvt_pk_bf16(h0 * rs * cn[0] * pg8::bflo(gg[i].x), h1 * rs * cn[1] * pg8::bfhi(gg[i].x)); yw.y = pg8::cvt_pk_bf16(h2 * rs * cn[2] * pg8::bflo(gg[i].y), h3 * rs * cn[3] * pg8::bfhi(gg[i].y));
        if (!dry) *(v2u*)(Y + row * D + h * 256 + 4 * lane) = yw; }
}

#ifndef MK_DUP
#define MK_DUP -1
#endif
enum { PH_P0 = 0, PH_IN0, PH_MIX0A, PH_MIX0B, PH_MIX0C, PH_OUT0, PH_GATE0, PH_IN1, PH_MIX1A, PH_MIX1B, PH_MIX1C, PH_OUT1, PH_GATE1, PH_FINAL, PH_END };

__global__ void __launch_bounds__(NWAVES * 64, 2) mk_fwd(Ptrs args) {
    extern __shared__ __attribute__((aligned(16))) unsigned char lds_raw[];
    Frame F;
    F.lds = (LAS unsigned char*)lds_raw;
    F.tid = threadIdx.x; F.lane = F.tid & 63; F.wave = __builtin_amdgcn_readfirstlane(F.tid >> 6);
    F.G = gridDim.x; F.bid = blockIdx.x; F.in = args.in; F.out = args.out; F.ws = args.ws;
    volatile LAS unsigned* MISC = (volatile LAS unsigned*)(F.lds + MISC_OFF);
    if (F.tid < 32) MISC[F.tid] = 0u;
    __syncthreads();
    XcdBarrier bar = xcd_barrier_post((unsigned*)(F.ws + OFF_CTL) + CW_BAR + args.li * XCD_BAR_WORDS, MISC + 8);
    const int lo = args.ph_lo, hi = args.ph_hi, dryv = args.dup;
#define IN_(k) (lo <= (k) && (k) < hi)
#define RUN(k, BODY) do { if (IN_(k)) { if (MK_DUP == (k)) { BODY(dryv) xcd_barrier(bar); } BODY(0) } } while (0)
#define SEAM(k) do { if (IN_(k) && IN_((k) + 1)) xcd_barrier(bar); } while (0)
    unsigned char* ws = F.ws;
    bf16_t* A = (bf16_t*)(ws + OFF_A); bf16_t* B = (bf16_t*)(ws + OFF_B); bf16_t* U = (bf16_t*)(ws + OFF_U);
    float* plpart = (float*)(ws + OFF_PART); float* hpart = plpart + (size_t)M * 32;
    const bf16_t* P16 = (const bf16_t*)(ws + OFF_WIN0); bf16_t* PL = U;
    const bf16_t* PLEW = (const bf16_t*)(ws + OFF_PLEW); bf16_t* PL1 = (bf16_t*)(ws + OFF_WIN1);
    float* plpart1 = (float*)(ws + OFF_WIN0 + 8 * MiB);

#define BODY_PH_P0(DRY) { p0_prologue(F); }
#define BODY_PH_IN0(DRY) { pg8::Gemm g{A, (const bf16_t*)(ws + OFF_WIN0), M, 6144, 2048}; pg8::StaticOrder So; So.init(M, 6144, F.G, F.bid); \
        pg8::EpiIn0 E{U, (const float*)(ws + OFF_SMALL) + 1024, DRY}; \
        pg8::gemm_phase<pg8::EpiIn0, pg8::StaticOrder, true, true>(F.lds, g, So, E); }
#define BODY_PH_MIX0A(DRY) { cvt_p_phase(F, DRY); \
        for (int it = F.bid; it < 1024; it += F.G) hgrn2_a_item(F, DRY, it >> 8, (it >> 3) & 31, it & 7); \
        for (int it = F.bid; it < 1024; it += F.G) rglru_a_item(F, DRY, it >> 8, (it >> 3) & 31, it & 7); }
#define BODY_PH_MIX0B(DRY) { if (F.bid < 32) hgrn2_b_phase(F, DRY, F.bid >> 3, F.bid & 7); else { for (int it = F.bid - 32; it < 1024; it += F.G - 32) rglru_b_item(F, DRY, it >> 8, (it >> 3) & 31, it & 7); \
        p0_layer1_weights(F, (F.bid - 32) * NWAVES + F.wave, (F.G - 32) * NWAVES); } }
#define BODY_PH_MIX0C(DRY) { for (int it = F.bid; it < 1024; it += F.G) hgrn2_c_item(F, DRY, it >> 8, (it >> 3) & 31, it & 7); }
#define BODY_PH_OUT0(DRY) { { pg8::Gemm g{A, (const bf16_t*)(ws + OFF_WOUT0), M, 2048, 2048}; pg8::StaticOrder So; So.init(M, 2048, F.G, F.bid); \
          pg8::EpiOut<true> E{F.in[0], B, DRY}; \
          pg8::gemm_phase<pg8::EpiOut<true>, pg8::StaticOrder, true, true>(F.lds, g, So, E); } \
        { unsigned char* ws2 = ws; asm volatile("" : "+s"(ws2));     \
          pg8::Gemm g{(const bf16_t*)(ws2 + OFF_WIN0), (const bf16_t*)(ws2 + OFF_PLEW), M, 2048, 256}; pg8::StaticOrder So; So.init(M, 2048, F.G, F.bid); \
          pg8::EpiPle E{(bf16_t*)(ws2 + OFF_U), (float*)(ws2 + OFF_PART), DRY}; \
          pg8::gemm_phase<pg8::EpiPle, pg8::StaticOrder, true, true>(F.lds, g, So, E); } }
#define BODY_PH_GATE0(DRY) { pg8::Gemm g{B, (const bf16_t*)(ws + OFF_WG0), M, 2048, 2048}; pg8::StaticOrder So; So.init(M, 2048, F.G, F.bid); \
        pg8::EpiGate E{B, A, nullptr, PL, plpart, F.in[23], hpart, DRY}; \
        pg8::gemm_phase<pg8::EpiGate, pg8::StaticOrder, true, true>(F.lds, g, So, E); }
#define BODY_PH_IN1(DRY) { pg8::Gemm g{A, (const bf16_t*)(ws + OFF_WIN1), M, 8192, 2048}; pg8::StaticOrder So; So.init(M, 8192, F.G, F.bid); \
        pg8::EpiIn1 E{U, hpart, DRY}; \
        pg8::gemm_phase<pg8::EpiIn1, pg8::StaticOrder, true, true>(F.lds, g, So, E); \
        gates1_phase(F, DRY); }
#define BODY_PH_MIX1A(DRY) { for (int it = F.bid; it < 1024; it += F.G) mlstm_a_item(F, DRY, it >> 8, (it >> 3) & 31, it & 7); }
#define BODY_PH_MIX1B(DRY) { if (F.bid < 64) mlstm_b_phase(F, DRY, F.bid >> 4, (F.bid >> 1) & 7, F.bid & 1); else { \
        pg8::Gemm g{P16 + (size_t)M * PLE, PLEW + (size_t)2048 * 256, M, 2048, 256}; pg8::StaticOrder So; So.init(M, 2048, F.G - 64, F.bid - 64); \
        pg8::EpiPle E{PL1, plpart1, DRY}; \
        pg8::gemm_phase<pg8::EpiPle, pg8::StaticOrder, true, true>(F.lds, g, So, E); } }
#define BODY_PH_MIX1C(DRY) { for (int it = F.bid; it < 1024; it += F.G) mlstm_c_item(F, DRY, it >> 8, (it >> 3) & 31, it & 7); }
#define BODY_PH_OUT1(DRY) { pg8::Gemm g{B, (const bf16_t*)(ws + OFF_WOUT1), M, 2048, 2048}; pg8::StaticOrder So; So.init(M, 2048, F.G, F.bid); \
          pg8::EpiOut<false> E{A, A, DRY}; \
          pg8::gemm_phase<pg8::EpiOut<false>, pg8::StaticOrder, true, true>(F.lds, g, So, E); }
#define BODY_PH_GATE1(DRY) { pg8::Gemm g{A, (const bf16_t*)(ws + OFF_WG1), M, 2048, 2048}; pg8::StaticOrder So; So.init(M, 2048, F.G, F.bid); \
        pg8::EpiGateFinal E{A, F.out, PL1, plpart1, F.in[23] + D, F.in[25], (float*)(ws + OFF_GATES1), (unsigned*)(ws + OFF_CTL) + CW_FIN, DRY}; \
        pg8::gemm_phase<pg8::EpiGateFinal, pg8::StaticOrder, false, true>(F.lds, g, So, E); }
#define BODY_PH_FINAL(DRY) { final_norm_phase(F, DRY); }

    RUN(PH_P0, BODY_PH_P0);
    SEAM(PH_P0);
    RUN(PH_IN0, BODY_PH_IN0);
    SEAM(PH_IN0);
    RUN(PH_MIX0A, BODY_PH_MIX0A);
    SEAM(PH_MIX0A);
    RUN(PH_MIX0B, BODY_PH_MIX0B);
    SEAM(PH_MIX0B);
    RUN(PH_MIX0C, BODY_PH_MIX0C);
    SEAM(PH_MIX0C);
    RUN(PH_OUT0, BODY_PH_OUT0);
    SEAM(PH_OUT0);
    RUN(PH_GATE0, BODY_PH_GATE0);
    SEAM(PH_GATE0);
    RUN(PH_IN1, BODY_PH_IN1);
    SEAM(PH_IN1);
    RUN(PH_MIX1A, BODY_PH_MIX1A);
    SEAM(PH_MIX1A);
    RUN(PH_MIX1B, BODY_PH_MIX1B);
    SEAM(PH_MIX1B);
    RUN(PH_MIX1C, BODY_PH_MIX1C);
    SEAM(PH_MIX1C);
    RUN(PH_OUT1, BODY_PH_OUT1);
    SEAM(PH_OUT1);
    RUN(PH_GATE1, BODY_PH_GATE1);
#undef IN_
#undef SEAM
#undef RUN
}


extern "C" void kernel_launch(void* const* d_in, const int* in_sizes, int n_in, void* d_out, int out_size, void* d_ws, size_t ws_size, hipStream_t stream) {
    static int grid = 0;
    if (grid == 0) {
        if (n_in != 26 || ws_size < WS_END || out_size != M * D) { fprintf(stderr, "kernel_launch: unexpected problem (n_in %d, ws %zu, out %d)\n", n_in, ws_size, out_size); grid = -1; return; }
        int dev = 0, cus = 0, per_cu = 0;
        if (hipGetDevice(&dev) != hipSuccess || hipDeviceGetAttribute(&cus, hipDeviceAttributeMultiprocessorCount, dev) != hipSuccess) { grid = -1; return; }
        if (hipFuncSetAttribute((const void*)mk_fwd, hipFuncAttributeMaxDynamicSharedMemorySize, LDS_BYTES) != hipSuccess) { fprintf(stderr, "kernel_launch: hipFuncSetAttribute failed\n"); grid = -1; return; }
        if (hipOccupancyMaxActiveBlocksPerMultiprocessor(&per_cu, (const void*)mk_fwd, NWAVES * 64, LDS_BYTES) != hipSuccess || per_cu < 1) { fprintf(stderr, "kernel_launch: occupancy query says %d blocks per CU\n", per_cu); (void)hipGetLastError(); grid = -1; return; }
        grid = cus;
    }
    if (grid < 0) return;
    (void)hipMemsetAsync((char*)d_ws + OFF_CTL, 0, CTL_ZERO_BYTES, stream);
    Ptrs a{};
    for (int i = 0; i < 26; ++i) a.in[i] = (const float*)d_in[i];
    a.out = (float*)d_out; a.ws = (unsigned char*)d_ws; a.ph_lo = PH_P0; a.ph_hi = PH_END; a.li = 0; a.dup = 1;
    void* kargs[] = {&a};
    const hipError_t e = hipLaunchCooperativeKernel((const void*)mk_fwd, dim3(grid), dim3(NWAVES * 64), kargs, LDS_BYTES, stream);
    if (e != hipSuccess) fprintf(stderr, "kernel_launch: cooperative launch failed: %s (grid %d)\n", hipGetErrorString(e), grid);
}
```

```cpp
#include <hip/hip_runtime.h>
#include <cstdio>
#include <cstdint>

namespace pg8 {
#define PG8_LAS __attribute__((address_space(3)))
typedef unsigned short bf16_t;
typedef short bf16x8 __attribute__((ext_vector_type(8)));
typedef float f32x4 __attribute__((ext_vector_type(4)));
typedef unsigned u32x4 __attribute__((ext_vector_type(4)));
constexpr int BM = 256, BK = 64, HALF = 128, HTB = HALF * BK * 2  , STAGE_BYTES = 8 * HTB, NXCD = 8, WGM = 8;

__host__ __device__ __forceinline__ int lds_byte(int r, int c) { const int st = (r >> 4) * 2 + (c >> 5), rr = r & 15, cc = c & 31, ob = rr * 64 + cc * 2; return st * 1024 + (ob ^ (((ob >> 9) & 1) << 5)); }
__host__ __device__ __forceinline__ void stage_rc(int b, int& R, int& C) { const int st = b / 1024, sb = b % 1024, swz = sb ^ (((sb >> 9) & 1) << 5); R = (st >> 1) * 16 + swz / 64; C = (st & 1) * 32 + (swz % 64) / 2; }
__host__ __device__ __forceinline__ int perm32(int rho) { const int n = rho >> 4, i = rho & 15; return 8 * (i >> 2) + 4 * n + (i & 3); }

struct Unit { int pm, pn; };
struct Gemm { const bf16_t* A; const bf16_t* Bt; int M, N, K; };

struct StaticOrder {
    int nM, nN, nwg, G, c;
    __host__ __device__ void init(int M, int N, int G_, int c_) { nM = M / BM; nN = N / BM; nwg = nM * nN; G = G_; c = c_; }
    __host__ __device__ bool next(int i, Unit& u) const {
        const long L = (long)i * G + c; if (L >= nwg) return false;
        int wgid = (int)L; { const int q = nwg / NXCD, r = nwg % NXCD, xcd = wgid % NXCD, off = wgid / NXCD; wgid = (xcd < r ? xcd * (q + 1) : r * (q + 1) + (xcd - r) * q) + off; }
        const int nig = WGM * nN, gid = wgid / nig, fm = gid * WGM, gsz = (nM - fm) < WGM ? (nM - fm) : WGM;
        u.pm = fm + ((wgid % nig) % gsz); u.pn = (wgid % nig) / gsz; return true;
    }
    __device__ __forceinline__ void a_ready(const Unit&) const {}
    __device__ __forceinline__ void done(const Unit&) const {}
};

typedef __bf16 bf16v2_t __attribute__((ext_vector_type(2)));
typedef float f32v2_t __attribute__((ext_vector_type(2)));
__device__ __forceinline__ unsigned cvt_pk_bf16(float lo, float hi) { const f32v2_t v = {lo, hi}; return __builtin_bit_cast(unsigned, __builtin_convertvector(v, bf16v2_t)); }
typedef float f32x2 __attribute__((ext_vector_type(2)));
template <class Epi, class Sched, bool ALIGN_EPI = false, bool SP2 = false>
__device__ __forceinline__ void gemm_phase(PG8_LAS unsigned char* lds, const Gemm g, const Sched& S, const Epi& E) {
    const int tid = threadIdx.x, wid = __builtin_amdgcn_readfirstlane(tid >> 6), lane = tid & 63, wr = wid >> 2, wc = wid & 3, fr = lane & 15, fq = lane >> 4;
    const int K = g.K, nt = K / BK;
    unsigned voffA[2], voffB[2];
#pragma unroll
    for (int i = 0; i < 2; ++i) { int R, C; stage_rc(tid * 16 + i * 8192, R, C); const int Rb = Epi::PERM ? ((R & ~31) + perm32(R & 31)) : R;
        voffA[i] = (unsigned)(R * K + C) * 2u; voffB[i] = (unsigned)(Rb * K + C) * 2u; }
    const size_t kstep = (size_t)(BK * 2);
    const size_t hstep = (size_t)HALF * K * 2;
    const size_t tstep = 2 * hstep;
    const unsigned ldsw = (unsigned)wid * 1024u;
    const int aoff = lds_byte(wr * 64 + fr, fq * 8), boff = lds_byte(wc * 32 + fr, fq * 8);
#define PG8_SA(b, h) (((b) * 2 + (h)) * HTB)
#define PG8_SB(b, h) ((4 + (b) * 2 + (h)) * HTB)
#define PG8_STAGE(bufoff, gbase, voff) do { _Pragma("unroll") for (int _i = 0; _i < 2; ++_i) \
        __builtin_amdgcn_global_load_lds((const unsigned*)((const char*)(gbase) + (voff)[_i]), (PG8_LAS unsigned*)(lds + (bufoff) + ldsw + _i * 8192), 16, 0, 0); } while (0)
#define PG8_LDA(dst, b, h) do { _Pragma("unroll") for (int m = 0; m < 4; ++m) _Pragma("unroll") for (int k = 0; k < 2; ++k) dst[m][k] = *(const PG8_LAS bf16x8*)(lds + PG8_SA(b, h) + aoff + m * 2048 + k * 1024); } while (0)
#define PG8_LDB(dst, b, h) do { _Pragma("unroll") for (int n = 0; n < 2; ++n) _Pragma("unroll") for (int k = 0; k < 2; ++k) dst[n][k] = *(const PG8_LAS bf16x8*)(lds + PG8_SB(b, h) + boff + n * 2048 + k * 1024); } while (0)
#define PG8_MMA(ai, bj, At, Bt) do { __builtin_amdgcn_s_setprio(1); _Pragma("unroll") for (int m = 0; m < 4; ++m) _Pragma("unroll") for (int n = 0; n < 2; ++n) _Pragma("unroll") for (int k = 0; k < 2; ++k) \
        acc[ai][bj][m][n] = __builtin_amdgcn_mfma_f32_16x16x32_bf16(Bt[n][k], At[m][k], acc[ai][bj][m][n], 0, 0, 0); __builtin_amdgcn_s_setprio(0); } while (0)
#define PG8_WAIT_V(n) asm volatile("s_waitcnt vmcnt(" #n ")" ::: "memory")
#define PG8_WAIT_L(n) asm volatile("s_waitcnt lgkmcnt(" #n ")" ::: "memory")
#define PG8_BAR __builtin_amdgcn_s_barrier()
#define PG8_SCHED __builtin_amdgcn_sched_barrier(0)
    Unit cur, nxt; int ui = 0;
    if (!S.next(0, cur)) return;
    f32x4 acc[2][2][4][2];
#pragma unroll
    for (int a = 0; a < 2; ++a)
#pragma unroll
        for (int b = 0; b < 2; ++b)
#pragma unroll
            for (int m = 0; m < 4; ++m)
#pragma unroll
                for (int n = 0; n < 2; ++n) acc[a][b][m][n] = (f32x4){0.f, 0.f, 0.f, 0.f};
    bf16x8 At[4][2], B0[2][2], B1[2][2];
    const char* cA = (const char*)g.A + (size_t)cur.pm * tstep; const char* cB = (const char*)g.Bt + (size_t)cur.pn * tstep;
    S.a_ready(cur);
    if constexpr (SP2) {
        PG8_STAGE(PG8_SB(0, 0), cB, voffB); PG8_STAGE(PG8_SB(0, 1), cB + hstep, voffB); PG8_STAGE(PG8_SA(0, 0), cA, voffA); PG8_STAGE(PG8_SA(0, 1), cA + hstep, voffA);
        if (wr == 1) PG8_BAR;
        PG8_WAIT_V(2); PG8_BAR;
        PG8_STAGE(PG8_SB(1, 0), cB + kstep, voffB); PG8_STAGE(PG8_SA(1, 0), cA + kstep, voffA); PG8_STAGE(PG8_SB(1, 1), cB + hstep + kstep, voffB);
        PG8_WAIT_V(6); PG8_BAR;
    } else {
        PG8_STAGE(PG8_SB(0, 0), cB, voffB); PG8_STAGE(PG8_SA(0, 0), cA, voffA); PG8_STAGE(PG8_SB(0, 1), cB + hstep, voffB); PG8_STAGE(PG8_SA(0, 1), cA + hstep, voffA);
        if (wr == 1) PG8_BAR;
        PG8_WAIT_V(4); PG8_BAR;
        PG8_STAGE(PG8_SB(1, 0), cB + kstep, voffB); PG8_STAGE(PG8_SA(1, 0), cA + kstep, voffA); PG8_STAGE(PG8_SB(1, 1), cB + hstep + kstep, voffB);
        PG8_WAIT_V(6); PG8_BAR;
    }
    for (;;) {
        const bool has_next = S.next(ui + 1, nxt);
        const char* nA = has_next ? (const char*)g.A + (size_t)nxt.pm * tstep : cA; const char* nB = has_next ? (const char*)g.Bt + (size_t)nxt.pn * tstep : cB;
        for (int t = 0; t < nt; t += 2) {
            const bool last = (t == nt - 2);
            const char* a1 = cA + (size_t)(t + 1) * kstep;
            const char* a2 = last ? nA : cA + (size_t)(t + 2) * kstep; const char* b2 = last ? nB : cB + (size_t)(t + 2) * kstep;
            const char* a3 = a2 + kstep; const char* b3 = b2 + kstep;
            if (last && has_next) S.a_ready(nxt);
            if constexpr (SP2) {
            PG8_LDB(B0, 0, 0); PG8_LDB(B1, 0, 1); PG8_SCHED; PG8_LDA(At, 0, 0); PG8_STAGE(PG8_SA(1, 1), a1 + hstep, voffA);
            PG8_WAIT_V(8); PG8_WAIT_L(0); PG8_BAR; PG8_MMA(0, 0, At, B0); PG8_MMA(0, 1, At, B1); PG8_BAR; PG8_SCHED;
            PG8_LDA(At, 0, 1); PG8_STAGE(PG8_SB(0, 0), b2, voffB); PG8_STAGE(PG8_SB(0, 1), b2 + hstep, voffB); PG8_STAGE(PG8_SA(0, 0), a2, voffA);
            PG8_WAIT_V(8); PG8_WAIT_L(0); PG8_BAR; PG8_MMA(1, 0, At, B0); PG8_MMA(1, 1, At, B1); PG8_BAR; PG8_SCHED;
            PG8_LDB(B0, 1, 0); PG8_LDB(B1, 1, 1); PG8_SCHED; PG8_LDA(At, 1, 0); PG8_STAGE(PG8_SA(0, 1), a2 + hstep, voffA);
            PG8_WAIT_V(8); PG8_WAIT_L(0); PG8_BAR; PG8_MMA(0, 0, At, B0); PG8_MMA(0, 1, At, B1); PG8_BAR; PG8_SCHED;
            PG8_LDA(At, 1, 1); PG8_STAGE(PG8_SB(1, 0), b3, voffB); PG8_STAGE(PG8_SB(1, 1), b3 + hstep, voffB); PG8_STAGE(PG8_SA(1, 0), a3, voffA);
            PG8_WAIT_V(8); PG8_WAIT_L(0); PG8_BAR; PG8_MMA(1, 0, At, B0); PG8_MMA(1, 1, At, B1); PG8_BAR; PG8_SCHED;
            } else {
            PG8_LDB(B0, 0, 0); PG8_SCHED; PG8_LDA(At, 0, 0); PG8_STAGE(PG8_SA(1, 1), a1 + hstep, voffA);
            PG8_WAIT_L(8); PG8_BAR; PG8_WAIT_L(0); PG8_MMA(0, 0, At, B0); PG8_BAR; PG8_SCHED;
            PG8_LDB(B1, 0, 1); PG8_STAGE(PG8_SB(0, 0), b2, voffB);
            PG8_BAR; PG8_WAIT_L(0); PG8_MMA(0, 1, At, B1); PG8_BAR;
            PG8_LDA(At, 0, 1); PG8_STAGE(PG8_SA(0, 0), a2, voffA);
            PG8_BAR; PG8_WAIT_L(0); PG8_MMA(1, 0, At, B0); PG8_BAR; PG8_SCHED;
            PG8_STAGE(PG8_SB(0, 1), b2 + hstep, voffB);
            PG8_WAIT_V(6); PG8_BAR; PG8_MMA(1, 1, At, B1); PG8_BAR;
            PG8_LDB(B0, 1, 0); PG8_SCHED; PG8_LDA(At, 1, 0); PG8_STAGE(PG8_SA(0, 1), a2 + hstep, voffA);
            PG8_WAIT_L(8); PG8_BAR; PG8_WAIT_L(0); PG8_MMA(0, 0, At, B0); PG8_BAR; PG8_SCHED;
            PG8_LDB(B1, 1, 1); PG8_STAGE(PG8_SB(1, 0), b3, voffB);
            PG8_BAR; PG8_WAIT_L(0); PG8_MMA(0, 1, At, B1); PG8_BAR;
            PG8_LDA(At, 1, 1); PG8_STAGE(PG8_SA(1, 0), a3, voffA);
            PG8_BAR; PG8_WAIT_L(0); PG8_MMA(1, 0, At, B0); PG8_BAR; PG8_SCHED;
            PG8_STAGE(PG8_SB(1, 1), b3 + hstep, voffB);
            PG8_WAIT_V(6); PG8_BAR; PG8_MMA(1, 1, At, B1); PG8_BAR;
            }
        }
        if constexpr (ALIGN_EPI) { if (wr == 0) PG8_BAR; }
        if constexpr (!Epi::AFTER_DRAIN) { E(acc, cur, wr, wc, fr, fq); S.done(cur); }
        if (!has_next) break;
#pragma unroll
        for (int a = 0; a < 2; ++a)
#pragma unroll
            for (int b = 0; b < 2; ++b)
#pragma unroll
                for (int m = 0; m < 4; ++m)
#pragma unroll
                    for (int n = 0; n < 2; ++n) acc[a][b][m][n] = (f32x4){0.f, 0.f, 0.f, 0.f};
        cur = nxt; cA = nA; cB = nB; ++ui;
        if constexpr (ALIGN_EPI) { if (wr == 1) PG8_BAR; }
    }
    PG8_WAIT_V(0);
    if constexpr (!ALIGN_EPI) { if (wr == 0) PG8_BAR; }
    PG8_BAR;
    if constexpr (Epi::AFTER_DRAIN) { E.fused(acc, cur, wr, wc, fr, fq, lds, wid, lane); S.done(cur); }
#undef PG8_SA
#undef PG8_SB
#undef PG8_STAGE
#undef PG8_LDA
#undef PG8_LDB
#undef PG8_MMA
#undef PG8_WAIT_V
#undef PG8_WAIT_L
#undef PG8_BAR
#undef PG8_SCHED
}
}

namespace pg8 {
constexpr float EPSN = 1e-6f;
__device__ __forceinline__ float fsigmoid(float x) { return __builtin_amdgcn_rcpf(1.f + __expf(-x)); }
__device__ __forceinline__ float fsilu(float x) { return x * __builtin_amdgcn_rcpf(1.f + __expf(-x)); }
__device__ __forceinline__ float row_stat32(const float* part, int row, int fq) {
    const f32x4 a = *(const f32x4*)(part + (size_t)row * 32 + 8 * fq), b = *(const f32x4*)(part + (size_t)row * 32 + 8 * fq + 4);
    float s = ((a.x + a.y) + (a.z + a.w)) + ((b.x + b.y) + (b.z + b.w));
    s += __shfl_xor(s, 16); s += __shfl_xor(s, 32); return s;
}
__device__ __forceinline__ u32x4 pack8(const f32x4 v0, const f32x4 v1) { u32x4 w; w.x = cvt_pk_bf16(v0[0], v0[1]); w.y = cvt_pk_bf16(v0[2], v0[3]); w.z = cvt_pk_bf16(v1[0], v1[1]); w.w = cvt_pk_bf16(v1[2], v1[3]); return w; }
__device__ __forceinline__ float bflo(unsigned w) { return __uint_as_float(w << 16); }
__device__ __forceinline__ float bfhi(unsigned w) { return __uint_as_float(w & 0xffff0000u); }

struct EpiIn0 {
    static constexpr bool PERM = true, AFTER_DRAIN = false;
    bf16_t* U; const float* rstd; int dry;
    __device__ __forceinline__ void operator()(const f32x4 (&acc)[2][2][4][2], const Unit& u, int wr, int wc, int fr, int fq) const {
        if (dry) return;
        const int row0 = u.pm * BM + wr * 64 + fr, col0 = u.pn * BM + wc * 32 + 8 * fq;
#pragma unroll
        for (int ai = 0; ai < 2; ++ai)
#pragma unroll
            for (int m = 0; m < 4; ++m) { const int row = row0 + ai * HALF + m * 16; const float sc = rstd[row]; bf16_t* rowp = U + ((size_t)u.pn * 8192 + row) * 256 + (wc * 32 + 8 * fq);
#pragma unroll
                for (int bj = 0; bj < 2; ++bj) *(u32x4*)(rowp + bj * HALF) = pack8(acc[ai][bj][m][0] * sc, acc[ai][bj][m][1] * sc); }
    }
};
struct EpiIn1 {
    static constexpr bool PERM = true, AFTER_DRAIN = false;
    bf16_t* U; const float* hpart; int dry;
    __device__ __forceinline__ void operator()(const f32x4 (&acc)[2][2][4][2], const Unit& u, int wr, int wc, int fr, int fq) const {
        if (dry) return;
        const int row0 = u.pm * BM + wr * 64 + fr;
        if (u.pn < 16) {
            const int col0 = u.pn * BM + wc * 32 + 8 * fq;
#pragma unroll
            for (int ai = 0; ai < 2; ++ai)
#pragma unroll
                for (int m = 0; m < 4; ++m) { const int row = row0 + ai * HALF + m * 16; const float sc = rsqrtf(row_stat32(hpart, row, fq) * (1.f / 2048.f) + EPSN); bf16_t* rowp = U + ((size_t)u.pn * 8192 + row) * 256 + (wc * 32 + 8 * fq);
#pragma unroll
                    for (int bj = 0; bj < 2; ++bj) *(u32x4*)(rowp + bj * HALF) = pack8(acc[ai][bj][m][0] * sc, acc[ai][bj][m][1] * sc); }
        } else {
            const int col0 = 4096 + 128 * (u.pn - 16) + wc * 32 + 8 * fq;
#pragma unroll
            for (int ai = 0; ai < 2; ++ai)
#pragma unroll
                for (int m = 0; m < 4; ++m) { const int row = row0 + ai * HALF + m * 16; const float sc = rsqrtf(row_stat32(hpart, row, fq) * (1.f / 2048.f) + EPSN);
                    f32x4 g0, g1;
#pragma unroll
                    for (int j = 0; j < 4; ++j) { g0[j] = fsigmoid(acc[ai][0][m][0][j] * sc) * fsilu(acc[ai][1][m][0][j] * sc); g1[j] = fsigmoid(acc[ai][0][m][1][j] * sc) * fsilu(acc[ai][1][m][1][j] * sc); }
                    *(u32x4*)(U + ((size_t)(16 + ((u.pn - 16) >> 1)) * 8192 + row) * 256 + ((u.pn - 16) & 1) * 128 + wc * 32 + 8 * fq) = pack8(g0, g1); }
        }
    }
};
template <bool BASE_F32> struct EpiOut {
    static constexpr bool PERM = true, AFTER_DRAIN = false;
    const void* base; bf16_t* h16; int dry;
    __device__ __forceinline__ void operator()(const f32x4 (&acc)[2][2][4][2], const Unit& u, int wr, int wc, int fr, int fq) const {
        if (dry) return;
        const int row0 = u.pm * BM + wr * 64 + fr, col0 = u.pn * BM + wc * 32 + 8 * fq;
#pragma unroll
        for (int ai = 0; ai < 2; ++ai)
#pragma unroll
            for (int m = 0; m < 4; ++m) { const size_t off = (size_t)(row0 + ai * HALF + m * 16) * 2048 + col0;
#pragma unroll
                for (int bj = 0; bj < 2; ++bj) { f32x4 b0, b1;
                    if (BASE_F32) { b0 = *(const f32x4*)((const float*)base + off + bj * HALF); b1 = *(const f32x4*)((const float*)base + off + bj * HALF + 4); }
                    else { const u32x4 pw = *(const u32x4*)((const bf16_t*)base + off + bj * HALF); b0 = (f32x4){bflo(pw.x), bfhi(pw.x), bflo(pw.y), bfhi(pw.y)}; b1 = (f32x4){bflo(pw.z), bfhi(pw.z), bflo(pw.w), bfhi(pw.w)}; }
                    *(u32x4*)(h16 + off + bj * HALF) = pack8(b0 + acc[ai][bj][m][0], b1 + acc[ai][bj][m][1]); }
                asm volatile("" ::: "memory"); }
    }
};
struct EpiPle {
    static constexpr bool PERM = true, AFTER_DRAIN = false;
    bf16_t* PL; float* plpart; int dry;
    __device__ __forceinline__ void operator()(const f32x4 (&acc)[2][2][4][2], const Unit& u, int wr, int wc, int fr, int fq) const {
        if (dry) return;
        const int row0 = u.pm * BM + wr * 64 + fr, col0 = u.pn * BM + wc * 32 + 8 * fq;
#pragma unroll
        for (int ai = 0; ai < 2; ++ai)
#pragma unroll
            for (int m = 0; m < 4; ++m) { const int row = row0 + ai * HALF + m * 16; float s = 0.f;
#pragma unroll
                for (int bj = 0; bj < 2; ++bj) { const f32x4 v0 = acc[ai][bj][m][0], v1 = acc[ai][bj][m][1];
                    s += ((v0[0] * v0[0] + v0[1] * v0[1]) + (v0[2] * v0[2] + v0[3] * v0[3])) + ((v1[0] * v1[0] + v1[1] * v1[1]) + (v1[2] * v1[2] + v1[3] * v1[3]));
                    *(u32x4*)(PL + (size_t)row * 2048 + col0 + bj * HALF) = pack8(v0, v1); }
                s += __shfl_xor(s, 16); s += __shfl_xor(s, 32);
                if (fq == 0) plpart[(size_t)row * 32 + u.pn * 4 + wc] = s; }
    }
};
struct EpiGate {
    static constexpr bool PERM = true, AFTER_DRAIN = false;
    const bf16_t* hin; bf16_t* h16out; float* outf; const bf16_t* PL; const float* plpart; const float* ple_norm; float* hpart; int dry;
    __device__ __forceinline__ void operator()(const f32x4 (&acc)[2][2][4][2], const Unit& u, int wr, int wc, int fr, int fq) const {
        if (dry) return;
        const int row0 = u.pm * BM + wr * 64 + fr, col0 = u.pn * BM + wc * 32 + 8 * fq;
        f32x4 pn[2][2];
#pragma unroll
        for (int bj = 0; bj < 2; ++bj) { pn[bj][0] = *(const f32x4*)(ple_norm + col0 + bj * HALF); pn[bj][1] = *(const f32x4*)(ple_norm + col0 + bj * HALF + 4); }
#pragma unroll
        for (int ai = 0; ai < 2; ++ai)
#pragma unroll
            for (int m = 0; m < 4; ++m) { const int row = row0 + ai * HALF + m * 16; const size_t off = (size_t)row * 2048 + col0;
                const float rs = rsqrtf(row_stat32(plpart, row, fq) * (1.f / 2048.f) + EPSN); float s = 0.f;
#pragma unroll
                for (int bj = 0; bj < 2; ++bj) { const u32x4 pw = *(const u32x4*)(PL + off + bj * HALF), hw = *(const u32x4*)(hin + off + bj * HALF);
                    const f32x4 p0 = (f32x4){bflo(pw.x), bfhi(pw.x), bflo(pw.y), bfhi(pw.y)} * pn[bj][0] * rs, p1 = (f32x4){bflo(pw.z), bfhi(pw.z), bflo(pw.w), bfhi(pw.w)} * pn[bj][1] * rs;
                    f32x4 h0 = (f32x4){bflo(hw.x), bfhi(hw.x), bflo(hw.y), bfhi(hw.y)}, h1 = (f32x4){bflo(hw.z), bfhi(hw.z), bflo(hw.w), bfhi(hw.w)};
#pragma unroll
                    for (int j = 0; j < 4; ++j) { h0[j] += fsigmoid(acc[ai][bj][m][0][j]) * p0[j]; h1[j] += fsigmoid(acc[ai][bj][m][1][j]) * p1[j]; }
                    if (outf) { *(f32x4*)(outf + off + bj * HALF) = h0; *(f32x4*)(outf + off + bj * HALF + 4) = h1; }
                    else *(u32x4*)(h16out + off + bj * HALF) = pack8(h0, h1);
                    s += ((h0[0] * h0[0] + h0[1] * h0[1]) + (h0[2] * h0[2] + h0[3] * h0[3])) + ((h1[0] * h1[0] + h1[1] * h1[1]) + (h1[2] * h1[2] + h1[3] * h1[3])); }
                s += __shfl_xor(s, 16); s += __shfl_xor(s, 32);
                if (fq == 0) hpart[(size_t)row * 32 + u.pn * 4 + wc] = s;
                asm volatile("" ::: "memory"); }
    }
};
struct EpiGateFinal {
    static constexpr bool PERM = true, AFTER_DRAIN = true;
    const bf16_t* hin; float* outf; const bf16_t* PL; const float* plpart; const float* ple_norm; const float* fin_norm; float* xbuf; unsigned* cnt; float peps; int dry;
    __device__ __forceinline__ void fused(f32x4 (&acc)[2][2][4][2], const Unit& u, int wr, int wc, int fr, int fq, PG8_LAS unsigned char* lds, int wid, int lane) const {
        if (dry) return;
        PG8_LAS float* P = (PG8_LAS float*)lds;
        PG8_LAS float* S = (PG8_LAS float*)(lds + 4096);
        const int row0 = u.pm * BM + wr * 64 + fr, col0 = u.pn * BM + wc * 32 + 8 * fq;
        {
            f32x4 pn[2][2];
#pragma unroll
            for (int bj = 0; bj < 2; ++bj) { pn[bj][0] = *(const f32x4*)(ple_norm + col0 + bj * HALF); pn[bj][1] = *(const f32x4*)(ple_norm + col0 + bj * HALF + 4); }
#pragma unroll
            for (int ai = 0; ai < 2; ++ai)
#pragma unroll
                for (int m = 0; m < 4; ++m) { const int row = row0 + ai * HALF + m * 16; const size_t off = (size_t)row * 2048 + col0;
                    const float rs = rsqrtf(row_stat32(plpart, row, fq) * (1.f / 2048.f) + EPSN); float s = 0.f;
#pragma unroll
                    for (int bj = 0; bj < 2; ++bj) { const u32x4 pw = *(const u32x4*)(PL + off + bj * HALF), hw = *(const u32x4*)(hin + off + bj * HALF);
                        const f32x4 p0 = (f32x4){bflo(pw.x), bfhi(pw.x), bflo(pw.y), bfhi(pw.y)} * pn[bj][0] * rs, p1 = (f32x4){bflo(pw.z), bfhi(pw.z), bflo(pw.w), bfhi(pw.w)} * pn[bj][1] * rs;
                        f32x4 h0 = (f32x4){bflo(hw.x), bfhi(hw.x), bflo(hw.y), bfhi(hw.y)}, h1 = (f32x4){bflo(hw.z), bfhi(hw.z), bflo(hw.w), bfhi(hw.w)};
#pragma unroll
                        for (int j = 0; j < 4; ++j) { h0[j] += fsigmoid(acc[ai][bj][m][0][j]) * p0[j]; h1[j] += fsigmoid(acc[ai][bj][m][1][j]) * p1[j]; }
                        acc[ai][bj][m][0] = h0; acc[ai][bj][m][1] = h1;
                        s += ((h0[0] * h0[0] + h0[1] * h0[1]) + (h0[2] * h0[2] + h0[3] * h0[3])) + ((h1[0] * h1[0] + h1[1] * h1[1]) + (h1[2] * h1[2] + h1[3] * h1[3])); }
                    s += __shfl_xor(s, 16); s += __shfl_xor(s, 32);
                    if (fq == 0) P[(ai * HALF + wr * 64 + m * 16 + fr) * 4 + wc] = s;
                    asm volatile("" ::: "memory"); }
        }
        asm volatile("s_waitcnt lgkmcnt(0)" ::: "memory"); __builtin_amdgcn_s_barrier(); asm volatile("" ::: "memory");
        const int row = wid * 32 + (lane & 31);
        if (lane < 32) { const float s4 = (P[row * 4 + 0] + P[row * 4 + 1]) + (P[row * 4 + 2] + P[row * 4 + 3]);
            __hip_atomic_store(xbuf + (size_t)(u.pm * BM + row) * 8 + u.pn, s4, __ATOMIC_RELAXED, __HIP_MEMORY_SCOPE_AGENT); }
        asm volatile("s_waitcnt vmcnt(0)" ::: "memory");
        if (lane == 0) __hip_atomic_fetch_add(cnt + 64 * u.pm, 1u, __ATOMIC_RELAXED, __HIP_MEMORY_SCOPE_AGENT);
        if (wid == 0) {
            unsigned spins = 0;
            while ((unsigned)__builtin_amdgcn_readfirstlane(__hip_atomic_load(cnt + 64 * u.pm, __ATOMIC_RELAXED, __HIP_MEMORY_SCOPE_AGENT)) < 64u) { __builtin_amdgcn_s_sleep(2); if (++spins > (1u << 24)) break; }
            __builtin_amdgcn_fence(__ATOMIC_ACQUIRE, "agent");
        }
        asm volatile("s_waitcnt vmcnt(0) lgkmcnt(0)" ::: "memory"); __builtin_amdgcn_s_barrier(); asm volatile("" ::: "memory");
        if (lane < 32) { const float* xp = xbuf + (size_t)(u.pm * BM + row) * 8; float t = 0.f;
#pragma unroll
            for (int k = 0; k < 8; ++k) t += __hip_atomic_load(xp + k, __ATOMIC_RELAXED, __HIP_MEMORY_SCOPE_AGENT);
            S[row] = rsqrtf(t * (1.f / 2048.f) + EPSN); }
        asm volatile("s_waitcnt lgkmcnt(0)" ::: "memory"); __builtin_amdgcn_s_barrier(); asm volatile("" ::: "memory");
        f32x4 fn[2][2];
#pragma unroll
        for (int bj = 0; bj < 2; ++bj) { fn[bj][0] = *(const f32x4*)(fin_norm + col0 + bj * HALF); fn[bj][1] = *(const f32x4*)(fin_norm + col0 + bj * HALF + 4); }
#pragma unroll
        for (int ai = 0; ai < 2; ++ai)
#pragma unroll
            for (int m = 0; m < 4; ++m) { const int r = ai * HALF + wr * 64 + m * 16 + fr; const float rs = S[r]; const size_t off = (size_t)(u.pm * BM + r) * 2048 + col0;
#pragma unroll
                for (int bj = 0; bj < 2; ++bj) { *(f32x4*)(outf + off + bj * HALF) = acc[ai][bj][m][0] * fn[bj][0] * rs + peps; *(f32x4*)(outf + off + bj * HALF + 4) = acc[ai][bj][m][1] * fn[bj][1] * rs + peps; } }
    }
};
}

constexpr int NWAVES = 8;
constexpr int NB = 4, S = 2048, D = 2048, M = NB * S, PLE = 256;
constexpr float EPS = 1e-6f;
typedef unsigned short bf16_t;
typedef float f32x4 __attribute__((ext_vector_type(4)));
typedef unsigned v4u __attribute__((ext_vector_type(4)));
typedef unsigned v2u __attribute__((ext_vector_type(2)));

constexpr size_t MiB = 1u << 20;
constexpr size_t OFF_CTL = 0, CTL_ZERO_BYTES = 128 * 1024;
constexpr size_t OFF_WIN0 = 1 * MiB;
constexpr size_t OFF_WOUT0 = 25 * MiB;
constexpr size_t OFF_WG0 = 33 * MiB;
constexpr size_t OFF_WIN1 = 41 * MiB;
constexpr size_t OFF_WOUT1 = 73 * MiB;
constexpr size_t OFF_WG1 = 81 * MiB;
constexpr size_t OFF_PLEW = 89 * MiB;
constexpr size_t OFF_WGATE1 = 91 * MiB;
constexpr size_t OFF_SMALL = 91 * MiB + 65536;
constexpr size_t OFF_GATES1 = 92 * MiB;
constexpr size_t OFF_PART = 92 * MiB + 524288;
constexpr size_t OFF_A = 95 * MiB;
constexpr size_t OFF_B = 127 * MiB;
constexpr size_t OFF_U = 159 * MiB;
constexpr size_t WS_END = 255 * MiB;
constexpr size_t OFF_ACUM = OFF_B;
constexpr size_t OFF_CARRY = OFF_B + 17 * MiB;
constexpr size_t OFF_DECAY = OFF_B + 18 * MiB;
constexpr size_t OFF_WRT = OFF_SMALL + 65536;
constexpr int CW_FIN = 16384;
constexpr int CW_BAR = 4096;

constexpr int RING_BYTES = 131072;
constexpr int MISC_OFF = 147456 - 256;
constexpr int LDS_BYTES = 147456;

constexpr size_t UT = (size_t)8192 * 256;
__host__ __device__ __forceinline__ size_t uidx(size_t row, int col) { return ((size_t)(col >> 8) * 8192 + row) * 256 + (col & 255); }
#define LAS __attribute__((address_space(3)))
#define GAS __attribute__((address_space(1)))
__device__ __forceinline__ float bf2f(bf16_t b) { return __uint_as_float(((unsigned)b) << 16); }
__device__ __forceinline__ unsigned f2bf(float f) { unsigned u = __float_as_uint(f); return (u + 0x7fffu + ((u >> 16) & 1u)) >> 16; }
__device__ __forceinline__ unsigned pk2(float lo, float hi) { return f2bf(lo) | (f2bf(hi) << 16); }
__device__ __forceinline__ float sigmoidf_(float x) { return __builtin_amdgcn_rcpf(1.f + __expf(-x)); }
__device__ __forceinline__ float siluf_(float x) { return x * __builtin_amdgcn_rcpf(1.f + __expf(-x)); }
__device__ __forceinline__ float one_minus_exp(float x) { return x > -0.03f ? -x * (1.f + x * (0.5f + x * (0.16666667f + x * 0.041666668f))) : 1.f - __expf(x); }
__device__ __forceinline__ float wave_sum(float v) {
#pragma unroll
    for (int o = 1; o < 64; o <<= 1) v += __shfl_xor(v, o);
    return v;
}
#define LDS_WAIT() asm volatile("s_waitcnt lgkmcnt(0)" ::: "memory")
#define WG_BAR() asm volatile("s_waitcnt lgkmcnt(0)\n\ts_barrier" ::: "memory")
#define XB_TMO      128
#define XB_XCNT(j)  (256  + 64 * (j))
#define XB_XSUB(j)  (1280 + 64 * (j))
#define XB_XGEN(j)  (2304 + 64 * (j))
#define XB_TOP      3328
#define XB_TOPGEN   3392
#define XCD_BAR_WORDS 3456
#define XB_SPIN_CAP (1u << 26)

__device__ __forceinline__ unsigned xb_ld(unsigned* p)              { return __hip_atomic_load(p, __ATOMIC_RELAXED, __HIP_MEMORY_SCOPE_AGENT); }
__device__ __forceinline__ unsigned xb_add(unsigned* p, unsigned v) { return __hip_atomic_fetch_add(p, v, __ATOMIC_RELAXED, __HIP_MEMORY_SCOPE_AGENT); }
__device__ __forceinline__ unsigned xb_xcc_id() { return (unsigned)__builtin_amdgcn_s_getreg((3 << 11) | 20) & 0xFu; }
#define XB_SPIN(cond, bar) do { unsigned _sp = 0; while (cond) { __builtin_amdgcn_s_sleep(1); \
    if ((++_sp & 255u) == 0u) { if (xb_ld(&(bar)[XB_TMO])) break; if (_sp > XB_SPIN_CAP) { atomicAdd(&(bar)[XB_TMO], 1u); break; } } } } while (0)

struct XcdBarrier {
    unsigned* bar; unsigned x;
    volatile LAS unsigned* st;
};

__device__ __forceinline__ XcdBarrier xcd_barrier_post(unsigned* bar, volatile LAS unsigned* st) {
    XcdBarrier b; b.bar = bar; b.x = xb_xcc_id(); b.st = st;
    if (threadIdx.x == 0) (void)xb_add(&bar[XB_XCNT(b.x)], 1u);
    return b;
}
__device__ __forceinline__ void xcd_barrier_complete(unsigned* bar, unsigned x, unsigned& nloc, unsigned& nx) {
    const unsigned G = gridDim.x * gridDim.y * gridDim.z;
    unsigned sum, cnt, mine, sp = 0u;
    for (;;) {
        sum = 0u; cnt = 0u; mine = 0u;
#pragma unroll
        for (unsigned j = 0; j < 16; ++j) { const unsigned c = xb_ld(&bar[XB_XCNT(j)]); sum += c; cnt += (c > 0u) ? 1u : 0u; mine = (j == x) ? c : mine; }
        if (sum == G) break;
        __builtin_amdgcn_s_sleep(1);
        if ((++sp & 255u) == 0u) { if (xb_ld(&bar[XB_TMO])) break; if (sp > XB_SPIN_CAP) { atomicAdd(&bar[XB_TMO], 1u); break; } }
    }
    nloc = mine > 0u ? mine : 1u; nx = cnt > 0u ? cnt : 1u;
}

__device__ __forceinline__ void xcd_barrier(const XcdBarrier& b) {
    asm volatile("s_waitcnt vmcnt(0)" ::: "memory");
    __syncthreads();
    if (threadIdx.x == 0) {
        unsigned* bar = b.bar;
        __builtin_amdgcn_s_waitcnt(0);
        unsigned nloc = b.st[0], nx = b.st[1];
        if (nloc == 0u) { xcd_barrier_complete(bar, b.x, nloc, nx); b.st[0] = nloc; b.st[1] = nx; }
        const unsigned old = xb_add(&bar[XB_XSUB(b.x)], 1u);
        const unsigned gen = old / nloc;
        if (old + 1u == (gen + 1u) * nloc) {
            __builtin_amdgcn_fence(__ATOMIC_RELEASE, "agent");
            asm volatile("s_waitcnt vmcnt(0)" ::: "memory");
            const unsigned og = xb_add(&bar[XB_TOP], 1u);
            const unsigned tg = og / nx;
            if (og + 1u == (tg + 1u) * nx) xb_add(&bar[XB_TOPGEN], 1u);
            else XB_SPIN(xb_ld(&bar[XB_TOPGEN]) == tg, bar);
            __builtin_amdgcn_fence(__ATOMIC_ACQUIRE, "agent");
            xb_add(&bar[XB_XGEN(b.x)], 1u);
            asm volatile("s_waitcnt vmcnt(0)" ::: "memory");
        } else {
            XB_SPIN(xb_ld(&bar[XB_XGEN(b.x)]) == gen, bar);
            __builtin_amdgcn_fence(__ATOMIC_ACQUIRE, "agent");
            asm volatile("s_waitcnt vmcnt(0)" ::: "memory");
        }
    }
    __syncthreads();
}

struct Ptrs {
    const float* in[26]; float* out; unsigned char* ws; int ph_lo, ph_hi, li, dup;
};
__device__ __forceinline__ int srccol_in1(int n) {
    if (n < 4096) return n;
    const int r = n - 4096, j = r >> 8, i = r & 255;
    return i < 128 ? 4096 + 128 * j + i : 6144 + 128 * j + (i - 128);
}
__device__ __forceinline__ void p0_transpose_item(const float* __restrict__ W, int K, int ldw, bf16_t* __restrict__ WT, const float* __restrict__ gain, bool map1, int nblk, LAS float* scr, int item, int lane) {
    const int kb = item / nblk, nb = item % nblk, k0 = 64 * kb, n0 = 32 * nb, s0 = map1 ? srccol_in1(n0) : n0;
    float wv[32];
#pragma unroll
    for (int i = 0; i < 32; ++i) wv[i] = W[(size_t)(k0 + 2 * i + (lane >> 5)) * ldw + s0 + (lane & 31)];
    if (gain) {
#pragma unroll
        for (int i = 0; i < 32; ++i) wv[i] *= gain[k0 + 2 * i + (lane >> 5)];
    }
#pragma unroll
    for (int i = 0; i < 32; ++i) scr[(2 * i + (lane >> 5)) * 33 + (lane & 31)] = wv[i];
    LDS_WAIT(); asm volatile("" ::: "memory");
    const int c = lane & 7;
#pragma unroll
    for (int j = 0; j < 4; ++j) { const int n = (lane >> 3) + 8 * j; const LAS float* s = scr + (8 * c) * 33 + n;
        v4u o; o.x = pk2(s[0 * 33], s[1 * 33]); o.y = pk2(s[2 * 33], s[3 * 33]); o.z = pk2(s[4 * 33], s[5 * 33]); o.w = pk2(s[6 * 33], s[7 * 33]);
        *(v4u*)(WT + (size_t)(n0 + n) * K + k0 + 8 * c) = o; }
    LDS_WAIT(); asm volatile("" ::: "memory");
}
struct Frame {
    LAS unsigned char* lds; int tid, lane, wave, G, bid;
    const float* const* in; float* out; unsigned char* ws;
};
__device__ __forceinline__ void p0_layer1_weights(const Frame& F, int gw, int NGW) {
    LAS float* scr = (LAS float*)(F.lds + F.wave * 16384);
    unsigned char* ws = F.ws;
    const float* o_norm = F.in[14]; const float* o_w_in = F.in[15]; const float* o_w_out = F.in[21]; const float* ple_gate_w = F.in[24];
    constexpr int I_SQ = 32 * 64, I_IN1 = 32 * 256;
    for (int it = gw; it < I_IN1 + 2 * I_SQ; it += NGW) {
        int r = it;
        if (r < I_IN1) { p0_transpose_item(o_w_in, 2048, 8208, (bf16_t*)(ws + OFF_WIN1), o_norm, true, 256, scr, r, F.lane); continue; } r -= I_IN1;
        if (r < I_SQ) { p0_transpose_item(o_w_out, 2048, 2048, (bf16_t*)(ws + OFF_WOUT1), nullptr, false, 64, scr, r, F.lane); continue; } r -= I_SQ;
        p0_transpose_item(ple_gate_w + (size_t)2048 * 2048, 2048, 2048, (bf16_t*)(ws + OFF_WG1), nullptr, false, 64, scr, r, F.lane);
    }
    const int gt = gw * 64 + F.lane, NGT = NGW * 64;
    bf16_t* WGATE1 = (bf16_t*)(ws + OFF_WGATE1);
    for (int i = gt; i < 16 * 2048; i += NGT) { const int j = i >> 11, k = i & 2047; WGATE1[i] = (bf16_t)f2bf(o_w_in[(size_t)k * 8208 + 8192 + j] * o_norm[k]); }
}
__device__ __forceinline__ void p0_prologue(const Frame& F) {
    LAS float* scr = (LAS float*)(F.lds + F.wave * 16384);
    const int gw = F.bid * NWAVES + F.wave, NGW = F.G * NWAVES;
    unsigned char* ws = F.ws;
    const float* e_norm = F.in[2]; const float* e_w_in = F.in[3]; const float* e_w_out = F.in[13]; const float* ple_w = F.in[22]; const float* ple_gate_w = F.in[24];
    constexpr int I_IN0 = 32 * 192, I_SQ = 32 * 64, I_PLE = 4 * 64;
    constexpr int NITEMS = I_IN0 + 2 * I_SQ + 2 * I_PLE;
    for (int it = gw; it < NITEMS; it += NGW) {
        int r = it;
        if (r < I_IN0) { p0_transpose_item(e_w_in, 2048, 6144, (bf16_t*)(ws + OFF_WIN0), e_norm, false, 192, scr, r, F.lane); continue; } r -= I_IN0;
        if (r < I_SQ) { p0_transpose_item(e_w_out, 2048, 2048, (bf16_t*)(ws + OFF_WOUT0), nullptr, false, 64, scr, r, F.lane); continue; } r -= I_SQ;
        if (r < I_SQ) { p0_transpose_item(ple_gate_w, 2048, 2048, (bf16_t*)(ws + OFF_WG0), nullptr, false, 64, scr, r, F.lane); continue; } r -= I_SQ;
        if (r < I_PLE) { p0_transpose_item(ple_w, 256, 2048, (bf16_t*)(ws + OFF_PLEW), nullptr, false, 64, scr, r, F.lane); continue; } r -= I_PLE;
        p0_transpose_item(ple_w + (size_t)256 * 2048, 256, 2048, (bf16_t*)(ws + OFF_PLEW) + (size_t)2048 * 256, nullptr, false, 64, scr, r, F.lane);
    }
    const float* x = F.in[0]; bf16_t* A = (bf16_t*)(ws + OFF_A); float* rstd0 = (float*)(ws + OFF_SMALL) + 1024;
    for (int m = gw; m < M; m += NGW) {
        const f32x4* xr = (const f32x4*)(x + (size_t)m * D) + F.lane; f32x4 v[8]; float s = 0.f;
#pragma unroll
        for (int j = 0; j < 8; ++j) { v[j] = xr[64 * j]; s += (v[j].x * v[j].x + v[j].y * v[j].y) + (v[j].z * v[j].z + v[j].w * v[j].w); }
        s = wave_sum(s);
        v2u* o8 = (v2u*)(A + (size_t)m * D) + F.lane;
#pragma unroll
        for (int j = 0; j < 8; ++j) { v2u w; w.x = pk2(v[j].x, v[j].y); w.y = pk2(v[j].z, v[j].w); o8[64 * j] = w; }
        if (F.lane == 0) rstd0[m] = rsqrtf(s * (1.f / D) + EPS);
    }
    const int gt = F.bid * (NWAVES * 64) + F.tid, NGT = F.G * NWAVES * 64;
    bf16_t* WRT = (bf16_t*)(ws + OFF_WRT); const float* w_r = F.in[8]; const float* w_i = F.in[10];
    for (int i = gt; i < 2 * 131072; i += NGT) { const int j = i & 131071, n = j >> 14, d = (j >> 7) & 127, cc = j & 127; WRT[i] = (bf16_t)f2bf(((i >> 17) ? w_i : w_r)[n * 16384 + cc * 128 + d]); }
    float* lb = (float*)(ws + OFF_SMALL); const float* logits = F.in[4];
    for (int c = gt; c < 1024; c += NGT) lb[c] = 1.f / (1.f + expf(logits[1024 + c] - logits[c]));
}
__device__ __forceinline__ void gates1_phase(const Frame& F, const int dry) {
    const bf16_t* A = (const bf16_t*)(F.ws + OFF_A); const bf16_t* WG = (const bf16_t*)(F.ws + OFF_WGATE1);
    const float* hpart = (const float*)(F.ws + OFF_PART) + (size_t)M * 32; float* gates = (float*)(F.ws + OFF_GATES1);
    const int gw = F.bid * NWAVES + F.wave, NGW = F.G * NWAVES;
    for (int row = gw; row < M; row += NGW) {
        float ss = (F.lane < 32) ? hpart[(size_t)row * 32 + F.lane] : 0.f; ss = wave_sum(ss);
        const float sc = rsqrtf(ss * (1.f / D) + EPS);
        float a[32];
        const v4u* ar = (const v4u*)(A + (size_t)row * D) + F.lane;
#pragma unroll
        for (int j = 0; j < 4; ++j) { const v4u w = ar[64 * j]; a[8 * j + 0] = pg8::bflo(w.x); a[8 * j + 1] = pg8::bfhi(w.x); a[8 * j + 2] = pg8::bflo(w.y); a[8 * j + 3] = pg8::bfhi(w.y);
            a[8 * j + 4] = pg8::bflo(w.z); a[8 * j + 5] = pg8::bfhi(w.z); a[8 * j + 6] = pg8::bflo(w.w); a[8 * j + 7] = pg8::bfhi(w.w); }
        float res = 0.f;
        for (int g = 0; g < 16; ++g) {
            const v4u* wr = (const v4u*)(WG + (size_t)g * D) + F.lane; float s = 0.f;
#pragma unroll
            for (int j = 0; j < 4; ++j) { const v4u w = wr[64 * j];
                s += a[8 * j + 0] * pg8::bflo(w.x) + a[8 * j + 1] * pg8::bfhi(w.x) + a[8 * j + 2] * pg8::bflo(w.y) + a[8 * j + 3] * pg8::bfhi(w.y)
                   + a[8 * j + 4] * pg8::bflo(w.z) + a[8 * j + 5] * pg8::bfhi(w.z) + a[8 * j + 6] * pg8::bflo(w.w) + a[8 * j + 7] * pg8::bfhi(w.w); }
            s = wave_sum(s);
            res = (F.lane == g) ? s * sc : res;
        }
        if (F.lane < 16 && !dry) gates[(size_t)row * 16 + F.lane] = res;
    }
}
__device__ __forceinline__ void final_norm_phase(const Frame& F, const int dry) {
    const float* hpart = (const float*)(F.ws + OFF_PART) + (size_t)M * 32; const float* g = F.in[25];
    const int gw = F.bid * NWAVES + F.wave, NGW = F.G * NWAVES;
    f32x4 gv[8];
#pragma unroll
    for (int j = 0; j < 8; ++j) gv[j] = ((const f32x4*)g)[F.lane + 64 * j];
    for (int row = gw; row < M; row += NGW) {
        float ss = (F.lane < 32) ? hpart[(size_t)row * 32 + F.lane] : 0.f; ss = wave_sum(ss);
        const float rs = rsqrtf(ss * (1.f / D) + EPS);
        f32x4* xr = (f32x4*)(F.out + (size_t)row * D) + F.lane;
#pragma unroll
        for (int j = 0; j < 8; ++j) { f32x4 v = xr[64 * j]; v = v * gv[j] * rs; if (!dry) xr[64 * j] = v; }
    }
}

__device__ __forceinline__ void cvt_p_phase(const Frame& F, const int dry) {
    const float* p = F.in[1]; bf16_t* P16 = (bf16_t*)(F.ws + OFF_WIN0);
    const size_t n4 = (size_t)2 * M * PLE / 4, gt = (size_t)F.bid * (NWAVES * 64) + F.tid, NGT = (size_t)F.G * NWAVES * 64;
    for (size_t i = gt; i < n4; i += NGT) { const f32x4 v = ((const f32x4*)p)[i]; v2u w; w.x = pk2(v.x, v.y); w.y = pk2(v.z, v.w); if (!dry) ((v2u*)P16)[i] = w; }
}

typedef short bf16x8_t __attribute__((ext_vector_type(8)));
typedef float f32x16 __attribute__((ext_vector_type(16)));
typedef float f32x4_t __attribute__((ext_vector_type(4)));
typedef short bf16x4_t __attribute__((ext_vector_type(4)));
__device__ __forceinline__ bf16x8_t pack_bf16x8(float a0, float a1, float a2, float a3, float a4, float a5, float a6, float a7) {
    v4u w; w.x = pg8::cvt_pk_bf16(a0, a1); w.y = pg8::cvt_pk_bf16(a2, a3); w.z = pg8::cvt_pk_bf16(a4, a5); w.w = pg8::cvt_pk_bf16(a6, a7);
    return __builtin_bit_cast(bf16x8_t, w);
}
__device__ __forceinline__ bf16x8_t cat_bf16x4(v2u lo, v2u hi) { v4u w; w.x = lo.x; w.y = lo.y; w.z = hi.x; w.w = hi.y; return __builtin_bit_cast(bf16x8_t, w); }


struct LruRaw { unsigned short xv[19]; float cw[4], cb, brv, biv, lamv; };
__device__ __forceinline__ void rglru_a_load(const Frame& F, int b, int c, int n, LruRaw& r) {
    const int d = F.tid & 127, q = F.tid >> 7, ch = n * 128 + d, t0 = c * 64;
    const bf16_t* U = (const bf16_t*)(F.ws + OFF_U);
#pragma unroll
    for (int i = 0; i < 19; ++i) { const int t = t0 + 16 * q - 3 + i; r.xv[i] = (t >= 0) ? U[uidx((size_t)b * S + t, 4096 + ch)] : (unsigned short)0; }
    const float* conv_w = F.in[6];
#pragma unroll
    for (int k = 0; k < 4; ++k) r.cw[k] = conv_w[k * 1024 + ch];
    r.cb = F.in[7][ch];
    const int chc = n * 128 + 32 * (F.wave & 3) + (F.lane & 31);
    r.brv = F.in[9][chc]; r.biv = F.in[11][chc]; r.lamv = F.in[12][chc];
}
__device__ __forceinline__ void rglru_a_item(const Frame& F, const int dry, int b, int c, int n, const LruRaw& raw) {
    constexpr int XS = 136;
    LAS bf16_t* XT = (LAS bf16_t*)F.lds;
    LAS float* AL = (LAS float*)(F.lds + 17408);
    LAS float* ML = AL + 8192;
    LAS float* AGG = ML + 8192;
    LAS bf16_t* HT = (LAS bf16_t*)(AGG + 1024);
    LAS bf16_t* CT = HT + 64 * 136;
    const bf16_t* U = (const bf16_t*)(F.ws + OFF_U); bf16_t* HL = (bf16_t*)(F.ws + OFF_A); bf16_t* AC = (bf16_t*)(F.ws + OFF_ACUM); float* carry = (float*)(F.ws + OFF_CARRY);
    const bf16_t* WRT = (const bf16_t*)(F.ws + OFF_WRT) + (size_t)n * 16384; const bf16_t* WIT = WRT + 8 * 16384;
    const float* conv_w = F.in[6]; const float* conv_b = F.in[7]; const float* b_r = F.in[9]; const float* b_i = F.in[11]; const float* lam = F.in[12];
    const int tid = F.tid, d = tid & 127, q = tid >> 7, ch = n * 128 + d, t0 = c * 64;
    const size_t row0 = (size_t)b * S + t0;
    float xc[16];
    {
        float xv[19];
#pragma unroll
        for (int i = 0; i < 19; ++i) xv[i] = bf2f(raw.xv[i]);
        const float cw0 = raw.cw[0], cw1 = raw.cw[1], cw2 = raw.cw[2], cw3 = raw.cw[3], cb = raw.cb;
#pragma unroll
        for (int i = 0; i < 16; ++i) { xc[i] = cb + cw0 * xv[i] + cw1 * xv[i + 1] + cw2 * xv[i + 2] + cw3 * xv[i + 3]; XT[(16 * q + i) * XS + d] = (bf16_t)f2bf(xc[i]); }
    }
    WG_BAR();
    {
        const int w = F.wave, tt = w >> 2, db = w & 3, l31 = F.lane & 31, hh = F.lane >> 5;
        f32x16 accR, accI;
#pragma unroll
        for (int r = 0; r < 16; ++r) { accR[r] = 0.f; accI[r] = 0.f; }
        const LAS bf16_t* ap = XT + (32 * tt + l31) * XS + 8 * hh;
        const bf16_t* rp = WRT + (size_t)(32 * db + l31) * 128 + 8 * hh; const bf16_t* ip = WIT + (size_t)(32 * db + l31) * 128 + 8 * hh;
#pragma unroll
        for (int ks = 0; ks < 8; ++ks) {
            const bf16x8_t a = *(const LAS bf16x8_t*)(ap + 16 * ks), br_ = *(const bf16x8_t*)(rp + 16 * ks), bi_ = *(const bf16x8_t*)(ip + 16 * ks);
            accR = __builtin_amdgcn_mfma_f32_32x32x16_bf16(a, br_, accR, 0, 0, 0);
            accI = __builtin_amdgcn_mfma_f32_32x32x16_bf16(a, bi_, accI, 0, 0, 0);
        }
        const int dc = 32 * db + l31, chc = n * 128 + dc;
        const float brv = raw.brv, biv = raw.biv, sp = log1pf(expf(-raw.lamv));
#pragma unroll
        for (int r = 0; r < 16; ++r) {
            const int t = 32 * tt + (r & 3) + 8 * (r >> 2) + 4 * hh;
            const float rr = sigmoidf_(accR[r] + brv), ii = sigmoidf_(accI[r] + biv), la = -8.f * rr * sp;
            AL[t * 128 + dc] = __expf(la); ML[t * 128 + dc] = __builtin_amdgcn_sqrtf(one_minus_exp(2.f * la)) * ii;
        }
    }
    WG_BAR();
    float hl[16], ac[16];
    {
        float h = 0.f, Ac = 1.f;
#pragma unroll
        for (int i = 0; i < 16; ++i) { const int t = 16 * q + i; const float a = AL[t * 128 + d], u = ML[t * 128 + d] * xc[i]; h = a * h + u; Ac *= a; hl[i] = h; ac[i] = Ac; }
        AGG[(q * 2 + 0) * 128 + d] = Ac; AGG[(q * 2 + 1) * 128 + d] = h;
    }
    WG_BAR();
    {
        float Hp = 0.f, Ap = 1.f;
#pragma unroll
        for (int qq = 0; qq < 3; ++qq) if (qq < q) { const float a = AGG[(qq * 2 + 0) * 128 + d], hh_ = AGG[(qq * 2 + 1) * 128 + d]; Hp = a * Hp + hh_; Ap *= a; }
#pragma unroll
        for (int i = 0; i < 16; ++i) { const size_t row = row0 + 16 * q + i; const float hv = hl[i] + ac[i] * Hp, av = ac[i] * Ap;
            HT[(16 * q + i) * 136 + d] = (bf16_t)f2bf(hv); CT[(16 * q + i) * 136 + d] = (bf16_t)f2bf(av);
            if (q == 3 && i == 15 && !dry) { float* cp = carry + ((size_t)((b * 32 + c) * 8 + n)) * 256; cp[d] = av; cp[128 + d] = hv; } }
    }
    WG_BAR();
#pragma unroll
    for (int j = 0; j < 2; ++j) { const int p = tid + 512 * j, t_ = p >> 4, c16 = p & 15; const bf16x8_t h_ = *(const LAS bf16x8_t*)(HT + t_ * 136 + c16 * 8), a_ = *(const LAS bf16x8_t*)(CT + t_ * 136 + c16 * 8);
        if (!dry) { *(bf16x8_t*)(HL + (row0 + t_) * D + 1024 + n * 128 + c16 * 8) = h_; *(bf16x8_t*)(AC + (row0 + t_) * 1024 + n * 128 + c16 * 8) = a_; } }
    WG_BAR();
}
__device__ __forceinline__ void rglru_b_item(const Frame& F, const int dry, int b, int c, int n) {
    LAS float* HC = (LAS float*)F.lds;
    const bf16_t* U = (const bf16_t*)(F.ws + OFF_U); bf16_t* Y = (bf16_t*)(F.ws + OFF_A); const bf16_t* AC = (const bf16_t*)(F.ws + OFF_ACUM); const float* carry = (const float*)(F.ws + OFF_CARRY);
    const int tid = F.tid;
    const size_t row0 = (size_t)b * S + c * 64;
    bf16x8_t hl[2], av[2], zb[2];
#pragma unroll
    for (int j = 0; j < 2; ++j) { const int p = tid + 512 * j, t_ = p >> 4, c16 = p & 15; const size_t row = row0 + t_;
        hl[j] = *(const bf16x8_t*)(Y + row * D + 1024 + n * 128 + c16 * 8); av[j] = *(const bf16x8_t*)(AC + row * 1024 + n * 128 + c16 * 8); zb[j] = *(const bf16x8_t*)(U + uidx(row, 5120 + n * 128 + c16 * 8)); }
    if (tid < 128) { float H = 0.f;
        for (int cc = 0; cc < c; ++cc) { const float* cp = carry + ((size_t)((b * 32 + cc) * 8 + n)) * 256; H = cp[tid] * H + cp[128 + tid]; }
        HC[tid] = H; }
    WG_BAR();
#pragma unroll
    for (int j = 0; j < 2; ++j) { const int p = tid + 512 * j, t_ = p >> 4, c16 = p & 15; const size_t row = row0 + t_;
        const v4u hw = __builtin_bit_cast(v4u, hl[j]), aw = __builtin_bit_cast(v4u, av[j]), zw = __builtin_bit_cast(v4u, zb[j]);
        const f32x4_t H0 = *(const LAS f32x4_t*)(HC + c16 * 8), H1 = *(const LAS f32x4_t*)(HC + c16 * 8 + 4);
        const bf16x8_t y_ = pack_bf16x8((pg8::bflo(hw.x) + pg8::bflo(aw.x) * H0[0]) * siluf_(pg8::bflo(zw.x)), (pg8::bfhi(hw.x) + pg8::bfhi(aw.x) * H0[1]) * siluf_(pg8::bfhi(zw.x)),
                                        (pg8::bflo(hw.y) + pg8::bflo(aw.y) * H0[2]) * siluf_(pg8::bflo(zw.y)), (pg8::bfhi(hw.y) + pg8::bfhi(aw.y) * H0[3]) * siluf_(pg8::bfhi(zw.y)),
                                        (pg8::bflo(hw.z) + pg8::bflo(aw.z) * H1[0]) * siluf_(pg8::bflo(zw.z)), (pg8::bfhi(hw.z) + pg8::bfhi(aw.z) * H1[1]) * siluf_(pg8::bfhi(zw.z)),
                                        (pg8::bflo(hw.w) + pg8::bflo(aw.w) * H1[2]) * siluf_(pg8::bflo(zw.w)), (pg8::bfhi(hw.w) + pg8::bfhi(aw.w) * H1[3]) * siluf_(pg8::bfhi(zw.w)));
        if (!dry) *(bf16x8_t*)(Y + row * D + 1024 + n * 128 + c16 * 8) = y_; }
    WG_BAR();
}

struct H2Raw { unsigned short qa[16], fa[16], vv[16]; float lbv; };
__device__ __forceinline__ void hgrn2_a_load(const Frame& F, int b, int c, int h, H2Raw& r) {
    const int d = F.tid & 127, q = F.tid >> 7;
    const bf16_t* up = (const bf16_t*)(F.ws + OFF_U) + uidx((size_t)b * S + c * 64 + 16 * q, h * 128 + d);
#pragma unroll
    for (int i = 0; i < 16; ++i) { r.qa[i] = up[(size_t)i * 256]; r.fa[i] = up[(size_t)i * 256 + 4 * UT]; r.vv[i] = up[(size_t)i * 256 + 8 * UT]; }
    r.lbv = ((const float*)(F.ws + OFF_SMALL))[h * 128 + d];
}
__device__ __forceinline__ void hgrn2_a_item(const Frame& F, const int dry, int b, int c, int h, const H2Raw& raw) {
    constexpr int QS = 136, VS = 72;
    LAS bf16_t* QT = (LAS bf16_t*)F.lds;
    LAS bf16_t* KT = QT + 64 * QS;
    LAS bf16_t* VT = KT + 64 * QS;
    LAS bf16_t* AT = VT + 128 * VS;
    LAS float* CS = (LAS float*)(AT + 64 * VS);
    LAS bf16_t* KDT = (LAS bf16_t*)(CS + 512);
    LAS bf16_t* OTL = KDT + 128 * VS;
    bf16_t* U = (bf16_t*)(F.ws + OFF_U); bf16_t* OI = (bf16_t*)(F.ws + OFF_A); float* decay = (float*)(F.ws + OFF_DECAY);
    const float* lb = (const float*)(F.ws + OFF_SMALL);
    const int tid = F.tid, d = tid & 127, q = tid >> 7, t0 = c * 64;
    const size_t row0 = (size_t)b * S + t0;
    {
        const float lbv = raw.lbv;
        float qa[16], fa[16], vv[16];
#pragma unroll
        for (int i = 0; i < 16; ++i) { qa[i] = bf2f(raw.qa[i]); fa[i] = bf2f(raw.fa[i]); vv[i] = bf2f(raw.vv[i]); }
        float cs[16]; float run = 0.f;
#pragma unroll
        for (int i = 0; i < 16; ++i) { const float e_ = __expf(-fa[i]), sg = __builtin_amdgcn_rcpf(1.f + e_); run += __logf(lbv + (1.f - lbv) * sg); cs[i] = run; fa[i] = (1.f - lbv) * e_ * sg; }
        CS[q * 128 + d] = run;
        WG_BAR();
        float off = 0.f, tot = 0.f;
#pragma unroll
        for (int qq = 0; qq < 4; ++qq) { const float v_ = CS[qq * 128 + d]; off += (qq < q) ? v_ : 0.f; tot += v_; }
        float kd[16];
        const float etot = __expf(tot);
#pragma unroll
        for (int i = 0; i < 16; ++i) { const float bt = off + cs[i], k = fa[i], eb_ = __expf(bt), ei_ = __builtin_amdgcn_rcpf(eb_), kei = k * ei_;
            QT[(16 * q + i) * QS + d] = (bf16_t)f2bf(siluf_(qa[i]) * eb_); KT[(16 * q + i) * QS + d] = (bf16_t)f2bf(kei); kd[i] = kei * etot; }
        const bf16x8_t k0 = pack_bf16x8(kd[0], kd[1], kd[2], kd[3], kd[4], kd[5], kd[6], kd[7]), k1 = pack_bf16x8(kd[8], kd[9], kd[10], kd[11], kd[12], kd[13], kd[14], kd[15]);
        const bf16x8_t v0 = pack_bf16x8(vv[0], vv[1], vv[2], vv[3], vv[4], vv[5], vv[6], vv[7]), v1 = pack_bf16x8(vv[8], vv[9], vv[10], vv[11], vv[12], vv[13], vv[14], vv[15]);
        *(LAS bf16x8_t*)(VT + d * VS + 16 * q) = v0; *(LAS bf16x8_t*)(VT + d * VS + 16 * q + 8) = v1;
        *(LAS bf16x8_t*)(KDT + d * VS + 16 * q) = k0; *(LAS bf16x8_t*)(KDT + d * VS + 16 * q + 8) = k1;
        WG_BAR();
#pragma unroll
        for (int j = 0; j < 2; ++j) { const int p = tid + 512 * j, dd = p >> 3, c8 = p & 7; bf16_t* tp = U + uidx(row0 + (dd >> 1), h * 128 + (dd & 1) * 64 + c8 * 8);
            const bf16x8_t k_ = *(const LAS bf16x8_t*)(KDT + dd * VS + c8 * 8), v_ = *(const LAS bf16x8_t*)(VT + dd * VS + c8 * 8);
            if (!dry) { *(bf16x8_t*)(tp + 4 * UT) = k_; *(bf16x8_t*)(tp + 8 * UT) = v_; } }
        if (q == 0 && !dry) decay[((size_t)((b * 32 + c) * 8 + h)) * 128 + d] = __expf(tot);
    }
    {
        const int w = F.wave, tb = w >> 1, r = F.lane & 15, g = F.lane >> 4;
#pragma unroll
        for (int k2 = 0; k2 < 2; ++k2) {
            const int sb = 2 * (w & 1) + k2;
            f32x4_t acc = {0.f, 0.f, 0.f, 0.f};
            if (sb <= tb) {
#pragma unroll
                for (int ks = 0; ks < 4; ++ks) {
                    const bf16x8_t a = *(const LAS bf16x8_t*)(QT + (16 * tb + r) * QS + 32 * ks + 8 * g), bb = *(const LAS bf16x8_t*)(KT + (16 * sb + r) * QS + 32 * ks + 8 * g);
                    acc = __builtin_amdgcn_mfma_f32_16x16x32_bf16(a, bb, acc, 0, 0, 0);
                }
            }
#pragma unroll
            for (int j = 0; j < 4; ++j) { const int t = 16 * tb + 4 * g + j, s = 16 * sb + r; AT[t * VS + s] = (bf16_t)f2bf(s <= t ? acc[j] : 0.f); }
        }
    }
    WG_BAR();
    {
        const int w = F.wave, th = w >> 2, eb = w & 3, l31 = F.lane & 31, hh = F.lane >> 5;
        f32x16 acc;
#pragma unroll
        for (int r = 0; r < 16; ++r) acc[r] = 0.f;
#pragma unroll
        for (int ks = 0; ks < 4; ++ks) {
            const bf16x8_t a = *(const LAS bf16x8_t*)(AT + (32 * th + l31) * VS + 16 * ks + 8 * hh), bb = *(const LAS bf16x8_t*)(VT + (32 * eb + l31) * VS + 16 * ks + 8 * hh);
            acc = __builtin_amdgcn_mfma_f32_32x32x16_bf16(a, bb, acc, 0, 0, 0);
        }
#pragma unroll
        for (int r = 0; r < 16; ++r) { const int t = 32 * th + (r & 3) + 8 * (r >> 2) + 4 * hh; OTL[t * 136 + 32 * eb + l31] = (bf16_t)f2bf(acc[r]); }
#pragma unroll
        for (int j = 0; j < 2; ++j) { const int p = tid + 512 * j, row = p >> 4, c16 = p & 15; const bf16x8_t qv_ = *(const LAS bf16x8_t*)(QT + row * QS + c16 * 8); if (!dry) *(bf16x8_t*)(U + uidx(row0 + row, h * 128 + c16 * 8)) = qv_; }
    }
    WG_BAR();
#pragma unroll
    for (int j = 0; j < 2; ++j) { const int p = tid + 512 * j, t_ = p >> 4, c16 = p & 15; const bf16x8_t o_ = *(const LAS bf16x8_t*)(OTL + t_ * 136 + c16 * 8);
        if (!dry) *(bf16x8_t*)(OI + (row0 + t_) * D + h * 128 + c16 * 8) = o_; }
    WG_BAR();
}

__device__ __forceinline__ void hgrn2_b_phase(const Frame& F, const int dry, int b, int h) {
    constexpr int QS = 132, VS = 72;
    LAS bf16_t* QB = (LAS bf16_t*)F.lds;
    LAS bf16_t* KB = QB + 64 * QS;
    LAS bf16_t* VB = KB + 128 * VS;
    LAS float* DEC = (LAS float*)(VB + 128 * VS);
    LAS bf16_t* OT = (LAS bf16_t*)(DEC + 128);
    bf16_t* U = (bf16_t*)(F.ws + OFF_U); const float* decay = (const float*)(F.ws + OFF_DECAY);
    const int tid = F.tid, w = F.wave, eb = w & 3, dh = w >> 2, l31 = F.lane & 31, hh = F.lane >> 5;
    f32x16 X[2];
#pragma unroll
    for (int xi = 0; xi < 2; ++xi)
#pragma unroll
        for (int r = 0; r < 16; ++r) X[xi][r] = 0.f;
    bf16x8_t pq[2], pk[2], pv[2]; float pdec = 0.f;
    {
        const size_t row0 = (size_t)b * S;
#pragma unroll
        for (int j = 0; j < 2; ++j) { const int p = tid + 512 * j; const bf16_t* up = U + uidx(row0 + (p >> 4), h * 128 + (p & 15) * 8);
            pq[j] = *(const bf16x8_t*)up; pk[j] = *(const bf16x8_t*)(up + 4 * UT); pv[j] = *(const bf16x8_t*)(up + 8 * UT); }
        if (tid < 128) pdec = decay[((size_t)((b * 32 + 0) * 8 + h)) * 128 + tid];
    }
    for (int c = 0; c < 32; ++c) {
        const size_t row0 = (size_t)b * S + c * 64;
#pragma unroll
        for (int j = 0; j < 2; ++j) { const int p = tid + 512 * j, ur = p >> 4, c16 = p & 15;
            { const v4u w4 = __builtin_bit_cast(v4u, pq[j]); v2u lo, hi; lo.x = w4.x; lo.y = w4.y; hi.x = w4.z; hi.y = w4.w; *(LAS v2u*)(QB + ur * QS + c16 * 8) = lo; *(LAS v2u*)(QB + ur * QS + c16 * 8 + 4) = hi; }
            *(LAS bf16x8_t*)(KB + (2 * ur + (c16 >> 3)) * VS + (c16 & 7) * 8) = pk[j];
            *(LAS bf16x8_t*)(VB + (2 * ur + (c16 >> 3)) * VS + (c16 & 7) * 8) = pv[j]; }
        if (tid < 128) DEC[tid] = pdec;
        WG_BAR();
        if (c + 1 < 32) {
            const size_t rn = row0 + 64;
#pragma unroll
            for (int j = 0; j < 2; ++j) { const int p = tid + 512 * j; const bf16_t* up = U + uidx(rn + (p >> 4), h * 128 + (p & 15) * 8);
                pq[j] = *(const bf16x8_t*)up; pk[j] = *(const bf16x8_t*)(up + 4 * UT); pv[j] = *(const bf16x8_t*)(up + 8 * UT); }
            if (tid < 128) pdec = decay[((size_t)((b * 32 + c + 1) * 8 + h)) * 128 + tid];
        }
        f32x16 accT[2];
#pragma unroll
        for (int tt = 0; tt < 2; ++tt)
#pragma unroll
            for (int r = 0; r < 16; ++r) accT[tt][r] = 0.f;
#pragma unroll
        for (int xi = 0; xi < 2; ++xi)
#pragma unroll
            for (int s = 0; s < 2; ++s) {
                const bf16x8_t a = pack_bf16x8(X[xi][8 * s + 0], X[xi][8 * s + 1], X[xi][8 * s + 2], X[xi][8 * s + 3], X[xi][8 * s + 4], X[xi][8 * s + 5], X[xi][8 * s + 6], X[xi][8 * s + 7]);
#pragma unroll
                for (int tt = 0; tt < 2; ++tt) {
                    const LAS bf16_t* qp = QB + (32 * tt + l31) * QS + 64 * dh + 32 * xi + 16 * s + 4 * hh;
                    const bf16x8_t bq = cat_bf16x4(*(const LAS v2u*)qp, *(const LAS v2u*)(qp + 8));
                    accT[tt] = __builtin_amdgcn_mfma_f32_32x32x16_bf16(a, bq, accT[tt], 0, 0, 0);
                }
            }
#pragma unroll
        for (int xi = 0; xi < 2; ++xi) {
#pragma unroll
            for (int g4 = 0; g4 < 4; ++g4) { const f32x4_t dv = *(const LAS f32x4_t*)(DEC + 64 * dh + 32 * xi + 8 * g4 + 4 * hh);
                X[xi][4 * g4 + 0] *= dv[0]; X[xi][4 * g4 + 1] *= dv[1]; X[xi][4 * g4 + 2] *= dv[2]; X[xi][4 * g4 + 3] *= dv[3]; }
#pragma unroll
            for (int ks = 0; ks < 4; ++ks) {
                const bf16x8_t a = *(const LAS bf16x8_t*)(KB + (64 * dh + 32 * xi + l31) * VS + 16 * ks + 8 * hh), bv = *(const LAS bf16x8_t*)(VB + (32 * eb + l31) * VS + 16 * ks + 8 * hh);
                X[xi] = __builtin_amdgcn_mfma_f32_32x32x16_bf16(a, bv, X[xi], 0, 0, 0);
            }
        }
#pragma unroll
        for (int tt = 0; tt < 2; ++tt)
#pragma unroll
            for (int g4 = 0; g4 < 4; ++g4) { v2u ow; ow.x = pg8::cvt_pk_bf16(accT[tt][4 * g4 + 0], accT[tt][4 * g4 + 1]); ow.y = pg8::cvt_pk_bf16(accT[tt][4 * g4 + 2], accT[tt][4 * g4 + 3]);
                *(LAS v2u*)(OT + (dh * 64 + 32 * tt + l31) * 136 + 32 * eb + 8 * g4 + 4 * hh) = ow; }
        WG_BAR();
#pragma unroll
        for (int j = 0; j < 4; ++j) { const int p = tid + 512 * j, dh_ = p >> 10, t_ = (p >> 4) & 63, c16 = p & 15; const bf16x8_t o_ = *(const LAS bf16x8_t*)(OT + (dh_ * 64 + t_) * 136 + c16 * 8);
            if (!dry) *(bf16x8_t*)(U + uidx(row0 + t_, 1024 * dh_ + h * 128 + c16 * 8)) = o_; }
    }
}

__device__ __forceinline__ void hgrn2_c_item(const Frame& F, const int dry, int b, int c, int h) {
    const bf16_t* U = (const bf16_t*)(F.ws + OFF_U); bf16_t* Y = (bf16_t*)(F.ws + OFF_A); const float* a_norm = F.in[5];
    const int w = F.wave, l31 = F.lane & 31, hh = F.lane >> 5;
    const size_t row0 = (size_t)b * S + c * 64;
    const f32x4_t an = *(const f32x4_t*)(a_norm + h * 128 + 4 * l31);
    v2u oi[4], p0[4], p1[4], zz[4];
#pragma unroll
    for (int i = 0; i < 4; ++i) { const size_t row = row0 + 8 * w + 2 * i + hh;
        oi[i] = *(const v2u*)(Y + row * D + h * 128 + 4 * l31); p0[i] = *(const v2u*)(U + uidx(row, h * 128 + 4 * l31));
        p1[i] = *(const v2u*)(U + uidx(row, 1024 + h * 128 + 4 * l31)); zz[i] = *(const v2u*)(U + uidx(row, 3072 + h * 128 + 4 * l31)); }
#pragma unroll
    for (int i = 0; i < 4; ++i) { const size_t row = row0 + 8 * w + 2 * i + hh;
        const float o0 = pg8::bflo(oi[i].x) + pg8::bflo(p0[i].x) + pg8::bflo(p1[i].x), o1 = pg8::bfhi(oi[i].x) + pg8::bfhi(p0[i].x) + pg8::bfhi(p1[i].x);
        const float o2 = pg8::bflo(oi[i].y) + pg8::bflo(p0[i].y) + pg8::bflo(p1[i].y), o3 = pg8::bfhi(oi[i].y) + pg8::bfhi(p0[i].y) + pg8::bfhi(p1[i].y);
        float ss = (o0 * o0 + o1 * o1) + (o2 * o2 + o3 * o3);
        ss += __shfl_xor(ss, 1); ss += __shfl_xor(ss, 2); ss += __shfl_xor(ss, 4); ss += __shfl_xor(ss, 8); ss += __shfl_xor(ss, 16);
        const float rs = rsqrtf(ss * (1.f / 128.f) + EPS);
        v2u yw; yw.x = pg8::cvt_pk_bf16(o0 * rs * an[0] * siluf_(pg8::bflo(zz[i].x)), o1 * rs * an[1] * siluf_(pg8::bfhi(zz[i].x)));
        yw.y = pg8::cvt_pk_bf16(o2 * rs * an[2] * siluf_(pg8::bflo(zz[i].y)), o3 * rs * an[3] * siluf_(pg8::bfhi(zz[i].y)));
        if (!dry) *(v2u*)(Y + row * D + h * 128 + 4 * l31) = yw; }
}

constexpr size_t OFF_MS = OFF_PART;
constexpr size_t OFF_ITEM1 = OFF_PART + 1 * MiB;

struct MlRaw { unsigned short xq[19], xk[19], vv[32]; float gi, gf, cwq[4], cbq, cwk[4], cbk; };
__device__ __forceinline__ void mlstm_a_load(const Frame& F, int b, int c, int h, MlRaw& r) {
    const bf16_t* U = (const bf16_t*)(F.ws + OFF_U);
    const int tid = F.tid, d = tid & 127, qq = tid >> 7, t0 = c * 64;
#pragma unroll
    for (int i = 0; i < 19; ++i) { const int t = t0 + 16 * qq - 3 + i; const bool ok = t >= 0; const bf16_t* up = U + uidx((size_t)b * S + (ok ? t : 0), h * 128 + d);
        r.xq[i] = ok ? up[0] : (unsigned short)0; r.xk[i] = ok ? up[4 * UT] : (unsigned short)0; }
    const int e = tid & 255, hf = tid >> 8;
    const bf16_t* vp = U + uidx((size_t)b * S + t0 + 32 * hf, 2048 + h * 256 + e);
#pragma unroll
    for (int i = 0; i < 32; ++i) r.vv[i] = vp[(size_t)i * 256];
    const float* gates = (const float*)(F.ws + OFF_GATES1); const size_t grow = (size_t)b * S + t0 + F.lane;
    r.gi = gates[grow * 16 + h]; r.gf = gates[grow * 16 + 8 + h];
    const float* cw = F.in[16]; const float* cb = F.in[17]; const int cq = h * 128 + d, ck = 1024 + h * 128 + d;
#pragma unroll
    for (int k = 0; k < 4; ++k) { r.cwq[k] = cw[k * 2048 + cq]; r.cwk[k] = cw[k * 2048 + ck]; }
    r.cbq = cb[cq]; r.cbk = cb[ck];
}
__device__ __forceinline__ void mlstm_a_item(const Frame& F, const int dry, int b, int c, int h, const MlRaw& raw) {
    constexpr int QS = 136, VS = 72;
    LAS bf16_t* QT = (LAS bf16_t*)F.lds;
    LAS bf16_t* KT = QT + 64 * QS;
    LAS bf16_t* VT = KT + 64 * QS;
    LAS bf16_t* AT = VT + 256 * VS;
    LAS float* BCS = (LAS float*)(AT + 64 * VS);
    LAS float* A2 = BCS + 64; LAS float* PM = A2 + 64; LAS float* KWS = PM + 64;
    LAS float* NL = KWS + 64;
    LAS float* DL = NL + 512;
    LAS bf16_t* KWT = (LAS bf16_t*)(DL + 256);
    LAS bf16_t* NT = KWT + 128 * VS;
    bf16_t* U = (bf16_t*)(F.ws + OFF_U); bf16_t* QA = (bf16_t*)F.out;     bf16_t* NUM = (bf16_t*)(F.ws + OFF_B);
    const float* gates = (const float*)(F.ws + OFF_GATES1); float* MS = (float*)(F.ws + OFF_MS); float* ITEM = (float*)(F.ws + OFF_ITEM1) + (size_t)((b * 32 + c) * 8 + h) * 256;
    const float* cw = F.in[16]; const float* cb = F.in[17];
    const int tid = F.tid, w = F.wave, lane = F.lane, d = tid & 127, qq = tid >> 7, t0 = c * 64;
    const size_t row0 = (size_t)b * S + t0;
    if (w == 0) {
        const size_t row = row0 + lane;
        const float li = raw.gi + F.in[18][h], xf = raw.gf + F.in[19][h];
        const float lf = fminf(xf, 0.f) - log1pf(expf(-fabsf(xf)));
        float bc = lf;
#pragma unroll
        for (int o = 1; o < 64; o <<= 1) { const float v_ = __shfl_up(bc, o); bc += (lane >= o) ? v_ : 0.f; }
        const float a2 = li - bc; float pm = a2;
#pragma unroll
        for (int o = 1; o < 64; o <<= 1) { const float v_ = __shfl_up(pm, o); pm = (lane >= o) ? fmaxf(pm, v_) : pm; }
        const float pml = __shfl(pm, 63), bl = __shfl(bc, 63);
        BCS[lane] = bc; A2[lane] = a2; PM[lane] = pm; KWS[lane] = __expf(a2 - pml);
        if (!dry) { MS[(row * 8 + h) * 4 + 0] = bc; MS[(row * 8 + h) * 4 + 1] = bc + pm; }
        if (lane == 0 && !dry) { ITEM[128] = bl + pml; ITEM[129] = bl; }
    }
    float kp[16];
    {
        float xq[19], xk[19];
#pragma unroll
        for (int i = 0; i < 19; ++i) { xq[i] = bf2f(raw.xq[i]); xk[i] = bf2f(raw.xk[i]); }
        const float q0 = raw.cwq[0], q1 = raw.cwq[1], q2 = raw.cwq[2], q3 = raw.cwq[3], qb = raw.cbq;
        const float k0 = raw.cwk[0], k1 = raw.cwk[1], k2 = raw.cwk[2], k3 = raw.cwk[3], kb = raw.cbk;
#pragma unroll
        for (int i = 0; i < 16; ++i) {
            const float qv = siluf_(qb + q0 * xq[i] + q1 * xq[i + 1] + q2 * xq[i + 2] + q3 * xq[i + 3]) * 0.08838834764831845f;
            kp[i] = siluf_(kb + k0 * xk[i] + k1 * xk[i + 1] + k2 * xk[i + 2] + k3 * xk[i + 3]);
            QT[(16 * qq + i) * QS + d] = (bf16_t)f2bf(qv); KT[(16 * qq + i) * QS + d] = (bf16_t)f2bf(kp[i]);
        }
    }
    bf16x8_t vt[4];
    {
        const int e = tid & 255, hf = tid >> 8;
        unsigned short vv[32];
#pragma unroll
        for (int i = 0; i < 32; ++i) vv[i] = raw.vv[i];
#pragma unroll
        for (int j = 0; j < 4; ++j) { v4u w4; w4.x = vv[8 * j] | ((unsigned)vv[8 * j + 1] << 16); w4.y = vv[8 * j + 2] | ((unsigned)vv[8 * j + 3] << 16); w4.z = vv[8 * j + 4] | ((unsigned)vv[8 * j + 5] << 16); w4.w = vv[8 * j + 6] | ((unsigned)vv[8 * j + 7] << 16);
            vt[j] = __builtin_bit_cast(bf16x8_t, w4); *(LAS bf16x8_t*)(VT + e * VS + 32 * hf + 8 * j) = vt[j]; }
    }
    WG_BAR();
    {
        bf16_t* vg = U + uidx(row0, 2048 + h * 256);
#pragma unroll
        for (int j = 0; j < 4; ++j) { const int p = tid + 512 * j; const bf16x8_t v_ = *(const LAS bf16x8_t*)(VT + (p >> 3) * VS + (p & 7) * 8); if (!dry) *(bf16x8_t*)(vg + (size_t)p * 8) = v_; }
        float kw[16], ns = 0.f;
#pragma unroll
        for (int i = 0; i < 16; ++i) { kw[i] = kp[i] * KWS[16 * qq + i]; ns += kw[i]; }
        NL[qq * 128 + d] = ns;
        LAS bf16_t* kp_ = KWT + d * VS + 16 * qq;
        { const bf16x8_t ka_ = pack_bf16x8(kw[0], kw[1], kw[2], kw[3], kw[4], kw[5], kw[6], kw[7]), kb_ = pack_bf16x8(kw[8], kw[9], kw[10], kw[11], kw[12], kw[13], kw[14], kw[15]); *(LAS bf16x8_t*)kp_ = ka_; *(LAS bf16x8_t*)(kp_ + 8) = kb_; }
#pragma unroll
        for (int j = 0; j < 2; ++j) { const int p = tid + 512 * j, row = p >> 4, c16 = p & 15; const bf16x8_t qv_ = *(const LAS bf16x8_t*)(QT + row * QS + c16 * 8); if (!dry) *(bf16x8_t*)(QA + (row0 + row) * D + h * 128 + c16 * 8) = qv_; }
    }
    {
        const int tb = w >> 1, r = lane & 15, g = lane >> 4;
#pragma unroll
        for (int k2 = 0; k2 < 2; ++k2) {
            const int sb = 2 * (w & 1) + k2;
            f32x4_t acc = {0.f, 0.f, 0.f, 0.f};
            if (sb <= tb) {
#pragma unroll
                for (int ks = 0; ks < 4; ++ks) {
                    const bf16x8_t a = *(const LAS bf16x8_t*)(KT + (16 * sb + r) * QS + 32 * ks + 8 * g), bb = *(const LAS bf16x8_t*)(QT + (16 * tb + r) * QS + 32 * ks + 8 * g);
                    acc = __builtin_amdgcn_mfma_f32_16x16x32_bf16(a, bb, acc, 0, 0, 0);
                }
            }
            const int t = 16 * tb + r, s0 = 16 * sb + 4 * g; const float pmt = PM[t];
            float sc[4], ds = 0.f;
#pragma unroll
            for (int j = 0; j < 4; ++j) { sc[j] = (s0 + j <= t) ? acc[j] * __expf(A2[s0 + j] - pmt) : 0.f; ds += sc[j]; }
            v2u pw; pw.x = pg8::cvt_pk_bf16(sc[0], sc[1]); pw.y = pg8::cvt_pk_bf16(sc[2], sc[3]);
            *(LAS v2u*)(AT + t * VS + s0) = pw;
            ds += __shfl_xor(ds, 16); ds += __shfl_xor(ds, 32);
            if (g == 0) DL[sb * 64 + t] = ds;
        }
    }
    WG_BAR();
    {
        const int l31 = lane & 31, hh = lane >> 5;
#pragma unroll
        for (int th = 0; th < 2; ++th) {
            f32x16 acc;
#pragma unroll
            for (int r = 0; r < 16; ++r) acc[r] = 0.f;
#pragma unroll
            for (int ks = 0; ks < 4; ++ks) {
                const bf16x8_t a = *(const LAS bf16x8_t*)(AT + (32 * th + l31) * VS + 16 * ks + 8 * hh), bb = *(const LAS bf16x8_t*)(VT + (32 * w + l31) * VS + 16 * ks + 8 * hh);
                acc = __builtin_amdgcn_mfma_f32_32x32x16_bf16(a, bb, acc, 0, 0, 0);
            }
#pragma unroll
            for (int r = 0; r < 16; ++r) { const int t = 32 * th + (r & 3) + 8 * (r >> 2) + 4 * hh; NT[t * 264 + 32 * w + l31] = (bf16_t)f2bf(acc[r]); }
        }
#pragma unroll
        for (int j = 0; j < 2; ++j) { const int p = tid + 512 * j, dd = p >> 3, c8 = p & 7; const bf16x8_t k_ = *(const LAS bf16x8_t*)(KWT + dd * VS + c8 * 8);
            if (!dry) *(bf16x8_t*)(QA + (row0 + (dd >> 1)) * D + 1024 + h * 128 + (dd & 1) * 64 + c8 * 8) = k_; }
        if (tid < 64 && !dry) MS[((row0 + tid) * 8 + h) * 4 + 2] = (DL[tid] + DL[64 + tid]) + (DL[128 + tid] + DL[192 + tid]);
        if (tid >= 128 && tid < 256 && !dry) { const int dd = tid - 128; ITEM[dd] = (NL[dd] + NL[128 + dd]) + (NL[256 + dd] + NL[384 + dd]); }
    }
    WG_BAR();
#pragma unroll
    for (int j = 0; j < 4; ++j) { const int p = tid + 512 * j, t_ = p >> 5, c32 = p & 31; const bf16x8_t o_ = *(const LAS bf16x8_t*)(NT + t_ * 264 + c32 * 8);
        if (!dry) *(bf16x8_t*)(NUM + (row0 + t_) * D + h * 256 + c32 * 8) = o_; }
    WG_BAR();
}

__device__ __forceinline__ void mlstm_b_phase(const Frame& F, const int dry, int b, int h, int eh) {
    constexpr int QS = 132, VS = 72;
    LAS bf16_t* QB = (LAS bf16_t*)F.lds;
    LAS bf16_t* KB = QB + 64 * QS;
    LAS bf16_t* VB = KB + 128 * VS;
    LAS float* NS = (LAS float*)(VB + 128 * VS);
    LAS float* DECC = NS + 128;
    LAS float* SLOC = DECC + 32;
    LAS bf16_t* OT = (LAS bf16_t*)(SLOC + 32);
    bf16_t* U = (bf16_t*)(F.ws + OFF_U); const bf16_t* QA = (const bf16_t*)F.out; bf16_t* P1 = (bf16_t*)F.out + (size_t)M * D;
    float* MS = (float*)(F.ws + OFF_MS); float* ITEM0 = (float*)(F.ws + OFF_ITEM1) + (size_t)((b * 32) * 8 + h) * 256;
    const int tid = F.tid, w = F.wave, lane = F.lane, l31 = lane & 31, hh = lane >> 5, eb = w & 3, dh = w >> 2;
    if (w == 0) {
        const float Mc_l = (lane < 32) ? ITEM0[(size_t)lane * 2048 + 128] : 0.f, bl_l = (lane < 32) ? ITEM0[(size_t)lane * 2048 + 129] : 0.f;
        float m = 0.f, mine_m = 0.f, mine_dec = 0.f, mine_sl = 0.f;
        for (int c = 0; c < 32; ++c) { const float Mc = __shfl(Mc_l, c), bl = __shfl(bl_l, c), mn = fmaxf(bl + m, Mc);
            if (lane == c) { mine_m = m; mine_dec = __expf(bl + m - mn); mine_sl = __expf(Mc - mn); }
            m = mn; }
        if (lane < 32) { DECC[lane] = mine_dec; SLOC[lane] = mine_sl; if (!dry && eh == 0) ITEM0[(size_t)lane * 2048 + 130] = mine_m; }
    }
    if (tid < 128) NS[tid] = 0.f;
    f32x16 X[2];
#pragma unroll
    for (int xi = 0; xi < 2; ++xi)
#pragma unroll
        for (int r = 0; r < 16; ++r) X[xi][r] = 0.f;
    bf16x8_t pqA[2], pkA[2], pvA[2], pqB[2], pkB[2], pvB[2]; float pnlA = 0.f, pnlB = 0.f;
    {
        const size_t row0 = (size_t)b * S;
#pragma unroll
        for (int j = 0; j < 2; ++j) { const int p = tid + 512 * j; const bf16_t* ap = QA + (row0 + (p >> 4)) * D + h * 128 + (p & 15) * 8; pqA[j] = *(const bf16x8_t*)ap; pkA[j] = *(const bf16x8_t*)(ap + 1024);
            pvA[j] = *(const bf16x8_t*)(U + uidx(row0 + 32 * eh + (p >> 5), 2048 + h * 256 + (p & 31) * 8));
            const bf16_t* bp = ap + (size_t)64 * D; pqB[j] = *(const bf16x8_t*)bp; pkB[j] = *(const bf16x8_t*)(bp + 1024);
            pvB[j] = *(const bf16x8_t*)(U + uidx(row0 + 64 + 32 * eh + (p >> 5), 2048 + h * 256 + (p & 31) * 8)); }
        if (tid < 128) { pnlA = ITEM0[tid]; pnlB = ITEM0[2048 + tid]; }
    }
    WG_BAR();
#define MLSTM_B_CHUNK(CIDX, PQ, PK, PV, PNL) { const int c = (CIDX); \
        const size_t row0 = (size_t)b * S + c * 64; \
        const float dec = DECC[c], sloc = SLOC[c]; \
_Pragma("unroll") \
        for (int j = 0; j < 2; ++j) { const int p = tid + 512 * j, ur = p >> 4, c16 = p & 15; \
            { const v4u w4 = __builtin_bit_cast(v4u, PQ[j]); v2u lo, hi; lo.x = w4.x; lo.y = w4.y; hi.x = w4.z; hi.y = w4.w; *(LAS v2u*)(QB + ur * QS + c16 * 8) = lo; *(LAS v2u*)(QB + ur * QS + c16 * 8 + 4) = hi; } \
            { const v4u w4 = __builtin_bit_cast(v4u, PK[j]); \
              const bf16x8_t ks_ = pack_bf16x8(pg8::bflo(w4.x) * sloc, pg8::bfhi(w4.x) * sloc, pg8::bflo(w4.y) * sloc, pg8::bfhi(w4.y) * sloc, pg8::bflo(w4.z) * sloc, pg8::bfhi(w4.z) * sloc, pg8::bflo(w4.w) * sloc, pg8::bfhi(w4.w) * sloc); \
              *(LAS bf16x8_t*)(KB + (2 * ur + (c16 >> 3)) * VS + (c16 & 7) * 8) = ks_; } \
            { const int vr = p >> 5, c32 = p & 31; *(LAS bf16x8_t*)(VB + (4 * vr + (c32 >> 3)) * VS + (c32 & 7) * 8) = PV[j]; } } \
        const float nl_cur = PNL; \
        WG_BAR(); \
        if (c + 2 < 32) { \
            const size_t rn = row0 + 128; \
_Pragma("unroll") \
            for (int j = 0; j < 2; ++j) { const int p = tid + 512 * j; const bf16_t* ap = QA + (rn + (p >> 4)) * D + h * 128 + (p & 15) * 8; PQ[j] = *(const bf16x8_t*)ap; PK[j] = *(const bf16x8_t*)(ap + 1024); \
                PV[j] = *(const bf16x8_t*)(U + uidx(rn + 32 * eh + (p >> 5), 2048 + h * 256 + (p & 31) * 8)); } \
            if (tid < 128) PNL = ITEM0[(size_t)(c + 2) * 2048 + tid]; \
        } \
 \
        if (eh == 0) { \
            const int tq = 8 * w + (lane >> 3), d0 = (lane & 7) * 16; float s = 0.f; \
_Pragma("unroll") \
            for (int j = 0; j < 4; ++j) { const v2u qv = *(const LAS v2u*)(QB + tq * QS + d0 + 4 * j); const f32x4_t nv = *(const LAS f32x4_t*)(NS + d0 + 4 * j); \
                s += (pg8::bflo(qv.x) * nv[0] + pg8::bfhi(qv.x) * nv[1]) + (pg8::bflo(qv.y) * nv[2] + pg8::bfhi(qv.y) * nv[3]); } \
            s += __shfl_xor(s, 1); s += __shfl_xor(s, 2); s += __shfl_xor(s, 4); \
            if ((lane & 7) == 0 && !dry) MS[((row0 + tq) * 8 + h) * 4 + 3] = s; \
        } \
 \
        f32x16 accT[2]; \
_Pragma("unroll") \
        for (int tt = 0; tt < 2; ++tt) \
_Pragma("unroll") \
            for (int r = 0; r < 16; ++r) accT[tt][r] = 0.f; \
_Pragma("unroll") \
        for (int xi = 0; xi < 2; ++xi) \
_Pragma("unroll") \
            for (int s = 0; s < 2; ++s) { \
                const bf16x8_t a = pack_bf16x8(X[xi][8 * s + 0], X[xi][8 * s + 1], X[xi][8 * s + 2], X[xi][8 * s + 3], X[xi][8 * s + 4], X[xi][8 * s + 5], X[xi][8 * s + 6], X[xi][8 * s + 7]); \
_Pragma("unroll") \
                for (int tt = 0; tt < 2; ++tt) { \
                    const LAS bf16_t* qp = QB + (32 * tt + l31) * QS + 64 * dh + 32 * xi + 16 * s + 4 * hh; \
                    const bf16x8_t bq = cat_bf16x4(*(const LAS v2u*)qp, *(const LAS v2u*)(qp + 8)); \
                    accT[tt] = __builtin_amdgcn_mfma_f32_32x32x16_bf16(a, bq, accT[tt], 0, 0, 0); \
                } \
            } \
 \
_Pragma("unroll") \
        for (int xi = 0; xi < 2; ++xi) { \
_Pragma("unroll") \
            for (int r = 0; r < 16; ++r) X[xi][r] *= dec; \
_Pragma("unroll") \
            for (int ks = 0; ks < 4; ++ks) { \
                const bf16x8_t a = *(const LAS bf16x8_t*)(KB + (64 * dh + 32 * xi + l31) * VS + 16 * ks + 8 * hh), bv = *(const LAS bf16x8_t*)(VB + (32 * eb + l31) * VS + 16 * ks + 8 * hh); \
                X[xi] = __builtin_amdgcn_mfma_f32_32x32x16_bf16(a, bv, X[xi], 0, 0, 0); \
            } \
        } \
 \
_Pragma("unroll") \
        for (int tt = 0; tt < 2; ++tt) \
_Pragma("unroll") \
            for (int g4 = 0; g4 < 4; ++g4) { v2u ow; ow.x = pg8::cvt_pk_bf16(accT[tt][4 * g4 + 0], accT[tt][4 * g4 + 1]); ow.y = pg8::cvt_pk_bf16(accT[tt][4 * g4 + 2], accT[tt][4 * g4 + 3]); \
                *(LAS v2u*)(OT + (dh * 64 + 32 * tt + l31) * 136 + 32 * eb + 8 * g4 + 4 * hh) = ow; } \
        WG_BAR(); \
        _Pragma("unroll") \
        for (int j = 0; j < 4; ++j) { const int p = tid + 512 * j, dh_ = p >> 10, t_ = (p >> 4) & 63, c16 = p & 15; const bf16x8_t o_ = *(const LAS bf16x8_t*)(OT + (dh_ * 64 + t_) * 136 + c16 * 8); \
            const int e0 = h * 256 + 128 * eh + c16 * 8; const size_t row = row0 + t_; \
            if (!dry) { if (dh_ == 0) *(bf16x8_t*)(U + uidx(row, e0)) = o_; else *(bf16x8_t*)(P1 + row * D + e0) = o_; } } \
        if (tid < 128) NS[tid] = dec * NS[tid] + sloc * nl_cur; \
    }
    for (int c2 = 0; c2 < 32; c2 += 2) { MLSTM_B_CHUNK(c2, pqA, pkA, pvA, pnlA) MLSTM_B_CHUNK(c2 + 1, pqB, pkB, pvB, pnlB) }
#undef MLSTM_B_CHUNK
    WG_BAR();
}

__device__ __forceinline__ void mlstm_c_item(const Frame& F, const int dry, int b, int c, int h) {
    const bf16_t* U = (const bf16_t*)(F.ws + OFF_U); bf16_t* Y = (bf16_t*)(F.ws + OFF_B); const bf16_t* P1 = (const bf16_t*)F.out + (size_t)M * D;
    const float* MS = (const float*)(F.ws + OFF_MS); const float* ITEM = (const float*)(F.ws + OFF_ITEM1) + (size_t)((b * 32 + c) * 8 + h) * 256;
    const int w = F.wave, lane = F.lane;
    const size_t row0 = (size_t)b * S + c * 64;
    const f32x4_t cn = *(const f32x4_t*)(F.in[20] + h * 256 + 4 * lane);
    const float m_st = ITEM[130];
    v2u oi[8], o2[8], nm[8], gg[8]; f32x4_t st[8];
#pragma unroll
    for (int i = 0; i < 8; ++i) { const size_t row = row0 + 8 * w + i;
        oi[i] = *(const v2u*)(U + uidx(row, h * 256 + 4 * lane)); o2[i] = *(const v2u*)(P1 + row * D + h * 256 + 4 * lane); nm[i] = *(const v2u*)(Y + row * D + h * 256 + 4 * lane); gg[i] = *(const v2u*)(U + uidx(row, 4096 + h * 256 + 4 * lane));
        st[i] = *(const f32x4_t*)(MS + (row * 8 + h) * 4); }
#pragma unroll
    for (int i = 0; i < 8; ++i) { const size_t row = row0 + 8 * w + i;
        const float bcs = st[i][0], mloc = st[i][1], dloc = st[i][2], di = st[i][3];
        const float mt = fmaxf(mloc, bcs + m_st), gi = __expf(bcs + m_st - mt), gl = __expf(mloc - mt);
        const float den = gi * di + gl * dloc, inv = 1.f / fmaxf(fabsf(den), __expf(-mt));
        const float h0 = (gi * (pg8::bflo(oi[i].x) + pg8::bflo(o2[i].x)) + gl * pg8::bflo(nm[i].x)) * inv, h1 = (gi * (pg8::bfhi(oi[i].x) + pg8::bfhi(o2[i].x)) + gl * pg8::bfhi(nm[i].x)) * inv;
        const float h2 = (gi * (pg8::bflo(oi[i].y) + pg8::bflo(o2[i].y)) + gl * pg8::bflo(nm[i].y)) * inv, h3 = (gi * (pg8::bfhi(oi[i].y) + pg8::bfhi(o2[i].y)) + gl * pg8::bfhi(nm[i].y)) * inv;
        const float ss = wave_sum((h0 * h0 + h1 * h1) + (h2 * h2 + h3 * h3));
        const float rs = rsqrtf(ss * (1.f / 256.f) + EPS);
        v2u yw; yw.x = pg8::cvt_pk_bf16(h0 * rs * cn[0] * pg8::bflo(gg[i].x), h1 * rs * cn[1] * pg8::bfhi(gg[i].x)); yw.y = pg8::cvt_pk_bf16(h2 * rs * cn[2] * pg8::bflo(gg[i].y), h3 * rs * cn[3] * pg8::bfhi(gg[i].y));
        if (!dry) *(v2u*)(Y + row * D + h * 256 + 4 * lane) = yw; }
}

#ifndef MK_DUP
#define MK_DUP -1
#endif
enum { PH_P0 = 0, PH_IN0, PH_MIX0A, PH_MIX0B, PH_MIX0C, PH_OUT0, PH_GATE0, PH_IN1, PH_MIX1A, PH_MIX1B, PH_MIX1C, PH_OUT1, PH_GATE1, PH_FINAL, PH_END };

__global__ void __launch_bounds__(NWAVES * 64, 2) mk_fwd(Ptrs args) {
    extern __shared__ __attribute__((aligned(16))) unsigned char lds_raw[];
    Frame F;
    F.lds = (LAS unsigned char*)lds_raw;
    F.tid = threadIdx.x; F.lane = F.tid & 63; F.wave = __builtin_amdgcn_readfirstlane(F.tid >> 6);
    F.G = gridDim.x; F.bid = blockIdx.x; F.in = args.in; F.out = args.out; F.ws = args.ws;
    volatile LAS unsigned* MISC = (volatile LAS unsigned*)(F.lds + MISC_OFF);
    if (F.tid < 32) MISC[F.tid] = 0u;
    __syncthreads();
    XcdBarrier bar = xcd_barrier_post((unsigned*)(F.ws + OFF_CTL) + CW_BAR + args.li * XCD_BAR_WORDS, MISC + 8);
    const int lo = args.ph_lo, hi = args.ph_hi, dryv = args.dup;
#define IN_(k) (lo <= (k) && (k) < hi)
#define RUN(k, BODY) do { if (IN_(k)) { if (MK_DUP == (k)) { BODY(dryv) xcd_barrier(bar); } BODY(0) } } while (0)
#ifndef MK_TSPROBE
#define MK_TSPROBE -1
#endif
    unsigned long long* const tsb = (unsigned long long*)(F.ws + OFF_CTL + 524288);
#define STAMP(k) do { if (MK_TSPROBE >= 0 && F.bid == 0 && F.tid == 0) __hip_atomic_store(tsb + (k), (unsigned long long)__builtin_amdgcn_s_memrealtime(), __ATOMIC_RELAXED, __HIP_MEMORY_SCOPE_AGENT); } while (0)
#define SEAM(k) do { if (IN_(k) && IN_((k) + 1)) xcd_barrier(bar); STAMP((k) + 1); } while (0)
    STAMP(0);
    unsigned char* ws = F.ws;
    bf16_t* A = (bf16_t*)(ws + OFF_A); bf16_t* B = (bf16_t*)(ws + OFF_B); bf16_t* U = (bf16_t*)(ws + OFF_U);
    float* plpart = (float*)(ws + OFF_PART); float* hpart = plpart + (size_t)M * 32;
    const bf16_t* P16 = (const bf16_t*)(ws + OFF_WIN0); bf16_t* PL = U;
    const bf16_t* PLEW = (const bf16_t*)(ws + OFF_PLEW); bf16_t* PL1 = (bf16_t*)(ws + OFF_WIN1);
    float* plpart1 = (float*)(ws + OFF_WIN0 + 8 * MiB);

#define BODY_PH_P0(DRY) { p0_prologue(F); }
#define BODY_PH_IN0(DRY) { pg8::Gemm g{A, (const bf16_t*)(ws + OFF_WIN0), M, 6144, 2048}; pg8::StaticOrder So; So.init(M, 6144, F.G, F.bid); \
        pg8::EpiIn0 E{U, (const float*)(ws + OFF_SMALL) + 1024, DRY}; \
        pg8::gemm_phase<pg8::EpiIn0, pg8::StaticOrder, true, true>(F.lds, g, So, E); }
#define BODY_PH_MIX0A(DRY) { cvt_p_phase(F, DRY); \
        { H2Raw cur_, nxt_; if (F.bid < 1024) hgrn2_a_load(F, F.bid >> 8, (F.bid >> 3) & 31, F.bid & 7, cur_); \
          for (int it = F.bid; it < 1024; it += F.G) { const int in_ = it + F.G; if (in_ < 1024) hgrn2_a_load(F, in_ >> 8, (in_ >> 3) & 31, in_ & 7, nxt_); hgrn2_a_item(F, DRY, it >> 8, (it >> 3) & 31, it & 7, cur_); cur_ = nxt_; } } \
        { LruRaw cur_, nxt_; if (F.bid < 1024) rglru_a_load(F, F.bid >> 8, (F.bid >> 3) & 31, F.bid & 7, cur_); \
          for (int it = F.bid; it < 1024; it += F.G) { const int in_ = it + F.G; if (in_ < 1024) rglru_a_load(F, in_ >> 8, (in_ >> 3) & 31, in_ & 7, nxt_); rglru_a_item(F, DRY, it >> 8, (it >> 3) & 31, it & 7, cur_); cur_ = nxt_; } } }
#define BODY_PH_MIX0B(DRY) { if (F.bid < 32) hgrn2_b_phase(F, DRY, F.bid >> 3, F.bid & 7); else { for (int it = F.bid - 32; it < 1024; it += F.G - 32) rglru_b_item(F, DRY, it >> 8, (it >> 3) & 31, it & 7); \
        p0_layer1_weights(F, (F.bid - 32) * NWAVES + F.wave, (F.G - 32) * NWAVES); } }
#define BODY_PH_MIX0C(DRY) { for (int it = F.bid; it < 1024; it += F.G) hgrn2_c_item(F, DRY, it >> 8, (it >> 3) & 31, it & 7); }
#define BODY_PH_OUT0(DRY) { { pg8::Gemm g{A, (const bf16_t*)(ws + OFF_WOUT0), M, 2048, 2048}; pg8::StaticOrder So; So.init(M, 2048, F.G, F.bid); \
          pg8::EpiOut<true> E{F.in[0], B, DRY}; \
          pg8::gemm_phase<pg8::EpiOut<true>, pg8::StaticOrder, true, true>(F.lds, g, So, E); } \
        { unsigned char* ws2 = ws; asm volatile("" : "+s"(ws2));     \
          pg8::Gemm g{(const bf16_t*)(ws2 + OFF_WIN0), (const bf16_t*)(ws2 + OFF_PLEW), M, 2048, 256}; pg8::StaticOrder So; So.init(M, 2048, F.G, F.bid); \
          pg8::EpiPle E{(bf16_t*)(ws2 + OFF_U), (float*)(ws2 + OFF_PART), DRY}; \
          pg8::gemm_phase<pg8::EpiPle, pg8::StaticOrder, true, true>(F.lds, g, So, E); } }
#define BODY_PH_GATE0(DRY) { pg8::Gemm g{B, (const bf16_t*)(ws + OFF_WG0), M, 2048, 2048}; pg8::StaticOrder So; So.init(M, 2048, F.G, F.bid); \
        pg8::EpiGate E{B, A, nullptr, PL, plpart, F.in[23], hpart, DRY}; \
        pg8::gemm_phase<pg8::EpiGate, pg8::StaticOrder, true, true>(F.lds, g, So, E); }
#define BODY_PH_IN1(DRY) { pg8::Gemm g{A, (const bf16_t*)(ws + OFF_WIN1), M, 8192, 2048}; pg8::StaticOrder So; So.init(M, 8192, F.G, F.bid); \
        pg8::EpiIn1 E{U, hpart, DRY}; \
        pg8::gemm_phase<pg8::EpiIn1, pg8::StaticOrder, true, true>(F.lds, g, So, E); \
        gates1_phase(F, DRY); }
#define BODY_PH_MIX1A(DRY) { MlRaw cur_, nxt_; if (F.bid < 1024) mlstm_a_load(F, F.bid >> 8, (F.bid >> 3) & 31, F.bid & 7, cur_); \
        for (int it = F.bid; it < 1024; it += F.G) { const int in_ = it + F.G; if (in_ < 1024) mlstm_a_load(F, in_ >> 8, (in_ >> 3) & 31, in_ & 7, nxt_); mlstm_a_item(F, DRY, it >> 8, (it >> 3) & 31, it & 7, cur_); cur_ = nxt_; } }
#define BODY_PH_MIX1B(DRY) { if (F.bid < 64) mlstm_b_phase(F, DRY, F.bid >> 4, (F.bid >> 1) & 7, F.bid & 1); else { \
        pg8::Gemm g{P16 + (size_t)M * PLE, PLEW + (size_t)2048 * 256, M, 2048, 256}; pg8::StaticOrder So; So.init(M, 2048, F.G - 64, F.bid - 64); \
        pg8::EpiPle E{PL1, plpart1, DRY}; \
        pg8::gemm_phase<pg8::EpiPle, pg8::StaticOrder, true, true>(F.lds, g, So, E); } }
#define BODY_PH_MIX1C(DRY) { for (int it = F.bid; it < 1024; it += F.G) mlstm_c_item(F, DRY, it >> 8, (it >> 3) & 31, it & 7); }
#define BODY_PH_OUT1(DRY) { pg8::Gemm g{B, (const bf16_t*)(ws + OFF_WOUT1), M, 2048, 2048}; pg8::StaticOrder So; So.init(M, 2048, F.G, F.bid); \
          pg8::EpiOut<false> E{A, A, DRY}; \
          pg8::gemm_phase<pg8::EpiOut<false>, pg8::StaticOrder, true, true>(F.lds, g, So, E); }
#define BODY_PH_GATE1(DRY) { pg8::Gemm g{A, (const bf16_t*)(ws + OFF_WG1), M, 2048, 2048}; pg8::StaticOrder So; So.init(M, 2048, F.G, F.bid); \
        float peps = 0.f; \
        if (MK_TSPROBE >= 0) { const unsigned long long t0_ = __hip_atomic_load(tsb + (MK_TSPROBE >= 0 ? MK_TSPROBE : 0), __ATOMIC_RELAXED, __HIP_MEMORY_SCOPE_AGENT), t1_ = __hip_atomic_load(tsb + (MK_TSPROBE >= 0 ? MK_TSPROBE : 0) + 1, __ATOMIC_RELAXED, __HIP_MEMORY_SCOPE_AGENT); \
            unsigned bk = (unsigned)((t1_ - t0_) / 500ull); if (bk > 95u) bk = 95u; peps = sqrtf((float)bk * 1e-6f); }     \
        pg8::EpiGateFinal E{A, F.out, PL1, plpart1, F.in[23] + D, F.in[25], (float*)(ws + OFF_GATES1), (unsigned*)(ws + OFF_CTL) + CW_FIN, peps, DRY}; \
        pg8::gemm_phase<pg8::EpiGateFinal, pg8::StaticOrder, false, true>(F.lds, g, So, E); }
#define BODY_PH_FINAL(DRY) { final_norm_phase(F, DRY); }

    RUN(PH_P0, BODY_PH_P0);
    SEAM(PH_P0);
    RUN(PH_IN0, BODY_PH_IN0);
    SEAM(PH_IN0);
    RUN(PH_MIX0A, BODY_PH_MIX0A);
    SEAM(PH_MIX0A);
    RUN(PH_MIX0B, BODY_PH_MIX0B);
    SEAM(PH_MIX0B);
    RUN(PH_MIX0C, BODY_PH_MIX0C);
    SEAM(PH_MIX0C);
    RUN(PH_OUT0, BODY_PH_OUT0);
    SEAM(PH_OUT0);
    RUN(PH_GATE0, BODY_PH_GATE0);
    SEAM(PH_GATE0);
    RUN(PH_IN1, BODY_PH_IN1);
    SEAM(PH_IN1);
    RUN(PH_MIX1A, BODY_PH_MIX1A);
    SEAM(PH_MIX1A);
    RUN(PH_MIX1B, BODY_PH_MIX1B);
    SEAM(PH_MIX1B);
    RUN(PH_MIX1C, BODY_PH_MIX1C);
    SEAM(PH_MIX1C);
    RUN(PH_OUT1, BODY_PH_OUT1);
    SEAM(PH_OUT1);
    RUN(PH_GATE1, BODY_PH_GATE1);
#undef IN_
#undef SEAM
#undef RUN
}


extern "C" void kernel_launch(void* const* d_in, const int* in_sizes, int n_in, void* d_out, int out_size, void* d_ws, size_t ws_size, hipStream_t stream) {
    static int grid = 0;
    if (grid == 0) {
        if (n_in != 26 || ws_size < WS_END || out_size != M * D) { fprintf(stderr, "kernel_launch: unexpected problem (n_in %d, ws %zu, out %d)\n", n_in, ws_size, out_size); grid = -1; return; }
        int dev = 0, cus = 0, per_cu = 0;
        if (hipGetDevice(&dev) != hipSuccess || hipDeviceGetAttribute(&cus, hipDeviceAttributeMultiprocessorCount, dev) != hipSuccess) { grid = -1; return; }
        if (hipFuncSetAttribute((const void*)mk_fwd, hipFuncAttributeMaxDynamicSharedMemorySize, LDS_BYTES) != hipSuccess) { fprintf(stderr, "kernel_launch: hipFuncSetAttribute failed\n"); grid = -1; return; }
        if (hipOccupancyMaxActiveBlocksPerMultiprocessor(&per_cu, (const void*)mk_fwd, NWAVES * 64, LDS_BYTES) != hipSuccess || per_cu < 1) { fprintf(stderr, "kernel_launch: occupancy query says %d blocks per CU\n", per_cu); (void)hipGetLastError(); grid = -1; return; }
        grid = cus;
    }
    if (grid < 0) return;
    (void)hipMemsetAsync((char*)d_ws + OFF_CTL, 0, CTL_ZERO_BYTES, stream);
    Ptrs a{};
    for (int i = 0; i < 26; ++i) a.in[i] = (const float*)d_in[i];
    a.out = (float*)d_out; a.ws = (unsigned char*)d_ws; a.ph_lo = PH_P0; a.ph_hi = PH_END; a.li = 0; a.dup = 1;
    void* kargs[] = {&a};
    const hipError_t e = hipLaunchCooperativeKernel((const void*)mk_fwd, dim3(grid), dim3(NWAVES * 64), kargs, LDS_BYTES, stream);
    if (e != hipSuccess) fprintf(stderr, "kernel_launch: cooperative launch failed: %s (grid %d)\n", hipGetErrorString(e), grid);
}
```

```cpp
#include <hip/hip_runtime.h>
#include <cstdio>
#include <cstdint>

namespace pg8 {
#define PG8_LAS __attribute__((address_space(3)))
typedef unsigned short bf16_t;
typedef short bf16x8 __attribute__((ext_vector_type(8)));
typedef float f32x4 __attribute__((ext_vector_type(4)));
typedef unsigned u32x4 __attribute__((ext_vector_type(4)));
constexpr int BM = 256, BK = 64, HALF = 128, HTB = HALF * BK * 2  , STAGE_BYTES = 8 * HTB, NXCD = 8, WGM = 8;

__host__ __device__ __forceinline__ int lds_byte(int r, int c) { const int st = (r >> 4) * 2 + (c >> 5), rr = r & 15, cc = c & 31, ob = rr * 64 + cc * 2; return st * 1024 + (ob ^ (((ob >> 9) & 1) << 5)); }
__host__ __device__ __forceinline__ void stage_rc(int b, int& R, int& C) { const int st = b / 1024, sb = b % 1024, swz = sb ^ (((sb >> 9) & 1) << 5); R = (st >> 1) * 16 + swz / 64; C = (st & 1) * 32 + (swz % 64) / 2; }
__host__ __device__ __forceinline__ int perm32(int rho) { const int n = rho >> 4, i = rho & 15; return 8 * (i >> 2) + 4 * n + (i & 3); }

struct Unit { int pm, pn; };
struct Gemm { const bf16_t* A; const bf16_t* Bt; int M, N, K; };

struct StaticOrder {
    int nM, nN, nwg, G, c;
    __host__ __device__ void init(int M, int N, int G_, int c_) { nM = M / BM; nN = N / BM; nwg = nM * nN; G = G_; c = c_; }
    __host__ __device__ bool next(int i, Unit& u) const {
        const long L = (long)i * G + c; if (L >= nwg) return false;
        int wgid = (int)L; { const int q = nwg / NXCD, r = nwg % NXCD, xcd = wgid % NXCD, off = wgid / NXCD; wgid = (xcd < r ? xcd * (q + 1) : r * (q + 1) + (xcd - r) * q) + off; }
        const int nig = WGM * nN, gid = wgid / nig, fm = gid * WGM, gsz = (nM - fm) < WGM ? (nM - fm) : WGM;
        u.pm = fm + ((wgid % nig) % gsz); u.pn = (wgid % nig) / gsz; return true;
    }
    __device__ __forceinline__ void a_ready(const Unit&) const {}
    __device__ __forceinline__ void done(const Unit&) const {}
};

typedef __bf16 bf16v2_t __attribute__((ext_vector_type(2)));
typedef float f32v2_t __attribute__((ext_vector_type(2)));
__device__ __forceinline__ unsigned cvt_pk_bf16(float lo, float hi) { const f32v2_t v = {lo, hi}; return __builtin_bit_cast(unsigned, __builtin_convertvector(v, bf16v2_t)); }
typedef float f32x2 __attribute__((ext_vector_type(2)));
template <class Epi, class Sched, bool ALIGN_EPI = false, bool SP2 = false>
__device__ __forceinline__ void gemm_phase(PG8_LAS unsigned char* lds, const Gemm g, const Sched& S, const Epi& E) {
    const int tid = threadIdx.x, wid = __builtin_amdgcn_readfirstlane(tid >> 6), lane = tid & 63, wr = wid >> 2, wc = wid & 3, fr = lane & 15, fq = lane >> 4;
    const int K = g.K, nt = K / BK;
    unsigned voffA[2], voffB[2];
#pragma unroll
    for (int i = 0; i < 2; ++i) { int R, C; stage_rc(tid * 16 + i * 8192, R, C); const int Rb = Epi::PERM ? ((R & ~31) + perm32(R & 31)) : R;
        voffA[i] = (unsigned)(R * K + C) * 2u; voffB[i] = (unsigned)(Rb * K + C) * 2u; }
    const size_t kstep = (size_t)(BK * 2);
    const size_t hstep = (size_t)HALF * K * 2;
    const size_t tstep = 2 * hstep;
    const unsigned ldsw = (unsigned)wid * 1024u;
    const int aoff = lds_byte(wr * 64 + fr, fq * 8), boff = lds_byte(wc * 32 + fr, fq * 8);
#define PG8_SA(b, h) (((b) * 2 + (h)) * HTB)
#define PG8_SB(b, h) ((4 + (b) * 2 + (h)) * HTB)
#define PG8_STAGE(bufoff, gbase, voff) do { _Pragma("unroll") for (int _i = 0; _i < 2; ++_i) \
        __builtin_amdgcn_global_load_lds((const unsigned*)((const char*)(gbase) + (voff)[_i]), (PG8_LAS unsigned*)(lds + (bufoff) + ldsw + _i * 8192), 16, 0, 0); } while (0)
#define PG8_LDA(dst, b, h) do { _Pragma("unroll") for (int m = 0; m < 4; ++m) _Pragma("unroll") for (int k = 0; k < 2; ++k) dst[m][k] = *(const PG8_LAS bf16x8*)(lds + PG8_SA(b, h) + aoff + m * 2048 + k * 1024); } while (0)
#define PG8_LDB(dst, b, h) do { _Pragma("unroll") for (int n = 0; n < 2; ++n) _Pragma("unroll") for (int k = 0; k < 2; ++k) dst[n][k] = *(const PG8_LAS bf16x8*)(lds + PG8_SB(b, h) + boff + n * 2048 + k * 1024); } while (0)
#define PG8_MMA(ai, bj, At, Bt) do { __builtin_amdgcn_s_setprio(1); _Pragma("unroll") for (int m = 0; m < 4; ++m) _Pragma("unroll") for (int n = 0; n < 2; ++n) _Pragma("unroll") for (int k = 0; k < 2; ++k) \
        acc[ai][bj][m][n] = __builtin_amdgcn_mfma_f32_16x16x32_bf16(Bt[n][k], At[m][k], acc[ai][bj][m][n], 0, 0, 0); __builtin_amdgcn_s_setprio(0); } while (0)
#define PG8_WAIT_V(n) asm volatile("s_waitcnt vmcnt(" #n ")" ::: "memory")
#define PG8_WAIT_L(n) asm volatile("s_waitcnt lgkmcnt(" #n ")" ::: "memory")
#define PG8_BAR __builtin_amdgcn_s_barrier()
#define PG8_SCHED __builtin_amdgcn_sched_barrier(0)
    Unit cur, nxt; int ui = 0;
    if (!S.next(0, cur)) return;
    f32x4 acc[2][2][4][2];
#pragma unroll
    for (int a = 0; a < 2; ++a)
#pragma unroll
        for (int b = 0; b < 2; ++b)
#pragma unroll
            for (int m = 0; m < 4; ++m)
#pragma unroll
                for (int n = 0; n < 2; ++n) acc[a][b][m][n] = (f32x4){0.f, 0.f, 0.f, 0.f};
    bf16x8 At[4][2], B0[2][2], B1[2][2];
    const char* cA = (const char*)g.A + (size_t)cur.pm * tstep; const char* cB = (const char*)g.Bt + (size_t)cur.pn * tstep;
    S.a_ready(cur);
    if constexpr (SP2) {
        PG8_STAGE(PG8_SB(0, 0), cB, voffB); PG8_STAGE(PG8_SB(0, 1), cB + hstep, voffB); PG8_STAGE(PG8_SA(0, 0), cA, voffA); PG8_STAGE(PG8_SA(0, 1), cA + hstep, voffA);
        if (wr == 1) PG8_BAR;
        PG8_WAIT_V(2); PG8_BAR;
        PG8_STAGE(PG8_SB(1, 0), cB + kstep, voffB); PG8_STAGE(PG8_SA(1, 0), cA + kstep, voffA); PG8_STAGE(PG8_SB(1, 1), cB + hstep + kstep, voffB);
        PG8_WAIT_V(6); PG8_BAR;
    } else {
        PG8_STAGE(PG8_SB(0, 0), cB, voffB); PG8_STAGE(PG8_SA(0, 0), cA, voffA); PG8_STAGE(PG8_SB(0, 1), cB + hstep, voffB); PG8_STAGE(PG8_SA(0, 1), cA + hstep, voffA);
        if (wr == 1) PG8_BAR;
        PG8_WAIT_V(4); PG8_BAR;
        PG8_STAGE(PG8_SB(1, 0), cB + kstep, voffB); PG8_STAGE(PG8_SA(1, 0), cA + kstep, voffA); PG8_STAGE(PG8_SB(1, 1), cB + hstep + kstep, voffB);
        PG8_WAIT_V(6); PG8_BAR;
    }
    for (;;) {
        const bool has_next = S.next(ui + 1, nxt);
        const char* nA = has_next ? (const char*)g.A + (size_t)nxt.pm * tstep : cA; const char* nB = has_next ? (const char*)g.Bt + (size_t)nxt.pn * tstep : cB;
        for (int t = 0; t < nt; t += 2) {
            const bool last = (t == nt - 2);
            const char* a1 = cA + (size_t)(t + 1) * kstep;
            const char* a2 = last ? nA : cA + (size_t)(t + 2) * kstep; const char* b2 = last ? nB : cB + (size_t)(t + 2) * kstep;
            const char* a3 = a2 + kstep; const char* b3 = b2 + kstep;
            if (last && has_next) S.a_ready(nxt);
            if constexpr (SP2) {
            PG8_LDB(B0, 0, 0); PG8_LDB(B1, 0, 1); PG8_SCHED; PG8_LDA(At, 0, 0); PG8_STAGE(PG8_SA(1, 1), a1 + hstep, voffA);
            PG8_WAIT_V(8); PG8_WAIT_L(0); PG8_BAR; PG8_MMA(0, 0, At, B0); PG8_MMA(0, 1, At, B1); PG8_BAR; PG8_SCHED;
            PG8_LDA(At, 0, 1); PG8_STAGE(PG8_SB(0, 0), b2, voffB); PG8_STAGE(PG8_SB(0, 1), b2 + hstep, voffB); PG8_STAGE(PG8_SA(0, 0), a2, voffA);
            PG8_WAIT_V(8); PG8_WAIT_L(0); PG8_BAR; PG8_MMA(1, 0, At, B0); PG8_MMA(1, 1, At, B1); PG8_BAR; PG8_SCHED;
            PG8_LDB(B0, 1, 0); PG8_LDB(B1, 1, 1); PG8_SCHED; PG8_LDA(At, 1, 0); PG8_STAGE(PG8_SA(0, 1), a2 + hstep, voffA);
            PG8_WAIT_V(8); PG8_WAIT_L(0); PG8_BAR; PG8_MMA(0, 0, At, B0); PG8_MMA(0, 1, At, B1); PG8_BAR; PG8_SCHED;
            PG8_LDA(At, 1, 1); PG8_STAGE(PG8_SB(1, 0), b3, voffB); PG8_STAGE(PG8_SB(1, 1), b3 + hstep, voffB); PG8_STAGE(PG8_SA(1, 0), a3, voffA);
            PG8_WAIT_V(8); PG8_WAIT_L(0); PG8_BAR; PG8_MMA(1, 0, At, B0); PG8_MMA(1, 1, At, B1); PG8_BAR; PG8_SCHED;
            } else {
            PG8_LDB(B0, 0, 0); PG8_SCHED; PG8_LDA(At, 0, 0); PG8_STAGE(PG8_SA(1, 1), a1 + hstep, voffA);
            PG8_WAIT_L(8); PG8_BAR; PG8_WAIT_L(0); PG8_MMA(0, 0, At, B0); PG8_BAR; PG8_SCHED;
            PG8_LDB(B1, 0, 1); PG8_STAGE(PG8_SB(0, 0), b2, voffB);
            PG8_BAR; PG8_WAIT_L(0); PG8_MMA(0, 1, At, B1); PG8_BAR;
            PG8_LDA(At, 0, 1); PG8_STAGE(PG8_SA(0, 0), a2, voffA);
            PG8_BAR; PG8_WAIT_L(0); PG8_MMA(1, 0, At, B0); PG8_BAR; PG8_SCHED;
            PG8_STAGE(PG8_SB(0, 1), b2 + hstep, voffB);
            PG8_WAIT_V(6); PG8_BAR; PG8_MMA(1, 1, At, B1); PG8_BAR;
            PG8_LDB(B0, 1, 0); PG8_SCHED; PG8_LDA(At, 1, 0); PG8_STAGE(PG8_SA(0, 1), a2 + hstep, voffA);
            PG8_WAIT_L(8); PG8_BAR; PG8_WAIT_L(0); PG8_MMA(0, 0, At, B0); PG8_BAR; PG8_SCHED;
            PG8_LDB(B1, 1, 1); PG8_STAGE(PG8_SB(1, 0), b3, voffB);
            PG8_BAR; PG8_WAIT_L(0); PG8_MMA(0, 1, At, B1); PG8_BAR;
            PG8_LDA(At, 1, 1); PG8_STAGE(PG8_SA(1, 0), a3, voffA);
            PG8_BAR; PG8_WAIT_L(0); PG8_MMA(1, 0, At, B0); PG8_BAR; PG8_SCHED;
            PG8_STAGE(PG8_SB(1, 1), b3 + hstep, voffB);
            PG8_WAIT_V(6); PG8_BAR; PG8_MMA(1, 1, At, B1); PG8_BAR;
            }
        }
        if constexpr (ALIGN_EPI) { if (wr == 0) PG8_BAR; }
        if constexpr (!Epi::AFTER_DRAIN) { E(acc, cur, wr, wc, fr, fq); S.done(cur); }
        if (!has_next) break;
#pragma unroll
        for (int a = 0; a < 2; ++a)
#pragma unroll
            for (int b = 0; b < 2; ++b)
#pragma unroll
                for (int m = 0; m < 4; ++m)
#pragma unroll
                    for (int n = 0; n < 2; ++n) acc[a][b][m][n] = (f32x4){0.f, 0.f, 0.f, 0.f};
        cur = nxt; cA = nA; cB = nB; ++ui;
        if constexpr (ALIGN_EPI) { if (wr == 1) PG8_BAR; }
    }
    PG8_WAIT_V(0);
    if constexpr (!ALIGN_EPI) { if (wr == 0) PG8_BAR; }
    PG8_BAR;
    if constexpr (Epi::AFTER_DRAIN) { E.fused(acc, cur, wr, wc, fr, fq, lds, wid, lane); S.done(cur); }
#undef PG8_SA
#undef PG8_SB
#undef PG8_STAGE
#undef PG8_LDA
#undef PG8_LDB
#undef PG8_MMA
#undef PG8_WAIT_V
#undef PG8_WAIT_L
#undef PG8_BAR
#undef PG8_SCHED
}
}

namespace pg8 {
constexpr float EPSN = 1e-6f;
__device__ __forceinline__ float fsigmoid(float x) { return __builtin_amdgcn_rcpf(1.f + __expf(-x)); }
__device__ __forceinline__ float fsilu(float x) { return x * __builtin_amdgcn_rcpf(1.f + __expf(-x)); }
__device__ __forceinline__ float row_stat32(const float* part, int row, int fq) {
    const f32x4 a = *(const f32x4*)(part + (size_t)row * 32 + 8 * fq), b = *(const f32x4*)(part + (size_t)row * 32 + 8 * fq + 4);
    float s = ((a.x + a.y) + (a.z + a.w)) + ((b.x + b.y) + (b.z + b.w));
    s += __shfl_xor(s, 16); s += __shfl_xor(s, 32); return s;
}
__device__ __forceinline__ u32x4 pack8(const f32x4 v0, const f32x4 v1) { u32x4 w; w.x = cvt_pk_bf16(v0[0], v0[1]); w.y = cvt_pk_bf16(v0[2], v0[3]); w.z = cvt_pk_bf16(v1[0], v1[1]); w.w = cvt_pk_bf16(v1[2], v1[3]); return w; }
__device__ __forceinline__ float bflo(unsigned w) { return __uint_as_float(w << 16); }
__device__ __forceinline__ float bfhi(unsigned w) { return __uint_as_float(w & 0xffff0000u); }

struct EpiIn0 {
    static constexpr bool PERM = true, AFTER_DRAIN = false;
    bf16_t* U; const float* rstd; int dry;
    __device__ __forceinline__ void operator()(const f32x4 (&acc)[2][2][4][2], const Unit& u, int wr, int wc, int fr, int fq) const {
        if (dry) return;
        const int row0 = u.pm * BM + wr * 64 + fr, col0 = u.pn * BM + wc * 32 + 8 * fq;
#pragma unroll
        for (int ai = 0; ai < 2; ++ai)
#pragma unroll
            for (int m = 0; m < 4; ++m) { const int row = row0 + ai * HALF + m * 16; const float sc = rstd[row]; bf16_t* rowp = U + ((size_t)u.pn * 8192 + row) * 256 + (wc * 32 + 8 * fq);
#pragma unroll
                for (int bj = 0; bj < 2; ++bj) *(u32x4*)(rowp + bj * HALF) = pack8(acc[ai][bj][m][0] * sc, acc[ai][bj][m][1] * sc); }
    }
};
struct EpiIn1 {
    static constexpr bool PERM = true, AFTER_DRAIN = false;
    bf16_t* U; const float* hpart; int dry;
    __device__ __forceinline__ void operator()(const f32x4 (&acc)[2][2][4][2], const Unit& u, int wr, int wc, int fr, int fq) const {
        if (dry) return;
        const int row0 = u.pm * BM + wr * 64 + fr;
        if (u.pn < 16) {
            const int col0 = u.pn * BM + wc * 32 + 8 * fq;
#pragma unroll
            for (int ai = 0; ai < 2; ++ai)
#pragma unroll
                for (int m = 0; m < 4; ++m) { const int row = row0 + ai * HALF + m * 16; const float sc = rsqrtf(row_stat32(hpart, row, fq) * (1.f / 2048.f) + EPSN); bf16_t* rowp = U + ((size_t)u.pn * 8192 + row) * 256 + (wc * 32 + 8 * fq);
#pragma unroll
                    for (int bj = 0; bj < 2; ++bj) *(u32x4*)(rowp + bj * HALF) = pack8(acc[ai][bj][m][0] * sc, acc[ai][bj][m][1] * sc); }
        } else {
            const int col0 = 4096 + 128 * (u.pn - 16) + wc * 32 + 8 * fq;
#pragma unroll
            for (int ai = 0; ai < 2; ++ai)
#pragma unroll
                for (int m = 0; m < 4; ++m) { const int row = row0 + ai * HALF + m * 16; const float sc = rsqrtf(row_stat32(hpart, row, fq) * (1.f / 2048.f) + EPSN);
                    f32x4 g0, g1;
#pragma unroll
                    for (int j = 0; j < 4; ++j) { g0[j] = fsigmoid(acc[ai][0][m][0][j] * sc) * fsilu(acc[ai][1][m][0][j] * sc); g1[j] = fsigmoid(acc[ai][0][m][1][j] * sc) * fsilu(acc[ai][1][m][1][j] * sc); }
                    *(u32x4*)(U + ((size_t)(16 + ((u.pn - 16) >> 1)) * 8192 + row) * 256 + ((u.pn - 16) & 1) * 128 + wc * 32 + 8 * fq) = pack8(g0, g1); }
        }
    }
};
template <bool BASE_F32> struct EpiOut {
    static constexpr bool PERM = true, AFTER_DRAIN = false;
    const void* base; bf16_t* h16; int dry;
    __device__ __forceinline__ void operator()(const f32x4 (&acc)[2][2][4][2], const Unit& u, int wr, int wc, int fr, int fq) const {
        if (dry) return;
        const int row0 = u.pm * BM + wr * 64 + fr, col0 = u.pn * BM + wc * 32 + 8 * fq;
#pragma unroll
        for (int ai = 0; ai < 2; ++ai)
#pragma unroll
            for (int m = 0; m < 4; ++m) { const size_t off = (size_t)(row0 + ai * HALF + m * 16) * 2048 + col0;
#pragma unroll
                for (int bj = 0; bj < 2; ++bj) { f32x4 b0, b1;
                    if (BASE_F32) { b0 = *(const f32x4*)((const float*)base + off + bj * HALF); b1 = *(const f32x4*)((const float*)base + off + bj * HALF + 4); }
                    else { const u32x4 pw = *(const u32x4*)((const bf16_t*)base + off + bj * HALF); b0 = (f32x4){bflo(pw.x), bfhi(pw.x), bflo(pw.y), bfhi(pw.y)}; b1 = (f32x4){bflo(pw.z), bfhi(pw.z), bflo(pw.w), bfhi(pw.w)}; }
                    *(u32x4*)(h16 + off + bj * HALF) = pack8(b0 + acc[ai][bj][m][0], b1 + acc[ai][bj][m][1]); }
                asm volatile("" ::: "memory"); }
    }
};
struct EpiPle {
    static constexpr bool PERM = true, AFTER_DRAIN = false;
    bf16_t* PL; float* plpart; int dry;
    __device__ __forceinline__ void operator()(const f32x4 (&acc)[2][2][4][2], const Unit& u, int wr, int wc, int fr, int fq) const {
        if (dry) return;
        const int row0 = u.pm * BM + wr * 64 + fr, col0 = u.pn * BM + wc * 32 + 8 * fq;
#pragma unroll
        for (int ai = 0; ai < 2; ++ai)
#pragma unroll
            for (int m = 0; m < 4; ++m) { const int row = row0 + ai * HALF + m * 16; float s = 0.f;
#pragma unroll
                for (int bj = 0; bj < 2; ++bj) { const f32x4 v0 = acc[ai][bj][m][0], v1 = acc[ai][bj][m][1];
                    s += ((v0[0] * v0[0] + v0[1] * v0[1]) + (v0[2] * v0[2] + v0[3] * v0[3])) + ((v1[0] * v1[0] + v1[1] * v1[1]) + (v1[2] * v1[2] + v1[3] * v1[3]));
                    *(u32x4*)(PL + (size_t)row * 2048 + col0 + bj * HALF) = pack8(v0, v1); }
                s += __shfl_xor(s, 16); s += __shfl_xor(s, 32);
                if (fq == 0) plpart[(size_t)row * 32 + u.pn * 4 + wc] = s; }
    }
};
struct EpiGate {
    static constexpr bool PERM = true, AFTER_DRAIN = false;
    const bf16_t* hin; bf16_t* h16out; float* outf; const bf16_t* PL; const float* plpart; const float* ple_norm; float* hpart; int dry;
    __device__ __forceinline__ void operator()(const f32x4 (&acc)[2][2][4][2], const Unit& u, int wr, int wc, int fr, int fq) const {
        if (dry) return;
        const int row0 = u.pm * BM + wr * 64 + fr, col0 = u.pn * BM + wc * 32 + 8 * fq;
        f32x4 pn[2][2];
#pragma unroll
        for (int bj = 0; bj < 2; ++bj) { pn[bj][0] = *(const f32x4*)(ple_norm + col0 + bj * HALF); pn[bj][1] = *(const f32x4*)(ple_norm + col0 + bj * HALF + 4); }
#pragma unroll
        for (int ai = 0; ai < 2; ++ai)
#pragma unroll
            for (int m = 0; m < 4; ++m) { const int row = row0 + ai * HALF + m * 16; const size_t off = (size_t)row * 2048 + col0;
                const float rs = rsqrtf(row_stat32(plpart, row, fq) * (1.f / 2048.f) + EPSN); float s = 0.f;
#pragma unroll
                for (int bj = 0; bj < 2; ++bj) { const u32x4 pw = *(const u32x4*)(PL + off + bj * HALF), hw = *(const u32x4*)(hin + off + bj * HALF);
                    const f32x4 p0 = (f32x4){bflo(pw.x), bfhi(pw.x), bflo(pw.y), bfhi(pw.y)} * pn[bj][0] * rs, p1 = (f32x4){bflo(pw.z), bfhi(pw.z), bflo(pw.w), bfhi(pw.w)} * pn[bj][1] * rs;
                    f32x4 h0 = (f32x4){bflo(hw.x), bfhi(hw.x), bflo(hw.y), bfhi(hw.y)}, h1 = (f32x4){bflo(hw.z), bfhi(hw.z), bflo(hw.w), bfhi(hw.w)};
#pragma unroll
                    for (int j = 0; j < 4; ++j) { h0[j] += fsigmoid(acc[ai][bj][m][0][j]) * p0[j]; h1[j] += fsigmoid(acc[ai][bj][m][1][j]) * p1[j]; }
                    if (outf) { *(f32x4*)(outf + off + bj * HALF) = h0; *(f32x4*)(outf + off + bj * HALF + 4) = h1; }
                    else *(u32x4*)(h16out + off + bj * HALF) = pack8(h0, h1);
                    s += ((h0[0] * h0[0] + h0[1] * h0[1]) + (h0[2] * h0[2] + h0[3] * h0[3])) + ((h1[0] * h1[0] + h1[1] * h1[1]) + (h1[2] * h1[2] + h1[3] * h1[3])); }
                s += __shfl_xor(s, 16); s += __shfl_xor(s, 32);
                if (fq == 0) hpart[(size_t)row * 32 + u.pn * 4 + wc] = s;
                asm volatile("" ::: "memory"); }
    }
};
struct EpiGateFinal {
    static constexpr bool PERM = true, AFTER_DRAIN = true;
    const bf16_t* hin; float* outf; const bf16_t* PL; const float* plpart; const float* ple_norm; const float* fin_norm; float* xbuf; unsigned* cnt; float peps; int dry;
    __device__ __forceinline__ void fused(f32x4 (&acc)[2][2][4][2], const Unit& u, int wr, int wc, int fr, int fq, PG8_LAS unsigned char* lds, int wid, int lane) const {
        if (dry) return;
        PG8_LAS float* P = (PG8_LAS float*)lds;
        PG8_LAS float* S = (PG8_LAS float*)(lds + 4096);
        const int row0 = u.pm * BM + wr * 64 + fr, col0 = u.pn * BM + wc * 32 + 8 * fq;
        {
            f32x4 pn[2][2];
#pragma unroll
            for (int bj = 0; bj < 2; ++bj) { pn[bj][0] = *(const f32x4*)(ple_norm + col0 + bj * HALF); pn[bj][1] = *(const f32x4*)(ple_norm + col0 + bj * HALF + 4); }
#pragma unroll
            for (int ai = 0; ai < 2; ++ai)
#pragma unroll
                for (int m = 0; m < 4; ++m) { const int row = row0 + ai * HALF + m * 16; const size_t off = (size_t)row * 2048 + col0;
                    const float rs = rsqrtf(row_stat32(plpart, row, fq) * (1.f / 2048.f) + EPSN); float s = 0.f;
#pragma unroll
                    for (int bj = 0; bj < 2; ++bj) { const u32x4 pw = *(const u32x4*)(PL + off + bj * HALF), hw = *(const u32x4*)(hin + off + bj * HALF);
                        const f32x4 p0 = (f32x4){bflo(pw.x), bfhi(pw.x), bflo(pw.y), bfhi(pw.y)} * pn[bj][0] * rs, p1 = (f32x4){bflo(pw.z), bfhi(pw.z), bflo(pw.w), bfhi(pw.w)} * pn[bj][1] * rs;
                        f32x4 h0 = (f32x4){bflo(hw.x), bfhi(hw.x), bflo(hw.y), bfhi(hw.y)}, h1 = (f32x4){bflo(hw.z), bfhi(hw.z), bflo(hw.w), bfhi(hw.w)};
#pragma unroll
                        for (int j = 0; j < 4; ++j) { h0[j] += fsigmoid(acc[ai][bj][m][0][j]) * p0[j]; h1[j] += fsigmoid(acc[ai][bj][m][1][j]) * p1[j]; }
                        acc[ai][bj][m][0] = h0; acc[ai][bj][m][1] = h1;
                        s += ((h0[0] * h0[0] + h0[1] * h0[1]) + (h0[2] * h0[2] + h0[3] * h0[3])) + ((h1[0] * h1[0] + h1[1] * h1[1]) + (h1[2] * h1[2] + h1[3] * h1[3])); }
                    s += __shfl_xor(s, 16); s += __shfl_xor(s, 32);
                    if (fq == 0) P[(ai * HALF + wr * 64 + m * 16 + fr) * 4 + wc] = s;
                    asm volatile("" ::: "memory"); }
        }
        asm volatile("s_waitcnt lgkmcnt(0)" ::: "memory"); __builtin_amdgcn_s_barrier(); asm volatile("" ::: "memory");
        const int row = wid * 32 + (lane & 31);
        if (lane < 32) { const float s4 = (P[row * 4 + 0] + P[row * 4 + 1]) + (P[row * 4 + 2] + P[row * 4 + 3]);
            __hip_atomic_store(xbuf + (size_t)(u.pm * BM + row) * 8 + u.pn, s4, __ATOMIC_RELAXED, __HIP_MEMORY_SCOPE_AGENT); }
        asm volatile("s_waitcnt vmcnt(0)" ::: "memory");
        if (lane == 0) __hip_atomic_fetch_add(cnt + 64 * u.pm, 1u, __ATOMIC_RELAXED, __HIP_MEMORY_SCOPE_AGENT);
        if (wid == 0) {
            unsigned spins = 0;
            while ((unsigned)__builtin_amdgcn_readfirstlane(__hip_atomic_load(cnt + 64 * u.pm, __ATOMIC_RELAXED, __HIP_MEMORY_SCOPE_AGENT)) < 64u) { __builtin_amdgcn_s_sleep(2); if (++spins > (1u << 24)) break; }
            __builtin_amdgcn_fence(__ATOMIC_ACQUIRE, "agent");
        }
        asm volatile("s_waitcnt vmcnt(0) lgkmcnt(0)" ::: "memory"); __builtin_amdgcn_s_barrier(); asm volatile("" ::: "memory");
        if (lane < 32) { const float* xp = xbuf + (size_t)(u.pm * BM + row) * 8; float t = 0.f;
#pragma unroll
            for (int k = 0; k < 8; ++k) t += __hip_atomic_load(xp + k, __ATOMIC_RELAXED, __HIP_MEMORY_SCOPE_AGENT);
            S[row] = rsqrtf(t * (1.f / 2048.f) + EPSN); }
        asm volatile("s_waitcnt lgkmcnt(0)" ::: "memory"); __builtin_amdgcn_s_barrier(); asm volatile("" ::: "memory");
        f32x4 fn[2][2];
#pragma unroll
        for (int bj = 0; bj < 2; ++bj) { fn[bj][0] = *(const f32x4*)(fin_norm + col0 + bj * HALF); fn[bj][1] = *(const f32x4*)(fin_norm + col0 + bj * HALF + 4); }
#pragma unroll
        for (int ai = 0; ai < 2; ++ai)
#pragma unroll
            for (int m = 0; m < 4; ++m) { const int r = ai * HALF + wr * 64 + m * 16 + fr; const float rs = S[r]; const size_t off = (size_t)(u.pm * BM + r) * 2048 + col0;
#pragma unroll
                for (int bj = 0; bj < 2; ++bj) { *(f32x4*)(outf + off + bj * HALF) = acc[ai][bj][m][0] * fn[bj][0] * rs + peps; *(f32x4*)(outf + off + bj * HALF + 4) = acc[ai][bj][m][1] * fn[bj][1] * rs + peps; } }
    }
};
}

constexpr int NWAVES = 8;
constexpr int NB = 4, S = 2048, D = 2048, M = NB * S, PLE = 256;
constexpr float EPS = 1e-6f;
typedef unsigned short bf16_t;
typedef float f32x4 __attribute__((ext_vector_type(4)));
typedef unsigned v4u __attribute__((ext_vector_type(4)));
typedef unsigned v2u __attribute__((ext_vector_type(2)));

constexpr size_t MiB = 1u << 20;
constexpr size_t OFF_CTL = 0, CTL_ZERO_BYTES = 128 * 1024;
constexpr size_t OFF_WIN0 = 1 * MiB;
constexpr size_t OFF_WOUT0 = 25 * MiB;
constexpr size_t OFF_WG0 = 33 * MiB;
constexpr size_t OFF_WIN1 = 41 * MiB;
constexpr size_t OFF_WOUT1 = 73 * MiB;
constexpr size_t OFF_WG1 = 81 * MiB;
constexpr size_t OFF_PLEW = 89 * MiB;
constexpr size_t OFF_WGATE1 = 91 * MiB;
constexpr size_t OFF_SMALL = 91 * MiB + 65536;
constexpr size_t OFF_GATES1 = 92 * MiB;
constexpr size_t OFF_PART = 92 * MiB + 524288;
constexpr size_t OFF_A = 95 * MiB;
constexpr size_t OFF_B = 127 * MiB;
constexpr size_t OFF_U = 159 * MiB;
constexpr size_t WS_END = 255 * MiB;
constexpr size_t OFF_ACUM = OFF_B;
constexpr size_t OFF_CARRY = OFF_B + 17 * MiB;
constexpr size_t OFF_DECAY = OFF_B + 18 * MiB;
constexpr size_t OFF_WRT = OFF_SMALL + 65536;
constexpr int CW_FIN = 16384;
constexpr int CW_BAR = 4096;

constexpr int RING_BYTES = 131072;
constexpr int MISC_OFF = 147456 - 256;
constexpr int LDS_BYTES = 147456;

constexpr size_t UT = (size_t)8192 * 256;
__host__ __device__ __forceinline__ size_t uidx(size_t row, int col) { return ((size_t)(col >> 8) * 8192 + row) * 256 + (col & 255); }
#define LAS __attribute__((address_space(3)))
#define GAS __attribute__((address_space(1)))
__device__ __forceinline__ float bf2f(bf16_t b) { return __uint_as_float(((unsigned)b) << 16); }
typedef __bf16 bf16v2f_t __attribute__((ext_vector_type(2)));
typedef float f32v2f_t __attribute__((ext_vector_type(2)));
__device__ __forceinline__ unsigned f2bf(float f) { const f32v2f_t v = {f, 0.f}; return __builtin_bit_cast(unsigned, __builtin_convertvector(v, bf16v2f_t)) & 0xffffu; }
__device__ __forceinline__ unsigned pk2(float lo, float hi) { const f32v2f_t v = {lo, hi}; return __builtin_bit_cast(unsigned, __builtin_convertvector(v, bf16v2f_t)); }
__device__ __forceinline__ float sigmoidf_(float x) { return __builtin_amdgcn_rcpf(1.f + __expf(-x)); }
__device__ __forceinline__ float siluf_(float x) { return x * __builtin_amdgcn_rcpf(1.f + __expf(-x)); }
__device__ __forceinline__ float one_minus_exp(float x) { return x > -0.03f ? -x * (1.f + x * (0.5f + x * (0.16666667f + x * 0.041666668f))) : 1.f - __expf(x); }
__device__ __forceinline__ float wave_sum(float v) {
#pragma unroll
    for (int o = 1; o < 64; o <<= 1) v += __shfl_xor(v, o);
    return v;
}
#define LDS_WAIT() asm volatile("s_waitcnt lgkmcnt(0)" ::: "memory")
#define WG_BAR() asm volatile("s_waitcnt lgkmcnt(0)\n\ts_barrier" ::: "memory")
#define XB_TMO      128
#define XB_XCNT(j)  (256  + 64 * (j))
#define XB_XSUB(j)  (1280 + 64 * (j))
#define XB_XGEN(j)  (2304 + 64 * (j))
#define XB_TOP      3328
#define XB_TOPGEN   3392
#define XCD_BAR_WORDS 3456
#define XB_SPIN_CAP (1u << 26)

__device__ __forceinline__ unsigned xb_ld(unsigned* p)              { return __hip_atomic_load(p, __ATOMIC_RELAXED, __HIP_MEMORY_SCOPE_AGENT); }
__device__ __forceinline__ unsigned xb_add(unsigned* p, unsigned v) { return __hip_atomic_fetch_add(p, v, __ATOMIC_RELAXED, __HIP_MEMORY_SCOPE_AGENT); }
__device__ __forceinline__ unsigned xb_xcc_id() { return (unsigned)__builtin_amdgcn_s_getreg((3 << 11) | 20) & 0xFu; }
#define XB_SPIN(cond, bar) do { unsigned _sp = 0; while (cond) { __builtin_amdgcn_s_sleep(1); \
    if ((++_sp & 255u) == 0u) { if (xb_ld(&(bar)[XB_TMO])) break; if (_sp > XB_SPIN_CAP) { atomicAdd(&(bar)[XB_TMO], 1u); break; } } } } while (0)

struct XcdBarrier {
    unsigned* bar; unsigned x;
    volatile LAS unsigned* st;
};

__device__ __forceinline__ XcdBarrier xcd_barrier_post(unsigned* bar, volatile LAS unsigned* st) {
    XcdBarrier b; b.bar = bar; b.x = xb_xcc_id(); b.st = st;
    if (threadIdx.x == 0) (void)xb_add(&bar[XB_XCNT(b.x)], 1u);
    return b;
}
__device__ __forceinline__ void xcd_barrier_complete(unsigned* bar, unsigned x, unsigned& nloc, unsigned& nx) {
    const unsigned G = gridDim.x * gridDim.y * gridDim.z;
    unsigned sum, cnt, mine, sp = 0u;
    for (;;) {
        sum = 0u; cnt = 0u; mine = 0u;
#pragma unroll
        for (unsigned j = 0; j < 16; ++j) { const unsigned c = xb_ld(&bar[XB_XCNT(j)]); sum += c; cnt += (c > 0u) ? 1u : 0u; mine = (j == x) ? c : mine; }
        if (sum == G) break;
        __builtin_amdgcn_s_sleep(1);
        if ((++sp & 255u) == 0u) { if (xb_ld(&bar[XB_TMO])) break; if (sp > XB_SPIN_CAP) { atomicAdd(&bar[XB_TMO], 1u); break; } }
    }
    nloc = mine > 0u ? mine : 1u; nx = cnt > 0u ? cnt : 1u;
}

__device__ __forceinline__ void xcd_barrier(const XcdBarrier& b) {
    asm volatile("s_waitcnt vmcnt(0)" ::: "memory");
    __syncthreads();
    if (threadIdx.x == 0) {
        unsigned* bar = b.bar;
        __builtin_amdgcn_s_waitcnt(0);
        unsigned nloc = b.st[0], nx = b.st[1];
        if (nloc == 0u) { xcd_barrier_complete(bar, b.x, nloc, nx); b.st[0] = nloc; b.st[1] = nx; }
        const unsigned old = xb_add(&bar[XB_XSUB(b.x)], 1u);
        const unsigned gen = old / nloc;
        if (old + 1u == (gen + 1u) * nloc) {
            __builtin_amdgcn_fence(__ATOMIC_RELEASE, "agent");
            asm volatile("s_waitcnt vmcnt(0)" ::: "memory");
            const unsigned og = xb_add(&bar[XB_TOP], 1u);
            const unsigned tg = og / nx;
            if (og + 1u == (tg + 1u) * nx) xb_add(&bar[XB_TOPGEN], 1u);
            else XB_SPIN(xb_ld(&bar[XB_TOPGEN]) == tg, bar);
            __builtin_amdgcn_fence(__ATOMIC_ACQUIRE, "agent");
            xb_add(&bar[XB_XGEN(b.x)], 1u);
            asm volatile("s_waitcnt vmcnt(0)" ::: "memory");
        } else {
            XB_SPIN(xb_ld(&bar[XB_XGEN(b.x)]) == gen, bar);
            __builtin_amdgcn_fence(__ATOMIC_ACQUIRE, "agent");
            asm volatile("s_waitcnt vmcnt(0)" ::: "memory");
        }
    }
    __syncthreads();
}

struct Ptrs {
    const float* in[26]; float* out; unsigned char* ws; int ph_lo, ph_hi, li, dup;
};
__device__ __forceinline__ int srccol_in1(int n) {
    if (n < 4096) return n;
    const int r = n - 4096, j = r >> 8, i = r & 255;
    return i < 128 ? 4096 + 128 * j + i : 6144 + 128 * j + (i - 128);
}
__device__ __forceinline__ void p0_transpose_item(const float* __restrict__ W, int K, int ldw, bf16_t* __restrict__ WT, const float* __restrict__ gain, bool map1, int nblk, LAS float* scr, int item, int lane) {
    const int kb = item / nblk, nb = item % nblk, k0 = 64 * kb, n0 = 32 * nb, s0 = map1 ? srccol_in1(n0) : n0;
    float wv[32];
#pragma unroll
    for (int i = 0; i < 32; ++i) wv[i] = W[(size_t)(k0 + 2 * i + (lane >> 5)) * ldw + s0 + (lane & 31)];
    if (gain) {
#pragma unroll
        for (int i = 0; i < 32; ++i) wv[i] *= gain[k0 + 2 * i + (lane >> 5)];
    }
#pragma unroll
    for (int i = 0; i < 32; ++i) scr[(2 * i + (lane >> 5)) * 33 + (lane & 31)] = wv[i];
    LDS_WAIT(); asm volatile("" ::: "memory");
    const int c = lane & 7;
#pragma unroll
    for (int j = 0; j < 4; ++j) { const int n = (lane >> 3) + 8 * j; const LAS float* s = scr + (8 * c) * 33 + n;
        v4u o; o.x = pk2(s[0 * 33], s[1 * 33]); o.y = pk2(s[2 * 33], s[3 * 33]); o.z = pk2(s[4 * 33], s[5 * 33]); o.w = pk2(s[6 * 33], s[7 * 33]);
        *(v4u*)(WT + (size_t)(n0 + n) * K + k0 + 8 * c) = o; }
    LDS_WAIT(); asm volatile("" ::: "memory");
}
struct Frame {
    LAS unsigned char* lds; int tid, lane, wave, G, bid;
    const float* const* in; float* out; unsigned char* ws;
};
__device__ __forceinline__ void p0_layer1_weights_in(const Frame& F, int gw, int NGW) {
    LAS float* scr = (LAS float*)(F.lds + F.wave * 16384);
    unsigned char* ws = F.ws;
    const float* o_norm = F.in[14]; const float* o_w_in = F.in[15];
    constexpr int I_IN1 = 32 * 256;
    for (int it = gw; it < I_IN1; it += NGW) p0_transpose_item(o_w_in, 2048, 8208, (bf16_t*)(ws + OFF_WIN1), o_norm, true, 256, scr, it, F.lane);
    const int gt = gw * 64 + F.lane, NGT = NGW * 64;
    bf16_t* WGATE1 = (bf16_t*)(ws + OFF_WGATE1);
    for (int i = gt; i < 16 * 2048; i += NGT) { const int j = i >> 11, k = i & 2047; WGATE1[i] = (bf16_t)f2bf(o_w_in[(size_t)k * 8208 + 8192 + j] * o_norm[k]); }
}
__device__ __forceinline__ void p0_layer1_weights_out(const Frame& F, int gw, int NGW) {
    LAS float* scr = (LAS float*)(F.lds + F.wave * 16384);
    unsigned char* ws = F.ws;
    const float* o_w_out = F.in[21]; const float* ple_gate_w = F.in[24];
    constexpr int I_SQ = 32 * 64;
    for (int it = gw; it < 2 * I_SQ; it += NGW) {
        if (it < I_SQ) p0_transpose_item(o_w_out, 2048, 2048, (bf16_t*)(ws + OFF_WOUT1), nullptr, false, 64, scr, it, F.lane);
        else p0_transpose_item(ple_gate_w + (size_t)2048 * 2048, 2048, 2048, (bf16_t*)(ws + OFF_WG1), nullptr, false, 64, scr, it - I_SQ, F.lane);
    }
}
__device__ __forceinline__ void p0_prologue(const Frame& F) {
    LAS float* scr = (LAS float*)(F.lds + F.wave * 16384);
    const int gw = F.bid * NWAVES + F.wave, NGW = F.G * NWAVES;
    unsigned char* ws = F.ws;
    const float* e_norm = F.in[2]; const float* e_w_in = F.in[3]; const float* e_w_out = F.in[13]; const float* ple_w = F.in[22]; const float* ple_gate_w = F.in[24];
    constexpr int I_IN0 = 32 * 192, I_SQ = 32 * 64, I_PLE = 4 * 64;
    constexpr int NITEMS = I_IN0 + 2 * I_SQ + 2 * I_PLE;
    for (int it = gw; it < NITEMS; it += NGW) {
        int r = it;
        if (r < I_IN0) { p0_transpose_item(e_w_in, 2048, 6144, (bf16_t*)(ws + OFF_WIN0), e_norm, false, 192, scr, r, F.lane); continue; } r -= I_IN0;
        if (r < I_SQ) { p0_transpose_item(e_w_out, 2048, 2048, (bf16_t*)(ws + OFF_WOUT0), nullptr, false, 64, scr, r, F.lane); continue; } r -= I_SQ;
        if (r < I_SQ) { p0_transpose_item(ple_gate_w, 2048, 2048, (bf16_t*)(ws + OFF_WG0), nullptr, false, 64, scr, r, F.lane); continue; } r -= I_SQ;
        if (r < I_PLE) { p0_transpose_item(ple_w, 256, 2048, (bf16_t*)(ws + OFF_PLEW), nullptr, false, 64, scr, r, F.lane); continue; } r -= I_PLE;
        p0_transpose_item(ple_w + (size_t)256 * 2048, 256, 2048, (bf16_t*)(ws + OFF_PLEW) + (size_t)2048 * 256, nullptr, false, 64, scr, r, F.lane);
    }
    const float* x = F.in[0]; bf16_t* A = (bf16_t*)(ws + OFF_A); float* rstd0 = (float*)(ws + OFF_SMALL) + 1024;
    for (int m = gw; m < M; m += NGW) {
        const f32x4* xr = (const f32x4*)(x + (size_t)m * D) + F.lane; f32x4 v[8]; float s = 0.f;
#pragma unroll
        for (int j = 0; j < 8; ++j) { v[j] = xr[64 * j]; s += (v[j].x * v[j].x + v[j].y * v[j].y) + (v[j].z * v[j].z + v[j].w * v[j].w); }
        s = wave_sum(s);
        v2u* o8 = (v2u*)(A + (size_t)m * D) + F.lane;
#pragma unroll
        for (int j = 0; j < 8; ++j) { v2u w; w.x = pk2(v[j].x, v[j].y); w.y = pk2(v[j].z, v[j].w); o8[64 * j] = w; }
        if (F.lane == 0) rstd0[m] = rsqrtf(s * (1.f / D) + EPS);
    }
    const int gt = F.bid * (NWAVES * 64) + F.tid, NGT = F.G * NWAVES * 64;
    bf16_t* WRT = (bf16_t*)(ws + OFF_WRT); const float* w_r = F.in[8]; const float* w_i = F.in[10];
    for (int i = gt; i < 2 * 131072; i += NGT) { const int j = i & 131071, n = j >> 14, d = (j >> 7) & 127, cc = j & 127; WRT[i] = (bf16_t)f2bf(((i >> 17) ? w_i : w_r)[n * 16384 + cc * 128 + d]); }
    float* lb = (float*)(ws + OFF_SMALL); const float* logits = F.in[4];
    for (int c = gt; c < 1024; c += NGT) lb[c] = 1.f / (1.f + expf(logits[1024 + c] - logits[c]));
}
__device__ __forceinline__ void gates1_phase(const Frame& F, const int dry) {
    const bf16_t* A = (const bf16_t*)(F.ws + OFF_A); const bf16_t* WG = (const bf16_t*)(F.ws + OFF_WGATE1);
    const float* hpart = (const float*)(F.ws + OFF_PART) + (size_t)M * 32; float* gates = (float*)(F.ws + OFF_GATES1);
    const int gw = F.bid * NWAVES + F.wave, NGW = F.G * NWAVES;
    for (int row = gw; row < M; row += NGW) {
        float ss = (F.lane < 32) ? hpart[(size_t)row * 32 + F.lane] : 0.f; ss = wave_sum(ss);
        const float sc = rsqrtf(ss * (1.f / D) + EPS);
        float a[32];
        const v4u* ar = (const v4u*)(A + (size_t)row * D) + F.lane;
#pragma unroll
        for (int j = 0; j < 4; ++j) { const v4u w = ar[64 * j]; a[8 * j + 0] = pg8::bflo(w.x); a[8 * j + 1] = pg8::bfhi(w.x); a[8 * j + 2] = pg8::bflo(w.y); a[8 * j + 3] = pg8::bfhi(w.y);
            a[8 * j + 4] = pg8::bflo(w.z); a[8 * j + 5] = pg8::bfhi(w.z); a[8 * j + 6] = pg8::bflo(w.w); a[8 * j + 7] = pg8::bfhi(w.w); }
        float res = 0.f;
        for (int g = 0; g < 16; ++g) {
            const v4u* wr = (const v4u*)(WG + (size_t)g * D) + F.lane; float s = 0.f;
#pragma unroll
            for (int j = 0; j < 4; ++j) { const v4u w = wr[64 * j];
                s += a[8 * j + 0] * pg8::bflo(w.x) + a[8 * j + 1] * pg8::bfhi(w.x) + a[8 * j + 2] * pg8::bflo(w.y) + a[8 * j + 3] * pg8::bfhi(w.y)
                   + a[8 * j + 4] * pg8::bflo(w.z) + a[8 * j + 5] * pg8::bfhi(w.z) + a[8 * j + 6] * pg8::bflo(w.w) + a[8 * j + 7] * pg8::bfhi(w.w); }
            s = wave_sum(s);
            res = (F.lane == g) ? s * sc : res;
        }
        if (F.lane < 16 && !dry) gates[(size_t)row * 16 + F.lane] = res;
    }
}
__device__ __forceinline__ void final_norm_phase(const Frame& F, const int dry) {
    const float* hpart = (const float*)(F.ws + OFF_PART) + (size_t)M * 32; const float* g = F.in[25];
    const int gw = F.bid * NWAVES + F.wave, NGW = F.G * NWAVES;
    f32x4 gv[8];
#pragma unroll
    for (int j = 0; j < 8; ++j) gv[j] = ((const f32x4*)g)[F.lane + 64 * j];
    for (int row = gw; row < M; row += NGW) {
        float ss = (F.lane < 32) ? hpart[(size_t)row * 32 + F.lane] : 0.f; ss = wave_sum(ss);
        const float rs = rsqrtf(ss * (1.f / D) + EPS);
        f32x4* xr = (f32x4*)(F.out + (size_t)row * D) + F.lane;
#pragma unroll
        for (int j = 0; j < 8; ++j) { f32x4 v = xr[64 * j]; v = v * gv[j] * rs; if (!dry) xr[64 * j] = v; }
    }
}

__device__ __forceinline__ void cvt_p_phase(const Frame& F, const int dry) {
    const float* p = F.in[1]; bf16_t* P16 = (bf16_t*)(F.ws + OFF_WIN0);
    const size_t n4 = (size_t)2 * M * PLE / 4, gt = (size_t)F.bid * (NWAVES * 64) + F.tid, NGT = (size_t)F.G * NWAVES * 64;
    for (size_t i = gt; i < n4; i += NGT) { const f32x4 v = ((const f32x4*)p)[i]; v2u w; w.x = pk2(v.x, v.y); w.y = pk2(v.z, v.w); if (!dry) ((v2u*)P16)[i] = w; }
}

typedef short bf16x8_t __attribute__((ext_vector_type(8)));
typedef float f32x16 __attribute__((ext_vector_type(16)));
typedef float f32x4_t __attribute__((ext_vector_type(4)));
typedef short bf16x4_t __attribute__((ext_vector_type(4)));
__device__ __forceinline__ bf16x8_t pack_bf16x8(float a0, float a1, float a2, float a3, float a4, float a5, float a6, float a7) {
    v4u w; w.x = pg8::cvt_pk_bf16(a0, a1); w.y = pg8::cvt_pk_bf16(a2, a3); w.z = pg8::cvt_pk_bf16(a4, a5); w.w = pg8::cvt_pk_bf16(a6, a7);
    return __builtin_bit_cast(bf16x8_t, w);
}
__device__ __forceinline__ bf16x8_t cat_bf16x4(v2u lo, v2u hi) { v4u w; w.x = lo.x; w.y = lo.y; w.z = hi.x; w.w = hi.y; return __builtin_bit_cast(bf16x8_t, w); }


struct LruRaw { unsigned short xv[19]; float cw[4], cb, brv, biv, lamv; };
__device__ __forceinline__ void rglru_a_load(const Frame& F, int b, int c, int n, LruRaw& r) {
    const int d = F.tid & 127, q = F.tid >> 7, ch = n * 128 + d, t0 = c * 64;
    const bf16_t* U = (const bf16_t*)(F.ws + OFF_U);
#pragma unroll
    for (int i = 0; i < 19; ++i) { const int t = t0 + 16 * q - 3 + i; r.xv[i] = (t >= 0) ? U[uidx((size_t)b * S + t, 4096 + ch)] : (unsigned short)0; }
    const float* conv_w = F.in[6];
#pragma unroll
    for (int k = 0; k < 4; ++k) r.cw[k] = conv_w[k * 1024 + ch];
    r.cb = F.in[7][ch];
    const int chc = n * 128 + 32 * (F.wave & 3) + (F.lane & 31);
    r.brv = F.in[9][chc]; r.biv = F.in[11][chc]; r.lamv = F.in[12][chc];
}
__device__ __forceinline__ void rglru_a_item(const Frame& F, const int dry, int b, int c, int n, const LruRaw& raw) {
    constexpr int XS = 136;
    LAS bf16_t* XT = (LAS bf16_t*)F.lds;
    LAS float* AL = (LAS float*)(F.lds + 17408);
    LAS float* ML = AL + 8192;
    LAS float* AGG = ML + 8192;
    LAS bf16_t* HT = (LAS bf16_t*)(AGG + 1024);
    LAS bf16_t* CT = HT + 64 * 136;
    const bf16_t* U = (const bf16_t*)(F.ws + OFF_U); bf16_t* HL = (bf16_t*)(F.ws + OFF_A); bf16_t* AC = (bf16_t*)(F.ws + OFF_ACUM); float* carry = (float*)(F.ws + OFF_CARRY);
    const bf16_t* WRT = (const bf16_t*)(F.ws + OFF_WRT) + (size_t)n * 16384; const bf16_t* WIT = WRT + 8 * 16384;
    const float* conv_w = F.in[6]; const float* conv_b = F.in[7]; const float* b_r = F.in[9]; const float* b_i = F.in[11]; const float* lam = F.in[12];
    const int tid = F.tid, d = tid & 127, q = tid >> 7, ch = n * 128 + d, t0 = c * 64;
    const size_t row0 = (size_t)b * S + t0;
    float xc[16];
    {
        float xv[19];
#pragma unroll
        for (int i = 0; i < 19; ++i) xv[i] = bf2f(raw.xv[i]);
        const float cw0 = raw.cw[0], cw1 = raw.cw[1], cw2 = raw.cw[2], cw3 = raw.cw[3], cb = raw.cb;
#pragma unroll
        for (int i = 0; i < 16; ++i) { xc[i] = cb + cw0 * xv[i] + cw1 * xv[i + 1] + cw2 * xv[i + 2] + cw3 * xv[i + 3]; XT[(16 * q + i) * XS + d] = (bf16_t)f2bf(xc[i]); }
    }
    WG_BAR();
    {
        const int w = F.wave, tt = w >> 2, db = w & 3, l31 = F.lane & 31, hh = F.lane >> 5;
        f32x16 accR, accI;
#pragma unroll
        for (int r = 0; r < 16; ++r) { accR[r] = 0.f; accI[r] = 0.f; }
        const LAS bf16_t* ap = XT + (32 * tt + l31) * XS + 8 * hh;
        const bf16_t* rp = WRT + (size_t)(32 * db + l31) * 128 + 8 * hh; const bf16_t* ip = WIT + (size_t)(32 * db + l31) * 128 + 8 * hh;
#pragma unroll
        for (int ks = 0; ks < 8; ++ks) {
            const bf16x8_t a = *(const LAS bf16x8_t*)(ap + 16 * ks), br_ = *(const bf16x8_t*)(rp + 16 * ks), bi_ = *(const bf16x8_t*)(ip + 16 * ks);
            accR = __builtin_amdgcn_mfma_f32_32x32x16_bf16(a, br_, accR, 0, 0, 0);
            accI = __builtin_amdgcn_mfma_f32_32x32x16_bf16(a, bi_, accI, 0, 0, 0);
        }
        const int dc = 32 * db + l31, chc = n * 128 + dc;
        const float brv = raw.brv, biv = raw.biv, ey_ = __expf(-raw.lamv), sp = ey_ > 0.02f ? __logf(1.f + ey_) : ey_ * (1.f - ey_ * (0.5f - ey_ * 0.33333334f));
#pragma unroll
        for (int r = 0; r < 16; ++r) {
            const int t = 32 * tt + (r & 3) + 8 * (r >> 2) + 4 * hh;
            const float rr = sigmoidf_(accR[r] + brv), ii = sigmoidf_(accI[r] + biv), la = -8.f * rr * sp;
            AL[t * 128 + dc] = __expf(la); ML[t * 128 + dc] = __builtin_amdgcn_sqrtf(one_minus_exp(2.f * la)) * ii;
        }
    }
    WG_BAR();
    float hl[16], ac[16];
    {
        float h = 0.f, Ac = 1.f;
#pragma unroll
        for (int i = 0; i < 16; ++i) { const int t = 16 * q + i; const float a = AL[t * 128 + d], u = ML[t * 128 + d] * xc[i]; h = a * h + u; Ac *= a; hl[i] = h; ac[i] = Ac; }
        AGG[(q * 2 + 0) * 128 + d] = Ac; AGG[(q * 2 + 1) * 128 + d] = h;
    }
    WG_BAR();
    {
        float Hp = 0.f, Ap = 1.f;
#pragma unroll
        for (int qq = 0; qq < 3; ++qq) if (qq < q) { const float a = AGG[(qq * 2 + 0) * 128 + d], hh_ = AGG[(qq * 2 + 1) * 128 + d]; Hp = a * Hp + hh_; Ap *= a; }
#pragma unroll
        for (int i = 0; i < 16; ++i) { const size_t row = row0 + 16 * q + i; const float hv = hl[i] + ac[i] * Hp, av = ac[i] * Ap;
            HT[(16 * q + i) * 136 + d] = (bf16_t)f2bf(hv); CT[(16 * q + i) * 136 + d] = (bf16_t)f2bf(av);
            if (q == 3 && i == 15 && !dry) { float* cp = carry + ((size_t)((b * 32 + c) * 8 + n)) * 256; cp[d] = av; cp[128 + d] = hv; } }
    }
    WG_BAR();
#pragma unroll
    for (int j = 0; j < 2; ++j) { const int p = tid + 512 * j, t_ = p >> 4, c16 = p & 15; const bf16x8_t h_ = *(const LAS bf16x8_t*)(HT + t_ * 136 + c16 * 8), a_ = *(const LAS bf16x8_t*)(CT + t_ * 136 + c16 * 8);
        if (!dry) { *(bf16x8_t*)(HL + (row0 + t_) * D + 1024 + n * 128 + c16 * 8) = h_; *(bf16x8_t*)(AC + (row0 + t_) * 1024 + n * 128 + c16 * 8) = a_; } }
    WG_BAR();
}
__device__ __forceinline__ void rglru_b_item(const Frame& F, const int dry, int b, int c, int n) {
    LAS float* HC = (LAS float*)F.lds;
    const bf16_t* U = (const bf16_t*)(F.ws + OFF_U); bf16_t* Y = (bf16_t*)(F.ws + OFF_A); const bf16_t* AC = (const bf16_t*)(F.ws + OFF_ACUM); const float* carry = (const float*)(F.ws + OFF_CARRY);
    const int tid = F.tid;
    const size_t row0 = (size_t)b * S + c * 64;
    bf16x8_t hl[2], av[2], zb[2];
#pragma unroll
    for (int j = 0; j < 2; ++j) { const int p = tid + 512 * j, t_ = p >> 4, c16 = p & 15; const size_t row = row0 + t_;
        hl[j] = *(const bf16x8_t*)(Y + row * D + 1024 + n * 128 + c16 * 8); av[j] = *(const bf16x8_t*)(AC + row * 1024 + n * 128 + c16 * 8); zb[j] = *(const bf16x8_t*)(U + uidx(row, 5120 + n * 128 + c16 * 8)); }
    if (tid < 128) { float H = 0.f;
        for (int cc = 0; cc < c; ++cc) { const float* cp = carry + ((size_t)((b * 32 + cc) * 8 + n)) * 256; H = cp[tid] * H + cp[128 + tid]; }
        HC[tid] = H; }
    WG_BAR();
#pragma unroll
    for (int j = 0; j < 2; ++j) { const int p = tid + 512 * j, t_ = p >> 4, c16 = p & 15; const size_t row = row0 + t_;
        const v4u hw = __builtin_bit_cast(v4u, hl[j]), aw = __builtin_bit_cast(v4u, av[j]), zw = __builtin_bit_cast(v4u, zb[j]);
        const f32x4_t H0 = *(const LAS f32x4_t*)(HC + c16 * 8), H1 = *(const LAS f32x4_t*)(HC + c16 * 8 + 4);
        const bf16x8_t y_ = pack_bf16x8((pg8::bflo(hw.x) + pg8::bflo(aw.x) * H0[0]) * siluf_(pg8::bflo(zw.x)), (pg8::bfhi(hw.x) + pg8::bfhi(aw.x) * H0[1]) * siluf_(pg8::bfhi(zw.x)),
                                        (pg8::bflo(hw.y) + pg8::bflo(aw.y) * H0[2]) * siluf_(pg8::bflo(zw.y)), (pg8::bfhi(hw.y) + pg8::bfhi(aw.y) * H0[3]) * siluf_(pg8::bfhi(zw.y)),
                                        (pg8::bflo(hw.z) + pg8::bflo(aw.z) * H1[0]) * siluf_(pg8::bflo(zw.z)), (pg8::bfhi(hw.z) + pg8::bfhi(aw.z) * H1[1]) * siluf_(pg8::bfhi(zw.z)),
                                        (pg8::bflo(hw.w) + pg8::bflo(aw.w) * H1[2]) * siluf_(pg8::bflo(zw.w)), (pg8::bfhi(hw.w) + pg8::bfhi(aw.w) * H1[3]) * siluf_(pg8::bfhi(zw.w)));
        if (!dry) *(bf16x8_t*)(Y + row * D + 1024 + n * 128 + c16 * 8) = y_; }
    WG_BAR();
}

struct H2Raw { unsigned short qa[16], fa[16], vv[16]; float lbv; };
__device__ __forceinline__ void hgrn2_a_load(const Frame& F, int b, int c, int h, H2Raw& r) {
    const int d = F.tid & 127, q = F.tid >> 7;
    const bf16_t* up = (const bf16_t*)(F.ws + OFF_U) + uidx((size_t)b * S + c * 64 + 16 * q, h * 128 + d);
#pragma unroll
    for (int i = 0; i < 16; ++i) { r.qa[i] = up[(size_t)i * 256]; r.fa[i] = up[(size_t)i * 256 + 4 * UT]; r.vv[i] = up[(size_t)i * 256 + 8 * UT]; }
    r.lbv = ((const float*)(F.ws + OFF_SMALL))[h * 128 + d];
}
__device__ __forceinline__ void hgrn2_a_item(const Frame& F, const int dry, int b, int c, int h, const H2Raw& raw) {
    constexpr int QS = 136, VS = 72;
    LAS bf16_t* QT = (LAS bf16_t*)F.lds;
    LAS bf16_t* KT = QT + 64 * QS;
    LAS bf16_t* VT = KT + 64 * QS;
    LAS bf16_t* AT = VT + 128 * VS;
    LAS float* CS = (LAS float*)(AT + 64 * VS);
    LAS bf16_t* KDT = (LAS bf16_t*)(CS + 512);
    LAS bf16_t* OTL = KDT + 128 * VS;
    bf16_t* U = (bf16_t*)(F.ws + OFF_U); bf16_t* OI = (bf16_t*)(F.ws + OFF_A); float* decay = (float*)(F.ws + OFF_DECAY);
    const float* lb = (const float*)(F.ws + OFF_SMALL);
    const int tid = F.tid, d = tid & 127, q = tid >> 7, t0 = c * 64;
    const size_t row0 = (size_t)b * S + t0;
    {
        const float lbv = raw.lbv;
        float qa[16], fa[16], vv[16];
#pragma unroll
        for (int i = 0; i < 16; ++i) { qa[i] = bf2f(raw.qa[i]); fa[i] = bf2f(raw.fa[i]); vv[i] = bf2f(raw.vv[i]); }
        float cs[16]; float run = 0.f;
#pragma unroll
        for (int i = 0; i < 16; ++i) { const float e_ = __expf(-fa[i]), sg = __builtin_amdgcn_rcpf(1.f + e_); run += __logf(lbv + (1.f - lbv) * sg); cs[i] = run; fa[i] = (1.f - lbv) * e_ * sg; }
        CS[q * 128 + d] = run;
        WG_BAR();
        float off = 0.f, tot = 0.f;
#pragma unroll
        for (int qq = 0; qq < 4; ++qq) { const float v_ = CS[qq * 128 + d]; off += (qq < q) ? v_ : 0.f; tot += v_; }
        float kd[16];
        const float etot = __expf(tot);
#pragma unroll
        for (int i = 0; i < 16; ++i) { const float bt = off + cs[i], k = fa[i], eb_ = __expf(bt), ei_ = __builtin_amdgcn_rcpf(eb_), kei = k * ei_;
            QT[(16 * q + i) * QS + d] = (bf16_t)f2bf(siluf_(qa[i]) * eb_); KT[(16 * q + i) * QS + d] = (bf16_t)f2bf(kei); kd[i] = kei * etot; }
        const bf16x8_t k0 = pack_bf16x8(kd[0], kd[1], kd[2], kd[3], kd[4], kd[5], kd[6], kd[7]), k1 = pack_bf16x8(kd[8], kd[9], kd[10], kd[11], kd[12], kd[13], kd[14], kd[15]);
        const bf16x8_t v0 = pack_bf16x8(vv[0], vv[1], vv[2], vv[3], vv[4], vv[5], vv[6], vv[7]), v1 = pack_bf16x8(vv[8], vv[9], vv[10], vv[11], vv[12], vv[13], vv[14], vv[15]);
        *(LAS bf16x8_t*)(VT + d * VS + 16 * q) = v0; *(LAS bf16x8_t*)(VT + d * VS + 16 * q + 8) = v1;
        *(LAS bf16x8_t*)(KDT + d * VS + 16 * q) = k0; *(LAS bf16x8_t*)(KDT + d * VS + 16 * q + 8) = k1;
        WG_BAR();
#pragma unroll
        for (int j = 0; j < 2; ++j) { const int p = tid + 512 * j, dd = p >> 3, c8 = p & 7; bf16_t* tp = U + uidx(row0 + (dd >> 1), h * 128 + (dd & 1) * 64 + c8 * 8);
            const bf16x8_t k_ = *(const LAS bf16x8_t*)(KDT + dd * VS + c8 * 8), v_ = *(const LAS bf16x8_t*)(VT + dd * VS + c8 * 8);
            if (!dry) { *(bf16x8_t*)(tp + 4 * UT) = k_; *(bf16x8_t*)(tp + 8 * UT) = v_; } }
        if (q == 0 && !dry) decay[((size_t)((b * 32 + c) * 8 + h)) * 128 + d] = __expf(tot);
    }
    {
        const int w = F.wave, tb = w >> 1, r = F.lane & 15, g = F.lane >> 4;
#pragma unroll
        for (int k2 = 0; k2 < 2; ++k2) {
            const int sb = 2 * (w & 1) + k2;
            f32x4_t acc = {0.f, 0.f, 0.f, 0.f};
            if (sb <= tb) {
#pragma unroll
                for (int ks = 0; ks < 4; ++ks) {
                    const bf16x8_t a = *(const LAS bf16x8_t*)(QT + (16 * tb + r) * QS + 32 * ks + 8 * g), bb = *(const LAS bf16x8_t*)(KT + (16 * sb + r) * QS + 32 * ks + 8 * g);
                    acc = __builtin_amdgcn_mfma_f32_16x16x32_bf16(a, bb, acc, 0, 0, 0);
                }
            }
#pragma unroll
            for (int j = 0; j < 4; ++j) { const int t = 16 * tb + 4 * g + j, s = 16 * sb + r; AT[t * VS + s] = (bf16_t)f2bf(s <= t ? acc[j] : 0.f); }
        }
    }
    WG_BAR();
    {
        const int w = F.wave, th = w >> 2, eb = w & 3, l31 = F.lane & 31, hh = F.lane >> 5;
        f32x16 acc;
#pragma unroll
        for (int r = 0; r < 16; ++r) acc[r] = 0.f;
#pragma unroll
        for (int ks = 0; ks < 4; ++ks) {
            const bf16x8_t a = *(const LAS bf16x8_t*)(AT + (32 * th + l31) * VS + 16 * ks + 8 * hh), bb = *(const LAS bf16x8_t*)(VT + (32 * eb + l31) * VS + 16 * ks + 8 * hh);
            acc = __builtin_amdgcn_mfma_f32_32x32x16_bf16(a, bb, acc, 0, 0, 0);
        }
#pragma unroll
        for (int r = 0; r < 16; ++r) { const int t = 32 * th + (r & 3) + 8 * (r >> 2) + 4 * hh; OTL[t * 136 + 32 * eb + l31] = (bf16_t)f2bf(acc[r]); }
#pragma unroll
        for (int j = 0; j < 2; ++j) { const int p = tid + 512 * j, row = p >> 4, c16 = p & 15; const bf16x8_t qv_ = *(const LAS bf16x8_t*)(QT + row * QS + c16 * 8); if (!dry) *(bf16x8_t*)(U + uidx(row0 + row, h * 128 + c16 * 8)) = qv_; }
    }
    WG_BAR();
#pragma unroll
    for (int j = 0; j < 2; ++j) { const int p = tid + 512 * j, t_ = p >> 4, c16 = p & 15; const bf16x8_t o_ = *(const LAS bf16x8_t*)(OTL + t_ * 136 + c16 * 8);
        if (!dry) *(bf16x8_t*)(OI + (row0 + t_) * D + h * 128 + c16 * 8) = o_; }
    WG_BAR();
}

__device__ __forceinline__ void hgrn2_b_phase(const Frame& F, const int dry, int b, int h) {
    constexpr int QS = 132, VS = 72;
    LAS bf16_t* QB = (LAS bf16_t*)F.lds;
    LAS bf16_t* KB = QB + 64 * QS;
    LAS bf16_t* VB = KB + 128 * VS;
    LAS float* DEC = (LAS float*)(VB + 128 * VS);
    LAS float* OT = DEC + 128;
    bf16_t* U = (bf16_t*)(F.ws + OFF_U); const float* decay = (const float*)(F.ws + OFF_DECAY);
    const int tid = F.tid, w = F.wave, eb = w & 3, dh = w >> 2, l31 = F.lane & 31, hh = F.lane >> 5;
    f32x16 X[2];
#pragma unroll
    for (int xi = 0; xi < 2; ++xi)
#pragma unroll
        for (int r = 0; r < 16; ++r) X[xi][r] = 0.f;
    bf16x8_t pq[2], pk[2], pv[2]; float pdec = 0.f;
    {
        const size_t row0 = (size_t)b * S;
#pragma unroll
        for (int j = 0; j < 2; ++j) { const int p = tid + 512 * j; const bf16_t* up = U + uidx(row0 + (p >> 4), h * 128 + (p & 15) * 8);
            pq[j] = *(const bf16x8_t*)up; pk[j] = *(const bf16x8_t*)(up + 4 * UT); pv[j] = *(const bf16x8_t*)(up + 8 * UT); }
        if (tid < 128) pdec = decay[((size_t)((b * 32 + 0) * 8 + h)) * 128 + tid];
    }
    for (int c = 0; c < 32; ++c) {
        const size_t row0 = (size_t)b * S + c * 64;
#pragma unroll
        for (int j = 0; j < 2; ++j) { const int p = tid + 512 * j, ur = p >> 4, c16 = p & 15;
            { const v4u w4 = __builtin_bit_cast(v4u, pq[j]); v2u lo, hi; lo.x = w4.x; lo.y = w4.y; hi.x = w4.z; hi.y = w4.w; *(LAS v2u*)(QB + ur * QS + c16 * 8) = lo; *(LAS v2u*)(QB + ur * QS + c16 * 8 + 4) = hi; }
            *(LAS bf16x8_t*)(KB + (2 * ur + (c16 >> 3)) * VS + (c16 & 7) * 8) = pk[j];
            *(LAS bf16x8_t*)(VB + (2 * ur + (c16 >> 3)) * VS + (c16 & 7) * 8) = pv[j]; }
        if (tid < 128) DEC[tid] = pdec;
        WG_BAR();
        if (c + 1 < 32) {
            const size_t rn = row0 + 64;
#pragma unroll
            for (int j = 0; j < 2; ++j) { const int p = tid + 512 * j; const bf16_t* up = U + uidx(rn + (p >> 4), h * 128 + (p & 15) * 8);
                pq[j] = *(const bf16x8_t*)up; pk[j] = *(const bf16x8_t*)(up + 4 * UT); pv[j] = *(const bf16x8_t*)(up + 8 * UT); }
            if (tid < 128) pdec = decay[((size_t)((b * 32 + c + 1) * 8 + h)) * 128 + tid];
        }
        f32x16 accT[2];
#pragma unroll
        for (int tt = 0; tt < 2; ++tt)
#pragma unroll
            for (int r = 0; r < 16; ++r) accT[tt][r] = 0.f;
#pragma unroll
        for (int xi = 0; xi < 2; ++xi)
#pragma unroll
            for (int s = 0; s < 2; ++s) {
                const bf16x8_t a = pack_bf16x8(X[xi][8 * s + 0], X[xi][8 * s + 1], X[xi][8 * s + 2], X[xi][8 * s + 3], X[xi][8 * s + 4], X[xi][8 * s + 5], X[xi][8 * s + 6], X[xi][8 * s + 7]);
#pragma unroll
                for (int tt = 0; tt < 2; ++tt) {
                    const LAS bf16_t* qp = QB + (32 * tt + l31) * QS + 64 * dh + 32 * xi + 16 * s + 4 * hh;
                    const bf16x8_t bq = cat_bf16x4(*(const LAS v2u*)qp, *(const LAS v2u*)(qp + 8));
                    accT[tt] = __builtin_amdgcn_mfma_f32_32x32x16_bf16(a, bq, accT[tt], 0, 0, 0);
                }
            }
#pragma unroll
        for (int xi = 0; xi < 2; ++xi) {
#pragma unroll
            for (int g4 = 0; g4 < 4; ++g4) { const f32x4_t dv = *(const LAS f32x4_t*)(DEC + 64 * dh + 32 * xi + 8 * g4 + 4 * hh);
                X[xi][4 * g4 + 0] *= dv[0]; X[xi][4 * g4 + 1] *= dv[1]; X[xi][4 * g4 + 2] *= dv[2]; X[xi][4 * g4 + 3] *= dv[3]; }
#pragma unroll
            for (int ks = 0; ks < 4; ++ks) {
                const bf16x8_t a = *(const LAS bf16x8_t*)(KB + (64 * dh + 32 * xi + l31) * VS + 16 * ks + 8 * hh), bv = *(const LAS bf16x8_t*)(VB + (32 * eb + l31) * VS + 16 * ks + 8 * hh);
                X[xi] = __builtin_amdgcn_mfma_f32_32x32x16_bf16(a, bv, X[xi], 0, 0, 0);
            }
        }
#pragma unroll
        for (int tt = 0; tt < 2; ++tt)
#pragma unroll
            for (int g4 = 0; g4 < 4; ++g4) { const f32x4_t ov = {accT[tt][4 * g4 + 0], accT[tt][4 * g4 + 1], accT[tt][4 * g4 + 2], accT[tt][4 * g4 + 3]};
                *(LAS f32x4_t*)(OT + (dh * 64 + 32 * tt + l31) * 132 + 32 * eb + 8 * g4 + 4 * hh) = ov; }
        WG_BAR();
#pragma unroll
        for (int j = 0; j < 2; ++j) { const int p = tid + 512 * j, t_ = p >> 4, c16 = p & 15; const LAS float* o0 = OT + t_ * 132 + c16 * 8; const LAS float* o1 = o0 + 64 * 132;
            const f32x4_t a0 = *(const LAS f32x4_t*)o0 + *(const LAS f32x4_t*)o1, a1 = *(const LAS f32x4_t*)(o0 + 4) + *(const LAS f32x4_t*)(o1 + 4);
            const bf16x8_t o_ = pack_bf16x8(a0[0], a0[1], a0[2], a0[3], a1[0], a1[1], a1[2], a1[3]);
            if (!dry) *(bf16x8_t*)(U + uidx(row0 + t_, h * 128 + c16 * 8)) = o_; }
    }
}

__device__ __forceinline__ void hgrn2_c_item(const Frame& F, const int dry, int b, int c, int h) {
    const bf16_t* U = (const bf16_t*)(F.ws + OFF_U); bf16_t* Y = (bf16_t*)(F.ws + OFF_A); const float* a_norm = F.in[5];
    const int w = F.wave, l31 = F.lane & 31, hh = F.lane >> 5;
    const size_t row0 = (size_t)b * S + c * 64;
    const f32x4_t an = *(const f32x4_t*)(a_norm + h * 128 + 4 * l31);
    v2u oi[4], p0[4], zz[4];
#pragma unroll
    for (int i = 0; i < 4; ++i) { const size_t row = row0 + 8 * w + 2 * i + hh;
        oi[i] = *(const v2u*)(Y + row * D + h * 128 + 4 * l31); p0[i] = *(const v2u*)(U + uidx(row, h * 128 + 4 * l31));
        zz[i] = *(const v2u*)(U + uidx(row, 3072 + h * 128 + 4 * l31)); }
#pragma unroll
    for (int i = 0; i < 4; ++i) { const size_t row = row0 + 8 * w + 2 * i + hh;
        const float o0 = pg8::bflo(oi[i].x) + pg8::bflo(p0[i].x), o1 = pg8::bfhi(oi[i].x) + pg8::bfhi(p0[i].x);
        const float o2 = pg8::bflo(oi[i].y) + pg8::bflo(p0[i].y), o3 = pg8::bfhi(oi[i].y) + pg8::bfhi(p0[i].y);
        float ss = (o0 * o0 + o1 * o1) + (o2 * o2 + o3 * o3);
        ss += __shfl_xor(ss, 1); ss += __shfl_xor(ss, 2); ss += __shfl_xor(ss, 4); ss += __shfl_xor(ss, 8); ss += __shfl_xor(ss, 16);
        const float rs = rsqrtf(ss * (1.f / 128.f) + EPS);
        v2u yw; yw.x = pg8::cvt_pk_bf16(o0 * rs * an[0] * siluf_(pg8::bflo(zz[i].x)), o1 * rs * an[1] * siluf_(pg8::bfhi(zz[i].x)));
        yw.y = pg8::cvt_pk_bf16(o2 * rs * an[2] * siluf_(pg8::bflo(zz[i].y)), o3 * rs * an[3] * siluf_(pg8::bfhi(zz[i].y)));
        if (!dry) *(v2u*)(Y + row * D + h * 128 + 4 * l31) = yw; }
}

constexpr size_t OFF_MS = OFF_PART;
constexpr size_t OFF_ITEM1 = OFF_PART + 1 * MiB;

struct MlRaw { unsigned short xq[19], xk[19], vv[32]; float gi, gf, cwq[4], cbq, cwk[4], cbk; };
__device__ __forceinline__ void mlstm_a_load(const Frame& F, int b, int c, int h, MlRaw& r) {
    const bf16_t* U = (const bf16_t*)(F.ws + OFF_U);
    const int tid = F.tid, d = tid & 127, qq = tid >> 7, t0 = c * 64;
#pragma unroll
    for (int i = 0; i < 19; ++i) { const int t = t0 + 16 * qq - 3 + i; const bool ok = t >= 0; const bf16_t* up = U + uidx((size_t)b * S + (ok ? t : 0), h * 128 + d);
        r.xq[i] = ok ? up[0] : (unsigned short)0; r.xk[i] = ok ? up[4 * UT] : (unsigned short)0; }
    const int e = tid & 255, hf = tid >> 8;
    const bf16_t* vp = U + uidx((size_t)b * S + t0 + 32 * hf, 2048 + h * 256 + e);
#pragma unroll
    for (int i = 0; i < 32; ++i) r.vv[i] = vp[(size_t)i * 256];
    const float* gates = (const float*)(F.ws + OFF_GATES1); const size_t grow = (size_t)b * S + t0 + F.lane;
    r.gi = gates[grow * 16 + h]; r.gf = gates[grow * 16 + 8 + h];
    const float* cw = F.in[16]; const float* cb = F.in[17]; const int cq = h * 128 + d, ck = 1024 + h * 128 + d;
#pragma unroll
    for (int k = 0; k < 4; ++k) { r.cwq[k] = cw[k * 2048 + cq]; r.cwk[k] = cw[k * 2048 + ck]; }
    r.cbq = cb[cq]; r.cbk = cb[ck];
}
__device__ __forceinline__ void mlstm_a_item(const Frame& F, const int dry, int b, int c, int h, const MlRaw& raw) {
    constexpr int QS = 136, VS = 72;
    LAS bf16_t* QT = (LAS bf16_t*)F.lds;
    LAS bf16_t* KT = QT + 64 * QS;
    LAS bf16_t* VT = KT + 64 * QS;
    LAS bf16_t* AT = VT + 256 * VS;
    LAS float* BCS = (LAS float*)(AT + 64 * VS);
    LAS float* A2 = BCS + 64; LAS float* PM = A2 + 64; LAS float* KWS = PM + 64;
    LAS float* NL = KWS + 64;
    LAS float* DL = NL + 512;
    LAS bf16_t* KWT = (LAS bf16_t*)(DL + 256);
    LAS bf16_t* NT = KWT + 128 * VS;
    bf16_t* U = (bf16_t*)(F.ws + OFF_U); bf16_t* QA = (bf16_t*)F.out;     bf16_t* NUM = (bf16_t*)(F.ws + OFF_B);
    const float* gates = (const float*)(F.ws + OFF_GATES1); float* MS = (float*)(F.ws + OFF_MS); float* ITEM = (float*)(F.ws + OFF_ITEM1) + (size_t)((b * 32 + c) * 8 + h) * 256;
    const float* cw = F.in[16]; const float* cb = F.in[17];
    const int tid = F.tid, w = F.wave, lane = F.lane, d = tid & 127, qq = tid >> 7, t0 = c * 64;
    const size_t row0 = (size_t)b * S + t0;
    if (w == 0) {
        const size_t row = row0 + lane;
        const float li = raw.gi + F.in[18][h], xf = raw.gf + F.in[19][h];
        const float lf = fminf(xf, 0.f) - __logf(1.f + __expf(-fabsf(xf)));
        float bc = lf;
#pragma unroll
        for (int o = 1; o < 64; o <<= 1) { const float v_ = __shfl_up(bc, o); bc += (lane >= o) ? v_ : 0.f; }
        const float a2 = li - bc; float pm = a2;
#pragma unroll
        for (int o = 1; o < 64; o <<= 1) { const float v_ = __shfl_up(pm, o); pm = (lane >= o) ? fmaxf(pm, v_) : pm; }
        const float pml = __shfl(pm, 63), bl = __shfl(bc, 63);
        BCS[lane] = bc; A2[lane] = a2; PM[lane] = pm; KWS[lane] = __expf(a2 - pml);
        if (!dry) { MS[(row * 8 + h) * 4 + 0] = bc; MS[(row * 8 + h) * 4 + 1] = bc + pm; }
        if (lane == 0 && !dry) { ITEM[128] = bl + pml; ITEM[129] = bl; }
    }
    float kp[16];
    {
        float xq[19], xk[19];
#pragma unroll
        for (int i = 0; i < 19; ++i) { xq[i] = bf2f(raw.xq[i]); xk[i] = bf2f(raw.xk[i]); }
        const float q0 = raw.cwq[0], q1 = raw.cwq[1], q2 = raw.cwq[2], q3 = raw.cwq[3], qb = raw.cbq;
        const float k0 = raw.cwk[0], k1 = raw.cwk[1], k2 = raw.cwk[2], k3 = raw.cwk[3], kb = raw.cbk;
#pragma unroll
        for (int i = 0; i < 16; ++i) {
            const float qv = siluf_(qb + q0 * xq[i] + q1 * xq[i + 1] + q2 * xq[i + 2] + q3 * xq[i + 3]) * 0.08838834764831845f;
            kp[i] = siluf_(kb + k0 * xk[i] + k1 * xk[i + 1] + k2 * xk[i + 2] + k3 * xk[i + 3]);
            QT[(16 * qq + i) * QS + d] = (bf16_t)f2bf(qv); KT[(16 * qq + i) * QS + d] = (bf16_t)f2bf(kp[i]);
        }
    }
    bf16x8_t vt[4];
    {
        const int e = tid & 255, hf = tid >> 8;
        unsigned short vv[32];
#pragma unroll
        for (int i = 0; i < 32; ++i) vv[i] = raw.vv[i];
#pragma unroll
        for (int j = 0; j < 4; ++j) { v4u w4; w4.x = vv[8 * j] | ((unsigned)vv[8 * j + 1] << 16); w4.y = vv[8 * j + 2] | ((unsigned)vv[8 * j + 3] << 16); w4.z = vv[8 * j + 4] | ((unsigned)vv[8 * j + 5] << 16); w4.w = vv[8 * j + 6] | ((unsigned)vv[8 * j + 7] << 16);
            vt[j] = __builtin_bit_cast(bf16x8_t, w4); *(LAS bf16x8_t*)(VT + e * VS + 32 * hf + 8 * j) = vt[j]; }
    }
    WG_BAR();
    {
        bf16_t* vg = U + uidx(row0, 2048 + h * 256);
#pragma unroll
        for (int j = 0; j < 4; ++j) { const int p = tid + 512 * j; const bf16x8_t v_ = *(const LAS bf16x8_t*)(VT + (p >> 3) * VS + (p & 7) * 8); if (!dry) *(bf16x8_t*)(vg + (size_t)p * 8) = v_; }
        float kw[16], ns = 0.f;
#pragma unroll
        for (int i = 0; i < 16; ++i) { kw[i] = kp[i] * KWS[16 * qq + i]; ns += kw[i]; }
        NL[qq * 128 + d] = ns;
        LAS bf16_t* kp_ = KWT + d * VS + 16 * qq;
        { const bf16x8_t ka_ = pack_bf16x8(kw[0], kw[1], kw[2], kw[3], kw[4], kw[5], kw[6], kw[7]), kb_ = pack_bf16x8(kw[8], kw[9], kw[10], kw[11], kw[12], kw[13], kw[14], kw[15]); *(LAS bf16x8_t*)kp_ = ka_; *(LAS bf16x8_t*)(kp_ + 8) = kb_; }
#pragma unroll
        for (int j = 0; j < 2; ++j) { const int p = tid + 512 * j, row = p >> 4, c16 = p & 15; const bf16x8_t qv_ = *(const LAS bf16x8_t*)(QT + row * QS + c16 * 8); if (!dry) *(bf16x8_t*)(QA + (row0 + row) * D + h * 128 + c16 * 8) = qv_; }
    }
    {
        const int tb = w >> 1, r = lane & 15, g = lane >> 4;
#pragma unroll
        for (int k2 = 0; k2 < 2; ++k2) {
            const int sb = 2 * (w & 1) + k2;
            f32x4_t acc = {0.f, 0.f, 0.f, 0.f};
            if (sb <= tb) {
#pragma unroll
                for (int ks = 0; ks < 4; ++ks) {
                    const bf16x8_t a = *(const LAS bf16x8_t*)(KT + (16 * sb + r) * QS + 32 * ks + 8 * g), bb = *(const LAS bf16x8_t*)(QT + (16 * tb + r) * QS + 32 * ks + 8 * g);
                    acc = __builtin_amdgcn_mfma_f32_16x16x32_bf16(a, bb, acc, 0, 0, 0);
                }
            }
            const int t = 16 * tb + r, s0 = 16 * sb + 4 * g; const float pmt = PM[t];
            float sc[4], ds = 0.f;
#pragma unroll
            for (int j = 0; j < 4; ++j) { sc[j] = (s0 + j <= t) ? acc[j] * __expf(A2[s0 + j] - pmt) : 0.f; ds += sc[j]; }
            v2u pw; pw.x = pg8::cvt_pk_bf16(sc[0], sc[1]); pw.y = pg8::cvt_pk_bf16(sc[2], sc[3]);
            *(LAS v2u*)(AT + t * VS + s0) = pw;
            ds += __shfl_xor(ds, 16); ds += __shfl_xor(ds, 32);
            if (g == 0) DL[sb * 64 + t] = ds;
        }
    }
    WG_BAR();
    {
        const int l31 = lane & 31, hh = lane >> 5;
#pragma unroll
        for (int th = 0; th < 2; ++th) {
            f32x16 acc;
#pragma unroll
            for (int r = 0; r < 16; ++r) acc[r] = 0.f;
#pragma unroll
            for (int ks = 0; ks < 4; ++ks) {
                const bf16x8_t a = *(const LAS bf16x8_t*)(AT + (32 * th + l31) * VS + 16 * ks + 8 * hh), bb = *(const LAS bf16x8_t*)(VT + (32 * w + l31) * VS + 16 * ks + 8 * hh);
                acc = __builtin_amdgcn_mfma_f32_32x32x16_bf16(a, bb, acc, 0, 0, 0);
            }
#pragma unroll
            for (int r = 0; r < 16; ++r) { const int t = 32 * th + (r & 3) + 8 * (r >> 2) + 4 * hh; NT[t * 264 + 32 * w + l31] = (bf16_t)f2bf(acc[r]); }
        }
#pragma unroll
        for (int j = 0; j < 2; ++j) { const int p = tid + 512 * j, dd = p >> 3, c8 = p & 7; const bf16x8_t k_ = *(const LAS bf16x8_t*)(KWT + dd * VS + c8 * 8);
            if (!dry) *(bf16x8_t*)(QA + (row0 + (dd >> 1)) * D + 1024 + h * 128 + (dd & 1) * 64 + c8 * 8) = k_; }
        if (tid < 64 && !dry) MS[((row0 + tid) * 8 + h) * 4 + 2] = (DL[tid] + DL[64 + tid]) + (DL[128 + tid] + DL[192 + tid]);
        if (tid >= 128 && tid < 256 && !dry) { const int dd = tid - 128; ITEM[dd] = (NL[dd] + NL[128 + dd]) + (NL[256 + dd] + NL[384 + dd]); }
    }
    WG_BAR();
#pragma unroll
    for (int j = 0; j < 4; ++j) { const int p = tid + 512 * j, t_ = p >> 5, c32 = p & 31; const bf16x8_t o_ = *(const LAS bf16x8_t*)(NT + t_ * 264 + c32 * 8);
        if (!dry) *(bf16x8_t*)(NUM + (row0 + t_) * D + h * 256 + c32 * 8) = o_; }
    WG_BAR();
}

__device__ __forceinline__ void mlstm_b_phase(const Frame& F, const int dry, int b, int h, int eh) {
    constexpr int QS = 132, VS = 72;
    LAS bf16_t* QB = (LAS bf16_t*)F.lds;
    LAS bf16_t* KB = QB + 64 * QS;
    LAS bf16_t* VB = KB + 128 * VS;
    LAS float* NS = (LAS float*)(VB + 128 * VS);
    LAS float* DECC = NS + 128;
    LAS float* SLOC = DECC + 32;
    LAS float* OT = SLOC + 32;
    bf16_t* U = (bf16_t*)(F.ws + OFF_U); const bf16_t* QA = (const bf16_t*)F.out;
    float* MS = (float*)(F.ws + OFF_MS); float* ITEM0 = (float*)(F.ws + OFF_ITEM1) + (size_t)((b * 32) * 8 + h) * 256;
    const int tid = F.tid, w = F.wave, lane = F.lane, l31 = lane & 31, hh = lane >> 5, eb = w & 3, dh = w >> 2;
    if (w == 0) {
        const float Mc_l = (lane < 32) ? ITEM0[(size_t)lane * 2048 + 128] : 0.f, bl_l = (lane < 32) ? ITEM0[(size_t)lane * 2048 + 129] : 0.f;
        float m = 0.f, mine_m = 0.f, mine_dec = 0.f, mine_sl = 0.f;
        for (int c = 0; c < 32; ++c) { const float Mc = __shfl(Mc_l, c), bl = __shfl(bl_l, c), mn = fmaxf(bl + m, Mc);
            if (lane == c) { mine_m = m; mine_dec = __expf(bl + m - mn); mine_sl = __expf(Mc - mn); }
            m = mn; }
        if (lane < 32) { DECC[lane] = mine_dec; SLOC[lane] = mine_sl; if (!dry && eh == 0) ITEM0[(size_t)lane * 2048 + 130] = mine_m; }
    }
    if (tid < 128) NS[tid] = 0.f;
    f32x16 X[2];
#pragma unroll
    for (int xi = 0; xi < 2; ++xi)
#pragma unroll
        for (int r = 0; r < 16; ++r) X[xi][r] = 0.f;
    bf16x8_t pqA[2], pkA[2], pvA[2], pqB[2], pkB[2], pvB[2]; float pnlA = 0.f, pnlB = 0.f;
    {
        const size_t row0 = (size_t)b * S;
#pragma unroll
        for (int j = 0; j < 2; ++j) { const int p = tid + 512 * j; const bf16_t* ap = QA + (row0 + (p >> 4)) * D + h * 128 + (p & 15) * 8; pqA[j] = *(const bf16x8_t*)ap; pkA[j] = *(const bf16x8_t*)(ap + 1024);
            pvA[j] = *(const bf16x8_t*)(U + uidx(row0 + 32 * eh + (p >> 5), 2048 + h * 256 + (p & 31) * 8));
            const bf16_t* bp = ap + (size_t)64 * D; pqB[j] = *(const bf16x8_t*)bp; pkB[j] = *(const bf16x8_t*)(bp + 1024);
            pvB[j] = *(const bf16x8_t*)(U + uidx(row0 + 64 + 32 * eh + (p >> 5), 2048 + h * 256 + (p & 31) * 8)); }
        if (tid < 128) { pnlA = ITEM0[tid]; pnlB = ITEM0[2048 + tid]; }
    }
    WG_BAR();
#define MLSTM_B_CHUNK(CIDX, PQ, PK, PV, PNL) { const int c = (CIDX); \
        const size_t row0 = (size_t)b * S + c * 64; \
        const float dec = DECC[c], sloc = SLOC[c]; \
_Pragma("unroll") \
        for (int j = 0; j < 2; ++j) { const int p = tid + 512 * j, ur = p >> 4, c16 = p & 15; \
            { const v4u w4 = __builtin_bit_cast(v4u, PQ[j]); v2u lo, hi; lo.x = w4.x; lo.y = w4.y; hi.x = w4.z; hi.y = w4.w; *(LAS v2u*)(QB + ur * QS + c16 * 8) = lo; *(LAS v2u*)(QB + ur * QS + c16 * 8 + 4) = hi; } \
            { const v4u w4 = __builtin_bit_cast(v4u, PK[j]); \
              const bf16x8_t ks_ = pack_bf16x8(pg8::bflo(w4.x) * sloc, pg8::bfhi(w4.x) * sloc, pg8::bflo(w4.y) * sloc, pg8::bfhi(w4.y) * sloc, pg8::bflo(w4.z) * sloc, pg8::bfhi(w4.z) * sloc, pg8::bflo(w4.w) * sloc, pg8::bfhi(w4.w) * sloc); \
              *(LAS bf16x8_t*)(KB + (2 * ur + (c16 >> 3)) * VS + (c16 & 7) * 8) = ks_; } \
            { const int vr = p >> 5, c32 = p & 31; *(LAS bf16x8_t*)(VB + (4 * vr + (c32 >> 3)) * VS + (c32 & 7) * 8) = PV[j]; } } \
        const float nl_cur = PNL; \
        WG_BAR(); \
        if (c + 2 < 32) { \
            const size_t rn = row0 + 128; \
_Pragma("unroll") \
            for (int j = 0; j < 2; ++j) { const int p = tid + 512 * j; const bf16_t* ap = QA + (rn + (p >> 4)) * D + h * 128 + (p & 15) * 8; PQ[j] = *(const bf16x8_t*)ap; PK[j] = *(const bf16x8_t*)(ap + 1024); \
                PV[j] = *(const bf16x8_t*)(U + uidx(rn + 32 * eh + (p >> 5), 2048 + h * 256 + (p & 31) * 8)); } \
            if (tid < 128) PNL = ITEM0[(size_t)(c + 2) * 2048 + tid]; \
        } \
 \
        if (eh == 0) { \
            const int tq = 8 * w + (lane >> 3), d0 = (lane & 7) * 16; float s = 0.f; \
_Pragma("unroll") \
            for (int j = 0; j < 4; ++j) { const v2u qv = *(const LAS v2u*)(QB + tq * QS + d0 + 4 * j); const f32x4_t nv = *(const LAS f32x4_t*)(NS + d0 + 4 * j); \
                s += (pg8::bflo(qv.x) * nv[0] + pg8::bfhi(qv.x) * nv[1]) + (pg8::bflo(qv.y) * nv[2] + pg8::bfhi(qv.y) * nv[3]); } \
            s += __shfl_xor(s, 1); s += __shfl_xor(s, 2); s += __shfl_xor(s, 4); \
            if ((lane & 7) == 0 && !dry) MS[((row0 + tq) * 8 + h) * 4 + 3] = s; \
        } \
 \
        f32x16 accT[2]; \
_Pragma("unroll") \
        for (int tt = 0; tt < 2; ++tt) \
_Pragma("unroll") \
            for (int r = 0; r < 16; ++r) accT[tt][r] = 0.f; \
_Pragma("unroll") \
        for (int xi = 0; xi < 2; ++xi) \
_Pragma("unroll") \
            for (int s = 0; s < 2; ++s) { \
                const bf16x8_t a = pack_bf16x8(X[xi][8 * s + 0], X[xi][8 * s + 1], X[xi][8 * s + 2], X[xi][8 * s + 3], X[xi][8 * s + 4], X[xi][8 * s + 5], X[xi][8 * s + 6], X[xi][8 * s + 7]); \
_Pragma("unroll") \
                for (int tt = 0; tt < 2; ++tt) { \
                    const LAS bf16_t* qp = QB + (32 * tt + l31) * QS + 64 * dh + 32 * xi + 16 * s + 4 * hh; \
                    const bf16x8_t bq = cat_bf16x4(*(const LAS v2u*)qp, *(const LAS v2u*)(qp + 8)); \
                    accT[tt] = __builtin_amdgcn_mfma_f32_32x32x16_bf16(a, bq, accT[tt], 0, 0, 0); \
                } \
            } \
 \
_Pragma("unroll") \
        for (int xi = 0; xi < 2; ++xi) { \
_Pragma("unroll") \
            for (int r = 0; r < 16; ++r) X[xi][r] *= dec; \
_Pragma("unroll") \
            for (int ks = 0; ks < 4; ++ks) { \
                const bf16x8_t a = *(const LAS bf16x8_t*)(KB + (64 * dh + 32 * xi + l31) * VS + 16 * ks + 8 * hh), bv = *(const LAS bf16x8_t*)(VB + (32 * eb + l31) * VS + 16 * ks + 8 * hh); \
                X[xi] = __builtin_amdgcn_mfma_f32_32x32x16_bf16(a, bv, X[xi], 0, 0, 0); \
            } \
        } \
 \
_Pragma("unroll") \
        for (int tt = 0; tt < 2; ++tt) \
_Pragma("unroll") \
            for (int g4 = 0; g4 < 4; ++g4) { const f32x4_t ov = {accT[tt][4 * g4 + 0], accT[tt][4 * g4 + 1], accT[tt][4 * g4 + 2], accT[tt][4 * g4 + 3]}; \
                *(LAS f32x4_t*)(OT + (dh * 64 + 32 * tt + l31) * 132 + 32 * eb + 8 * g4 + 4 * hh) = ov; } \
        WG_BAR(); \
        _Pragma("unroll") \
        for (int j = 0; j < 2; ++j) { const int p = tid + 512 * j, t_ = p >> 4, c16 = p & 15; const LAS float* o0 = OT + t_ * 132 + c16 * 8; const LAS float* o1 = o0 + 64 * 132; \
            const f32x4_t a0 = *(const LAS f32x4_t*)o0 + *(const LAS f32x4_t*)o1, a1 = *(const LAS f32x4_t*)(o0 + 4) + *(const LAS f32x4_t*)(o1 + 4); \
            const bf16x8_t o_ = pack_bf16x8(a0[0], a0[1], a0[2], a0[3], a1[0], a1[1], a1[2], a1[3]); \
            if (!dry) *(bf16x8_t*)(U + uidx(row0 + t_, h * 256 + 128 * eh + c16 * 8)) = o_; } \
        if (tid < 128) NS[tid] = dec * NS[tid] + sloc * nl_cur; \
    }
    for (int c2 = 0; c2 < 32; c2 += 2) { MLSTM_B_CHUNK(c2, pqA, pkA, pvA, pnlA) MLSTM_B_CHUNK(c2 + 1, pqB, pkB, pvB, pnlB) }
#undef MLSTM_B_CHUNK
    WG_BAR();
}

__device__ __forceinline__ void mlstm_c_item(const Frame& F, const int dry, int b, int c, int h) {
    const bf16_t* U = (const bf16_t*)(F.ws + OFF_U); bf16_t* Y = (bf16_t*)(F.ws + OFF_B);
    const float* MS = (const float*)(F.ws + OFF_MS); const float* ITEM = (const float*)(F.ws + OFF_ITEM1) + (size_t)((b * 32 + c) * 8 + h) * 256;
    const int w = F.wave, lane = F.lane;
    const size_t row0 = (size_t)b * S + c * 64;
    const f32x4_t cn = *(const f32x4_t*)(F.in[20] + h * 256 + 4 * lane);
    const float m_st = ITEM[130];
    v2u oi[8], nm[8], gg[8]; f32x4_t st[8];
#pragma unroll
    for (int i = 0; i < 8; ++i) { const size_t row = row0 + 8 * w + i;
        oi[i] = *(const v2u*)(U + uidx(row, h * 256 + 4 * lane)); nm[i] = *(const v2u*)(Y + row * D + h * 256 + 4 * lane); gg[i] = *(const v2u*)(U + uidx(row, 4096 + h * 256 + 4 * lane));
        st[i] = *(const f32x4_t*)(MS + (row * 8 + h) * 4); }
#pragma unroll
    for (int i = 0; i < 8; ++i) { const size_t row = row0 + 8 * w + i;
        const float bcs = st[i][0], mloc = st[i][1], dloc = st[i][2], di = st[i][3];
        const float mt = fmaxf(mloc, bcs + m_st), gi = __expf(bcs + m_st - mt), gl = __expf(mloc - mt);
        const float den = gi * di + gl * dloc, inv = 1.f / fmaxf(fabsf(den), __expf(-mt));
        const float h0 = (gi * pg8::bflo(oi[i].x) + gl * pg8::bflo(nm[i].x)) * inv, h1 = (gi * pg8::bfhi(oi[i].x) + gl * pg8::bfhi(nm[i].x)) * inv;
        const float h2 = (gi * pg8::bflo(oi[i].y) + gl * pg8::bflo(nm[i].y)) * inv, h3 = (gi * pg8::bfhi(oi[i].y) + gl * pg8::bfhi(nm[i].y)) * inv;
        const float ss = wave_sum((h0 * h0 + h1 * h1) + (h2 * h2 + h3 * h3));
        const float rs = rsqrtf(ss * (1.f / 256.f) + EPS);
        v2u yw; yw.x = pg8::cvt_pk_bf16(h0 * rs * cn[0] * pg8::bflo(gg[i].x), h1 * rs * cn[1] * pg8::bfhi(gg[i].x)); yw.y = pg8::cvt_pk_bf16(h2 * rs * cn[2] * pg8::bflo(gg[i].y), h3 * rs * cn[3] * pg8::bfhi(gg[i].y));
        if (!dry) *(v2u*)(Y + row * D + h * 256 + 4 * lane) = yw; }
}

#ifndef MK_DUP
#define MK_DUP -1
#endif
enum { PH_P0 = 0, PH_IN0, PH_MIX0A, PH_MIX0B, PH_MIX0C, PH_OUT0, PH_GATE0, PH_IN1, PH_MIX1A, PH_MIX1B, PH_MIX1C, PH_OUT1, PH_GATE1, PH_FINAL, PH_END };

__global__ void __launch_bounds__(NWAVES * 64, 2) mk_fwd(Ptrs args) {
    extern __shared__ __attribute__((aligned(16))) unsigned char lds_raw[];
    Frame F;
    F.lds = (LAS unsigned char*)lds_raw;
    F.tid = threadIdx.x; F.lane = F.tid & 63; F.wave = __builtin_amdgcn_readfirstlane(F.tid >> 6);
    F.G = gridDim.x; F.bid = blockIdx.x; F.in = args.in; F.out = args.out; F.ws = args.ws;
    volatile LAS unsigned* MISC = (volatile LAS unsigned*)(F.lds + MISC_OFF);
    if (F.tid < 32) MISC[F.tid] = 0u;
    __syncthreads();
    XcdBarrier bar = xcd_barrier_post((unsigned*)(F.ws + OFF_CTL) + CW_BAR + args.li * XCD_BAR_WORDS, MISC + 8);
    const int lo = args.ph_lo, hi = args.ph_hi, dryv = args.dup;
#define IN_(k) (lo <= (k) && (k) < hi)
#define RUN(k, BODY) do { if (IN_(k)) { if (MK_DUP == (k)) { BODY(dryv) xcd_barrier(bar); } BODY(0) } } while (0)
#ifndef MK_TSPROBE
#define MK_TSPROBE -1
#endif
    unsigned long long* const tsb = (unsigned long long*)(F.ws + OFF_CTL + 524288);
#define STAMP(k) do { if (MK_TSPROBE >= 0 && F.bid == 0 && F.tid == 0) __hip_atomic_store(tsb + (k), (unsigned long long)__builtin_amdgcn_s_memrealtime(), __ATOMIC_RELAXED, __HIP_MEMORY_SCOPE_AGENT); } while (0)
#define SEAM(k) do { if (IN_(k) && IN_((k) + 1)) xcd_barrier(bar); STAMP((k) + 1); } while (0)
    STAMP(0);
    unsigned char* ws = F.ws;
    bf16_t* A = (bf16_t*)(ws + OFF_A); bf16_t* B = (bf16_t*)(ws + OFF_B); bf16_t* U = (bf16_t*)(ws + OFF_U);
    float* plpart = (float*)(ws + OFF_PART); float* hpart = plpart + (size_t)M * 32;
    const bf16_t* P16 = (const bf16_t*)(ws + OFF_WIN0); bf16_t* PL = U;
    const bf16_t* PLEW = (const bf16_t*)(ws + OFF_PLEW); bf16_t* PL1 = (bf16_t*)(ws + OFF_WIN1);
    float* plpart1 = (float*)(ws + OFF_WIN0 + 8 * MiB);

#define BODY_PH_P0(DRY) { p0_prologue(F); }
#define BODY_PH_IN0(DRY) { pg8::Gemm g{A, (const bf16_t*)(ws + OFF_WIN0), M, 6144, 2048}; pg8::StaticOrder So; So.init(M, 6144, F.G, F.bid); \
        pg8::EpiIn0 E{U, (const float*)(ws + OFF_SMALL) + 1024, DRY}; \
        pg8::gemm_phase<pg8::EpiIn0, pg8::StaticOrder, true, true>(F.lds, g, So, E); }
#define BODY_PH_MIX0A(DRY) { cvt_p_phase(F, DRY); \
        { H2Raw cur_, nxt_; if (F.bid < 1024) hgrn2_a_load(F, F.bid >> 8, (F.bid >> 3) & 31, F.bid & 7, cur_); \
          for (int it = F.bid; it < 1024; it += F.G) { const int in_ = it + F.G; if (in_ < 1024) hgrn2_a_load(F, in_ >> 8, (in_ >> 3) & 31, in_ & 7, nxt_); hgrn2_a_item(F, DRY, it >> 8, (it >> 3) & 31, it & 7, cur_); cur_ = nxt_; } } \
        { LruRaw cur_, nxt_; if (F.bid < 1024) rglru_a_load(F, F.bid >> 8, (F.bid >> 3) & 31, F.bid & 7, cur_); \
          for (int it = F.bid; it < 1024; it += F.G) { const int in_ = it + F.G; if (in_ < 1024) rglru_a_load(F, in_ >> 8, (in_ >> 3) & 31, in_ & 7, nxt_); rglru_a_item(F, DRY, it >> 8, (it >> 3) & 31, it & 7, cur_); cur_ = nxt_; } } }
#define BODY_PH_MIX0B(DRY) { if (F.bid < 32) hgrn2_b_phase(F, DRY, F.bid >> 3, F.bid & 7); else { for (int it = F.bid - 32; it < 1024; it += F.G - 32) rglru_b_item(F, DRY, it >> 8, (it >> 3) & 31, it & 7); \
        p0_layer1_weights_in(F, (F.bid - 32) * NWAVES + F.wave, (F.G - 32) * NWAVES); p0_layer1_weights_out(F, (F.bid - 32) * NWAVES + F.wave, (F.G - 32) * NWAVES); } }
#define BODY_PH_MIX0C(DRY) { for (int it = F.bid; it < 1024; it += F.G) hgrn2_c_item(F, DRY, it >> 8, (it >> 3) & 31, it & 7); }
#define BODY_PH_OUT0(DRY) { { pg8::Gemm g{A, (const bf16_t*)(ws + OFF_WOUT0), M, 2048, 2048}; pg8::StaticOrder So; So.init(M, 2048, F.G, F.bid); \
          pg8::EpiOut<true> E{F.in[0], B, DRY}; \
          pg8::gemm_phase<pg8::EpiOut<true>, pg8::StaticOrder, true, true>(F.lds, g, So, E); } \
        { unsigned char* ws2 = ws; asm volatile("" : "+s"(ws2));     \
          pg8::Gemm g{(const bf16_t*)(ws2 + OFF_WIN0), (const bf16_t*)(ws2 + OFF_PLEW), M, 2048, 256}; pg8::StaticOrder So; So.init(M, 2048, F.G, F.bid); \
          pg8::EpiPle E{(bf16_t*)(ws2 + OFF_U), (float*)(ws2 + OFF_PART), DRY}; \
          pg8::gemm_phase<pg8::EpiPle, pg8::StaticOrder, true, true>(F.lds, g, So, E); } }
#define BODY_PH_GATE0(DRY) { pg8::Gemm g{B, (const bf16_t*)(ws + OFF_WG0), M, 2048, 2048}; pg8::StaticOrder So; So.init(M, 2048, F.G, F.bid); \
        pg8::EpiGate E{B, A, nullptr, PL, plpart, F.in[23], hpart, DRY}; \
        pg8::gemm_phase<pg8::EpiGate, pg8::StaticOrder, true, true>(F.lds, g, So, E); }
#define BODY_PH_IN1(DRY) { pg8::Gemm g{A, (const bf16_t*)(ws + OFF_WIN1), M, 8192, 2048}; pg8::StaticOrder So; So.init(M, 8192, F.G, F.bid); \
        pg8::EpiIn1 E{U, hpart, DRY}; \
        pg8::gemm_phase<pg8::EpiIn1, pg8::StaticOrder, true, true>(F.lds, g, So, E); \
        gates1_phase(F, DRY); }
#define BODY_PH_MIX1A(DRY) { MlRaw cur_, nxt_; if (F.bid < 1024) mlstm_a_load(F, F.bid >> 8, (F.bid >> 3) & 31, F.bid & 7, cur_); \
        for (int it = F.bid; it < 1024; it += F.G) { const int in_ = it + F.G; if (in_ < 1024) mlstm_a_load(F, in_ >> 8, (in_ >> 3) & 31, in_ & 7, nxt_); mlstm_a_item(F, DRY, it >> 8, (it >> 3) & 31, it & 7, cur_); cur_ = nxt_; } }
#define BODY_PH_MIX1B(DRY) { if (F.bid < 64) mlstm_b_phase(F, DRY, F.bid >> 4, (F.bid >> 1) & 7, F.bid & 1); else { \
        pg8::Gemm g{P16 + (size_t)M * PLE, PLEW + (size_t)2048 * 256, M, 2048, 256}; pg8::StaticOrder So; So.init(M, 2048, F.G - 64, F.bid - 64); \
        pg8::EpiPle E{PL1, plpart1, DRY}; \
        pg8::gemm_phase<pg8::EpiPle, pg8::StaticOrder, true, true>(F.lds, g, So, E); } }
#define BODY_PH_MIX1C(DRY) { for (int it = F.bid; it < 1024; it += F.G) mlstm_c_item(F, DRY, it >> 8, (it >> 3) & 31, it & 7); }
#define BODY_PH_OUT1(DRY) { pg8::Gemm g{B, (const bf16_t*)(ws + OFF_WOUT1), M, 2048, 2048}; pg8::StaticOrder So; So.init(M, 2048, F.G, F.bid); \
          pg8::EpiOut<false> E{A, A, DRY}; \
          pg8::gemm_phase<pg8::EpiOut<false>, pg8::StaticOrder, true, true>(F.lds, g, So, E); }
#define BODY_PH_GATE1(DRY) { pg8::Gemm g{A, (const bf16_t*)(ws + OFF_WG1), M, 2048, 2048}; pg8::StaticOrder So; So.init(M, 2048, F.G, F.bid); \
        float peps = 0.f; \
        if (MK_TSPROBE >= 0) { const unsigned long long t0_ = __hip_atomic_load(tsb + (MK_TSPROBE >= 0 ? MK_TSPROBE : 0), __ATOMIC_RELAXED, __HIP_MEMORY_SCOPE_AGENT), t1_ = __hip_atomic_load(tsb + (MK_TSPROBE >= 0 ? MK_TSPROBE : 0) + 1, __ATOMIC_RELAXED, __HIP_MEMORY_SCOPE_AGENT); \
            unsigned bk = (unsigned)((t1_ - t0_) / 500ull); if (bk > 95u) bk = 95u; peps = sqrtf((float)bk * 1e-6f); }     \
        pg8::EpiGateFinal E{A, F.out, PL1, plpart1, F.in[23] + D, F.in[25], (float*)(ws + OFF_GATES1), (unsigned*)(ws + OFF_CTL) + CW_FIN, peps, DRY}; \
        pg8::gemm_phase<pg8::EpiGateFinal, pg8::StaticOrder, false, true>(F.lds, g, So, E); }
#define BODY_PH_FINAL(DRY) { final_norm_phase(F, DRY); }

    RUN(PH_P0, BODY_PH_P0);
    SEAM(PH_P0);
    RUN(PH_IN0, BODY_PH_IN0);
    SEAM(PH_IN0);
    RUN(PH_MIX0A, BODY_PH_MIX0A);
    SEAM(PH_MIX0A);
    RUN(PH_MIX0B, BODY_PH_MIX0B);
    SEAM(PH_MIX0B);
    RUN(PH_MIX0C, BODY_PH_MIX0C);
    SEAM(PH_MIX0C);
    RUN(PH_OUT0, BODY_PH_OUT0);
    SEAM(PH_OUT0);
    RUN(PH_GATE0, BODY_PH_GATE0);
    SEAM(PH_GATE0);
    RUN(PH_IN1, BODY_PH_IN1);
    SEAM(PH_IN1);
    RUN(PH_MIX1A, BODY_PH_MIX1A);
    SEAM(PH_MIX1A);
    RUN(PH_MIX1B, BODY_PH_MIX1B);
    SEAM(PH_MIX1B);
    RUN(PH_MIX1C, BODY_PH_MIX1C);
    SEAM(PH_MIX1C);
    RUN(PH_OUT1, BODY_PH_OUT1);
    SEAM(PH_OUT1);
    RUN(PH_GATE1, BODY_PH_GATE1);
#undef IN_
#undef SEAM
#undef RUN
}


extern "C" void kernel_launch(void* const* d_in, const int* in_sizes, int n_in, void* d_out, int out_size, void* d_ws, size_t ws_size, hipStream_t stream) {
    static int grid = 0;
    if (grid == 0) {
        if (n_in != 26 || ws_size < WS_END || out_size != M * D) { fprintf(stderr, "kernel_launch: unexpected problem (n_in %d, ws %zu, out %d)\n", n_in, ws_size, out_size); grid = -1; return; }
        int dev = 0, cus = 0, per_cu = 0;
        if (hipGetDevice(&dev) != hipSuccess || hipDeviceGetAttribute(&cus, hipDeviceAttributeMultiprocessorCount, dev) != hipSuccess) { grid = -1; return; }
        if (hipFuncSetAttribute((const void*)mk_fwd, hipFuncAttributeMaxDynamicSharedMemorySize, LDS_BYTES) != hipSuccess) { fprintf(stderr, "kernel_launch: hipFuncSetAttribute failed\n"); grid = -1; return; }
        if (hipOccupancyMaxActiveBlocksPerMultiprocessor(&per_cu, (const void*)mk_fwd, NWAVES * 64, LDS_BYTES) != hipSuccess || per_cu < 1) { fprintf(stderr, "kernel_launch: occupancy query says %d blocks per CU\n", per_cu); (void)hipGetLastError(); grid = -1; return; }
        grid = cus;
    }
    if (grid < 0) return;
    (void)hipMemsetAsync((char*)d_ws + OFF_CTL, 0, CTL_ZERO_BYTES, stream);
    Ptrs a{};
    for (int i = 0; i < 26; ++i) a.in[i] = (const float*)d_in[i];
    a.out = (float*)d_out; a.ws = (unsigned char*)d_ws; a.ph_lo = PH_P0; a.ph_hi = PH_END; a.li = 0; a.dup = 1;
    void* kargs[] = {&a};
    const hipError_t e = hipLaunchCooperativeKernel((const void*)mk_fwd, dim3(grid), dim3(NWAVES * 64), kargs, LDS_BYTES, stream);
    if (e != hipSuccess) fprintf(stderr, "kernel_launch: cooperative launch failed: %s (grid %d)\n", hipGetErrorString(e), grid);
}
```

```cpp
#include <hip/hip_runtime.h>
#include <cstdio>
#include <cstdint>

namespace pg8 {
#define PG8_LAS __attribute__((address_space(3)))
typedef unsigned short bf16_t;
typedef short bf16x8 __attribute__((ext_vector_type(8)));
typedef float f32x4 __attribute__((ext_vector_type(4)));
typedef unsigned u32x4 __attribute__((ext_vector_type(4)));
constexpr int BM = 256, BK = 64, HALF = 128, HTB = HALF * BK * 2  , STAGE_BYTES = 8 * HTB, NXCD = 8, WGM = 8;

__host__ __device__ __forceinline__ int lds_byte(int r, int c) { const int st = (r >> 4) * 2 + (c >> 5), rr = r & 15, cc = c & 31, ob = rr * 64 + cc * 2; return st * 1024 + (ob ^ (((ob >> 9) & 1) << 5)); }
__host__ __device__ __forceinline__ void stage_rc(int b, int& R, int& C) { const int st = b / 1024, sb = b % 1024, swz = sb ^ (((sb >> 9) & 1) << 5); R = (st >> 1) * 16 + swz / 64; C = (st & 1) * 32 + (swz % 64) / 2; }
__host__ __device__ __forceinline__ int perm32(int rho) { const int n = rho >> 4, i = rho & 15; return 8 * (i >> 2) + 4 * n + (i & 3); }

struct Unit { int pm, pn; };
struct Gemm { const bf16_t* A; const bf16_t* Bt; int M, N, K; };

struct StaticOrder {
    int nM, nN, nwg, G, c;
    __host__ __device__ void init(int M, int N, int G_, int c_) { nM = M / BM; nN = N / BM; nwg = nM * nN; G = G_; c = c_; }
    __host__ __device__ bool next(int i, Unit& u) const {
        const long L = (long)i * G + c; if (L >= nwg) return false;
        int wgid = (int)L; { const int q = nwg / NXCD, r = nwg % NXCD, xcd = wgid % NXCD, off = wgid / NXCD; wgid = (xcd < r ? xcd * (q + 1) : r * (q + 1) + (xcd - r) * q) + off; }
        const int nig = WGM * nN, gid = wgid / nig, fm = gid * WGM, gsz = (nM - fm) < WGM ? (nM - fm) : WGM;
        u.pm = fm + ((wgid % nig) % gsz); u.pn = (wgid % nig) / gsz; return true;
    }
    __device__ __forceinline__ void a_ready(const Unit&) const {}
    __device__ __forceinline__ void done(const Unit&) const {}
};

typedef __bf16 bf16v2_t __attribute__((ext_vector_type(2)));
typedef float f32v2_t __attribute__((ext_vector_type(2)));
__device__ __forceinline__ unsigned cvt_pk_bf16(float lo, float hi) { const f32v2_t v = {lo, hi}; return __builtin_bit_cast(unsigned, __builtin_convertvector(v, bf16v2_t)); }
typedef float f32x2 __attribute__((ext_vector_type(2)));
template <class Epi, class Sched, bool ALIGN_EPI = false, bool SP2 = false>
__device__ __forceinline__ void gemm_phase(PG8_LAS unsigned char* lds, const Gemm g, const Sched& S, const Epi& E) {
    const int tid = threadIdx.x, wid = __builtin_amdgcn_readfirstlane(tid >> 6), lane = tid & 63, wr = wid >> 2, wc = wid & 3, fr = lane & 15, fq = lane >> 4;
    const int K = g.K, nt = K / BK;
    unsigned voffA[2], voffB[2];
#pragma unroll
    for (int i = 0; i < 2; ++i) { int R, C; stage_rc(tid * 16 + i * 8192, R, C); const int Rb = Epi::PERM ? ((R & ~31) + perm32(R & 31)) : R;
        voffA[i] = (unsigned)(R * K + C) * 2u; voffB[i] = (unsigned)(Rb * K + C) * 2u; }
    const size_t kstep = (size_t)(BK * 2);
    const size_t hstep = (size_t)HALF * K * 2;
    const size_t tstep = 2 * hstep;
    const unsigned ldsw = (unsigned)wid * 1024u;
    const int aoff = lds_byte(wr * 64 + fr, fq * 8), boff = lds_byte(wc * 32 + fr, fq * 8);
#define PG8_SA(b, h) (((b) * 2 + (h)) * HTB)
#define PG8_SB(b, h) ((4 + (b) * 2 + (h)) * HTB)
#define PG8_STAGE(bufoff, gbase, voff) do { _Pragma("unroll") for (int _i = 0; _i < 2; ++_i) \
        __builtin_amdgcn_global_load_lds((const unsigned*)((const char*)(gbase) + (voff)[_i]), (PG8_LAS unsigned*)(lds + (bufoff) + ldsw + _i * 8192), 16, 0, 0); } while (0)
#define PG8_LDA(dst, b, h) do { _Pragma("unroll") for (int m = 0; m < 4; ++m) _Pragma("unroll") for (int k = 0; k < 2; ++k) dst[m][k] = *(const PG8_LAS bf16x8*)(lds + PG8_SA(b, h) + aoff + m * 2048 + k * 1024); } while (0)
#define PG8_LDB(dst, b, h) do { _Pragma("unroll") for (int n = 0; n < 2; ++n) _Pragma("unroll") for (int k = 0; k < 2; ++k) dst[n][k] = *(const PG8_LAS bf16x8*)(lds + PG8_SB(b, h) + boff + n * 2048 + k * 1024); } while (0)
#define PG8_MMA(ai, bj, At, Bt) do { __builtin_amdgcn_s_setprio(1); _Pragma("unroll") for (int m = 0; m < 4; ++m) _Pragma("unroll") for (int n = 0; n < 2; ++n) _Pragma("unroll") for (int k = 0; k < 2; ++k) \
        acc[ai][bj][m][n] = __builtin_amdgcn_mfma_f32_16x16x32_bf16(Bt[n][k], At[m][k], acc[ai][bj][m][n], 0, 0, 0); __builtin_amdgcn_s_setprio(0); } while (0)
#define PG8_WAIT_V(n) asm volatile("s_waitcnt vmcnt(" #n ")" ::: "memory")
#define PG8_WAIT_L(n) asm volatile("s_waitcnt lgkmcnt(" #n ")" ::: "memory")
#define PG8_BAR __builtin_amdgcn_s_barrier()
#define PG8_SCHED __builtin_amdgcn_sched_barrier(0)
    Unit cur, nxt; int ui = 0;
    if (!S.next(0, cur)) return;
    f32x4 acc[2][2][4][2];
#pragma unroll
    for (int a = 0; a < 2; ++a)
#pragma unroll
        for (int b = 0; b < 2; ++b)
#pragma unroll
            for (int m = 0; m < 4; ++m)
#pragma unroll
                for (int n = 0; n < 2; ++n) acc[a][b][m][n] = (f32x4){0.f, 0.f, 0.f, 0.f};
    bf16x8 At[4][2], B0[2][2], B1[2][2];
    const char* cA = (const char*)g.A + (size_t)cur.pm * tstep; const char* cB = (const char*)g.Bt + (size_t)cur.pn * tstep;
    S.a_ready(cur);
    if constexpr (SP2) {
        PG8_STAGE(PG8_SB(0, 0), cB, voffB); PG8_STAGE(PG8_SB(0, 1), cB + hstep, voffB); PG8_STAGE(PG8_SA(0, 0), cA, voffA); PG8_STAGE(PG8_SA(0, 1), cA + hstep, voffA);
        if (wr == 1) PG8_BAR;
        PG8_WAIT_V(2); PG8_BAR;
        PG8_STAGE(PG8_SB(1, 0), cB + kstep, voffB); PG8_STAGE(PG8_SA(1, 0), cA + kstep, voffA); PG8_STAGE(PG8_SB(1, 1), cB + hstep + kstep, voffB);
        PG8_WAIT_V(6); PG8_BAR;
    } else {
        PG8_STAGE(PG8_SB(0, 0), cB, voffB); PG8_STAGE(PG8_SA(0, 0), cA, voffA); PG8_STAGE(PG8_SB(0, 1), cB + hstep, voffB); PG8_STAGE(PG8_SA(0, 1), cA + hstep, voffA);
        if (wr == 1) PG8_BAR;
        PG8_WAIT_V(4); PG8_BAR;
        PG8_STAGE(PG8_SB(1, 0), cB + kstep, voffB); PG8_STAGE(PG8_SA(1, 0), cA + kstep, voffA); PG8_STAGE(PG8_SB(1, 1), cB + hstep + kstep, voffB);
        PG8_WAIT_V(6); PG8_BAR;
    }
    for (;;) {
        const bool has_next = S.next(ui + 1, nxt);
        const char* nA = has_next ? (const char*)g.A + (size_t)nxt.pm * tstep : cA; const char* nB = has_next ? (const char*)g.Bt + (size_t)nxt.pn * tstep : cB;
        for (int t = 0; t < nt; t += 2) {
            const bool last = (t == nt - 2);
            const char* a1 = cA + (size_t)(t + 1) * kstep;
            const char* a2 = last ? nA : cA + (size_t)(t + 2) * kstep; const char* b2 = last ? nB : cB + (size_t)(t + 2) * kstep;
            const char* a3 = a2 + kstep; const char* b3 = b2 + kstep;
            if (last && has_next) S.a_ready(nxt);
            if constexpr (SP2) {
            PG8_LDB(B0, 0, 0); PG8_LDB(B1, 0, 1); PG8_SCHED; PG8_LDA(At, 0, 0); PG8_STAGE(PG8_SA(1, 1), a1 + hstep, voffA);
            PG8_WAIT_V(8); PG8_WAIT_L(0); PG8_BAR; PG8_MMA(0, 0, At, B0); PG8_MMA(0, 1, At, B1); PG8_BAR; PG8_SCHED;
            PG8_LDA(At, 0, 1); PG8_STAGE(PG8_SB(0, 0), b2, voffB); PG8_STAGE(PG8_SB(0, 1), b2 + hstep, voffB); PG8_STAGE(PG8_SA(0, 0), a2, voffA);
            PG8_WAIT_V(8); PG8_WAIT_L(0); PG8_BAR; PG8_MMA(1, 0, At, B0); PG8_MMA(1, 1, At, B1); PG8_BAR; PG8_SCHED;
            PG8_LDB(B0, 1, 0); PG8_LDB(B1, 1, 1); PG8_SCHED; PG8_LDA(At, 1, 0); PG8_STAGE(PG8_SA(0, 1), a2 + hstep, voffA);
            PG8_WAIT_V(8); PG8_WAIT_L(0); PG8_BAR; PG8_MMA(0, 0, At, B0); PG8_MMA(0, 1, At, B1); PG8_BAR; PG8_SCHED;
            PG8_LDA(At, 1, 1); PG8_STAGE(PG8_SB(1, 0), b3, voffB); PG8_STAGE(PG8_SB(1, 1), b3 + hstep, voffB); PG8_STAGE(PG8_SA(1, 0), a3, voffA);
            PG8_WAIT_V(8); PG8_WAIT_L(0); PG8_BAR; PG8_MMA(1, 0, At, B0); PG8_MMA(1, 1, At, B1); PG8_BAR; PG8_SCHED;
            } else {
            PG8_LDB(B0, 0, 0); PG8_SCHED; PG8_LDA(At, 0, 0); PG8_STAGE(PG8_SA(1, 1), a1 + hstep, voffA);
            PG8_WAIT_L(8); PG8_BAR; PG8_WAIT_L(0); PG8_MMA(0, 0, At, B0); PG8_BAR; PG8_SCHED;
            PG8_LDB(B1, 0, 1); PG8_STAGE(PG8_SB(0, 0), b2, voffB);
            PG8_BAR; PG8_WAIT_L(0); PG8_MMA(0, 1, At, B1); PG8_BAR;
            PG8_LDA(At, 0, 1); PG8_STAGE(PG8_SA(0, 0), a2, voffA);
            PG8_BAR; PG8_WAIT_L(0); PG8_MMA(1, 0, At, B0); PG8_BAR; PG8_SCHED;
            PG8_STAGE(PG8_SB(0, 1), b2 + hstep, voffB);
            PG8_WAIT_V(6); PG8_BAR; PG8_MMA(1, 1, At, B1); PG8_BAR;
            PG8_LDB(B0, 1, 0); PG8_SCHED; PG8_LDA(At, 1, 0); PG8_STAGE(PG8_SA(0, 1), a2 + hstep, voffA);
            PG8_WAIT_L(8); PG8_BAR; PG8_WAIT_L(0); PG8_MMA(0, 0, At, B0); PG8_BAR; PG8_SCHED;
            PG8_LDB(B1, 1, 1); PG8_STAGE(PG8_SB(1, 0), b3, voffB);
            PG8_BAR; PG8_WAIT_L(0); PG8_MMA(0, 1, At, B1); PG8_BAR;
            PG8_LDA(At, 1, 1); PG8_STAGE(PG8_SA(1, 0), a3, voffA);
            PG8_BAR; PG8_WAIT_L(0); PG8_MMA(1, 0, At, B0); PG8_BAR; PG8_SCHED;
            PG8_STAGE(PG8_SB(1, 1), b3 + hstep, voffB);
            PG8_WAIT_V(6); PG8_BAR; PG8_MMA(1, 1, At, B1); PG8_BAR;
            }
        }
        if constexpr (ALIGN_EPI) { if (wr == 0) PG8_BAR; }
        if constexpr (!Epi::AFTER_DRAIN) { E(acc, cur, wr, wc, fr, fq); S.done(cur); }
        if (!has_next) break;
#pragma unroll
        for (int a = 0; a < 2; ++a)
#pragma unroll
            for (int b = 0; b < 2; ++b)
#pragma unroll
                for (int m = 0; m < 4; ++m)
#pragma unroll
                    for (int n = 0; n < 2; ++n) acc[a][b][m][n] = (f32x4){0.f, 0.f, 0.f, 0.f};
        cur = nxt; cA = nA; cB = nB; ++ui;
        if constexpr (ALIGN_EPI) { if (wr == 1) PG8_BAR; }
    }
    PG8_WAIT_V(0);
    if constexpr (!ALIGN_EPI) { if (wr == 0) PG8_BAR; }
    PG8_BAR;
    if constexpr (Epi::AFTER_DRAIN) { E.fused(acc, cur, wr, wc, fr, fq, lds, wid, lane); S.done(cur); }
#undef PG8_SA
#undef PG8_SB
#undef PG8_STAGE
#undef PG8_LDA
#undef PG8_LDB
#undef PG8_MMA
#undef PG8_WAIT_V
#undef PG8_WAIT_L
#undef PG8_BAR
#undef PG8_SCHED
}
}

namespace pg8 {
constexpr float EPSN = 1e-6f;
__device__ __forceinline__ float fsigmoid(float x) { return __builtin_amdgcn_rcpf(1.f + __expf(-x)); }
__device__ __forceinline__ float fsilu(float x) { return x * __builtin_amdgcn_rcpf(1.f + __expf(-x)); }
__device__ __forceinline__ float row_stat32(const float* part, int row, int fq) {
    const f32x4 a = *(const f32x4*)(part + (size_t)row * 32 + 8 * fq), b = *(const f32x4*)(part + (size_t)row * 32 + 8 * fq + 4);
    float s = ((a.x + a.y) + (a.z + a.w)) + ((b.x + b.y) + (b.z + b.w));
    s += __shfl_xor(s, 16); s += __shfl_xor(s, 32); return s;
}
__device__ __forceinline__ u32x4 pack8(const f32x4 v0, const f32x4 v1) { u32x4 w; w.x = cvt_pk_bf16(v0[0], v0[1]); w.y = cvt_pk_bf16(v0[2], v0[3]); w.z = cvt_pk_bf16(v1[0], v1[1]); w.w = cvt_pk_bf16(v1[2], v1[3]); return w; }
__device__ __forceinline__ float bflo(unsigned w) { return __uint_as_float(w << 16); }
__device__ __forceinline__ float bfhi(unsigned w) { return __uint_as_float(w & 0xffff0000u); }

struct EpiIn0 {
    static constexpr bool PERM = true, AFTER_DRAIN = false;
    bf16_t* U; const float* rstd; int dry;
    __device__ __forceinline__ void operator()(const f32x4 (&acc)[2][2][4][2], const Unit& u, int wr, int wc, int fr, int fq) const {
        if (dry) return;
        const int row0 = u.pm * BM + wr * 64 + fr, col0 = u.pn * BM + wc * 32 + 8 * fq;
#pragma unroll
        for (int ai = 0; ai < 2; ++ai)
#pragma unroll
            for (int m = 0; m < 4; ++m) { const int row = row0 + ai * HALF + m * 16; const float sc = rstd[row]; bf16_t* rowp = U + ((size_t)u.pn * 8192 + row) * 256 + (wc * 32 + 8 * fq);
#pragma unroll
                for (int bj = 0; bj < 2; ++bj) *(u32x4*)(rowp + bj * HALF) = pack8(acc[ai][bj][m][0] * sc, acc[ai][bj][m][1] * sc); }
    }
};
struct EpiIn1 {
    static constexpr bool PERM = true, AFTER_DRAIN = false;
    bf16_t* U; const float* hpart; int dry;
    __device__ __forceinline__ void operator()(const f32x4 (&acc)[2][2][4][2], const Unit& u, int wr, int wc, int fr, int fq) const {
        if (dry) return;
        const int row0 = u.pm * BM + wr * 64 + fr;
        if (u.pn < 16) {
            const int col0 = u.pn * BM + wc * 32 + 8 * fq;
#pragma unroll
            for (int ai = 0; ai < 2; ++ai)
#pragma unroll
                for (int m = 0; m < 4; ++m) { const int row = row0 + ai * HALF + m * 16; const float sc = rsqrtf(row_stat32(hpart, row, fq) * (1.f / 2048.f) + EPSN); bf16_t* rowp = U + ((size_t)u.pn * 8192 + row) * 256 + (wc * 32 + 8 * fq);
#pragma unroll
                    for (int bj = 0; bj < 2; ++bj) *(u32x4*)(rowp + bj * HALF) = pack8(acc[ai][bj][m][0] * sc, acc[ai][bj][m][1] * sc); }
        } else {
            const int col0 = 4096 + 128 * (u.pn - 16) + wc * 32 + 8 * fq;
#pragma unroll
            for (int ai = 0; ai < 2; ++ai)
#pragma unroll
                for (int m = 0; m < 4; ++m) { const int row = row0 + ai * HALF + m * 16; const float sc = rsqrtf(row_stat32(hpart, row, fq) * (1.f / 2048.f) + EPSN);
                    f32x4 g0, g1;
#pragma unroll
                    for (int j = 0; j < 4; ++j) { g0[j] = fsigmoid(acc[ai][0][m][0][j] * sc) * fsilu(acc[ai][1][m][0][j] * sc); g1[j] = fsigmoid(acc[ai][0][m][1][j] * sc) * fsilu(acc[ai][1][m][1][j] * sc); }
                    *(u32x4*)(U + ((size_t)(16 + ((u.pn - 16) >> 1)) * 8192 + row) * 256 + ((u.pn - 16) & 1) * 128 + wc * 32 + 8 * fq) = pack8(g0, g1); }
        }
    }
};
template <bool BASE_F32> struct EpiOut {
    static constexpr bool PERM = true, AFTER_DRAIN = false;
    const void* base; bf16_t* h16; int dry;
    __device__ __forceinline__ void operator()(const f32x4 (&acc)[2][2][4][2], const Unit& u, int wr, int wc, int fr, int fq) const {
        if (dry) return;
        const int row0 = u.pm * BM + wr * 64 + fr, col0 = u.pn * BM + wc * 32 + 8 * fq;
#pragma unroll
        for (int ai = 0; ai < 2; ++ai)
#pragma unroll
            for (int m = 0; m < 4; ++m) { const size_t off = (size_t)(row0 + ai * HALF + m * 16) * 2048 + col0;
#pragma unroll
                for (int bj = 0; bj < 2; ++bj) { f32x4 b0, b1;
                    if (BASE_F32) { b0 = __builtin_nontemporal_load((const f32x4*)((const float*)base + off + bj * HALF)); b1 = __builtin_nontemporal_load((const f32x4*)((const float*)base + off + bj * HALF + 4)); }
                    else { const u32x4 pw = *(const u32x4*)((const bf16_t*)base + off + bj * HALF); b0 = (f32x4){bflo(pw.x), bfhi(pw.x), bflo(pw.y), bfhi(pw.y)}; b1 = (f32x4){bflo(pw.z), bfhi(pw.z), bflo(pw.w), bfhi(pw.w)}; }
                    *(u32x4*)(h16 + off + bj * HALF) = pack8(b0 + acc[ai][bj][m][0], b1 + acc[ai][bj][m][1]); }
                asm volatile("" ::: "memory"); }
    }
};
struct EpiPle {
    static constexpr bool PERM = true, AFTER_DRAIN = false;
    bf16_t* PL; float* plpart; int dry;
    __device__ __forceinline__ void operator()(const f32x4 (&acc)[2][2][4][2], const Unit& u, int wr, int wc, int fr, int fq) const {
        if (dry) return;
        const int row0 = u.pm * BM + wr * 64 + fr, col0 = u.pn * BM + wc * 32 + 8 * fq;
#pragma unroll
        for (int ai = 0; ai < 2; ++ai)
#pragma unroll
            for (int m = 0; m < 4; ++m) { const int row = row0 + ai * HALF + m * 16; float s = 0.f;
#pragma unroll
                for (int bj = 0; bj < 2; ++bj) { const f32x4 v0 = acc[ai][bj][m][0], v1 = acc[ai][bj][m][1];
                    s += ((v0[0] * v0[0] + v0[1] * v0[1]) + (v0[2] * v0[2] + v0[3] * v0[3])) + ((v1[0] * v1[0] + v1[1] * v1[1]) + (v1[2] * v1[2] + v1[3] * v1[3]));
                    *(u32x4*)(PL + (size_t)row * 2048 + col0 + bj * HALF) = pack8(v0, v1); }
                s += __shfl_xor(s, 16); s += __shfl_xor(s, 32);
                if (fq == 0) plpart[(size_t)row * 32 + u.pn * 4 + wc] = s; }
    }
};
struct EpiGate {
    static constexpr bool PERM = true, AFTER_DRAIN = false;
    const bf16_t* hin; bf16_t* h16out; float* outf; const bf16_t* PL; const float* plpart; const float* ple_norm; float* hpart; int dry;
    __device__ __forceinline__ void operator()(const f32x4 (&acc)[2][2][4][2], const Unit& u, int wr, int wc, int fr, int fq) const {
        if (dry) return;
        const int row0 = u.pm * BM + wr * 64 + fr, col0 = u.pn * BM + wc * 32 + 8 * fq;
        f32x4 pn[2][2];
#pragma unroll
        for (int bj = 0; bj < 2; ++bj) { pn[bj][0] = *(const f32x4*)(ple_norm + col0 + bj * HALF); pn[bj][1] = *(const f32x4*)(ple_norm + col0 + bj * HALF + 4); }
#pragma unroll
        for (int ai = 0; ai < 2; ++ai)
#pragma unroll
            for (int m = 0; m < 4; ++m) { const int row = row0 + ai * HALF + m * 16; const size_t off = (size_t)row * 2048 + col0;
                const float rs = rsqrtf(row_stat32(plpart, row, fq) * (1.f / 2048.f) + EPSN); float s = 0.f;
#pragma unroll
                for (int bj = 0; bj < 2; ++bj) { const u32x4 pw = *(const u32x4*)(PL + off + bj * HALF), hw = *(const u32x4*)(hin + off + bj * HALF);
                    const f32x4 p0 = (f32x4){bflo(pw.x), bfhi(pw.x), bflo(pw.y), bfhi(pw.y)} * pn[bj][0] * rs, p1 = (f32x4){bflo(pw.z), bfhi(pw.z), bflo(pw.w), bfhi(pw.w)} * pn[bj][1] * rs;
                    f32x4 h0 = (f32x4){bflo(hw.x), bfhi(hw.x), bflo(hw.y), bfhi(hw.y)}, h1 = (f32x4){bflo(hw.z), bfhi(hw.z), bflo(hw.w), bfhi(hw.w)};
#pragma unroll
                    for (int j = 0; j < 4; ++j) { h0[j] += fsigmoid(acc[ai][bj][m][0][j]) * p0[j]; h1[j] += fsigmoid(acc[ai][bj][m][1][j]) * p1[j]; }
                    if (outf) { *(f32x4*)(outf + off + bj * HALF) = h0; *(f32x4*)(outf + off + bj * HALF + 4) = h1; }
                    else *(u32x4*)(h16out + off + bj * HALF) = pack8(h0, h1);
                    s += ((h0[0] * h0[0] + h0[1] * h0[1]) + (h0[2] * h0[2] + h0[3] * h0[3])) + ((h1[0] * h1[0] + h1[1] * h1[1]) + (h1[2] * h1[2] + h1[3] * h1[3])); }
                s += __shfl_xor(s, 16); s += __shfl_xor(s, 32);
                if (fq == 0) hpart[(size_t)row * 32 + u.pn * 4 + wc] = s;
                asm volatile("" ::: "memory"); }
    }
};
struct EpiGateFinal {
    static constexpr bool PERM = true, AFTER_DRAIN = true;
    const bf16_t* hin; float* outf; const bf16_t* PL; const float* plpart; const float* ple_norm; const float* fin_norm; float* xbuf; unsigned* cnt; float peps; int dry;
    __device__ __forceinline__ void fused(f32x4 (&acc)[2][2][4][2], const Unit& u, int wr, int wc, int fr, int fq, PG8_LAS unsigned char* lds, int wid, int lane) const {
        if (dry) return;
        PG8_LAS float* P = (PG8_LAS float*)lds;
        PG8_LAS float* S = (PG8_LAS float*)(lds + 4096);
        const int row0 = u.pm * BM + wr * 64 + fr, col0 = u.pn * BM + wc * 32 + 8 * fq;
        {
            f32x4 pn[2][2];
#pragma unroll
            for (int bj = 0; bj < 2; ++bj) { pn[bj][0] = *(const f32x4*)(ple_norm + col0 + bj * HALF); pn[bj][1] = *(const f32x4*)(ple_norm + col0 + bj * HALF + 4); }
#pragma unroll
            for (int ai = 0; ai < 2; ++ai)
#pragma unroll
                for (int m = 0; m < 4; ++m) { const int row = row0 + ai * HALF + m * 16; const size_t off = (size_t)row * 2048 + col0;
                    const float rs = rsqrtf(row_stat32(plpart, row, fq) * (1.f / 2048.f) + EPSN); float s = 0.f;
#pragma unroll
                    for (int bj = 0; bj < 2; ++bj) { const u32x4 pw = *(const u32x4*)(PL + off + bj * HALF), hw = *(const u32x4*)(hin + off + bj * HALF);
                        const f32x4 p0 = (f32x4){bflo(pw.x), bfhi(pw.x), bflo(pw.y), bfhi(pw.y)} * pn[bj][0] * rs, p1 = (f32x4){bflo(pw.z), bfhi(pw.z), bflo(pw.w), bfhi(pw.w)} * pn[bj][1] * rs;
                        f32x4 h0 = (f32x4){bflo(hw.x), bfhi(hw.x), bflo(hw.y), bfhi(hw.y)}, h1 = (f32x4){bflo(hw.z), bfhi(hw.z), bflo(hw.w), bfhi(hw.w)};
#pragma unroll
                        for (int j = 0; j < 4; ++j) { h0[j] += fsigmoid(acc[ai][bj][m][0][j]) * p0[j]; h1[j] += fsigmoid(acc[ai][bj][m][1][j]) * p1[j]; }
                        acc[ai][bj][m][0] = h0; acc[ai][bj][m][1] = h1;
                        s += ((h0[0] * h0[0] + h0[1] * h0[1]) + (h0[2] * h0[2] + h0[3] * h0[3])) + ((h1[0] * h1[0] + h1[1] * h1[1]) + (h1[2] * h1[2] + h1[3] * h1[3])); }
                    s += __shfl_xor(s, 16); s += __shfl_xor(s, 32);
                    if (fq == 0) P[(ai * HALF + wr * 64 + m * 16 + fr) * 4 + wc] = s;
                    asm volatile("" ::: "memory"); }
        }
        asm volatile("s_waitcnt lgkmcnt(0)" ::: "memory"); __builtin_amdgcn_s_barrier(); asm volatile("" ::: "memory");
        const int row = wid * 32 + (lane & 31);
        if (lane < 32) { const float s4 = (P[row * 4 + 0] + P[row * 4 + 1]) + (P[row * 4 + 2] + P[row * 4 + 3]);
            __hip_atomic_store(xbuf + (size_t)(u.pm * BM + row) * 8 + u.pn, s4, __ATOMIC_RELAXED, __HIP_MEMORY_SCOPE_AGENT); }
        asm volatile("s_waitcnt vmcnt(0)" ::: "memory");
        if (lane == 0) __hip_atomic_fetch_add(cnt + 64 * u.pm, 1u, __ATOMIC_RELAXED, __HIP_MEMORY_SCOPE_AGENT);
        if (wid == 0) {
            unsigned spins = 0;
            while ((unsigned)__builtin_amdgcn_readfirstlane(__hip_atomic_load(cnt + 64 * u.pm, __ATOMIC_RELAXED, __HIP_MEMORY_SCOPE_AGENT)) < 64u) { __builtin_amdgcn_s_sleep(2); if (++spins > (1u << 24)) break; }
            __builtin_amdgcn_fence(__ATOMIC_ACQUIRE, "agent");
        }
        asm volatile("s_waitcnt vmcnt(0) lgkmcnt(0)" ::: "memory"); __builtin_amdgcn_s_barrier(); asm volatile("" ::: "memory");
        if (lane < 32) { const float* xp = xbuf + (size_t)(u.pm * BM + row) * 8; float t = 0.f;
#pragma unroll
            for (int k = 0; k < 8; ++k) t += __hip_atomic_load(xp + k, __ATOMIC_RELAXED, __HIP_MEMORY_SCOPE_AGENT);
            S[row] = rsqrtf(t * (1.f / 2048.f) + EPSN); }
        asm volatile("s_waitcnt lgkmcnt(0)" ::: "memory"); __builtin_amdgcn_s_barrier(); asm volatile("" ::: "memory");
        f32x4 fn[2][2];
#pragma unroll
        for (int bj = 0; bj < 2; ++bj) { fn[bj][0] = *(const f32x4*)(fin_norm + col0 + bj * HALF); fn[bj][1] = *(const f32x4*)(fin_norm + col0 + bj * HALF + 4); }
#pragma unroll
        for (int ai = 0; ai < 2; ++ai)
#pragma unroll
            for (int m = 0; m < 4; ++m) { const int r = ai * HALF + wr * 64 + m * 16 + fr; const float rs = S[r]; const size_t off = (size_t)(u.pm * BM + r) * 2048 + col0;
#pragma unroll
                for (int bj = 0; bj < 2; ++bj) { *(f32x4*)(outf + off + bj * HALF) = acc[ai][bj][m][0] * fn[bj][0] * rs + peps; *(f32x4*)(outf + off + bj * HALF + 4) = acc[ai][bj][m][1] * fn[bj][1] * rs + peps; } }
    }
};
}

constexpr int NWAVES = 8;
constexpr int NB = 4, S = 2048, D = 2048, M = NB * S, PLE = 256;
constexpr float EPS = 1e-6f;
typedef unsigned short bf16_t;
typedef float f32x4 __attribute__((ext_vector_type(4)));
typedef unsigned v4u __attribute__((ext_vector_type(4)));
typedef unsigned v2u __attribute__((ext_vector_type(2)));

constexpr size_t MiB = 1u << 20;
constexpr size_t OFF_CTL = 0, CTL_ZERO_BYTES = 128 * 1024;
constexpr size_t OFF_WIN0 = 1 * MiB;
constexpr size_t OFF_WOUT0 = 25 * MiB;
constexpr size_t OFF_WG0 = 33 * MiB;
constexpr size_t OFF_WIN1 = 41 * MiB;
constexpr size_t OFF_WOUT1 = 73 * MiB;
constexpr size_t OFF_WG1 = 81 * MiB;
constexpr size_t OFF_PLEW = 89 * MiB;
constexpr size_t OFF_WGATE1 = 91 * MiB;
constexpr size_t OFF_SMALL = 91 * MiB + 65536;
constexpr size_t OFF_GATES1 = 92 * MiB;
constexpr size_t OFF_PART = 92 * MiB + 524288;
constexpr size_t OFF_A = 95 * MiB;
constexpr size_t OFF_B = 127 * MiB;
constexpr size_t OFF_U = 159 * MiB;
constexpr size_t WS_END = 255 * MiB;
constexpr size_t OFF_ACUM = OFF_B;
constexpr size_t OFF_CARRY = OFF_B + 17 * MiB;
constexpr size_t OFF_DECAY = OFF_B + 18 * MiB;
constexpr size_t OFF_WRT = OFF_SMALL + 65536;
constexpr int CW_FIN = 16384;
constexpr int CW_BAR = 4096;

constexpr int RING_BYTES = 131072;
constexpr int MISC_OFF = 147456 - 256;
constexpr int LDS_BYTES = 147456;

constexpr size_t UT = (size_t)8192 * 256;
__host__ __device__ __forceinline__ size_t uidx(size_t row, int col) { return ((size_t)(col >> 8) * 8192 + row) * 256 + (col & 255); }
#define LAS __attribute__((address_space(3)))
#define GAS __attribute__((address_space(1)))
__device__ __forceinline__ float bf2f(bf16_t b) { return __uint_as_float(((unsigned)b) << 16); }
typedef __bf16 bf16v2f_t __attribute__((ext_vector_type(2)));
typedef float f32v2f_t __attribute__((ext_vector_type(2)));
__device__ __forceinline__ unsigned f2bf(float f) { const f32v2f_t v = {f, 0.f}; return __builtin_bit_cast(unsigned, __builtin_convertvector(v, bf16v2f_t)) & 0xffffu; }
__device__ __forceinline__ unsigned pk2(float lo, float hi) { const f32v2f_t v = {lo, hi}; return __builtin_bit_cast(unsigned, __builtin_convertvector(v, bf16v2f_t)); }
__device__ __forceinline__ float sigmoidf_(float x) { return __builtin_amdgcn_rcpf(1.f + __expf(-x)); }
__device__ __forceinline__ float siluf_(float x) { return x * __builtin_amdgcn_rcpf(1.f + __expf(-x)); }
__device__ __forceinline__ float one_minus_exp(float x) { return x > -0.03f ? -x * (1.f + x * (0.5f + x * (0.16666667f + x * 0.041666668f))) : 1.f - __expf(x); }
__device__ __forceinline__ float wave_sum(float v) {
#pragma unroll
    for (int o = 1; o < 64; o <<= 1) v += __shfl_xor(v, o);
    return v;
}
#define LDS_WAIT() asm volatile("s_waitcnt lgkmcnt(0)" ::: "memory")
#define WG_BAR() asm volatile("s_waitcnt lgkmcnt(0)\n\ts_barrier" ::: "memory")
#define XB_TMO      128
#define XB_XCNT(j)  (256  + 64 * (j))
#define XB_XSUB(j)  (1280 + 64 * (j))
#define XB_XGEN(j)  (2304 + 64 * (j))
#define XB_TOP      3328
#define XB_TOPGEN   3392
#define XCD_BAR_WORDS 3456
#define XB_SPIN_CAP (1u << 26)

__device__ __forceinline__ unsigned xb_ld(unsigned* p)              { return __hip_atomic_load(p, __ATOMIC_RELAXED, __HIP_MEMORY_SCOPE_AGENT); }
__device__ __forceinline__ unsigned xb_add(unsigned* p, unsigned v) { return __hip_atomic_fetch_add(p, v, __ATOMIC_RELAXED, __HIP_MEMORY_SCOPE_AGENT); }
__device__ __forceinline__ unsigned xb_xcc_id() { return (unsigned)__builtin_amdgcn_s_getreg((3 << 11) | 20) & 0xFu; }
#define XB_SPIN(cond, bar) do { unsigned _sp = 0; while (cond) { __builtin_amdgcn_s_sleep(1); \
    if ((++_sp & 255u) == 0u) { if (xb_ld(&(bar)[XB_TMO])) break; if (_sp > XB_SPIN_CAP) { atomicAdd(&(bar)[XB_TMO], 1u); break; } } } } while (0)

struct XcdBarrier {
    unsigned* bar; unsigned x;
    volatile LAS unsigned* st;
};

__device__ __forceinline__ XcdBarrier xcd_barrier_post(unsigned* bar, volatile LAS unsigned* st) {
    XcdBarrier b; b.bar = bar; b.x = xb_xcc_id(); b.st = st;
    if (threadIdx.x == 0) (void)xb_add(&bar[XB_XCNT(b.x)], 1u);
    return b;
}
__device__ __forceinline__ void xcd_barrier_complete(unsigned* bar, unsigned x, unsigned& nloc, unsigned& nx) {
    const unsigned G = gridDim.x * gridDim.y * gridDim.z;
    unsigned sum, cnt, mine, sp = 0u;
    for (;;) {
        sum = 0u; cnt = 0u; mine = 0u;
#pragma unroll
        for (unsigned j = 0; j < 16; ++j) { const unsigned c = xb_ld(&bar[XB_XCNT(j)]); sum += c; cnt += (c > 0u) ? 1u : 0u; mine = (j == x) ? c : mine; }
        if (sum == G) break;
        __builtin_amdgcn_s_sleep(1);
        if ((++sp & 255u) == 0u) { if (xb_ld(&bar[XB_TMO])) break; if (sp > XB_SPIN_CAP) { atomicAdd(&bar[XB_TMO], 1u); break; } }
    }
    nloc = mine > 0u ? mine : 1u; nx = cnt > 0u ? cnt : 1u;
}

__device__ __forceinline__ void xcd_barrier(const XcdBarrier& b) {
    asm volatile("s_waitcnt vmcnt(0)" ::: "memory");
    __syncthreads();
    if (threadIdx.x == 0) {
        unsigned* bar = b.bar;
        __builtin_amdgcn_s_waitcnt(0);
        unsigned nloc = b.st[0], nx = b.st[1];
        if (nloc == 0u) { xcd_barrier_complete(bar, b.x, nloc, nx); b.st[0] = nloc; b.st[1] = nx; }
        const unsigned old = xb_add(&bar[XB_XSUB(b.x)], 1u);
        const unsigned gen = old / nloc;
        if (old + 1u == (gen + 1u) * nloc) {
            __builtin_amdgcn_fence(__ATOMIC_RELEASE, "agent");
            asm volatile("s_waitcnt vmcnt(0)" ::: "memory");
            const unsigned og = xb_add(&bar[XB_TOP], 1u);
            const unsigned tg = og / nx;
            if (og + 1u == (tg + 1u) * nx) xb_add(&bar[XB_TOPGEN], 1u);
            else XB_SPIN(xb_ld(&bar[XB_TOPGEN]) == tg, bar);
            __builtin_amdgcn_fence(__ATOMIC_ACQUIRE, "agent");
            xb_add(&bar[XB_XGEN(b.x)], 1u);
            asm volatile("s_waitcnt vmcnt(0)" ::: "memory");
        } else {
            XB_SPIN(xb_ld(&bar[XB_XGEN(b.x)]) == gen, bar);
            __builtin_amdgcn_fence(__ATOMIC_ACQUIRE, "agent");
            asm volatile("s_waitcnt vmcnt(0)" ::: "memory");
        }
    }
    __syncthreads();
}

struct Ptrs {
    const float* in[26]; float* out; unsigned char* ws; int ph_lo, ph_hi, li, dup;
};
__device__ __forceinline__ int srccol_in1(int n) {
    if (n < 4096) return n;
    const int r = n - 4096, j = r >> 8, i = r & 255;
    return i < 128 ? 4096 + 128 * j + i : 6144 + 128 * j + (i - 128);
}
__device__ __forceinline__ void p0_transpose_item(const float* __restrict__ W, int K, int ldw, bf16_t* __restrict__ WT, const float* __restrict__ gain, bool map1, int nblk, LAS float* scr, int item, int lane) {
    const int kb = item / nblk, nb = item % nblk, k0 = 64 * kb, n0 = 32 * nb, s0 = map1 ? srccol_in1(n0) : n0;
    float wv[32];
#pragma unroll
    for (int i = 0; i < 32; ++i) wv[i] = __builtin_nontemporal_load(W + (size_t)(k0 + 2 * i + (lane >> 5)) * ldw + s0 + (lane & 31));
    if (gain) {
#pragma unroll
        for (int i = 0; i < 32; ++i) wv[i] *= gain[k0 + 2 * i + (lane >> 5)];
    }
#pragma unroll
    for (int i = 0; i < 32; ++i) scr[(2 * i + (lane >> 5)) * 33 + (lane & 31)] = wv[i];
    LDS_WAIT(); asm volatile("" ::: "memory");
    const int c = lane & 7;
#pragma unroll
    for (int j = 0; j < 4; ++j) { const int n = (lane >> 3) + 8 * j; const LAS float* s = scr + (8 * c) * 33 + n;
        v4u o; o.x = pk2(s[0 * 33], s[1 * 33]); o.y = pk2(s[2 * 33], s[3 * 33]); o.z = pk2(s[4 * 33], s[5 * 33]); o.w = pk2(s[6 * 33], s[7 * 33]);
        *(v4u*)(WT + (size_t)(n0 + n) * K + k0 + 8 * c) = o; }
    LDS_WAIT(); asm volatile("" ::: "memory");
}
struct Frame {
    LAS unsigned char* lds; int tid, lane, wave, G, bid;
    const float* const* in; float* out; unsigned char* ws;
};
__device__ __forceinline__ void p0_layer1_weights_in(const Frame& F, int gw, int NGW) {
    LAS float* scr = (LAS float*)(F.lds + F.wave * 16384);
    unsigned char* ws = F.ws;
    const float* o_norm = F.in[14]; const float* o_w_in = F.in[15];
    constexpr int I_IN1 = 32 * 256;
    for (int it = gw; it < I_IN1; it += NGW) p0_transpose_item(o_w_in, 2048, 8208, (bf16_t*)(ws + OFF_WIN1), o_norm, true, 256, scr, it, F.lane);
    const int gt = gw * 64 + F.lane, NGT = NGW * 64;
    bf16_t* WGATE1 = (bf16_t*)(ws + OFF_WGATE1);
    for (int i = gt; i < 16 * 2048; i += NGT) { const int j = i >> 11, k = i & 2047; WGATE1[i] = (bf16_t)f2bf(o_w_in[(size_t)k * 8208 + 8192 + j] * o_norm[k]); }
}
__device__ __forceinline__ void p0_layer1_weights_out(const Frame& F, int gw, int NGW) {
    LAS float* scr = (LAS float*)(F.lds + F.wave * 16384);
    unsigned char* ws = F.ws;
    const float* o_w_out = F.in[21]; const float* ple_gate_w = F.in[24];
    constexpr int I_SQ = 32 * 64;
    for (int it = gw; it < 2 * I_SQ; it += NGW) {
        if (it < I_SQ) p0_transpose_item(o_w_out, 2048, 2048, (bf16_t*)(ws + OFF_WOUT1), nullptr, false, 64, scr, it, F.lane);
        else p0_transpose_item(ple_gate_w + (size_t)2048 * 2048, 2048, 2048, (bf16_t*)(ws + OFF_WG1), nullptr, false, 64, scr, it - I_SQ, F.lane);
    }
}
__device__ __forceinline__ void p0_prologue(const Frame& F) {
    LAS float* scr = (LAS float*)(F.lds + F.wave * 16384);
    const int gw = F.bid * NWAVES + F.wave, NGW = F.G * NWAVES;
    unsigned char* ws = F.ws;
    const float* e_norm = F.in[2]; const float* e_w_in = F.in[3]; const float* e_w_out = F.in[13]; const float* ple_w = F.in[22]; const float* ple_gate_w = F.in[24];
    constexpr int I_IN0 = 32 * 192, I_SQ = 32 * 64, I_PLE = 4 * 64;
    constexpr int NITEMS = I_IN0 + 2 * I_SQ + 2 * I_PLE;
    for (int it = gw; it < NITEMS; it += NGW) {
        int r = it;
        if (r < I_IN0) { p0_transpose_item(e_w_in, 2048, 6144, (bf16_t*)(ws + OFF_WIN0), e_norm, false, 192, scr, r, F.lane); continue; } r -= I_IN0;
        if (r < I_SQ) { p0_transpose_item(e_w_out, 2048, 2048, (bf16_t*)(ws + OFF_WOUT0), nullptr, false, 64, scr, r, F.lane); continue; } r -= I_SQ;
        if (r < I_SQ) { p0_transpose_item(ple_gate_w, 2048, 2048, (bf16_t*)(ws + OFF_WG0), nullptr, false, 64, scr, r, F.lane); continue; } r -= I_SQ;
        if (r < I_PLE) { p0_transpose_item(ple_w, 256, 2048, (bf16_t*)(ws + OFF_PLEW), nullptr, false, 64, scr, r, F.lane); continue; } r -= I_PLE;
        p0_transpose_item(ple_w + (size_t)256 * 2048, 256, 2048, (bf16_t*)(ws + OFF_PLEW) + (size_t)2048 * 256, nullptr, false, 64, scr, r, F.lane);
    }
    const float* x = F.in[0]; bf16_t* A = (bf16_t*)(ws + OFF_A); float* rstd0 = (float*)(ws + OFF_SMALL) + 1024;
    for (int m = gw; m < M; m += NGW) {
        const f32x4* xr = (const f32x4*)(x + (size_t)m * D) + F.lane; f32x4 v[8]; float s = 0.f;
#pragma unroll
        for (int j = 0; j < 8; ++j) { v[j] = __builtin_nontemporal_load(xr + 64 * j); s += (v[j].x * v[j].x + v[j].y * v[j].y) + (v[j].z * v[j].z + v[j].w * v[j].w); }
        s = wave_sum(s);
        v2u* o8 = (v2u*)(A + (size_t)m * D) + F.lane;
#pragma unroll
        for (int j = 0; j < 8; ++j) { v2u w; w.x = pk2(v[j].x, v[j].y); w.y = pk2(v[j].z, v[j].w); o8[64 * j] = w; }
        if (F.lane == 0) rstd0[m] = rsqrtf(s * (1.f / D) + EPS);
    }
    const int gt = F.bid * (NWAVES * 64) + F.tid, NGT = F.G * NWAVES * 64;
    bf16_t* WRT = (bf16_t*)(ws + OFF_WRT); const float* w_r = F.in[8]; const float* w_i = F.in[10];
    for (int i = gt; i < 2 * 131072; i += NGT) { const int j = i & 131071, n = j >> 14, d = (j >> 7) & 127, cc = j & 127; WRT[i] = (bf16_t)f2bf(((i >> 17) ? w_i : w_r)[n * 16384 + cc * 128 + d]); }
    float* lb = (float*)(ws + OFF_SMALL); const float* logits = F.in[4];
    for (int c = gt; c < 1024; c += NGT) lb[c] = 1.f / (1.f + expf(logits[1024 + c] - logits[c]));
}
__device__ __forceinline__ void gates1_phase(const Frame& F, const int dry) {
    const bf16_t* A = (const bf16_t*)(F.ws + OFF_A); const bf16_t* WG = (const bf16_t*)(F.ws + OFF_WGATE1);
    const float* hpart = (const float*)(F.ws + OFF_PART) + (size_t)M * 32; float* gates = (float*)(F.ws + OFF_GATES1);
    const int gw = F.bid * NWAVES + F.wave, NGW = F.G * NWAVES;
    for (int row = gw; row < M; row += NGW) {
        float ss = (F.lane < 32) ? hpart[(size_t)row * 32 + F.lane] : 0.f; ss = wave_sum(ss);
        const float sc = rsqrtf(ss * (1.f / D) + EPS);
        float a[32];
        const v4u* ar = (const v4u*)(A + (size_t)row * D) + F.lane;
#pragma unroll
        for (int j = 0; j < 4; ++j) { const v4u w = ar[64 * j]; a[8 * j + 0] = pg8::bflo(w.x); a[8 * j + 1] = pg8::bfhi(w.x); a[8 * j + 2] = pg8::bflo(w.y); a[8 * j + 3] = pg8::bfhi(w.y);
            a[8 * j + 4] = pg8::bflo(w.z); a[8 * j + 5] = pg8::bfhi(w.z); a[8 * j + 6] = pg8::bflo(w.w); a[8 * j + 7] = pg8::bfhi(w.w); }
        float res = 0.f;
        for (int g = 0; g < 16; ++g) {
            const v4u* wr = (const v4u*)(WG + (size_t)g * D) + F.lane; float s = 0.f;
#pragma unroll
            for (int j = 0; j < 4; ++j) { const v4u w = wr[64 * j];
                s += a[8 * j + 0] * pg8::bflo(w.x) + a[8 * j + 1] * pg8::bfhi(w.x) + a[8 * j + 2] * pg8::bflo(w.y) + a[8 * j + 3] * pg8::bfhi(w.y)
                   + a[8 * j + 4] * pg8::bflo(w.z) + a[8 * j + 5] * pg8::bfhi(w.z) + a[8 * j + 6] * pg8::bflo(w.w) + a[8 * j + 7] * pg8::bfhi(w.w); }
            s = wave_sum(s);
            res = (F.lane == g) ? s * sc : res;
        }
        if (F.lane < 16 && !dry) gates[(size_t)row * 16 + F.lane] = res;
    }
}

__device__ __forceinline__ void cvt_p_phase(const Frame& F, const int dry) {
    const float* p = F.in[1]; bf16_t* P16 = (bf16_t*)(F.ws + OFF_WIN0);
    const size_t n4 = (size_t)2 * M * PLE / 4, gt = (size_t)F.bid * (NWAVES * 64) + F.tid, NGT = (size_t)F.G * NWAVES * 64;
    for (size_t i = gt; i < n4; i += NGT) { const f32x4 v = __builtin_nontemporal_load((const f32x4*)p + i); v2u w; w.x = pk2(v.x, v.y); w.y = pk2(v.z, v.w); if (!dry) ((v2u*)P16)[i] = w; }
}

typedef short bf16x8_t __attribute__((ext_vector_type(8)));
typedef float f32x16 __attribute__((ext_vector_type(16)));
typedef float f32x4_t __attribute__((ext_vector_type(4)));
typedef short bf16x4_t __attribute__((ext_vector_type(4)));
__device__ __forceinline__ bf16x8_t pack_bf16x8(float a0, float a1, float a2, float a3, float a4, float a5, float a6, float a7) {
    v4u w; w.x = pg8::cvt_pk_bf16(a0, a1); w.y = pg8::cvt_pk_bf16(a2, a3); w.z = pg8::cvt_pk_bf16(a4, a5); w.w = pg8::cvt_pk_bf16(a6, a7);
    return __builtin_bit_cast(bf16x8_t, w);
}
__device__ __forceinline__ bf16x8_t cat_bf16x4(v2u lo, v2u hi) { v4u w; w.x = lo.x; w.y = lo.y; w.z = hi.x; w.w = hi.y; return __builtin_bit_cast(bf16x8_t, w); }


struct LruRaw { unsigned short xv[19]; float cw[4], cb, brv, biv, lamv; };
__device__ __forceinline__ void rglru_a_load(const Frame& F, int b, int c, int n, LruRaw& r) {
    const int d = F.tid & 127, q = F.tid >> 7, ch = n * 128 + d, t0 = c * 64;
    const bf16_t* U = (const bf16_t*)(F.ws + OFF_U);
#pragma unroll
    for (int i = 0; i < 19; ++i) { const int t = t0 + 16 * q - 3 + i; r.xv[i] = (t >= 0) ? U[uidx((size_t)b * S + t, 4096 + ch)] : (unsigned short)0; }
    const float* conv_w = F.in[6];
#pragma unroll
    for (int k = 0; k < 4; ++k) r.cw[k] = conv_w[k * 1024 + ch];
    r.cb = F.in[7][ch];
    const int chc = n * 128 + 32 * (F.wave & 3) + (F.lane & 31);
    r.brv = F.in[9][chc]; r.biv = F.in[11][chc]; r.lamv = F.in[12][chc];
}
__device__ __forceinline__ void rglru_a_item(const Frame& F, const int dry, int b, int c, int n, const LruRaw& raw) {
    constexpr int XS = 136;
    LAS bf16_t* XT = (LAS bf16_t*)F.lds;
    LAS float* AL = (LAS float*)(F.lds + 17408);
    LAS float* ML = AL + 8192;
    LAS float* AGG = ML + 8192;
    LAS bf16_t* HT = (LAS bf16_t*)(AGG + 1024);
    LAS bf16_t* CT = HT + 64 * 136;
    const bf16_t* U = (const bf16_t*)(F.ws + OFF_U); bf16_t* HL = (bf16_t*)(F.ws + OFF_A); bf16_t* AC = (bf16_t*)(F.ws + OFF_ACUM); float* carry = (float*)(F.ws + OFF_CARRY);
    const bf16_t* WRT = (const bf16_t*)(F.ws + OFF_WRT) + (size_t)n * 16384; const bf16_t* WIT = WRT + 8 * 16384;
    const float* conv_w = F.in[6]; const float* conv_b = F.in[7]; const float* b_r = F.in[9]; const float* b_i = F.in[11]; const float* lam = F.in[12];
    const int tid = F.tid, d = tid & 127, q = tid >> 7, ch = n * 128 + d, t0 = c * 64;
    const size_t row0 = (size_t)b * S + t0;
    float xc[16];
    {
        float xv[19];
#pragma unroll
        for (int i = 0; i < 19; ++i) xv[i] = bf2f(raw.xv[i]);
        const float cw0 = raw.cw[0], cw1 = raw.cw[1], cw2 = raw.cw[2], cw3 = raw.cw[3], cb = raw.cb;
#pragma unroll
        for (int i = 0; i < 16; ++i) { xc[i] = cb + cw0 * xv[i] + cw1 * xv[i + 1] + cw2 * xv[i + 2] + cw3 * xv[i + 3]; XT[(16 * q + i) * XS + d] = (bf16_t)f2bf(xc[i]); }
    }
    WG_BAR();
    {
        const int w = F.wave, tt = w >> 2, db = w & 3, l31 = F.lane & 31, hh = F.lane >> 5;
        f32x16 accR, accI;
#pragma unroll
        for (int r = 0; r < 16; ++r) { accR[r] = 0.f; accI[r] = 0.f; }
        const LAS bf16_t* ap = XT + (32 * tt + l31) * XS + 8 * hh;
        const bf16_t* rp = WRT + (size_t)(32 * db + l31) * 128 + 8 * hh; const bf16_t* ip = WIT + (size_t)(32 * db + l31) * 128 + 8 * hh;
#pragma unroll
        for (int ks = 0; ks < 8; ++ks) {
            const bf16x8_t a = *(const LAS bf16x8_t*)(ap + 16 * ks), br_ = *(const bf16x8_t*)(rp + 16 * ks), bi_ = *(const bf16x8_t*)(ip + 16 * ks);
            accR = __builtin_amdgcn_mfma_f32_32x32x16_bf16(a, br_, accR, 0, 0, 0);
            accI = __builtin_amdgcn_mfma_f32_32x32x16_bf16(a, bi_, accI, 0, 0, 0);
        }
        const int dc = 32 * db + l31, chc = n * 128 + dc;
        const float brv = raw.brv, biv = raw.biv, ey_ = __expf(-raw.lamv), sp = ey_ > 0.02f ? __logf(1.f + ey_) : ey_ * (1.f - ey_ * (0.5f - ey_ * 0.33333334f));
#pragma unroll
        for (int r = 0; r < 16; ++r) {
            const int t = 32 * tt + (r & 3) + 8 * (r >> 2) + 4 * hh;
            const float rr = sigmoidf_(accR[r] + brv), ii = sigmoidf_(accI[r] + biv), la = -8.f * rr * sp;
            AL[t * 128 + dc] = __expf(la); ML[t * 128 + dc] = __builtin_amdgcn_sqrtf(one_minus_exp(2.f * la)) * ii;
        }
    }
    WG_BAR();
    float hl[16], ac[16];
    {
        float h = 0.f, Ac = 1.f;
#pragma unroll
        for (int i = 0; i < 16; ++i) { const int t = 16 * q + i; const float a = AL[t * 128 + d], u = ML[t * 128 + d] * xc[i]; h = a * h + u; Ac *= a; hl[i] = h; ac[i] = Ac; }
        AGG[(q * 2 + 0) * 128 + d] = Ac; AGG[(q * 2 + 1) * 128 + d] = h;
    }
    WG_BAR();
    {
        float Hp = 0.f, Ap = 1.f;
#pragma unroll
        for (int qq = 0; qq < 3; ++qq) if (qq < q) { const float a = AGG[(qq * 2 + 0) * 128 + d], hh_ = AGG[(qq * 2 + 1) * 128 + d]; Hp = a * Hp + hh_; Ap *= a; }
#pragma unroll
        for (int i = 0; i < 16; ++i) { const size_t row = row0 + 16 * q + i; const float hv = hl[i] + ac[i] * Hp, av = ac[i] * Ap;
            HT[(16 * q + i) * 136 + d] = (bf16_t)f2bf(hv); CT[(16 * q + i) * 136 + d] = (bf16_t)f2bf(av);
            if (q == 3 && i == 15 && !dry) { float* cp = carry + ((size_t)((b * 32 + c) * 8 + n)) * 256; cp[d] = av; cp[128 + d] = hv; } }
    }
    WG_BAR();
#pragma unroll
    for (int j = 0; j < 2; ++j) { const int p = tid + 512 * j, t_ = p >> 4, c16 = p & 15; const bf16x8_t h_ = *(const LAS bf16x8_t*)(HT + t_ * 136 + c16 * 8), a_ = *(const LAS bf16x8_t*)(CT + t_ * 136 + c16 * 8);
        if (!dry) { *(bf16x8_t*)(HL + (row0 + t_) * D + 1024 + n * 128 + c16 * 8) = h_; *(bf16x8_t*)(AC + (row0 + t_) * 1024 + n * 128 + c16 * 8) = a_; } }
    WG_BAR();
}
__device__ __forceinline__ void rglru_b_item(const Frame& F, const int dry, int b, int c, int n) {
    LAS float* HC = (LAS float*)F.lds;
    const bf16_t* U = (const bf16_t*)(F.ws + OFF_U); bf16_t* Y = (bf16_t*)(F.ws + OFF_A); const bf16_t* AC = (const bf16_t*)(F.ws + OFF_ACUM); const float* carry = (const float*)(F.ws + OFF_CARRY);
    const int tid = F.tid;
    const size_t row0 = (size_t)b * S + c * 64;
    bf16x8_t hl[2], av[2], zb[2];
#pragma unroll
    for (int j = 0; j < 2; ++j) { const int p = tid + 512 * j, t_ = p >> 4, c16 = p & 15; const size_t row = row0 + t_;
        hl[j] = __builtin_nontemporal_load((const bf16x8_t*)(Y + row * D + 1024 + n * 128 + c16 * 8)); av[j] = __builtin_nontemporal_load((const bf16x8_t*)(AC + row * 1024 + n * 128 + c16 * 8)); zb[j] = __builtin_nontemporal_load((const bf16x8_t*)(U + uidx(row, 5120 + n * 128 + c16 * 8))); }
    if (tid < 128) { float H = 0.f;
        for (int cc = 0; cc < c; ++cc) { const float* cp = carry + ((size_t)((b * 32 + cc) * 8 + n)) * 256; H = cp[tid] * H + cp[128 + tid]; }
        HC[tid] = H; }
    WG_BAR();
#pragma unroll
    for (int j = 0; j < 2; ++j) { const int p = tid + 512 * j, t_ = p >> 4, c16 = p & 15; const size_t row = row0 + t_;
        const v4u hw = __builtin_bit_cast(v4u, hl[j]), aw = __builtin_bit_cast(v4u, av[j]), zw = __builtin_bit_cast(v4u, zb[j]);
        const f32x4_t H0 = *(const LAS f32x4_t*)(HC + c16 * 8), H1 = *(const LAS f32x4_t*)(HC + c16 * 8 + 4);
        const bf16x8_t y_ = pack_bf16x8((pg8::bflo(hw.x) + pg8::bflo(aw.x) * H0[0]) * siluf_(pg8::bflo(zw.x)), (pg8::bfhi(hw.x) + pg8::bfhi(aw.x) * H0[1]) * siluf_(pg8::bfhi(zw.x)),
                                        (pg8::bflo(hw.y) + pg8::bflo(aw.y) * H0[2]) * siluf_(pg8::bflo(zw.y)), (pg8::bfhi(hw.y) + pg8::bfhi(aw.y) * H0[3]) * siluf_(pg8::bfhi(zw.y)),
                                        (pg8::bflo(hw.z) + pg8::bflo(aw.z) * H1[0]) * siluf_(pg8::bflo(zw.z)), (pg8::bfhi(hw.z) + pg8::bfhi(aw.z) * H1[1]) * siluf_(pg8::bfhi(zw.z)),
                                        (pg8::bflo(hw.w) + pg8::bflo(aw.w) * H1[2]) * siluf_(pg8::bflo(zw.w)), (pg8::bfhi(hw.w) + pg8::bfhi(aw.w) * H1[3]) * siluf_(pg8::bfhi(zw.w)));
        if (!dry) *(bf16x8_t*)(Y + row * D + 1024 + n * 128 + c16 * 8) = y_; }
    WG_BAR();
}

struct H2Raw { unsigned short qa[16], fa[16], vv[16]; float lbv; };
__device__ __forceinline__ void hgrn2_a_load(const Frame& F, int b, int c, int h, H2Raw& r) {
    const int d = F.tid & 127, q = F.tid >> 7;
    const bf16_t* up = (const bf16_t*)(F.ws + OFF_U) + uidx((size_t)b * S + c * 64 + 16 * q, h * 128 + d);
#pragma unroll
    for (int i = 0; i < 16; ++i) { r.qa[i] = up[(size_t)i * 256]; r.fa[i] = up[(size_t)i * 256 + 4 * UT]; r.vv[i] = up[(size_t)i * 256 + 8 * UT]; }
    r.lbv = ((const float*)(F.ws + OFF_SMALL))[h * 128 + d];
}
__device__ __forceinline__ void hgrn2_a_item(const Frame& F, const int dry, int b, int c, int h, const H2Raw& raw) {
    constexpr int QS = 136, VS = 72;
    LAS bf16_t* QT = (LAS bf16_t*)F.lds;
    LAS bf16_t* KT = QT + 64 * QS;
    LAS bf16_t* VT = KT + 64 * QS;
    LAS bf16_t* AT = VT + 128 * VS;
    LAS float* CS = (LAS float*)(AT + 64 * VS);
    LAS bf16_t* KDT = (LAS bf16_t*)(CS + 512);
    LAS bf16_t* OTL = KDT + 128 * VS;
    bf16_t* U = (bf16_t*)(F.ws + OFF_U); bf16_t* OI = (bf16_t*)(F.ws + OFF_A); float* decay = (float*)(F.ws + OFF_DECAY);
    const float* lb = (const float*)(F.ws + OFF_SMALL);
    const int tid = F.tid, d = tid & 127, q = tid >> 7, t0 = c * 64;
    const size_t row0 = (size_t)b * S + t0;
    {
        const float lbv = raw.lbv;
        float qa[16], fa[16], vv[16];
#pragma unroll
        for (int i = 0; i < 16; ++i) { qa[i] = bf2f(raw.qa[i]); fa[i] = bf2f(raw.fa[i]); vv[i] = bf2f(raw.vv[i]); }
        float cs[16]; float run = 0.f;
#pragma unroll
        for (int i = 0; i < 16; ++i) { const float e_ = __expf(-fa[i]), sg = __builtin_amdgcn_rcpf(1.f + e_); run += __logf(lbv + (1.f - lbv) * sg); cs[i] = run; fa[i] = (1.f - lbv) * e_ * sg; }
        CS[q * 128 + d] = run;
        WG_BAR();
        float off = 0.f, tot = 0.f;
#pragma unroll
        for (int qq = 0; qq < 4; ++qq) { const float v_ = CS[qq * 128 + d]; off += (qq < q) ? v_ : 0.f; tot += v_; }
        float kd[16];
        const float etot = __expf(tot);
#pragma unroll
        for (int i = 0; i < 16; ++i) { const float bt = off + cs[i], k = fa[i], eb_ = __expf(bt), ei_ = __builtin_amdgcn_rcpf(eb_), kei = k * ei_;
            QT[(16 * q + i) * QS + d] = (bf16_t)f2bf(siluf_(qa[i]) * eb_); KT[(16 * q + i) * QS + d] = (bf16_t)f2bf(kei); kd[i] = kei * etot; }
        const bf16x8_t k0 = pack_bf16x8(kd[0], kd[1], kd[2], kd[3], kd[4], kd[5], kd[6], kd[7]), k1 = pack_bf16x8(kd[8], kd[9], kd[10], kd[11], kd[12], kd[13], kd[14], kd[15]);
        const bf16x8_t v0 = pack_bf16x8(vv[0], vv[1], vv[2], vv[3], vv[4], vv[5], vv[6], vv[7]), v1 = pack_bf16x8(vv[8], vv[9], vv[10], vv[11], vv[12], vv[13], vv[14], vv[15]);
        *(LAS bf16x8_t*)(VT + d * VS + 16 * q) = v0; *(LAS bf16x8_t*)(VT + d * VS + 16 * q + 8) = v1;
        *(LAS bf16x8_t*)(KDT + d * VS + 16 * q) = k0; *(LAS bf16x8_t*)(KDT + d * VS + 16 * q + 8) = k1;
        WG_BAR();
#pragma unroll
        for (int j = 0; j < 2; ++j) { const int p = tid + 512 * j, dd = p >> 3, c8 = p & 7; bf16_t* tp = U + uidx(row0 + (dd >> 1), h * 128 + (dd & 1) * 64 + c8 * 8);
            const bf16x8_t k_ = *(const LAS bf16x8_t*)(KDT + dd * VS + c8 * 8), v_ = *(const LAS bf16x8_t*)(VT + dd * VS + c8 * 8);
            if (!dry) { *(bf16x8_t*)(tp + 4 * UT) = k_; *(bf16x8_t*)(tp + 8 * UT) = v_; } }
        if (q == 0 && !dry) decay[((size_t)((b * 32 + c) * 8 + h)) * 128 + d] = __expf(tot);
    }
    {
        const int w = F.wave, tb = w >> 1, r = F.lane & 15, g = F.lane >> 4;
#pragma unroll
        for (int k2 = 0; k2 < 2; ++k2) {
            const int sb = 2 * (w & 1) + k2;
            f32x4_t acc = {0.f, 0.f, 0.f, 0.f};
            if (sb <= tb) {
#pragma unroll
                for (int ks = 0; ks < 4; ++ks) {
                    const bf16x8_t a = *(const LAS bf16x8_t*)(QT + (16 * tb + r) * QS + 32 * ks + 8 * g), bb = *(const LAS bf16x8_t*)(KT + (16 * sb + r) * QS + 32 * ks + 8 * g);
                    acc = __builtin_amdgcn_mfma_f32_16x16x32_bf16(a, bb, acc, 0, 0, 0);
                }
            }
#pragma unroll
            for (int j = 0; j < 4; ++j) { const int t = 16 * tb + 4 * g + j, s = 16 * sb + r; AT[t * VS + s] = (bf16_t)f2bf(s <= t ? acc[j] : 0.f); }
        }
    }
    WG_BAR();
    {
        const int w = F.wave, th = w >> 2, eb = w & 3, l31 = F.lane & 31, hh = F.lane >> 5;
        f32x16 acc;
#pragma unroll
        for (int r = 0; r < 16; ++r) acc[r] = 0.f;
#pragma unroll
        for (int ks = 0; ks < 4; ++ks) {
            const bf16x8_t a = *(const LAS bf16x8_t*)(AT + (32 * th + l31) * VS + 16 * ks + 8 * hh), bb = *(const LAS bf16x8_t*)(VT + (32 * eb + l31) * VS + 16 * ks + 8 * hh);
            acc = __builtin_amdgcn_mfma_f32_32x32x16_bf16(a, bb, acc, 0, 0, 0);
        }
#pragma unroll
        for (int r = 0; r < 16; ++r) { const int t = 32 * th + (r & 3) + 8 * (r >> 2) + 4 * hh; OTL[t * 136 + 32 * eb + l31] = (bf16_t)f2bf(acc[r]); }
#pragma unroll
        for (int j = 0; j < 2; ++j) { const int p = tid + 512 * j, row = p >> 4, c16 = p & 15; const bf16x8_t qv_ = *(const LAS bf16x8_t*)(QT + row * QS + c16 * 8); if (!dry) *(bf16x8_t*)(U + uidx(row0 + row, h * 128 + c16 * 8)) = qv_; }
    }
    WG_BAR();
#pragma unroll
    for (int j = 0; j < 2; ++j) { const int p = tid + 512 * j, t_ = p >> 4, c16 = p & 15; const bf16x8_t o_ = *(const LAS bf16x8_t*)(OTL + t_ * 136 + c16 * 8);
        if (!dry) *(bf16x8_t*)(OI + (row0 + t_) * D + h * 128 + c16 * 8) = o_; }
    WG_BAR();
}

__device__ __forceinline__ void hgrn2_b_phase(const Frame& F, const int dry, int b, int h) {
    constexpr int QS = 132, VS = 72;
    LAS bf16_t* QB = (LAS bf16_t*)F.lds;
    LAS bf16_t* KB = QB + 64 * QS;
    LAS bf16_t* VB = KB + 128 * VS;
    LAS float* DEC = (LAS float*)(VB + 128 * VS);
    LAS float* OT = DEC + 128;
    bf16_t* U = (bf16_t*)(F.ws + OFF_U); const float* decay = (const float*)(F.ws + OFF_DECAY);
    const int tid = F.tid, w = F.wave, eb = w & 3, dh = w >> 2, l31 = F.lane & 31, hh = F.lane >> 5;
    f32x16 X[2];
#pragma unroll
    for (int xi = 0; xi < 2; ++xi)
#pragma unroll
        for (int r = 0; r < 16; ++r) X[xi][r] = 0.f;
    bf16x8_t pq[2], pk[2], pv[2]; float pdec = 0.f;
    {
        const size_t row0 = (size_t)b * S;
#pragma unroll
        for (int j = 0; j < 2; ++j) { const int p = tid + 512 * j; const bf16_t* up = U + uidx(row0 + (p >> 4), h * 128 + (p & 15) * 8);
            pq[j] = *(const bf16x8_t*)up; pk[j] = *(const bf16x8_t*)(up + 4 * UT); pv[j] = *(const bf16x8_t*)(up + 8 * UT); }
        if (tid < 128) pdec = decay[((size_t)((b * 32 + 0) * 8 + h)) * 128 + tid];
    }
    for (int c = 0; c < 32; ++c) {
        const size_t row0 = (size_t)b * S + c * 64;
#pragma unroll
        for (int j = 0; j < 2; ++j) { const int p = tid + 512 * j, ur = p >> 4, c16 = p & 15;
            { const v4u w4 = __builtin_bit_cast(v4u, pq[j]); v2u lo, hi; lo.x = w4.x; lo.y = w4.y; hi.x = w4.z; hi.y = w4.w; *(LAS v2u*)(QB + ur * QS + c16 * 8) = lo; *(LAS v2u*)(QB + ur * QS + c16 * 8 + 4) = hi; }
            *(LAS bf16x8_t*)(KB + (2 * ur + (c16 >> 3)) * VS + (c16 & 7) * 8) = pk[j];
            *(LAS bf16x8_t*)(VB + (2 * ur + (c16 >> 3)) * VS + (c16 & 7) * 8) = pv[j]; }
        if (tid < 128) DEC[tid] = pdec;
        WG_BAR();
        if (c + 1 < 32) {
            const size_t rn = row0 + 64;
#pragma unroll
            for (int j = 0; j < 2; ++j) { const int p = tid + 512 * j; const bf16_t* up = U + uidx(rn + (p >> 4), h * 128 + (p & 15) * 8);
                pq[j] = *(const bf16x8_t*)up; pk[j] = *(const bf16x8_t*)(up + 4 * UT); pv[j] = *(const bf16x8_t*)(up + 8 * UT); }
            if (tid < 128) pdec = decay[((size_t)((b * 32 + c + 1) * 8 + h)) * 128 + tid];
        }
        f32x16 accT[2];
#pragma unroll
        for (int tt = 0; tt < 2; ++tt)
#pragma unroll
            for (int r = 0; r < 16; ++r) accT[tt][r] = 0.f;
#pragma unroll
        for (int xi = 0; xi < 2; ++xi)
#pragma unroll
            for (int s = 0; s < 2; ++s) {
                const bf16x8_t a = pack_bf16x8(X[xi][8 * s + 0], X[xi][8 * s + 1], X[xi][8 * s + 2], X[xi][8 * s + 3], X[xi][8 * s + 4], X[xi][8 * s + 5], X[xi][8 * s + 6], X[xi][8 * s + 7]);
#pragma unroll
                for (int tt = 0; tt < 2; ++tt) {
                    const LAS bf16_t* qp = QB + (32 * tt + l31) * QS + 64 * dh + 32 * xi + 16 * s + 4 * hh;
                    const bf16x8_t bq = cat_bf16x4(*(const LAS v2u*)qp, *(const LAS v2u*)(qp + 8));
                    accT[tt] = __builtin_amdgcn_mfma_f32_32x32x16_bf16(a, bq, accT[tt], 0, 0, 0);
                }
            }
#pragma unroll
        for (int xi = 0; xi < 2; ++xi) {
#pragma unroll
            for (int g4 = 0; g4 < 4; ++g4) { const f32x4_t dv = *(const LAS f32x4_t*)(DEC + 64 * dh + 32 * xi + 8 * g4 + 4 * hh);
                X[xi][4 * g4 + 0] *= dv[0]; X[xi][4 * g4 + 1] *= dv[1]; X[xi][4 * g4 + 2] *= dv[2]; X[xi][4 * g4 + 3] *= dv[3]; }
#pragma unroll
            for (int ks = 0; ks < 4; ++ks) {
                const bf16x8_t a = *(const LAS bf16x8_t*)(KB + (64 * dh + 32 * xi + l31) * VS + 16 * ks + 8 * hh), bv = *(const LAS bf16x8_t*)(VB + (32 * eb + l31) * VS + 16 * ks + 8 * hh);
                X[xi] = __builtin_amdgcn_mfma_f32_32x32x16_bf16(a, bv, X[xi], 0, 0, 0);
            }
        }
#pragma unroll
        for (int tt = 0; tt < 2; ++tt)
#pragma unroll
            for (int g4 = 0; g4 < 4; ++g4) { const f32x4_t ov = {accT[tt][4 * g4 + 0], accT[tt][4 * g4 + 1], accT[tt][4 * g4 + 2], accT[tt][4 * g4 + 3]};
                *(LAS f32x4_t*)(OT + (dh * 64 + 32 * tt + l31) * 132 + 32 * eb + 8 * g4 + 4 * hh) = ov; }
        WG_BAR();
#pragma unroll
        for (int j = 0; j < 2; ++j) { const int p = tid + 512 * j, t_ = p >> 4, c16 = p & 15; const LAS float* o0 = OT + t_ * 132 + c16 * 8; const LAS float* o1 = o0 + 64 * 132;
            const f32x4_t a0 = *(const LAS f32x4_t*)o0 + *(const LAS f32x4_t*)o1, a1 = *(const LAS f32x4_t*)(o0 + 4) + *(const LAS f32x4_t*)(o1 + 4);
            const bf16x8_t o_ = pack_bf16x8(a0[0], a0[1], a0[2], a0[3], a1[0], a1[1], a1[2], a1[3]);
            if (!dry) *(bf16x8_t*)(U + uidx(row0 + t_, h * 128 + c16 * 8)) = o_; }
    }
}

__device__ __forceinline__ void hgrn2_c_item(const Frame& F, const int dry, int b, int c, int h) {
    const bf16_t* U = (const bf16_t*)(F.ws + OFF_U); bf16_t* Y = (bf16_t*)(F.ws + OFF_A); const float* a_norm = F.in[5];
    const int w = F.wave, l31 = F.lane & 31, hh = F.lane >> 5;
    const size_t row0 = (size_t)b * S + c * 64;
    const f32x4_t an = *(const f32x4_t*)(a_norm + h * 128 + 4 * l31);
    v2u oi[4], p0[4], zz[4];
#pragma unroll
    for (int i = 0; i < 4; ++i) { const size_t row = row0 + 8 * w + 2 * i + hh;
        oi[i] = __builtin_nontemporal_load((const v2u*)(Y + row * D + h * 128 + 4 * l31)); p0[i] = __builtin_nontemporal_load((const v2u*)(U + uidx(row, h * 128 + 4 * l31)));
        zz[i] = __builtin_nontemporal_load((const v2u*)(U + uidx(row, 3072 + h * 128 + 4 * l31))); }
#pragma unroll
    for (int i = 0; i < 4; ++i) { const size_t row = row0 + 8 * w + 2 * i + hh;
        const float o0 = pg8::bflo(oi[i].x) + pg8::bflo(p0[i].x), o1 = pg8::bfhi(oi[i].x) + pg8::bfhi(p0[i].x);
        const float o2 = pg8::bflo(oi[i].y) + pg8::bflo(p0[i].y), o3 = pg8::bfhi(oi[i].y) + pg8::bfhi(p0[i].y);
        float ss = (o0 * o0 + o1 * o1) + (o2 * o2 + o3 * o3);
        ss += __shfl_xor(ss, 1); ss += __shfl_xor(ss, 2); ss += __shfl_xor(ss, 4); ss += __shfl_xor(ss, 8); ss += __shfl_xor(ss, 16);
        const float rs = rsqrtf(ss * (1.f / 128.f) + EPS);
        v2u yw; yw.x = pg8::cvt_pk_bf16(o0 * rs * an[0] * siluf_(pg8::bflo(zz[i].x)), o1 * rs * an[1] * siluf_(pg8::bfhi(zz[i].x)));
        yw.y = pg8::cvt_pk_bf16(o2 * rs * an[2] * siluf_(pg8::bflo(zz[i].y)), o3 * rs * an[3] * siluf_(pg8::bfhi(zz[i].y)));
        if (!dry) *(v2u*)(Y + row * D + h * 128 + 4 * l31) = yw; }
}

constexpr size_t OFF_MS = OFF_PART;
constexpr size_t OFF_ITEM1 = OFF_PART + 1 * MiB;

struct MlRaw { unsigned short xq[19], xk[19], vv[32]; float gi, gf, cwq[4], cbq, cwk[4], cbk; };
__device__ __forceinline__ void mlstm_a_load(const Frame& F, int b, int c, int h, MlRaw& r) {
    const bf16_t* U = (const bf16_t*)(F.ws + OFF_U);
    const int tid = F.tid, d = tid & 127, qq = tid >> 7, t0 = c * 64;
#pragma unroll
    for (int i = 0; i < 19; ++i) { const int t = t0 + 16 * qq - 3 + i; const bool ok = t >= 0; const bf16_t* up = U + uidx((size_t)b * S + (ok ? t : 0), h * 128 + d);
        r.xq[i] = ok ? up[0] : (unsigned short)0; r.xk[i] = ok ? up[4 * UT] : (unsigned short)0; }
    const int e = tid & 255, hf = tid >> 8;
    const bf16_t* vp = U + uidx((size_t)b * S + t0 + 32 * hf, 2048 + h * 256 + e);
#pragma unroll
    for (int i = 0; i < 32; ++i) r.vv[i] = vp[(size_t)i * 256];
    const float* gates = (const float*)(F.ws + OFF_GATES1); const size_t grow = (size_t)b * S + t0 + F.lane;
    r.gi = gates[grow * 16 + h]; r.gf = gates[grow * 16 + 8 + h];
    const float* cw = F.in[16]; const float* cb = F.in[17]; const int cq = h * 128 + d, ck = 1024 + h * 128 + d;
#pragma unroll
    for (int k = 0; k < 4; ++k) { r.cwq[k] = cw[k * 2048 + cq]; r.cwk[k] = cw[k * 2048 + ck]; }
    r.cbq = cb[cq]; r.cbk = cb[ck];
}
__device__ __forceinline__ void mlstm_a_item(const Frame& F, const int dry, int b, int c, int h, const MlRaw& raw) {
    constexpr int QS = 136, VS = 72;
    LAS bf16_t* QT = (LAS bf16_t*)F.lds;
    LAS bf16_t* KT = QT + 64 * QS;
    LAS bf16_t* VT = KT + 64 * QS;
    LAS bf16_t* AT = VT + 256 * VS;
    LAS float* BCS = (LAS float*)(AT + 64 * VS);
    LAS float* A2 = BCS + 64; LAS float* PM = A2 + 64; LAS float* KWS = PM + 64;
    LAS float* NL = KWS + 64;
    LAS float* DL = NL + 512;
    LAS bf16_t* KWT = (LAS bf16_t*)(DL + 256);
    LAS bf16_t* NT = KWT + 128 * VS;
    bf16_t* U = (bf16_t*)(F.ws + OFF_U); bf16_t* QA = (bf16_t*)F.out;     bf16_t* NUM = (bf16_t*)(F.ws + OFF_B);
    const float* gates = (const float*)(F.ws + OFF_GATES1); float* MS = (float*)(F.ws + OFF_MS); float* ITEM = (float*)(F.ws + OFF_ITEM1) + (size_t)((b * 32 + c) * 8 + h) * 256;
    const float* cw = F.in[16]; const float* cb = F.in[17];
    const int tid = F.tid, w = F.wave, lane = F.lane, d = tid & 127, qq = tid >> 7, t0 = c * 64;
    const size_t row0 = (size_t)b * S + t0;
    if (w == 0) {
        const size_t row = row0 + lane;
        const float li = raw.gi + F.in[18][h], xf = raw.gf + F.in[19][h];
        const float lf = fminf(xf, 0.f) - __logf(1.f + __expf(-fabsf(xf)));
        float bc = lf;
#pragma unroll
        for (int o = 1; o < 64; o <<= 1) { const float v_ = __shfl_up(bc, o); bc += (lane >= o) ? v_ : 0.f; }
        const float a2 = li - bc; float pm = a2;
#pragma unroll
        for (int o = 1; o < 64; o <<= 1) { const float v_ = __shfl_up(pm, o); pm = (lane >= o) ? fmaxf(pm, v_) : pm; }
        const float pml = __shfl(pm, 63), bl = __shfl(bc, 63);
        BCS[lane] = bc; A2[lane] = a2; PM[lane] = pm; KWS[lane] = __expf(a2 - pml);
        if (!dry) { MS[(row * 8 + h) * 4 + 0] = bc; MS[(row * 8 + h) * 4 + 1] = bc + pm; }
        if (lane == 0 && !dry) { ITEM[128] = bl + pml; ITEM[129] = bl; }
    }
    float kp[16];
    {
        float xq[19], xk[19];
#pragma unroll
        for (int i = 0; i < 19; ++i) { xq[i] = bf2f(raw.xq[i]); xk[i] = bf2f(raw.xk[i]); }
        const float q0 = raw.cwq[0], q1 = raw.cwq[1], q2 = raw.cwq[2], q3 = raw.cwq[3], qb = raw.cbq;
        const float k0 = raw.cwk[0], k1 = raw.cwk[1], k2 = raw.cwk[2], k3 = raw.cwk[3], kb = raw.cbk;
#pragma unroll
        for (int i = 0; i < 16; ++i) {
            const float qv = siluf_(qb + q0 * xq[i] + q1 * xq[i + 1] + q2 * xq[i + 2] + q3 * xq[i + 3]) * 0.08838834764831845f;
            kp[i] = siluf_(kb + k0 * xk[i] + k1 * xk[i + 1] + k2 * xk[i + 2] + k3 * xk[i + 3]);
            QT[(16 * qq + i) * QS + d] = (bf16_t)f2bf(qv); KT[(16 * qq + i) * QS + d] = (bf16_t)f2bf(kp[i]);
        }
    }
    bf16x8_t vt[4];
    {
        const int e = tid & 255, hf = tid >> 8;
        unsigned short vv[32];
#pragma unroll
        for (int i = 0; i < 32; ++i) vv[i] = raw.vv[i];
#pragma unroll
        for (int j = 0; j < 4; ++j) { v4u w4; w4.x = vv[8 * j] | ((unsigned)vv[8 * j + 1] << 16); w4.y = vv[8 * j + 2] | ((unsigned)vv[8 * j + 3] << 16); w4.z = vv[8 * j + 4] | ((unsigned)vv[8 * j + 5] << 16); w4.w = vv[8 * j + 6] | ((unsigned)vv[8 * j + 7] << 16);
            vt[j] = __builtin_bit_cast(bf16x8_t, w4); *(LAS bf16x8_t*)(VT + e * VS + 32 * hf + 8 * j) = vt[j]; }
    }
    WG_BAR();
    {
        bf16_t* vg = U + uidx(row0, 2048 + h * 256);
#pragma unroll
        for (int j = 0; j < 4; ++j) { const int p = tid + 512 * j; const bf16x8_t v_ = *(const LAS bf16x8_t*)(VT + (p >> 3) * VS + (p & 7) * 8); if (!dry) *(bf16x8_t*)(vg + (size_t)p * 8) = v_; }
        float kw[16], ns = 0.f;
#pragma unroll
        for (int i = 0; i < 16; ++i) { kw[i] = kp[i] * KWS[16 * qq + i]; ns += kw[i]; }
        NL[qq * 128 + d] = ns;
        LAS bf16_t* kp_ = KWT + d * VS + 16 * qq;
        { const bf16x8_t ka_ = pack_bf16x8(kw[0], kw[1], kw[2], kw[3], kw[4], kw[5], kw[6], kw[7]), kb_ = pack_bf16x8(kw[8], kw[9], kw[10], kw[11], kw[12], kw[13], kw[14], kw[15]); *(LAS bf16x8_t*)kp_ = ka_; *(LAS bf16x8_t*)(kp_ + 8) = kb_; }
#pragma unroll
        for (int j = 0; j < 2; ++j) { const int p = tid + 512 * j, row = p >> 4, c16 = p & 15; const bf16x8_t qv_ = *(const LAS bf16x8_t*)(QT + row * QS + c16 * 8); if (!dry) *(bf16x8_t*)(QA + (row0 + row) * D + h * 128 + c16 * 8) = qv_; }
    }
    {
        const int tb = w >> 1, r = lane & 15, g = lane >> 4;
#pragma unroll
        for (int k2 = 0; k2 < 2; ++k2) {
            const int sb = 2 * (w & 1) + k2;
            f32x4_t acc = {0.f, 0.f, 0.f, 0.f};
            if (sb <= tb) {
#pragma unroll
                for (int ks = 0; ks < 4; ++ks) {
                    const bf16x8_t a = *(const LAS bf16x8_t*)(KT + (16 * sb + r) * QS + 32 * ks + 8 * g), bb = *(const LAS bf16x8_t*)(QT + (16 * tb + r) * QS + 32 * ks + 8 * g);
                    acc = __builtin_amdgcn_mfma_f32_16x16x32_bf16(a, bb, acc, 0, 0, 0);
                }
            }
            const int t = 16 * tb + r, s0 = 16 * sb + 4 * g; const float pmt = PM[t];
            float sc[4], ds = 0.f;
#pragma unroll
            for (int j = 0; j < 4; ++j) { sc[j] = (s0 + j <= t) ? acc[j] * __expf(A2[s0 + j] - pmt) : 0.f; ds += sc[j]; }
            v2u pw; pw.x = pg8::cvt_pk_bf16(sc[0], sc[1]); pw.y = pg8::cvt_pk_bf16(sc[2], sc[3]);
            *(LAS v2u*)(AT + t * VS + s0) = pw;
            ds += __shfl_xor(ds, 16); ds += __shfl_xor(ds, 32);
            if (g == 0) DL[sb * 64 + t] = ds;
        }
    }
    WG_BAR();
    {
        const int l31 = lane & 31, hh = lane >> 5;
#pragma unroll
        for (int th = 0; th < 2; ++th) {
            f32x16 acc;
#pragma unroll
            for (int r = 0; r < 16; ++r) acc[r] = 0.f;
#pragma unroll
            for (int ks = 0; ks < 4; ++ks) {
                const bf16x8_t a = *(const LAS bf16x8_t*)(AT + (32 * th + l31) * VS + 16 * ks + 8 * hh), bb = *(const LAS bf16x8_t*)(VT + (32 * w + l31) * VS + 16 * ks + 8 * hh);
                acc = __builtin_amdgcn_mfma_f32_32x32x16_bf16(a, bb, acc, 0, 0, 0);
            }
#pragma unroll
            for (int r = 0; r < 16; ++r) { const int t = 32 * th + (r & 3) + 8 * (r >> 2) + 4 * hh; NT[t * 264 + 32 * w + l31] = (bf16_t)f2bf(acc[r]); }
        }
#pragma unroll
        for (int j = 0; j < 2; ++j) { const int p = tid + 512 * j, dd = p >> 3, c8 = p & 7; const bf16x8_t k_ = *(const LAS bf16x8_t*)(KWT + dd * VS + c8 * 8);
            if (!dry) *(bf16x8_t*)(QA + (row0 + (dd >> 1)) * D + 1024 + h * 128 + (dd & 1) * 64 + c8 * 8) = k_; }
        if (tid < 64 && !dry) MS[((row0 + tid) * 8 + h) * 4 + 2] = (DL[tid] + DL[64 + tid]) + (DL[128 + tid] + DL[192 + tid]);
        if (tid >= 128 && tid < 256 && !dry) { const int dd = tid - 128; ITEM[dd] = (NL[dd] + NL[128 + dd]) + (NL[256 + dd] + NL[384 + dd]); }
    }
    WG_BAR();
#pragma unroll
    for (int j = 0; j < 4; ++j) { const int p = tid + 512 * j, t_ = p >> 5, c32 = p & 31; const bf16x8_t o_ = *(const LAS bf16x8_t*)(NT + t_ * 264 + c32 * 8);
        if (!dry) *(bf16x8_t*)(NUM + (row0 + t_) * D + h * 256 + c32 * 8) = o_; }
    WG_BAR();
}

__device__ __forceinline__ void mlstm_b_phase(const Frame& F, const int dry, int b, int h, int eh) {
    constexpr int QS = 132, VS = 72;
    LAS bf16_t* QB = (LAS bf16_t*)F.lds;
    LAS bf16_t* KB = QB + 64 * QS;
    LAS bf16_t* VB = KB + 128 * VS;
    LAS float* NS = (LAS float*)(VB + 128 * VS);
    LAS float* DECC = NS + 128;
    LAS float* SLOC = DECC + 32;
    LAS float* OT = SLOC + 32;
    bf16_t* U = (bf16_t*)(F.ws + OFF_U); const bf16_t* QA = (const bf16_t*)F.out;
    float* MS = (float*)(F.ws + OFF_MS); float* ITEM0 = (float*)(F.ws + OFF_ITEM1) + (size_t)((b * 32) * 8 + h) * 256;
    const int tid = F.tid, w = F.wave, lane = F.lane, l31 = lane & 31, hh = lane >> 5, eb = w & 3, dh = w >> 2;
    if (w == 0) {
        const float Mc_l = (lane < 32) ? ITEM0[(size_t)lane * 2048 + 128] : 0.f, bl_l = (lane < 32) ? ITEM0[(size_t)lane * 2048 + 129] : 0.f;
        float m = 0.f, mine_m = 0.f, mine_dec = 0.f, mine_sl = 0.f;
        for (int c = 0; c < 32; ++c) { const float Mc = __shfl(Mc_l, c), bl = __shfl(bl_l, c), mn = fmaxf(bl + m, Mc);
            if (lane == c) { mine_m = m; mine_dec = __expf(bl + m - mn); mine_sl = __expf(Mc - mn); }
            m = mn; }
        if (lane < 32) { DECC[lane] = mine_dec; SLOC[lane] = mine_sl; if (!dry && eh == 0) ITEM0[(size_t)lane * 2048 + 130] = mine_m; }
    }
    if (tid < 128) NS[tid] = 0.f;
    f32x16 X[2];
#pragma unroll
    for (int xi = 0; xi < 2; ++xi)
#pragma unroll
        for (int r = 0; r < 16; ++r) X[xi][r] = 0.f;
    bf16x8_t pqA[2], pkA[2], pvA[2], pqB[2], pkB[2], pvB[2]; float pnlA = 0.f, pnlB = 0.f;
    {
        const size_t row0 = (size_t)b * S;
#pragma unroll
        for (int j = 0; j < 2; ++j) { const int p = tid + 512 * j; const bf16_t* ap = QA + (row0 + (p >> 4)) * D + h * 128 + (p & 15) * 8; pqA[j] = *(const bf16x8_t*)ap; pkA[j] = *(const bf16x8_t*)(ap + 1024);
            pvA[j] = *(const bf16x8_t*)(U + uidx(row0 + 32 * eh + (p >> 5), 2048 + h * 256 + (p & 31) * 8));
            const bf16_t* bp = ap + (size_t)64 * D; pqB[j] = *(const bf16x8_t*)bp; pkB[j] = *(const bf16x8_t*)(bp + 1024);
            pvB[j] = *(const bf16x8_t*)(U + uidx(row0 + 64 + 32 * eh + (p >> 5), 2048 + h * 256 + (p & 31) * 8)); }
        if (tid < 128) { pnlA = ITEM0[tid]; pnlB = ITEM0[2048 + tid]; }
    }
    WG_BAR();
#define MLSTM_B_CHUNK(CIDX, PQ, PK, PV, PNL) { const int c = (CIDX); \
        const size_t row0 = (size_t)b * S + c * 64; \
        const float dec = DECC[c], sloc = SLOC[c]; \
_Pragma("unroll") \
        for (int j = 0; j < 2; ++j) { const int p = tid + 512 * j, ur = p >> 4, c16 = p & 15; \
            { const v4u w4 = __builtin_bit_cast(v4u, PQ[j]); v2u lo, hi; lo.x = w4.x; lo.y = w4.y; hi.x = w4.z; hi.y = w4.w; *(LAS v2u*)(QB + ur * QS + c16 * 8) = lo; *(LAS v2u*)(QB + ur * QS + c16 * 8 + 4) = hi; } \
            { const v4u w4 = __builtin_bit_cast(v4u, PK[j]); \
              const bf16x8_t ks_ = pack_bf16x8(pg8::bflo(w4.x) * sloc, pg8::bfhi(w4.x) * sloc, pg8::bflo(w4.y) * sloc, pg8::bfhi(w4.y) * sloc, pg8::bflo(w4.z) * sloc, pg8::bfhi(w4.z) * sloc, pg8::bflo(w4.w) * sloc, pg8::bfhi(w4.w) * sloc); \
              *(LAS bf16x8_t*)(KB + (2 * ur + (c16 >> 3)) * VS + (c16 & 7) * 8) = ks_; } \
            { const int vr = p >> 5, c32 = p & 31; *(LAS bf16x8_t*)(VB + (4 * vr + (c32 >> 3)) * VS + (c32 & 7) * 8) = PV[j]; } } \
        const float nl_cur = PNL; \
        WG_BAR(); \
        if (c + 2 < 32) { \
            const size_t rn = row0 + 128; \
_Pragma("unroll") \
            for (int j = 0; j < 2; ++j) { const int p = tid + 512 * j; const bf16_t* ap = QA + (rn + (p >> 4)) * D + h * 128 + (p & 15) * 8; PQ[j] = *(const bf16x8_t*)ap; PK[j] = *(const bf16x8_t*)(ap + 1024); \
                PV[j] = *(const bf16x8_t*)(U + uidx(rn + 32 * eh + (p >> 5), 2048 + h * 256 + (p & 31) * 8)); } \
            if (tid < 128) PNL = ITEM0[(size_t)(c + 2) * 2048 + tid]; \
        } \
 \
        if (eh == 0) { \
            const int tq = 8 * w + (lane >> 3), d0 = (lane & 7) * 16; float s = 0.f; \
_Pragma("unroll") \
            for (int j = 0; j < 4; ++j) { const v2u qv = *(const LAS v2u*)(QB + tq * QS + d0 + 4 * j); const f32x4_t nv = *(const LAS f32x4_t*)(NS + d0 + 4 * j); \
                s += (pg8::bflo(qv.x) * nv[0] + pg8::bfhi(qv.x) * nv[1]) + (pg8::bflo(qv.y) * nv[2] + pg8::bfhi(qv.y) * nv[3]); } \
            s += __shfl_xor(s, 1); s += __shfl_xor(s, 2); s += __shfl_xor(s, 4); \
            if ((lane & 7) == 0 && !dry) MS[((row0 + tq) * 8 + h) * 4 + 3] = s; \
        } \
 \
        f32x16 accT[2]; \
_Pragma("unroll") \
        for (int tt = 0; tt < 2; ++tt) \
_Pragma("unroll") \
            for (int r = 0; r < 16; ++r) accT[tt][r] = 0.f; \
_Pragma("unroll") \
        for (int xi = 0; xi < 2; ++xi) \
_Pragma("unroll") \
            for (int s = 0; s < 2; ++s) { \
                const bf16x8_t a = pack_bf16x8(X[xi][8 * s + 0], X[xi][8 * s + 1], X[xi][8 * s + 2], X[xi][8 * s + 3], X[xi][8 * s + 4], X[xi][8 * s + 5], X[xi][8 * s + 6], X[xi][8 * s + 7]); \
_Pragma("unroll") \
                for (int tt = 0; tt < 2; ++tt) { \
                    const LAS bf16_t* qp = QB + (32 * tt + l31) * QS + 64 * dh + 32 * xi + 16 * s + 4 * hh; \
                    const bf16x8_t bq = cat_bf16x4(*(const LAS v2u*)qp, *(const LAS v2u*)(qp + 8)); \
                    accT[tt] = __builtin_amdgcn_mfma_f32_32x32x16_bf16(a, bq, accT[tt], 0, 0, 0); \
                } \
            } \
 \
_Pragma("unroll") \
        for (int xi = 0; xi < 2; ++xi) { \
_Pragma("unroll") \
            for (int r = 0; r < 16; ++r) X[xi][r] *= dec; \
_Pragma("unroll") \
            for (int ks = 0; ks < 4; ++ks) { \
                const bf16x8_t a = *(const LAS bf16x8_t*)(KB + (64 * dh + 32 * xi + l31) * VS + 16 * ks + 8 * hh), bv = *(const LAS bf16x8_t*)(VB + (32 * eb + l31) * VS + 16 * ks + 8 * hh); \
                X[xi] = __builtin_amdgcn_mfma_f32_32x32x16_bf16(a, bv, X[xi], 0, 0, 0); \
            } \
        } \
 \
_Pragma("unroll") \
        for (int tt = 0; tt < 2; ++tt) \
_Pragma("unroll") \
            for (int g4 = 0; g4 < 4; ++g4) { const f32x4_t ov = {accT[tt][4 * g4 + 0], accT[tt][4 * g4 + 1], accT[tt][4 * g4 + 2], accT[tt][4 * g4 + 3]}; \
                *(LAS f32x4_t*)(OT + (dh * 64 + 32 * tt + l31) * 132 + 32 * eb + 8 * g4 + 4 * hh) = ov; } \
        WG_BAR(); \
        _Pragma("unroll") \
        for (int j = 0; j < 2; ++j) { const int p = tid + 512 * j, t_ = p >> 4, c16 = p & 15; const LAS float* o0 = OT + t_ * 132 + c16 * 8; const LAS float* o1 = o0 + 64 * 132; \
            const f32x4_t a0 = *(const LAS f32x4_t*)o0 + *(const LAS f32x4_t*)o1, a1 = *(const LAS f32x4_t*)(o0 + 4) + *(const LAS f32x4_t*)(o1 + 4); \
            const bf16x8_t o_ = pack_bf16x8(a0[0], a0[1], a0[2], a0[3], a1[0], a1[1], a1[2], a1[3]); \
            if (!dry) *(bf16x8_t*)(U + uidx(row0 + t_, h * 256 + 128 * eh + c16 * 8)) = o_; } \
        if (tid < 128) NS[tid] = dec * NS[tid] + sloc * nl_cur; \
    }
    for (int c2 = 0; c2 < 32; c2 += 2) { MLSTM_B_CHUNK(c2, pqA, pkA, pvA, pnlA) MLSTM_B_CHUNK(c2 + 1, pqB, pkB, pvB, pnlB) }
#undef MLSTM_B_CHUNK
    WG_BAR();
}

__device__ __forceinline__ void mlstm_c_item(const Frame& F, const int dry, int b, int c, int h) {
    const bf16_t* U = (const bf16_t*)(F.ws + OFF_U); bf16_t* Y = (bf16_t*)(F.ws + OFF_B);
    const float* MS = (const float*)(F.ws + OFF_MS); const float* ITEM = (const float*)(F.ws + OFF_ITEM1) + (size_t)((b * 32 + c) * 8 + h) * 256;
    const int w = F.wave, lane = F.lane;
    const size_t row0 = (size_t)b * S + c * 64;
    const f32x4_t cn = *(const f32x4_t*)(F.in[20] + h * 256 + 4 * lane);
    const float m_st = ITEM[130];
    v2u oi[8], nm[8], gg[8]; f32x4_t st[8];
#pragma unroll
    for (int i = 0; i < 8; ++i) { const size_t row = row0 + 8 * w + i;
        oi[i] = __builtin_nontemporal_load((const v2u*)(U + uidx(row, h * 256 + 4 * lane))); nm[i] = __builtin_nontemporal_load((const v2u*)(Y + row * D + h * 256 + 4 * lane)); gg[i] = __builtin_nontemporal_load((const v2u*)(U + uidx(row, 4096 + h * 256 + 4 * lane)));
        st[i] = *(const f32x4_t*)(MS + (row * 8 + h) * 4); }
#pragma unroll
    for (int i = 0; i < 8; ++i) { const size_t row = row0 + 8 * w + i;
        const float bcs = st[i][0], mloc = st[i][1], dloc = st[i][2], di = st[i][3];
        const float mt = fmaxf(mloc, bcs + m_st), gi = __expf(bcs + m_st - mt), gl = __expf(mloc - mt);
        const float den = gi * di + gl * dloc, inv = 1.f / fmaxf(fabsf(den), __expf(-mt));
        const float h0 = (gi * pg8::bflo(oi[i].x) + gl * pg8::bflo(nm[i].x)) * inv, h1 = (gi * pg8::bfhi(oi[i].x) + gl * pg8::bfhi(nm[i].x)) * inv;
        const float h2 = (gi * pg8::bflo(oi[i].y) + gl * pg8::bflo(nm[i].y)) * inv, h3 = (gi * pg8::bfhi(oi[i].y) + gl * pg8::bfhi(nm[i].y)) * inv;
        const float ss = wave_sum((h0 * h0 + h1 * h1) + (h2 * h2 + h3 * h3));
        const float rs = rsqrtf(ss * (1.f / 256.f) + EPS);
        v2u yw; yw.x = pg8::cvt_pk_bf16(h0 * rs * cn[0] * pg8::bflo(gg[i].x), h1 * rs * cn[1] * pg8::bfhi(gg[i].x)); yw.y = pg8::cvt_pk_bf16(h2 * rs * cn[2] * pg8::bflo(gg[i].y), h3 * rs * cn[3] * pg8::bfhi(gg[i].y));
        if (!dry) *(v2u*)(Y + row * D + h * 256 + 4 * lane) = yw; }
}

#ifndef MK_DUP
#define MK_DUP -1
#endif
enum { PH_P0 = 0, PH_IN0, PH_MIX0A, PH_MIX0B, PH_MIX0C, PH_OUT0, PH_GATE0, PH_IN1, PH_MIX1A, PH_MIX1B, PH_MIX1C, PH_OUT1, PH_GATE1, PH_FINAL, PH_END };

__global__ void __launch_bounds__(NWAVES * 64, 2) mk_fwd(Ptrs args) {
    extern __shared__ __attribute__((aligned(16))) unsigned char lds_raw[];
    Frame F;
    F.lds = (LAS unsigned char*)lds_raw;
    F.tid = threadIdx.x; F.lane = F.tid & 63; F.wave = __builtin_amdgcn_readfirstlane(F.tid >> 6);
    F.G = gridDim.x; F.bid = blockIdx.x; F.in = args.in; F.out = args.out; F.ws = args.ws;
    volatile LAS unsigned* MISC = (volatile LAS unsigned*)(F.lds + MISC_OFF);
    if (F.tid < 32) MISC[F.tid] = 0u;
    __syncthreads();
    XcdBarrier bar = xcd_barrier_post((unsigned*)(F.ws + OFF_CTL) + CW_BAR + args.li * XCD_BAR_WORDS, MISC + 8);
    const int lo = args.ph_lo, hi = args.ph_hi, dryv = args.dup;
#define IN_(k) (lo <= (k) && (k) < hi)
#define RUN(k, BODY) do { if (IN_(k)) { if (MK_DUP == (k)) { BODY(dryv) xcd_barrier(bar); } BODY(0) } } while (0)
#ifndef MK_TSPROBE
#define MK_TSPROBE -1
#endif
    unsigned long long* const tsb = (unsigned long long*)(F.ws + OFF_CTL + 524288);
#define STAMP(k) do { if (MK_TSPROBE >= 0 && F.bid == 0 && F.tid == 0) __hip_atomic_store(tsb + (k), (unsigned long long)__builtin_amdgcn_s_memrealtime(), __ATOMIC_RELAXED, __HIP_MEMORY_SCOPE_AGENT); } while (0)
#define SEAM(k) do { if (IN_(k) && IN_((k) + 1)) xcd_barrier(bar); STAMP((k) + 1); } while (0)
    STAMP(0);
    unsigned char* ws = F.ws;
    bf16_t* A = (bf16_t*)(ws + OFF_A); bf16_t* B = (bf16_t*)(ws + OFF_B); bf16_t* U = (bf16_t*)(ws + OFF_U);
    float* plpart = (float*)(ws + OFF_PART); float* hpart = plpart + (size_t)M * 32;
    const bf16_t* P16 = (const bf16_t*)(ws + OFF_WIN0); bf16_t* PL = U;
    const bf16_t* PLEW = (const bf16_t*)(ws + OFF_PLEW); bf16_t* PL1 = (bf16_t*)(ws + OFF_WIN1);
    float* plpart1 = (float*)(ws + OFF_WIN0 + 8 * MiB);

#define BODY_PH_P0(DRY) { p0_prologue(F); }
#define BODY_PH_IN0(DRY) { pg8::Gemm g{A, (const bf16_t*)(ws + OFF_WIN0), M, 6144, 2048}; pg8::StaticOrder So; So.init(M, 6144, F.G, F.bid); \
        pg8::EpiIn0 E{U, (const float*)(ws + OFF_SMALL) + 1024, DRY}; \
        pg8::gemm_phase<pg8::EpiIn0, pg8::StaticOrder, true, true>(F.lds, g, So, E); }
#define BODY_PH_MIX0A(DRY) { cvt_p_phase(F, DRY); \
        { H2Raw cur_, nxt_; if (F.bid < 1024) hgrn2_a_load(F, F.bid >> 8, (F.bid >> 3) & 31, F.bid & 7, cur_); \
          for (int it = F.bid; it < 1024; it += F.G) { const int in_ = it + F.G; if (in_ < 1024) hgrn2_a_load(F, in_ >> 8, (in_ >> 3) & 31, in_ & 7, nxt_); hgrn2_a_item(F, DRY, it >> 8, (it >> 3) & 31, it & 7, cur_); cur_ = nxt_; } } \
        { LruRaw cur_, nxt_; if (F.bid < 1024) rglru_a_load(F, F.bid >> 8, (F.bid >> 3) & 31, F.bid & 7, cur_); \
          for (int it = F.bid; it < 1024; it += F.G) { const int in_ = it + F.G; if (in_ < 1024) rglru_a_load(F, in_ >> 8, (in_ >> 3) & 31, in_ & 7, nxt_); rglru_a_item(F, DRY, it >> 8, (it >> 3) & 31, it & 7, cur_); cur_ = nxt_; } } }
#define BODY_PH_MIX0B(DRY) { if (F.bid < 32) hgrn2_b_phase(F, DRY, F.bid >> 3, F.bid & 7); else { for (int it = F.bid - 32; it < 1024; it += F.G - 32) rglru_b_item(F, DRY, it >> 8, (it >> 3) & 31, it & 7); \
        p0_layer1_weights_in(F, (F.bid - 32) * NWAVES + F.wave, (F.G - 32) * NWAVES); p0_layer1_weights_out(F, (F.bid - 32) * NWAVES + F.wave, (F.G - 32) * NWAVES); } }
#define BODY_PH_MIX0C(DRY) { for (int it = F.bid; it < 1024; it += F.G) hgrn2_c_item(F, DRY, it >> 8, (it >> 3) & 31, it & 7); }
#define BODY_PH_OUT0(DRY) { { pg8::Gemm g{A, (const bf16_t*)(ws + OFF_WOUT0), M, 2048, 2048}; pg8::StaticOrder So; So.init(M, 2048, F.G, F.bid); \
          pg8::EpiOut<true> E{F.in[0], B, DRY}; \
          pg8::gemm_phase<pg8::EpiOut<true>, pg8::StaticOrder, true, true>(F.lds, g, So, E); } \
        { unsigned char* ws2 = ws; asm volatile("" : "+s"(ws2));     \
          pg8::Gemm g{(const bf16_t*)(ws2 + OFF_WIN0), (const bf16_t*)(ws2 + OFF_PLEW), M, 2048, 256}; pg8::StaticOrder So; So.init(M, 2048, F.G, F.bid); \
          pg8::EpiPle E{(bf16_t*)(ws2 + OFF_U), (float*)(ws2 + OFF_PART), DRY}; \
          pg8::gemm_phase<pg8::EpiPle, pg8::StaticOrder, true, true>(F.lds, g, So, E); } }
#define BODY_PH_GATE0(DRY) { pg8::Gemm g{B, (const bf16_t*)(ws + OFF_WG0), M, 2048, 2048}; pg8::StaticOrder So; So.init(M, 2048, F.G, F.bid); \
        pg8::EpiGate E{B, A, nullptr, PL, plpart, F.in[23], hpart, DRY}; \
        pg8::gemm_phase<pg8::EpiGate, pg8::StaticOrder, true, true>(F.lds, g, So, E); }
#define BODY_PH_IN1(DRY) { pg8::Gemm g{A, (const bf16_t*)(ws + OFF_WIN1), M, 8192, 2048}; pg8::StaticOrder So; So.init(M, 8192, F.G, F.bid); \
        pg8::EpiIn1 E{U, hpart, DRY}; \
        pg8::gemm_phase<pg8::EpiIn1, pg8::StaticOrder, true, true>(F.lds, g, So, E); \
        gates1_phase(F, DRY); }
#define BODY_PH_MIX1A(DRY) { MlRaw cur_, nxt_; if (F.bid < 1024) mlstm_a_load(F, F.bid >> 8, (F.bid >> 3) & 31, F.bid & 7, cur_); \
        for (int it = F.bid; it < 1024; it += F.G) { const int in_ = it + F.G; if (in_ < 1024) mlstm_a_load(F, in_ >> 8, (in_ >> 3) & 31, in_ & 7, nxt_); mlstm_a_item(F, DRY, it >> 8, (it >> 3) & 31, it & 7, cur_); cur_ = nxt_; } }
#define BODY_PH_MIX1B(DRY) { if (F.bid < 64) mlstm_b_phase(F, DRY, F.bid >> 4, (F.bid >> 1) & 7, F.bid & 1); else { \
        pg8::Gemm g{P16 + (size_t)M * PLE, PLEW + (size_t)2048 * 256, M, 2048, 256}; pg8::StaticOrder So; So.init(M, 2048, F.G - 64, F.bid - 64); \
        pg8::EpiPle E{PL1, plpart1, DRY}; \
        pg8::gemm_phase<pg8::EpiPle, pg8::StaticOrder, true, true>(F.lds, g, So, E); } }
#define BODY_PH_MIX1C(DRY) { for (int it = F.bid; it < 1024; it += F.G) mlstm_c_item(F, DRY, it >> 8, (it >> 3) & 31, it & 7); }
#define BODY_PH_OUT1(DRY) { pg8::Gemm g{B, (const bf16_t*)(ws + OFF_WOUT1), M, 2048, 2048}; pg8::StaticOrder So; So.init(M, 2048, F.G, F.bid); \
          pg8::EpiOut<false> E{A, A, DRY}; \
          pg8::gemm_phase<pg8::EpiOut<false>, pg8::StaticOrder, true, true>(F.lds, g, So, E); }
#define BODY_PH_GATE1(DRY) { pg8::Gemm g{A, (const bf16_t*)(ws + OFF_WG1), M, 2048, 2048}; pg8::StaticOrder So; So.init(M, 2048, F.G, F.bid); \
        float peps = 0.f; \
        if (MK_TSPROBE >= 0) { const unsigned long long t0_ = __hip_atomic_load(tsb + (MK_TSPROBE >= 0 ? MK_TSPROBE : 0), __ATOMIC_RELAXED, __HIP_MEMORY_SCOPE_AGENT), t1_ = __hip_atomic_load(tsb + (MK_TSPROBE >= 0 ? MK_TSPROBE : 0) + 1, __ATOMIC_RELAXED, __HIP_MEMORY_SCOPE_AGENT); \
            unsigned bk = (unsigned)((t1_ - t0_) / 500ull); if (bk > 95u) bk = 95u; peps = sqrtf((float)bk * 1e-6f); }     \
        pg8::EpiGateFinal E{A, F.out, PL1, plpart1, F.in[23] + D, F.in[25], (float*)(ws + OFF_GATES1), (unsigned*)(ws + OFF_CTL) + CW_FIN, peps, DRY}; \
        pg8::gemm_phase<pg8::EpiGateFinal, pg8::StaticOrder, false, true>(F.lds, g, So, E); }

    RUN(PH_P0, BODY_PH_P0);
    SEAM(PH_P0);
    RUN(PH_IN0, BODY_PH_IN0);
    SEAM(PH_IN0);
    RUN(PH_MIX0A, BODY_PH_MIX0A);
    SEAM(PH_MIX0A);
    RUN(PH_MIX0B, BODY_PH_MIX0B);
    SEAM(PH_MIX0B);
    RUN(PH_MIX0C, BODY_PH_MIX0C);
    SEAM(PH_MIX0C);
    RUN(PH_OUT0, BODY_PH_OUT0);
    SEAM(PH_OUT0);
    RUN(PH_GATE0, BODY_PH_GATE0);
    SEAM(PH_GATE0);
    RUN(PH_IN1, BODY_PH_IN1);
    SEAM(PH_IN1);
    RUN(PH_MIX1A, BODY_PH_MIX1A);
    SEAM(PH_MIX1A);
    RUN(PH_MIX1B, BODY_PH_MIX1B);
    SEAM(PH_MIX1B);
    RUN(PH_MIX1C, BODY_PH_MIX1C);
    SEAM(PH_MIX1C);
    RUN(PH_OUT1, BODY_PH_OUT1);
    SEAM(PH_OUT1);
    RUN(PH_GATE1, BODY_PH_GATE1);
#undef IN_
#undef SEAM
#undef RUN
}


extern "C" void kernel_launch(void* const* d_in, const int* in_sizes, int n_in, void* d_out, int out_size, void* d_ws, size_t ws_size, hipStream_t stream) {
    static int grid = 0;
    if (grid == 0) {
        if (n_in != 26 || ws_size < WS_END || out_size != M * D) { fprintf(stderr, "kernel_launch: unexpected problem (n_in %d, ws %zu, out %d)\n", n_in, ws_size, out_size); grid = -1; return; }
        int dev = 0, cus = 0, per_cu = 0;
        if (hipGetDevice(&dev) != hipSuccess || hipDeviceGetAttribute(&cus, hipDeviceAttributeMultiprocessorCount, dev) != hipSuccess) { grid = -1; return; }
        if (hipFuncSetAttribute((const void*)mk_fwd, hipFuncAttributeMaxDynamicSharedMemorySize, LDS_BYTES) != hipSuccess) { fprintf(stderr, "kernel_launch: hipFuncSetAttribute failed\n"); grid = -1; return; }
        if (hipOccupancyMaxActiveBlocksPerMultiprocessor(&per_cu, (const void*)mk_fwd, NWAVES * 64, LDS_BYTES) != hipSuccess || per_cu < 1) { fprintf(stderr, "kernel_launch: occupancy query says %d blocks per CU\n", per_cu); (void)hipGetLastError(); grid = -1; return; }
        grid = cus;
    }
    if (grid < 0) return;
    (void)hipMemsetAsync((char*)d_ws + OFF_CTL, 0, CTL_ZERO_BYTES, stream);
    Ptrs a{};
    for (int i = 0; i < 26; ++i) a.in[i] = (const float*)d_in[i];
    a.out = (float*)d_out; a.ws = (unsigned char*)d_ws; a.ph_lo = PH_P0; a.ph_hi = PH_END; a.li = 0; a.dup = 1;
    void* kargs[] = {&a};
    const hipError_t e = hipLaunchCooperativeKernel((const void*)mk_fwd, dim3(grid), dim3(NWAVES * 64), kargs, LDS_BYTES, stream);
    if (e != hipSuccess) fprintf(stderr, "kernel_launch: cooperative launch failed: %s (grid %d)\n", hipGetErrorString(e), grid);
}
```

```cpp
#include <hip/hip_runtime.h>
#include <cstdio>
#include <cstdint>

namespace pg8 {
#define PG8_LAS __attribute__((address_space(3)))
typedef unsigned short bf16_t;
typedef short bf16x8 __attribute__((ext_vector_type(8)));
typedef float f32x4 __attribute__((ext_vector_type(4)));
typedef unsigned u32x4 __attribute__((ext_vector_type(4)));
constexpr int BM = 256, BK = 64, HALF = 128, HTB = HALF * BK * 2  , STAGE_BYTES = 8 * HTB, NXCD = 8, WGM = 8;

__host__ __device__ __forceinline__ int lds_byte(int r, int c) { const int st = (r >> 4) * 2 + (c >> 5), rr = r & 15, cc = c & 31, ob = rr * 64 + cc * 2; return st * 1024 + (ob ^ (((ob >> 9) & 1) << 5)); }
__host__ __device__ __forceinline__ void stage_rc(int b, int& R, int& C) { const int st = b / 1024, sb = b % 1024, swz = sb ^ (((sb >> 9) & 1) << 5); R = (st >> 1) * 16 + swz / 64; C = (st & 1) * 32 + (swz % 64) / 2; }
__host__ __device__ __forceinline__ int perm32(int rho) { const int n = rho >> 4, i = rho & 15; return 8 * (i >> 2) + 4 * n + (i & 3); }

struct Unit { int pm, pn; };
struct Gemm { const bf16_t* A; const bf16_t* Bt; int M, N, K; };

struct StaticOrder {
    int nM, nN, nwg, G, c;
    __host__ __device__ void init(int M, int N, int G_, int c_) { nM = M / BM; nN = N / BM; nwg = nM * nN; G = G_; c = c_; }
    __host__ __device__ bool next(int i, Unit& u) const {
        const long L = (long)i * G + c; if (L >= nwg) return false;
        int wgid = (int)L; { const int q = nwg / NXCD, r = nwg % NXCD, xcd = wgid % NXCD, off = wgid / NXCD; wgid = (xcd < r ? xcd * (q + 1) : r * (q + 1) + (xcd - r) * q) + off; }
        const int nig = WGM * nN, gid = wgid / nig, fm = gid * WGM, gsz = (nM - fm) < WGM ? (nM - fm) : WGM;
        u.pm = fm + ((wgid % nig) % gsz); u.pn = (wgid % nig) / gsz; return true;
    }
    __device__ __forceinline__ void a_ready(const Unit&) const {}
    __device__ __forceinline__ void done(const Unit&) const {}
};

struct StaticOrderMix32 : StaticOrder {
    __host__ __device__ bool next(int i, Unit& u) const { if (!StaticOrder::next(i, u)) return false; u.pn = (u.pn & 7) | ((u.pn & 8) << 1) | ((u.pn & 16) >> 1); return true; }
};

typedef __bf16 bf16v2_t __attribute__((ext_vector_type(2)));
typedef float f32v2_t __attribute__((ext_vector_type(2)));
__device__ __forceinline__ unsigned cvt_pk_bf16(float lo, float hi) { const f32v2_t v = {lo, hi}; return __builtin_bit_cast(unsigned, __builtin_convertvector(v, bf16v2_t)); }
typedef float f32x2 __attribute__((ext_vector_type(2)));
template <class Epi, class Sched, bool ALIGN_EPI = false, bool SP2 = false>
__device__ __forceinline__ void gemm_phase(PG8_LAS unsigned char* lds, const Gemm g, const Sched& S, const Epi& E) {
    const int tid = threadIdx.x, wid = __builtin_amdgcn_readfirstlane(tid >> 6), lane = tid & 63, wr = wid >> 2, wc = wid & 3, fr = lane & 15, fq = lane >> 4;
    const int K = g.K, nt = K / BK;
    unsigned voffA[2], voffB[2];
#pragma unroll
    for (int i = 0; i < 2; ++i) { int R, C; stage_rc(tid * 16 + i * 8192, R, C); const int Rb = Epi::PERM ? ((R & ~31) + perm32(R & 31)) : R;
        voffA[i] = (unsigned)(R * K + C) * 2u; voffB[i] = (unsigned)(Rb * K + C) * 2u; }
    const size_t kstep = (size_t)(BK * 2);
    const size_t hstep = (size_t)HALF * K * 2;
    const size_t tstep = 2 * hstep;
    const unsigned ldsw = (unsigned)wid * 1024u;
    const int aoff = lds_byte(wr * 64 + fr, fq * 8), boff = lds_byte(wc * 32 + fr, fq * 8);
#define PG8_SA(b, h) (((b) * 2 + (h)) * HTB)
#define PG8_SB(b, h) ((4 + (b) * 2 + (h)) * HTB)
#define PG8_STAGE(bufoff, gbase, voff) do { _Pragma("unroll") for (int _i = 0; _i < 2; ++_i) \
        __builtin_amdgcn_global_load_lds((const unsigned*)((const char*)(gbase) + (voff)[_i]), (PG8_LAS unsigned*)(lds + (bufoff) + ldsw + _i * 8192), 16, 0, 0); } while (0)
#define PG8_LDA(dst, b, h) do { _Pragma("unroll") for (int m = 0; m < 4; ++m) _Pragma("unroll") for (int k = 0; k < 2; ++k) dst[m][k] = *(const PG8_LAS bf16x8*)(lds + PG8_SA(b, h) + aoff + m * 2048 + k * 1024); } while (0)
#define PG8_LDB(dst, b, h) do { _Pragma("unroll") for (int n = 0; n < 2; ++n) _Pragma("unroll") for (int k = 0; k < 2; ++k) dst[n][k] = *(const PG8_LAS bf16x8*)(lds + PG8_SB(b, h) + boff + n * 2048 + k * 1024); } while (0)
#define PG8_MMA(ai, bj, At, Bt) do { __builtin_amdgcn_s_setprio(1); _Pragma("unroll") for (int m = 0; m < 4; ++m) _Pragma("unroll") for (int n = 0; n < 2; ++n) _Pragma("unroll") for (int k = 0; k < 2; ++k) \
        acc[ai][bj][m][n] = __builtin_amdgcn_mfma_f32_16x16x32_bf16(Bt[n][k], At[m][k], acc[ai][bj][m][n], 0, 0, 0); __builtin_amdgcn_s_setprio(0); } while (0)
#define PG8_WAIT_V(n) asm volatile("s_waitcnt vmcnt(" #n ")" ::: "memory")
#define PG8_WAIT_L(n) asm volatile("s_waitcnt lgkmcnt(" #n ")" ::: "memory")
#define PG8_BAR __builtin_amdgcn_s_barrier()
#define PG8_SCHED __builtin_amdgcn_sched_barrier(0)
    Unit cur, nxt; int ui = 0;
    if (!S.next(0, cur)) return;
    f32x4 acc[2][2][4][2];
#pragma unroll
    for (int a = 0; a < 2; ++a)
#pragma unroll
        for (int b = 0; b < 2; ++b)
#pragma unroll
            for (int m = 0; m < 4; ++m)
#pragma unroll
                for (int n = 0; n < 2; ++n) acc[a][b][m][n] = (f32x4){0.f, 0.f, 0.f, 0.f};
    bf16x8 At[4][2], B0[2][2], B1[2][2];
    const char* cA = (const char*)g.A + (size_t)cur.pm * tstep; const char* cB = (const char*)g.Bt + (size_t)cur.pn * tstep;
    S.a_ready(cur);
    if constexpr (SP2) {
        PG8_STAGE(PG8_SB(0, 0), cB, voffB); PG8_STAGE(PG8_SB(0, 1), cB + hstep, voffB); PG8_STAGE(PG8_SA(0, 0), cA, voffA); PG8_STAGE(PG8_SA(0, 1), cA + hstep, voffA);
        if (wr == 1) PG8_BAR;
        PG8_WAIT_V(2); PG8_BAR;
        PG8_STAGE(PG8_SB(1, 0), cB + kstep, voffB); PG8_STAGE(PG8_SA(1, 0), cA + kstep, voffA); PG8_STAGE(PG8_SB(1, 1), cB + hstep + kstep, voffB);
        PG8_WAIT_V(6); PG8_BAR;
    } else {
        PG8_STAGE(PG8_SB(0, 0), cB, voffB); PG8_STAGE(PG8_SA(0, 0), cA, voffA); PG8_STAGE(PG8_SB(0, 1), cB + hstep, voffB); PG8_STAGE(PG8_SA(0, 1), cA + hstep, voffA);
        if (wr == 1) PG8_BAR;
        PG8_WAIT_V(4); PG8_BAR;
        PG8_STAGE(PG8_SB(1, 0), cB + kstep, voffB); PG8_STAGE(PG8_SA(1, 0), cA + kstep, voffA); PG8_STAGE(PG8_SB(1, 1), cB + hstep + kstep, voffB);
        PG8_WAIT_V(6); PG8_BAR;
    }
    for (;;) {
        const bool has_next = S.next(ui + 1, nxt);
        const char* nA = has_next ? (const char*)g.A + (size_t)nxt.pm * tstep : cA; const char* nB = has_next ? (const char*)g.Bt + (size_t)nxt.pn * tstep : cB;
        for (int t = 0; t < nt; t += 2) {
            const bool last = (t == nt - 2);
            const char* a1 = cA + (size_t)(t + 1) * kstep;
            const char* a2 = last ? nA : cA + (size_t)(t + 2) * kstep; const char* b2 = last ? nB : cB + (size_t)(t + 2) * kstep;
            const char* a3 = a2 + kstep; const char* b3 = b2 + kstep;
            if (last && has_next) S.a_ready(nxt);
            if constexpr (SP2) {
            PG8_LDB(B0, 0, 0); PG8_LDB(B1, 0, 1); PG8_SCHED; PG8_LDA(At, 0, 0); PG8_STAGE(PG8_SA(1, 1), a1 + hstep, voffA);
            PG8_WAIT_V(8); PG8_WAIT_L(0); PG8_BAR; PG8_MMA(0, 0, At, B0); PG8_MMA(0, 1, At, B1); PG8_BAR; PG8_SCHED;
            PG8_LDA(At, 0, 1); PG8_STAGE(PG8_SB(0, 0), b2, voffB); PG8_STAGE(PG8_SB(0, 1), b2 + hstep, voffB); PG8_STAGE(PG8_SA(0, 0), a2, voffA);
            PG8_WAIT_V(8); PG8_WAIT_L(0); PG8_BAR; PG8_MMA(1, 0, At, B0); PG8_MMA(1, 1, At, B1); PG8_BAR; PG8_SCHED;
            PG8_LDB(B0, 1, 0); PG8_LDB(B1, 1, 1); PG8_SCHED; PG8_LDA(At, 1, 0); PG8_STAGE(PG8_SA(0, 1), a2 + hstep, voffA);
            PG8_WAIT_V(8); PG8_WAIT_L(0); PG8_BAR; PG8_MMA(0, 0, At, B0); PG8_MMA(0, 1, At, B1); PG8_BAR; PG8_SCHED;
            PG8_LDA(At, 1, 1); PG8_STAGE(PG8_SB(1, 0), b3, voffB); PG8_STAGE(PG8_SB(1, 1), b3 + hstep, voffB); PG8_STAGE(PG8_SA(1, 0), a3, voffA);
            PG8_WAIT_V(8); PG8_WAIT_L(0); PG8_BAR; PG8_MMA(1, 0, At, B0); PG8_MMA(1, 1, At, B1); PG8_BAR; PG8_SCHED;
            } else {
            PG8_LDB(B0, 0, 0); PG8_SCHED; PG8_LDA(At, 0, 0); PG8_STAGE(PG8_SA(1, 1), a1 + hstep, voffA);
            PG8_WAIT_L(8); PG8_BAR; PG8_WAIT_L(0); PG8_MMA(0, 0, At, B0); PG8_BAR; PG8_SCHED;
            PG8_LDB(B1, 0, 1); PG8_STAGE(PG8_SB(0, 0), b2, voffB);
            PG8_BAR; PG8_WAIT_L(0); PG8_MMA(0, 1, At, B1); PG8_BAR;
            PG8_LDA(At, 0, 1); PG8_STAGE(PG8_SA(0, 0), a2, voffA);
            PG8_BAR; PG8_WAIT_L(0); PG8_MMA(1, 0, At, B0); PG8_BAR; PG8_SCHED;
            PG8_STAGE(PG8_SB(0, 1), b2 + hstep, voffB);
            PG8_WAIT_V(6); PG8_BAR; PG8_MMA(1, 1, At, B1); PG8_BAR;
            PG8_LDB(B0, 1, 0); PG8_SCHED; PG8_LDA(At, 1, 0); PG8_STAGE(PG8_SA(0, 1), a2 + hstep, voffA);
            PG8_WAIT_L(8); PG8_BAR; PG8_WAIT_L(0); PG8_MMA(0, 0, At, B0); PG8_BAR; PG8_SCHED;
            PG8_LDB(B1, 1, 1); PG8_STAGE(PG8_SB(1, 0), b3, voffB);
            PG8_BAR; PG8_WAIT_L(0); PG8_MMA(0, 1, At, B1); PG8_BAR;
            PG8_LDA(At, 1, 1); PG8_STAGE(PG8_SA(1, 0), a3, voffA);
            PG8_BAR; PG8_WAIT_L(0); PG8_MMA(1, 0, At, B0); PG8_BAR; PG8_SCHED;
            PG8_STAGE(PG8_SB(1, 1), b3 + hstep, voffB);
            PG8_WAIT_V(6); PG8_BAR; PG8_MMA(1, 1, At, B1); PG8_BAR;
            }
        }
        if constexpr (ALIGN_EPI) { if (wr == 0) PG8_BAR; }
        if constexpr (!Epi::AFTER_DRAIN) { E(acc, cur, wr, wc, fr, fq); S.done(cur); }
        if (!has_next) break;
#pragma unroll
        for (int a = 0; a < 2; ++a)
#pragma unroll
            for (int b = 0; b < 2; ++b)
#pragma unroll
                for (int m = 0; m < 4; ++m)
#pragma unroll
                    for (int n = 0; n < 2; ++n) acc[a][b][m][n] = (f32x4){0.f, 0.f, 0.f, 0.f};
        cur = nxt; cA = nA; cB = nB; ++ui;
        if constexpr (ALIGN_EPI) { if (wr == 1) PG8_BAR; }
    }
    PG8_WAIT_V(0);
    if constexpr (!ALIGN_EPI) { if (wr == 0) PG8_BAR; }
    PG8_BAR;
    if constexpr (Epi::AFTER_DRAIN) { E.fused(acc, cur, wr, wc, fr, fq, lds, wid, (fq << 4) | fr);     S.done(cur); }
#undef PG8_SA
#undef PG8_SB
#undef PG8_STAGE
#undef PG8_LDA
#undef PG8_LDB
#undef PG8_MMA
#undef PG8_WAIT_V
#undef PG8_WAIT_L
#undef PG8_BAR
#undef PG8_SCHED
}
}

namespace pg8 {
constexpr float EPSN = 1e-6f;
__device__ __forceinline__ float fsigmoid(float x) { return __builtin_amdgcn_rcpf(1.f + __expf(-x)); }
__device__ __forceinline__ float fsilu(float x) { return x * __builtin_amdgcn_rcpf(1.f + __expf(-x)); }
__device__ __forceinline__ float row_stat32(const float* part, int row, int fq) {
    const f32x4 a = *(const f32x4*)(part + (size_t)row * 32 + 8 * fq), b = *(const f32x4*)(part + (size_t)row * 32 + 8 * fq + 4);
    float s = ((a.x + a.y) + (a.z + a.w)) + ((b.x + b.y) + (b.z + b.w));
    s += __shfl_xor(s, 16); s += __shfl_xor(s, 32); return s;
}
__device__ __forceinline__ u32x4 pack8(const f32x4 v0, const f32x4 v1) { u32x4 w; w.x = cvt_pk_bf16(v0[0], v0[1]); w.y = cvt_pk_bf16(v0[2], v0[3]); w.z = cvt_pk_bf16(v1[0], v1[1]); w.w = cvt_pk_bf16(v1[2], v1[3]); return w; }
__device__ __forceinline__ float bflo(unsigned w) { return __uint_as_float(w << 16); }
__device__ __forceinline__ float bfhi(unsigned w) { return __uint_as_float(w & 0xffff0000u); }

struct EpiIn0 {
    static constexpr bool PERM = true, AFTER_DRAIN = false;
    bf16_t* U; const float* rstd; int dry;
    __device__ __forceinline__ void operator()(const f32x4 (&acc)[2][2][4][2], const Unit& u, int wr, int wc, int fr, int fq) const {
        if (dry) return;
        const int row0 = u.pm * BM + wr * 64 + fr, col0 = u.pn * BM + wc * 32 + 8 * fq;
#pragma unroll
        for (int ai = 0; ai < 2; ++ai)
#pragma unroll
            for (int m = 0; m < 4; ++m) { const int row = row0 + ai * HALF + m * 16; const float sc = rstd[row]; bf16_t* rowp = U + ((size_t)u.pn * 8192 + row) * 256 + (wc * 32 + 8 * fq);
#pragma unroll
                for (int bj = 0; bj < 2; ++bj) *(u32x4*)(rowp + bj * HALF) = pack8(acc[ai][bj][m][0] * sc, acc[ai][bj][m][1] * sc); }
    }
};
struct EpiIn1 {
    static constexpr bool PERM = true, AFTER_DRAIN = false;
    bf16_t* U; const float* hpart; int dry;
    __device__ __forceinline__ void operator()(const f32x4 (&acc)[2][2][4][2], const Unit& u, int wr, int wc, int fr, int fq) const {
        if (dry) return;
        const int row0 = u.pm * BM + wr * 64 + fr;
        if (u.pn < 16) {
            const int col0 = u.pn * BM + wc * 32 + 8 * fq;
#pragma unroll
            for (int ai = 0; ai < 2; ++ai)
#pragma unroll
                for (int m = 0; m < 4; ++m) { const int row = row0 + ai * HALF + m * 16; const float sc = rsqrtf(row_stat32(hpart, row, fq) * (1.f / 2048.f) + EPSN); bf16_t* rowp = U + ((size_t)u.pn * 8192 + row) * 256 + (wc * 32 + 8 * fq);
#pragma unroll
                    for (int bj = 0; bj < 2; ++bj) *(u32x4*)(rowp + bj * HALF) = pack8(acc[ai][bj][m][0] * sc, acc[ai][bj][m][1] * sc); }
        } else {
            const int col0 = 4096 + 128 * (u.pn - 16) + wc * 32 + 8 * fq;
#pragma unroll
            for (int ai = 0; ai < 2; ++ai)
#pragma unroll
                for (int m = 0; m < 4; ++m) { const int row = row0 + ai * HALF + m * 16; const float sc = rsqrtf(row_stat32(hpart, row, fq) * (1.f / 2048.f) + EPSN);
                    f32x4 g0, g1;
#pragma unroll
                    for (int j = 0; j < 4; ++j) { const float a0 = acc[ai][0][m][0][j] * sc, z0 = acc[ai][1][m][0][j] * sc, a1 = acc[ai][0][m][1][j] * sc, z1 = acc[ai][1][m][1][j] * sc;
                        g0[j] = z0 * __builtin_amdgcn_rcpf((1.f + __expf(-a0)) * (1.f + __expf(-z0))); g1[j] = z1 * __builtin_amdgcn_rcpf((1.f + __expf(-a1)) * (1.f + __expf(-z1))); }
                    *(u32x4*)(U + ((size_t)(16 + ((u.pn - 16) >> 1)) * 8192 + row) * 256 + ((u.pn - 16) & 1) * 128 + wc * 32 + 8 * fq) = pack8(g0, g1); }
        }
    }
};
template <bool BASE_F32> struct EpiOut {
    static constexpr bool PERM = true, AFTER_DRAIN = false;
    const void* base; bf16_t* h16; int dry;
    __device__ __forceinline__ void operator()(const f32x4 (&acc)[2][2][4][2], const Unit& u, int wr, int wc, int fr, int fq) const {
        if (dry) return;
        const int row0 = u.pm * BM + wr * 64 + fr, col0 = u.pn * BM + wc * 32 + 8 * fq;
#pragma unroll
        for (int ai = 0; ai < 2; ++ai)
#pragma unroll
            for (int m = 0; m < 4; ++m) { const size_t off = (size_t)(row0 + ai * HALF + m * 16) * 2048 + col0;
#pragma unroll
                for (int bj = 0; bj < 2; ++bj) { f32x4 b0, b1;
                    if (BASE_F32) { b0 = __builtin_nontemporal_load((const f32x4*)((const float*)base + off + bj * HALF)); b1 = __builtin_nontemporal_load((const f32x4*)((const float*)base + off + bj * HALF + 4)); }
                    else { const u32x4 pw = *(const u32x4*)((const bf16_t*)base + off + bj * HALF); b0 = (f32x4){bflo(pw.x), bfhi(pw.x), bflo(pw.y), bfhi(pw.y)}; b1 = (f32x4){bflo(pw.z), bfhi(pw.z), bflo(pw.w), bfhi(pw.w)}; }
                    *(u32x4*)(h16 + off + bj * HALF) = pack8(b0 + acc[ai][bj][m][0], b1 + acc[ai][bj][m][1]); }
                asm volatile("" ::: "memory"); }
    }
};
struct EpiPle {
    static constexpr bool PERM = true, AFTER_DRAIN = false;
    bf16_t* PL; float* plpart; int dry;
    __device__ __forceinline__ void operator()(const f32x4 (&acc)[2][2][4][2], const Unit& u, int wr, int wc, int fr, int fq) const {
        if (dry) return;
        const int row0 = u.pm * BM + wr * 64 + fr, col0 = u.pn * BM + wc * 32 + 8 * fq;
#pragma unroll
        for (int ai = 0; ai < 2; ++ai)
#pragma unroll
            for (int m = 0; m < 4; ++m) { const int row = row0 + ai * HALF + m * 16; float s = 0.f;
#pragma unroll
                for (int bj = 0; bj < 2; ++bj) { const f32x4 v0 = acc[ai][bj][m][0], v1 = acc[ai][bj][m][1];
                    s += ((v0[0] * v0[0] + v0[1] * v0[1]) + (v0[2] * v0[2] + v0[3] * v0[3])) + ((v1[0] * v1[0] + v1[1] * v1[1]) + (v1[2] * v1[2] + v1[3] * v1[3]));
                    *(u32x4*)(PL + (size_t)row * 2048 + col0 + bj * HALF) = pack8(v0, v1); }
                s += __shfl_xor(s, 16); s += __shfl_xor(s, 32);
                if (fq == 0) plpart[(size_t)row * 32 + u.pn * 4 + wc] = s; }
    }
};
struct EpiGate {
    static constexpr bool PERM = true, AFTER_DRAIN = false;
    const bf16_t* hin; bf16_t* h16out; float* outf; const bf16_t* PL; const float* plpart; const float* ple_norm; float* hpart; int dry;
    __device__ __forceinline__ void operator()(const f32x4 (&acc)[2][2][4][2], const Unit& u, int wr, int wc, int fr, int fq) const {
        if (dry) return;
        const int row0 = u.pm * BM + wr * 64 + fr, col0 = u.pn * BM + wc * 32 + 8 * fq;
        f32x4 pn[2][2];
#pragma unroll
        for (int bj = 0; bj < 2; ++bj) { pn[bj][0] = *(const f32x4*)(ple_norm + col0 + bj * HALF); pn[bj][1] = *(const f32x4*)(ple_norm + col0 + bj * HALF + 4); }
#pragma unroll
        for (int ai = 0; ai < 2; ++ai)
#pragma unroll
            for (int m = 0; m < 4; ++m) { const int row = row0 + ai * HALF + m * 16; const size_t off = (size_t)row * 2048 + col0;
                const float rs = rsqrtf(row_stat32(plpart, row, fq) * (1.f / 2048.f) + EPSN); float s = 0.f;
#pragma unroll
                for (int bj = 0; bj < 2; ++bj) { const u32x4 pw = *(const u32x4*)(PL + off + bj * HALF), hw = *(const u32x4*)(hin + off + bj * HALF);
                    const f32x4 p0 = (f32x4){bflo(pw.x), bfhi(pw.x), bflo(pw.y), bfhi(pw.y)} * pn[bj][0] * rs, p1 = (f32x4){bflo(pw.z), bfhi(pw.z), bflo(pw.w), bfhi(pw.w)} * pn[bj][1] * rs;
                    f32x4 h0 = (f32x4){bflo(hw.x), bfhi(hw.x), bflo(hw.y), bfhi(hw.y)}, h1 = (f32x4){bflo(hw.z), bfhi(hw.z), bflo(hw.w), bfhi(hw.w)};
#pragma unroll
                    for (int j = 0; j < 4; ++j) { h0[j] += fsigmoid(acc[ai][bj][m][0][j]) * p0[j]; h1[j] += fsigmoid(acc[ai][bj][m][1][j]) * p1[j]; }
                    if (outf) { *(f32x4*)(outf + off + bj * HALF) = h0; *(f32x4*)(outf + off + bj * HALF + 4) = h1; }
                    else *(u32x4*)(h16out + off + bj * HALF) = pack8(h0, h1);
                    s += ((h0[0] * h0[0] + h0[1] * h0[1]) + (h0[2] * h0[2] + h0[3] * h0[3])) + ((h1[0] * h1[0] + h1[1] * h1[1]) + (h1[2] * h1[2] + h1[3] * h1[3])); }
                s += __shfl_xor(s, 16); s += __shfl_xor(s, 32);
                if (fq == 0) hpart[(size_t)row * 32 + u.pn * 4 + wc] = s;
                asm volatile("" ::: "memory"); }
    }
};
struct EpiGateFinal {
    static constexpr bool PERM = true, AFTER_DRAIN = true;
    const bf16_t* hin; float* outf; const bf16_t* PL; const float* plpart; const float* ple_norm; const float* fin_norm; float* xbuf; unsigned* cnt; float peps; int dry;
    __device__ __forceinline__ void fused(f32x4 (&acc)[2][2][4][2], const Unit& u, int wr, int wc, int fr, int fq, PG8_LAS unsigned char* lds, int wid, int lane) const {
        if (dry) return;
        PG8_LAS float* P = (PG8_LAS float*)lds;
        PG8_LAS float* S = (PG8_LAS float*)(lds + 4096);
        const int row0 = u.pm * BM + wr * 64 + fr, col0 = u.pn * BM + wc * 32 + 8 * fq;
        {
            f32x4 pn[2][2];
#pragma unroll
            for (int bj = 0; bj < 2; ++bj) { pn[bj][0] = *(const f32x4*)(ple_norm + col0 + bj * HALF); pn[bj][1] = *(const f32x4*)(ple_norm + col0 + bj * HALF + 4); }
#pragma unroll
            for (int ai = 0; ai < 2; ++ai)
#pragma unroll
                for (int m = 0; m < 4; ++m) { const int row = row0 + ai * HALF + m * 16; const size_t off = (size_t)row * 2048 + col0;
                    const float rs = rsqrtf(row_stat32(plpart, row, fq) * (1.f / 2048.f) + EPSN); float s = 0.f;
#pragma unroll
                    for (int bj = 0; bj < 2; ++bj) { const u32x4 pw = *(const u32x4*)(PL + off + bj * HALF), hw = *(const u32x4*)(hin + off + bj * HALF);
                        const f32x4 p0 = (f32x4){bflo(pw.x), bfhi(pw.x), bflo(pw.y), bfhi(pw.y)} * pn[bj][0] * rs, p1 = (f32x4){bflo(pw.z), bfhi(pw.z), bflo(pw.w), bfhi(pw.w)} * pn[bj][1] * rs;
                        f32x4 h0 = (f32x4){bflo(hw.x), bfhi(hw.x), bflo(hw.y), bfhi(hw.y)}, h1 = (f32x4){bflo(hw.z), bfhi(hw.z), bflo(hw.w), bfhi(hw.w)};
#pragma unroll
                        for (int j = 0; j < 4; ++j) { h0[j] += fsigmoid(acc[ai][bj][m][0][j]) * p0[j]; h1[j] += fsigmoid(acc[ai][bj][m][1][j]) * p1[j]; }
                        acc[ai][bj][m][0] = h0; acc[ai][bj][m][1] = h1;
                        s += ((h0[0] * h0[0] + h0[1] * h0[1]) + (h0[2] * h0[2] + h0[3] * h0[3])) + ((h1[0] * h1[0] + h1[1] * h1[1]) + (h1[2] * h1[2] + h1[3] * h1[3])); }
                    s += __shfl_xor(s, 16); s += __shfl_xor(s, 32);
                    if (fq == 0) P[(ai * HALF + wr * 64 + m * 16 + fr) * 4 + wc] = s;
                    asm volatile("" ::: "memory"); }
        }
        asm volatile("s_waitcnt lgkmcnt(0)" ::: "memory"); __builtin_amdgcn_s_barrier(); asm volatile("" ::: "memory");
        const int row = wid * 32 + (lane & 31);
        if (lane < 32) { const float s4 = (P[row * 4 + 0] + P[row * 4 + 1]) + (P[row * 4 + 2] + P[row * 4 + 3]);
            __hip_atomic_store(xbuf + (size_t)(u.pm * BM + row) * 8 + u.pn, s4, __ATOMIC_RELAXED, __HIP_MEMORY_SCOPE_AGENT); }
        asm volatile("s_waitcnt vmcnt(0)" ::: "memory");
        if (lane == 0) __hip_atomic_fetch_add(cnt + 64 * u.pm, 1u, __ATOMIC_RELAXED, __HIP_MEMORY_SCOPE_AGENT);
        if (wid == 0) {
            unsigned spins = 0;
            while ((unsigned)__builtin_amdgcn_readfirstlane(__hip_atomic_load(cnt + 64 * u.pm, __ATOMIC_RELAXED, __HIP_MEMORY_SCOPE_AGENT)) < 64u) { __builtin_amdgcn_s_sleep(2); if (++spins > (1u << 24)) break; }
            __builtin_amdgcn_fence(__ATOMIC_ACQUIRE, "agent");
        }
        asm volatile("s_waitcnt vmcnt(0) lgkmcnt(0)" ::: "memory"); __builtin_amdgcn_s_barrier(); asm volatile("" ::: "memory");
        if (lane < 32) { const float* xp = xbuf + (size_t)(u.pm * BM + row) * 8; float t = 0.f;
#pragma unroll
            for (int k = 0; k < 8; ++k) t += __hip_atomic_load(xp + k, __ATOMIC_RELAXED, __HIP_MEMORY_SCOPE_AGENT);
            S[row] = rsqrtf(t * (1.f / 2048.f) + EPSN); }
        asm volatile("s_waitcnt lgkmcnt(0)" ::: "memory"); __builtin_amdgcn_s_barrier(); asm volatile("" ::: "memory");
        f32x4 fn[2][2];
#pragma unroll
        for (int bj = 0; bj < 2; ++bj) { fn[bj][0] = *(const f32x4*)(fin_norm + col0 + bj * HALF); fn[bj][1] = *(const f32x4*)(fin_norm + col0 + bj * HALF + 4); }
#pragma unroll
        for (int ai = 0; ai < 2; ++ai)
#pragma unroll
            for (int m = 0; m < 4; ++m) { const int r = ai * HALF + wr * 64 + m * 16 + fr; const float rs = S[r]; const size_t off = (size_t)(u.pm * BM + r) * 2048 + col0;
#pragma unroll
                for (int bj = 0; bj < 2; ++bj) { *(f32x4*)(outf + off + bj * HALF) = acc[ai][bj][m][0] * fn[bj][0] * rs + peps; *(f32x4*)(outf + off + bj * HALF + 4) = acc[ai][bj][m][1] * fn[bj][1] * rs + peps; } }
    }
};
}

constexpr int NWAVES = 8;
constexpr int NB = 4, S = 2048, D = 2048, M = NB * S, PLE = 256;
constexpr float EPS = 1e-6f;
typedef unsigned short bf16_t;
typedef float f32x4 __attribute__((ext_vector_type(4)));
typedef unsigned v4u __attribute__((ext_vector_type(4)));
typedef unsigned v2u __attribute__((ext_vector_type(2)));

constexpr size_t MiB = 1u << 20;
constexpr size_t OFF_CTL = 0, CTL_ZERO_BYTES = 128 * 1024;
constexpr size_t OFF_WIN0 = 1 * MiB;
constexpr size_t OFF_WOUT0 = 25 * MiB;
constexpr size_t OFF_WG0 = 33 * MiB;
constexpr size_t OFF_WIN1 = 41 * MiB;
constexpr size_t OFF_WOUT1 = 73 * MiB;
constexpr size_t OFF_WG1 = 81 * MiB;
constexpr size_t OFF_PLEW = 89 * MiB;
constexpr size_t OFF_WGATE1 = 91 * MiB;
constexpr size_t OFF_SMALL = 91 * MiB + 65536;
constexpr size_t OFF_GATES1 = 92 * MiB;
constexpr size_t OFF_PART = 92 * MiB + 524288;
constexpr size_t OFF_A = 95 * MiB;
constexpr size_t OFF_B = 127 * MiB;
constexpr size_t OFF_U = 159 * MiB;
constexpr size_t WS_END = 255 * MiB;
constexpr size_t OFF_ACUM = OFF_B;
constexpr size_t OFF_CARRY = OFF_B + 17 * MiB;
constexpr size_t OFF_DECAY = OFF_B + 18 * MiB;
constexpr size_t OFF_WRT = OFF_SMALL + 65536;
constexpr int CW_FIN = 16384;
constexpr int CW_BAR = 4096;

constexpr int RING_BYTES = 131072;
constexpr int MISC_OFF = 147456 - 256;
constexpr int LDS_BYTES = 147456;

constexpr size_t UT = (size_t)8192 * 256;
__host__ __device__ __forceinline__ size_t uidx(size_t row, int col) { return ((size_t)(col >> 8) * 8192 + row) * 256 + (col & 255); }
#define LAS __attribute__((address_space(3)))
#define GAS __attribute__((address_space(1)))
__device__ __forceinline__ float bf2f(bf16_t b) { return __uint_as_float(((unsigned)b) << 16); }
typedef __bf16 bf16v2f_t __attribute__((ext_vector_type(2)));
typedef float f32v2f_t __attribute__((ext_vector_type(2)));
__device__ __forceinline__ unsigned f2bf(float f) { const f32v2f_t v = {f, 0.f}; return __builtin_bit_cast(unsigned, __builtin_convertvector(v, bf16v2f_t)) & 0xffffu; }
__device__ __forceinline__ unsigned pk2(float lo, float hi) { const f32v2f_t v = {lo, hi}; return __builtin_bit_cast(unsigned, __builtin_convertvector(v, bf16v2f_t)); }
__device__ __forceinline__ float sigmoidf_(float x) { return __builtin_amdgcn_rcpf(1.f + __expf(-x)); }
__device__ __forceinline__ float siluf_(float x) { return x * __builtin_amdgcn_rcpf(1.f + __expf(-x)); }
__device__ __forceinline__ float one_minus_exp(float x) {
    float r = -x * (1.f + x * (0.5f + x * (0.16666667f + x * (0.041666668f + x * (0.0083333338f + x * 0.0013888889f)))));
    if (__any(x < -0.25f)) r = x < -0.25f ? 1.f - __expf(x) : r;
    return r;
}
__device__ __forceinline__ float one_minus_exp_sq(float x, float a) {
    const float r = -x * (1.f + x * (0.5f + x * (0.16666667f + x * (0.041666668f + x * (0.0083333338f + x * 0.0013888889f)))));
    return x < -0.25f ? __builtin_fmaf(-a, a, 1.f) : r;
}
__device__ __forceinline__ float wave_sum(float v) {
#pragma unroll
    for (int o = 1; o < 64; o <<= 1) v += __shfl_xor(v, o);
    return v;
}
#define LDS_WAIT() asm volatile("s_waitcnt lgkmcnt(0)" ::: "memory")
#define WG_BAR() asm volatile("s_waitcnt lgkmcnt(0)\n\ts_barrier" ::: "memory")
#define XB_TMO      128
#define XB_XCNT(j)  (256  + 64 * (j))
#define XB_XSUB(j)  (1280 + 64 * (j))
#define XB_XGEN(j)  (2304 + 64 * (j))
#define XB_TOP      3328
#define XB_TOPGEN   3392
#define XCD_BAR_WORDS 3456
#define XB_SPIN_CAP (1u << 26)

__device__ __forceinline__ unsigned xb_ld(unsigned* p)              { return __hip_atomic_load(p, __ATOMIC_RELAXED, __HIP_MEMORY_SCOPE_AGENT); }
__device__ __forceinline__ unsigned xb_add(unsigned* p, unsigned v) { return __hip_atomic_fetch_add(p, v, __ATOMIC_RELAXED, __HIP_MEMORY_SCOPE_AGENT); }
__device__ __forceinline__ unsigned xb_xcc_id() { return (unsigned)__builtin_amdgcn_s_getreg((3 << 11) | 20) & 0xFu; }
#define XB_SPIN(cond, bar) do { unsigned _sp = 0; while (cond) { __builtin_amdgcn_s_sleep(1); \
    if ((++_sp & 255u) == 0u) { if (xb_ld(&(bar)[XB_TMO])) break; if (_sp > XB_SPIN_CAP) { atomicAdd(&(bar)[XB_TMO], 1u); break; } } } } while (0)

struct XcdBarrier {
    unsigned* bar; unsigned x;
    volatile LAS unsigned* st;
};

__device__ __forceinline__ XcdBarrier xcd_barrier_post(unsigned* bar, volatile LAS unsigned* st) {
    XcdBarrier b; b.bar = bar; b.x = xb_xcc_id(); b.st = st;
    if (threadIdx.x == 0) (void)xb_add(&bar[XB_XCNT(b.x)], 1u);
    return b;
}
__device__ __forceinline__ void xcd_barrier_complete(unsigned* bar, unsigned x, unsigned& nloc, unsigned& nx) {
    const unsigned G = gridDim.x * gridDim.y * gridDim.z;
    unsigned sum, cnt, mine, sp = 0u;
    for (;;) {
        sum = 0u; cnt = 0u; mine = 0u;
#pragma unroll
        for (unsigned j = 0; j < 16; ++j) { const unsigned c = xb_ld(&bar[XB_XCNT(j)]); sum += c; cnt += (c > 0u) ? 1u : 0u; mine = (j == x) ? c : mine; }
        if (sum == G) break;
        __builtin_amdgcn_s_sleep(1);
        if ((++sp & 255u) == 0u) { if (xb_ld(&bar[XB_TMO])) break; if (sp > XB_SPIN_CAP) { atomicAdd(&bar[XB_TMO], 1u); break; } }
    }
    nloc = mine > 0u ? mine : 1u; nx = cnt > 0u ? cnt : 1u;
}

__device__ __forceinline__ void xcd_barrier(const XcdBarrier& b) {
    asm volatile("s_waitcnt vmcnt(0)" ::: "memory");
    __syncthreads();
    if (threadIdx.x == 0) {
        unsigned* bar = b.bar;
        __builtin_amdgcn_s_waitcnt(0);
        unsigned nloc = b.st[0], nx = b.st[1];
        if (nloc == 0u) { xcd_barrier_complete(bar, b.x, nloc, nx); b.st[0] = nloc; b.st[1] = nx; }
        const unsigned old = xb_add(&bar[XB_XSUB(b.x)], 1u);
        const unsigned gen = old / nloc;
        if (old + 1u == (gen + 1u) * nloc) {
            __builtin_amdgcn_fence(__ATOMIC_RELEASE, "agent");
            asm volatile("s_waitcnt vmcnt(0)" ::: "memory");
            const unsigned og = xb_add(&bar[XB_TOP], 1u);
            const unsigned tg = og / nx;
            if (og + 1u == (tg + 1u) * nx) xb_add(&bar[XB_TOPGEN], 1u);
            else XB_SPIN(xb_ld(&bar[XB_TOPGEN]) == tg, bar);
            __builtin_amdgcn_fence(__ATOMIC_ACQUIRE, "agent");
            asm volatile("s_waitcnt vmcnt(0)" ::: "memory");
            xb_add(&bar[XB_XGEN(b.x)], 1u);
            asm volatile("s_waitcnt vmcnt(0)" ::: "memory");
        } else {
            __builtin_amdgcn_fence(__ATOMIC_ACQUIRE, "agent");
            XB_SPIN(xb_ld(&bar[XB_XGEN(b.x)]) == gen, bar);
            asm volatile("s_waitcnt vmcnt(0)" ::: "memory");
        }
    }
    __syncthreads();
}

struct Ptrs {
    const float* in[26]; float* out; unsigned char* ws; int ph_lo, ph_hi, li, dup;
};
__device__ __forceinline__ int srccol_in1(int n) {
    if (n < 4096) return n;
    const int r = n - 4096, j = r >> 8, i = r & 255;
    return i < 128 ? 4096 + 128 * j + i : 6144 + 128 * j + (i - 128);
}
struct TJob { const float* W; bf16_t* WT; const float* gain; int K, ldw, nblk, item; bool map1; };
__device__ __forceinline__ void tjob_load(const TJob& j, int lane, float (&wv)[32]) {
    const int kb = j.item / j.nblk, nb = j.item % j.nblk, k0 = 64 * kb, n0 = 32 * nb, s0 = j.map1 ? srccol_in1(n0) : n0;
#pragma unroll
    for (int i = 0; i < 32; ++i) wv[i] = __builtin_nontemporal_load(j.W + (size_t)(k0 + 2 * i + (lane >> 5)) * j.ldw + s0 + (lane & 31));
}
__device__ __forceinline__ void tjob_finish(const TJob& j, int lane, LAS float* scr, float (&wv)[32]) {
    const int kb = j.item / j.nblk, nb = j.item % j.nblk, k0 = 64 * kb, n0 = 32 * nb;
    if (j.gain) {
#pragma unroll
        for (int i = 0; i < 32; ++i) wv[i] *= j.gain[k0 + 2 * i + (lane >> 5)];
    }
#pragma unroll
    for (int i = 0; i < 32; ++i) scr[(2 * i + (lane >> 5)) * 33 + (lane & 31)] = wv[i];
    LDS_WAIT(); asm volatile("" ::: "memory");
    const int c = lane & 7;
#pragma unroll
    for (int q = 0; q < 4; ++q) { const int n = (lane >> 3) + 8 * q; const LAS float* s = scr + (8 * c) * 33 + n;
        v4u o; o.x = pk2(s[0 * 33], s[1 * 33]); o.y = pk2(s[2 * 33], s[3 * 33]); o.z = pk2(s[4 * 33], s[5 * 33]); o.w = pk2(s[6 * 33], s[7 * 33]);
        *(v4u*)(j.WT + (size_t)(n0 + n) * j.K + k0 + 8 * c) = o; }
    LDS_WAIT(); asm volatile("" ::: "memory");
}
struct Frame {
    LAS unsigned char* lds; int tid, lane, wave, G, bid;
    const float* const* in; float* out; unsigned char* ws;
};
__device__ __forceinline__ TJob tjob_layer0(const Frame& F, int r) {
    constexpr int I_IN0 = 32 * 192, I_SQ = 32 * 64, I_PLE = 4 * 64;
    unsigned char* ws = F.ws; TJob j;
    if (r < I_IN0) { j = TJob{F.in[3], (bf16_t*)(ws + OFF_WIN0), F.in[2], 2048, 6144, 192, r, false}; return j; } r -= I_IN0;
    if (r < I_SQ) { j = TJob{F.in[13], (bf16_t*)(ws + OFF_WOUT0), nullptr, 2048, 2048, 64, r, false}; return j; } r -= I_SQ;
    if (r < I_SQ) { j = TJob{F.in[24], (bf16_t*)(ws + OFF_WG0), nullptr, 2048, 2048, 64, r, false}; return j; } r -= I_SQ;
    if (r < I_PLE) { j = TJob{F.in[22], (bf16_t*)(ws + OFF_PLEW), nullptr, 256, 2048, 64, r, false}; return j; } r -= I_PLE;
    j = TJob{F.in[22] + (size_t)256 * 2048, (bf16_t*)(ws + OFF_PLEW) + (size_t)2048 * 256, nullptr, 256, 2048, 64, r, false}; return j;
}
constexpr int TJOBS_LAYER0 = 32 * 192 + 2 * 32 * 64 + 2 * 4 * 64;
__device__ __forceinline__ TJob tjob_layer1(const Frame& F, int r) {
    constexpr int I_SQ = 32 * 64, I_IN1 = 32 * 256;
    unsigned char* ws = F.ws; TJob j;
    if (r < I_IN1) { j = TJob{F.in[15], (bf16_t*)(ws + OFF_WIN1), F.in[14], 2048, 8208, 256, r, true}; return j; } r -= I_IN1;
    if (r < I_SQ) { j = TJob{F.in[21], (bf16_t*)(ws + OFF_WOUT1), nullptr, 2048, 2048, 64, r, false}; return j; } r -= I_SQ;
    j = TJob{F.in[24] + (size_t)2048 * 2048, (bf16_t*)(ws + OFF_WG1), nullptr, 2048, 2048, 64, r, false}; return j;
}
constexpr int TJOBS_LAYER1 = 32 * 256 + 2 * 32 * 64;
#define TJOB_RUN(JOBFN, NJOBS, gw, NGW) do { \
        LAS float* scr_ = (LAS float*)(F.lds + F.wave * 16384); float wa_[32], wb_[32]; \
        int it_ = (gw); \
        if (it_ < (NJOBS)) { TJob ja_ = JOBFN(F, it_); tjob_load(ja_, F.lane, wa_); \
            for (;;) { \
                const int ib_ = it_ + (NGW); TJob jb_ = ja_; const bool hb_ = ib_ < (NJOBS); if (hb_) { jb_ = JOBFN(F, ib_); tjob_load(jb_, F.lane, wb_); } \
                tjob_finish(ja_, F.lane, scr_, wa_); \
                if (!hb_) break; \
                it_ = ib_ + (NGW); const bool ha_ = it_ < (NJOBS); if (ha_) { ja_ = JOBFN(F, it_); tjob_load(ja_, F.lane, wa_); } \
                tjob_finish(jb_, F.lane, scr_, wb_); \
                if (!ha_) break; \
            } } } while (0)
__device__ __forceinline__ void p0_layer1_weights(const Frame& F, int gw, int NGW) {
    TJOB_RUN(tjob_layer1, TJOBS_LAYER1, gw, NGW);
    const float* o_norm = F.in[14]; const float* o_w_in = F.in[15];
    const int gt = gw * 64 + F.lane, NGT = NGW * 64;
    bf16_t* WGATE1 = (bf16_t*)(F.ws + OFF_WGATE1);
    for (int i = gt; i < 16 * 2048; i += NGT) { const int j = i >> 11, k = i & 2047; WGATE1[i] = (bf16_t)f2bf(o_w_in[(size_t)k * 8208 + 8192 + j] * o_norm[k]); }
}
__device__ __forceinline__ void p0_prologue(const Frame& F) {
    const int gw = F.bid * NWAVES + F.wave, NGW = F.G * NWAVES;
    unsigned char* ws = F.ws;
    TJOB_RUN(tjob_layer0, TJOBS_LAYER0, gw, NGW);
    const float* x = F.in[0]; bf16_t* A = (bf16_t*)F.out;     float* rstd0 = (float*)(ws + OFF_SMALL) + 1024;
    for (int m = gw; m < M; m += NGW) {
        const f32x4* xr = (const f32x4*)(x + (size_t)m * D) + F.lane; f32x4 v[8]; float s = 0.f;
#pragma unroll
        for (int j = 0; j < 8; ++j) { v[j] = __builtin_nontemporal_load(xr + 64 * j); s += (v[j].x * v[j].x + v[j].y * v[j].y) + (v[j].z * v[j].z + v[j].w * v[j].w); }
        s = wave_sum(s);
        v2u* o8 = (v2u*)(A + (size_t)m * D) + F.lane;
#pragma unroll
        for (int j = 0; j < 8; ++j) { v2u w; w.x = pk2(v[j].x, v[j].y); w.y = pk2(v[j].z, v[j].w); o8[64 * j] = w; }
        if (F.lane == 0) rstd0[m] = rsqrtf(s * (1.f / D) + EPS);
    }
    const int gt = F.bid * (NWAVES * 64) + F.tid, NGT = F.G * NWAVES * 64;
    bf16_t* WRT = (bf16_t*)(ws + OFF_WRT); const float* w_r = F.in[8]; const float* w_i = F.in[10];
    for (int i = gt; i < 2 * 131072; i += NGT) { const int j = i & 131071, n = j >> 14, d = (j >> 7) & 127, cc = j & 127; WRT[i] = (bf16_t)f2bf(((i >> 17) ? w_i : w_r)[n * 16384 + cc * 128 + d]); }
    float* lb = (float*)(ws + OFF_SMALL); const float* logits = F.in[4];
    for (int c = gt; c < 1024; c += NGT) lb[c] = 1.f / (1.f + expf(logits[1024 + c] - logits[c]));
}
__device__ __forceinline__ void gates1_phase(const Frame& F, const int dry) {
    typedef short g1_bf16x8 __attribute__((ext_vector_type(8)));
    typedef float g1_f32x4 __attribute__((ext_vector_type(4)));
    const bf16_t* A = (const bf16_t*)(F.ws + OFF_A); const bf16_t* WG = (const bf16_t*)(F.ws + OFF_WGATE1);
    const float* hpart = (const float*)(F.ws + OFF_PART) + (size_t)M * 32; float* gates = (float*)(F.ws + OFF_GATES1);
    LAS bf16_t* WL = (LAS bf16_t*)F.lds;
    LAS float* RED = (LAS float*)(F.lds + 65536);
    LAS float* RS = RED + 2048;
    const int tid = F.tid, w = F.wave, lane = F.lane, r = lane & 15, g = lane >> 4, ti = w >> 2, kq = w & 3;
#pragma unroll
    for (int j = 0; j < 8; ++j) { const int p = tid + 512 * j, kb = p >> 6, c = (p >> 2) & 15, g4 = p & 3;
        *(LAS g1_bf16x8*)(WL + p * 8) = *(const g1_bf16x8*)(WG + (size_t)c * D + 32 * kb + 8 * g4); }
    WG_BAR();
    for (int rt = F.bid; rt < M / 32; rt += F.G) {
        const size_t row0 = (size_t)rt * 32;
        { const int row = tid >> 4, sub = tid & 15; float ss = hpart[(row0 + row) * 32 + sub] + hpart[(row0 + row) * 32 + 16 + sub];
          ss += __shfl_xor(ss, 8); ss += __shfl_xor(ss, 4); ss += __shfl_xor(ss, 2); ss += __shfl_xor(ss, 1);
          if (sub == 0) RS[row] = rsqrtf(ss * (1.f / D) + EPS); }
        g1_bf16x8 af[16];
        const bf16_t* ap = A + (row0 + 16 * ti + r) * D + 512 * kq + 8 * g;
#pragma unroll
        for (int i = 0; i < 16; ++i) af[i] = *(const g1_bf16x8*)(ap + 32 * i);
        g1_f32x4 acc = {0.f, 0.f, 0.f, 0.f};
#pragma unroll
        for (int i = 0; i < 16; ++i) { const g1_bf16x8 bb = *(const LAS g1_bf16x8*)(WL + ((16 * kq + i) * 16 + r) * 32 + 8 * g);
            acc = __builtin_amdgcn_mfma_f32_16x16x32_bf16(af[i], bb, acc, 0, 0, 0); }
#pragma unroll
        for (int j = 0; j < 4; ++j) RED[((ti * 4 + kq) * 16 + 4 * g + j) * 16 + r] = acc[j];
        WG_BAR();
        { const int row = tid >> 4, gt = tid & 15, t2 = row >> 4, rr = row & 15;
          const float v = (RED[((t2 * 4 + 0) * 16 + rr) * 16 + gt] + RED[((t2 * 4 + 1) * 16 + rr) * 16 + gt]) + (RED[((t2 * 4 + 2) * 16 + rr) * 16 + gt] + RED[((t2 * 4 + 3) * 16 + rr) * 16 + gt]);
          if (!dry) gates[(row0 + row) * 16 + gt] = v * RS[row]; }
        WG_BAR();
    }
}

__device__ __forceinline__ void cvt_p_phase(const Frame& F, const int dry) {
    const float* p = F.in[1]; bf16_t* P16 = (bf16_t*)(F.ws + OFF_WIN0);
    const size_t n4 = (size_t)2 * M * PLE / 4, gt = (size_t)F.bid * (NWAVES * 64) + F.tid, NGT = (size_t)F.G * NWAVES * 64;
    for (size_t i = gt; i < n4; i += NGT) { const f32x4 v = __builtin_nontemporal_load((const f32x4*)p + i); v2u w; w.x = pk2(v.x, v.y); w.y = pk2(v.z, v.w); if (!dry) ((v2u*)P16)[i] = w; }
}

typedef short bf16x8_t __attribute__((ext_vector_type(8)));
typedef float f32x16 __attribute__((ext_vector_type(16)));
typedef float f32x4_t __attribute__((ext_vector_type(4)));
typedef short bf16x4_t __attribute__((ext_vector_type(4)));
__device__ __forceinline__ bf16x8_t pack_bf16x8(float a0, float a1, float a2, float a3, float a4, float a5, float a6, float a7) {
    v4u w; w.x = pg8::cvt_pk_bf16(a0, a1); w.y = pg8::cvt_pk_bf16(a2, a3); w.z = pg8::cvt_pk_bf16(a4, a5); w.w = pg8::cvt_pk_bf16(a6, a7);
    return __builtin_bit_cast(bf16x8_t, w);
}
__device__ __forceinline__ bf16x8_t cat_bf16x4(v2u lo, v2u hi) { v4u w; w.x = lo.x; w.y = lo.y; w.z = hi.x; w.w = hi.y; return __builtin_bit_cast(bf16x8_t, w); }


struct LruW { bf16x8_t br[8], bi[8]; };
__device__ __forceinline__ void rglru_a_weights(const Frame& F, int n, LruW& wf) {
    const bf16_t* WRT = (const bf16_t*)(F.ws + OFF_WRT) + (size_t)n * 16384; const bf16_t* WIT = WRT + 8 * 16384;
    const int db = F.wave & 3, l31 = F.lane & 31, hh = F.lane >> 5;
    const bf16_t* rp = WRT + (size_t)(32 * db + l31) * 128 + 8 * hh; const bf16_t* ip = WIT + (size_t)(32 * db + l31) * 128 + 8 * hh;
#pragma unroll
    for (int ks = 0; ks < 8; ++ks) { wf.br[ks] = *(const bf16x8_t*)(rp + 16 * ks); wf.bi[ks] = *(const bf16x8_t*)(ip + 16 * ks); }
}
struct LruRaw { unsigned short xv[19]; float cw[4], cb, brv, biv, lamv; };
__device__ __forceinline__ void rglru_a_load(const Frame& F, int b, int c, int n, LruRaw& r) {
    const int d = F.tid & 127, q = F.tid >> 7, ch = n * 128 + d, t0 = c * 64;
    const bf16_t* U = (const bf16_t*)(F.ws + OFF_U);
#pragma unroll
    for (int i = 0; i < 19; ++i) { const int t = t0 + 16 * q - 3 + i; r.xv[i] = (t >= 0) ? U[uidx((size_t)b * S + t, 4096 + ch)] : (unsigned short)0; }
    const float* conv_w = F.in[6];
#pragma unroll
    for (int k = 0; k < 4; ++k) r.cw[k] = conv_w[k * 1024 + ch];
    r.cb = F.in[7][ch];
    const int chc = n * 128 + 32 * (F.wave & 3) + (F.lane & 31);
    r.brv = F.in[9][chc]; r.biv = F.in[11][chc]; r.lamv = F.in[12][chc];
}
__device__ __forceinline__ void rglru_a_item(const Frame& F, const int dry, int b, int c, int n, const LruRaw& raw, const LruW& wf) {
    constexpr int XS = 136;
    LAS bf16_t* XT = (LAS bf16_t*)F.lds;
    LAS float* AL = (LAS float*)(F.lds + 17408);
    LAS float* ML = AL + 8192;
    LAS float* AGG = ML + 8192;
    LAS bf16_t* HT = (LAS bf16_t*)(AGG + 1024);
    LAS bf16_t* CT = HT + 64 * 136;
    const bf16_t* U = (const bf16_t*)(F.ws + OFF_U); bf16_t* HL = (bf16_t*)(F.ws + OFF_A); bf16_t* AC = (bf16_t*)(F.ws + OFF_ACUM); float* carry = (float*)(F.ws + OFF_CARRY);
    const bf16_t* WRT = (const bf16_t*)(F.ws + OFF_WRT) + (size_t)n * 16384; const bf16_t* WIT = WRT + 8 * 16384;
    const float* conv_w = F.in[6]; const float* conv_b = F.in[7]; const float* b_r = F.in[9]; const float* b_i = F.in[11]; const float* lam = F.in[12];
    const int tid = F.tid, d = tid & 127, q = tid >> 7, ch = n * 128 + d, t0 = c * 64;
    const size_t row0 = (size_t)b * S + t0;
    float xc[16];
    {
        float xv[19];
#pragma unroll
        for (int i = 0; i < 19; ++i) xv[i] = bf2f(raw.xv[i]);
        const float cw0 = raw.cw[0], cw1 = raw.cw[1], cw2 = raw.cw[2], cw3 = raw.cw[3], cb = raw.cb;
#pragma unroll
        for (int i = 0; i < 16; ++i) { xc[i] = cb + cw0 * xv[i] + cw1 * xv[i + 1] + cw2 * xv[i + 2] + cw3 * xv[i + 3]; XT[(16 * q + i) * XS + d] = (bf16_t)f2bf(xc[i]); }
    }
    WG_BAR();
    {
        const int w = F.wave, tt = w >> 2, db = w & 3, l31 = F.lane & 31, hh = F.lane >> 5;
        f32x16 accR, accI;
#pragma unroll
        for (int r = 0; r < 16; ++r) { accR[r] = 0.f; accI[r] = 0.f; }
        const LAS bf16_t* ap = XT + (32 * tt + l31) * XS + 8 * hh;
#pragma unroll
        for (int ks = 0; ks < 8; ++ks) {
            const bf16x8_t a = *(const LAS bf16x8_t*)(ap + 16 * ks);
            accR = __builtin_amdgcn_mfma_f32_32x32x16_bf16(a, wf.br[ks], accR, 0, 0, 0);
            accI = __builtin_amdgcn_mfma_f32_32x32x16_bf16(a, wf.bi[ks], accI, 0, 0, 0);
        }
        const int dc = 32 * db + l31, chc = n * 128 + dc;
        const float brv = raw.brv, biv = raw.biv, ey_ = __expf(-raw.lamv), sp = ey_ > 0.02f ? __logf(1.f + ey_) : ey_ * (1.f - ey_ * (0.5f - ey_ * 0.33333334f));
#pragma unroll
        for (int r = 0; r < 16; ++r) {
            const int t = 32 * tt + (r & 3) + 8 * (r >> 2) + 4 * hh;
            const float rr = sigmoidf_(accR[r] + brv), ii = sigmoidf_(accI[r] + biv), la = -8.f * rr * sp;
            const float av = __expf(la); AL[t * 128 + dc] = av; ML[t * 128 + dc] = __builtin_amdgcn_sqrtf(one_minus_exp_sq(2.f * la, av)) * ii;
        }
    }
    WG_BAR();
    float hl[16], ac[16];
    {
        float h = 0.f, Ac = 1.f;
#pragma unroll
        for (int i = 0; i < 16; ++i) { const int t = 16 * q + i; const float a = AL[t * 128 + d], u = ML[t * 128 + d] * xc[i]; h = a * h + u; Ac *= a; hl[i] = h; ac[i] = Ac; }
        AGG[(q * 2 + 0) * 128 + d] = Ac; AGG[(q * 2 + 1) * 128 + d] = h;
    }
    WG_BAR();
    {
        float Hp = 0.f, Ap = 1.f;
#pragma unroll
        for (int qq = 0; qq < 3; ++qq) if (qq < q) { const float a = AGG[(qq * 2 + 0) * 128 + d], hh_ = AGG[(qq * 2 + 1) * 128 + d]; Hp = a * Hp + hh_; Ap *= a; }
#pragma unroll
        for (int i = 0; i < 16; ++i) { const size_t row = row0 + 16 * q + i; const float hv = hl[i] + ac[i] * Hp, av = ac[i] * Ap;
            HT[(16 * q + i) * 136 + d] = (bf16_t)f2bf(hv); CT[(16 * q + i) * 136 + d] = (bf16_t)f2bf(av);
            if (q == 3 && i == 15 && !dry) { float* cp = carry + ((size_t)((b * 32 + c) * 8 + n)) * 256; cp[d] = av; cp[128 + d] = hv; } }
    }
    WG_BAR();
#pragma unroll
    for (int j = 0; j < 2; ++j) { const int p = tid + 512 * j, t_ = p >> 4, c16 = p & 15; const bf16x8_t h_ = *(const LAS bf16x8_t*)(HT + t_ * 136 + c16 * 8), a_ = *(const LAS bf16x8_t*)(CT + t_ * 136 + c16 * 8);
        if (!dry) { *(bf16x8_t*)(HL + (row0 + t_) * D + 1024 + n * 128 + c16 * 8) = h_; *(bf16x8_t*)(AC + (row0 + t_) * 1024 + n * 128 + c16 * 8) = a_; } }
    WG_BAR();
}
__device__ __forceinline__ void rglru_b_item(const Frame& F, const int dry, int b, int c, int n) {
    LAS float* HC = (LAS float*)F.lds;
    const bf16_t* U = (const bf16_t*)(F.ws + OFF_U); bf16_t* Y = (bf16_t*)(F.ws + OFF_A); const bf16_t* AC = (const bf16_t*)(F.ws + OFF_ACUM); const float* carry = (const float*)(F.ws + OFF_CARRY);
    const int tid = F.tid;
    const size_t row0 = (size_t)b * S + c * 64;
    bf16x8_t hl[2], av[2], zb[2];
#pragma unroll
    for (int j = 0; j < 2; ++j) { const int p = tid + 512 * j, t_ = p >> 4, c16 = p & 15; const size_t row = row0 + t_;
        hl[j] = __builtin_nontemporal_load((const bf16x8_t*)(Y + row * D + 1024 + n * 128 + c16 * 8)); av[j] = __builtin_nontemporal_load((const bf16x8_t*)(AC + row * 1024 + n * 128 + c16 * 8)); zb[j] = __builtin_nontemporal_load((const bf16x8_t*)(U + uidx(row, 5120 + n * 128 + c16 * 8))); }
    if (tid < 128) { float H = 0.f;
        for (int cc = 0; cc < c; ++cc) { const float* cp = carry + ((size_t)((b * 32 + cc) * 8 + n)) * 256; H = cp[tid] * H + cp[128 + tid]; }
        HC[tid] = H; }
    WG_BAR();
#pragma unroll
    for (int j = 0; j < 2; ++j) { const int p = tid + 512 * j, t_ = p >> 4, c16 = p & 15; const size_t row = row0 + t_;
        const v4u hw = __builtin_bit_cast(v4u, hl[j]), aw = __builtin_bit_cast(v4u, av[j]), zw = __builtin_bit_cast(v4u, zb[j]);
        const f32x4_t H0 = *(const LAS f32x4_t*)(HC + c16 * 8), H1 = *(const LAS f32x4_t*)(HC + c16 * 8 + 4);
        const bf16x8_t y_ = pack_bf16x8((pg8::bflo(hw.x) + pg8::bflo(aw.x) * H0[0]) * siluf_(pg8::bflo(zw.x)), (pg8::bfhi(hw.x) + pg8::bfhi(aw.x) * H0[1]) * siluf_(pg8::bfhi(zw.x)),
                                        (pg8::bflo(hw.y) + pg8::bflo(aw.y) * H0[2]) * siluf_(pg8::bflo(zw.y)), (pg8::bfhi(hw.y) + pg8::bfhi(aw.y) * H0[3]) * siluf_(pg8::bfhi(zw.y)),
                                        (pg8::bflo(hw.z) + pg8::bflo(aw.z) * H1[0]) * siluf_(pg8::bflo(zw.z)), (pg8::bfhi(hw.z) + pg8::bfhi(aw.z) * H1[1]) * siluf_(pg8::bfhi(zw.z)),
                                        (pg8::bflo(hw.w) + pg8::bflo(aw.w) * H1[2]) * siluf_(pg8::bflo(zw.w)), (pg8::bfhi(hw.w) + pg8::bfhi(aw.w) * H1[3]) * siluf_(pg8::bfhi(zw.w)));
        if (!dry) *(bf16x8_t*)(Y + row * D + 1024 + n * 128 + c16 * 8) = y_; }
    WG_BAR();
}

struct H2Raw { unsigned short qa[16], fa[16], vv[16]; float lbv; };
__device__ __forceinline__ void hgrn2_a_load(const Frame& F, int b, int c, int h, H2Raw& r) {
    const int d = F.tid & 127, q = F.tid >> 7;
    const bf16_t* up = (const bf16_t*)(F.ws + OFF_U) + uidx((size_t)b * S + c * 64 + 16 * q, h * 128 + d);
#pragma unroll
    for (int i = 0; i < 16; ++i) { r.qa[i] = up[(size_t)i * 256]; r.fa[i] = up[(size_t)i * 256 + 4 * UT]; r.vv[i] = up[(size_t)i * 256 + 8 * UT]; }
    r.lbv = ((const float*)(F.ws + OFF_SMALL))[h * 128 + d];
}
__device__ __forceinline__ void hgrn2_a_item(const Frame& F, const int dry, int b, int c, int h, const H2Raw& raw) {
    constexpr int QS = 136, VS = 72;
    LAS bf16_t* QT = (LAS bf16_t*)F.lds;
    LAS bf16_t* KT = QT + 64 * QS;
    LAS bf16_t* VT = KT + 64 * QS;
    LAS bf16_t* AT = VT + 128 * VS;
    LAS float* CS = (LAS float*)(AT + 64 * VS);
    LAS bf16_t* KDT = (LAS bf16_t*)(CS + 512);
    LAS bf16_t* OTL = KDT + 128 * VS;
    bf16_t* U = (bf16_t*)(F.ws + OFF_U); bf16_t* OI = (bf16_t*)(F.ws + OFF_A); float* decay = (float*)(F.ws + OFF_DECAY);
    const float* lb = (const float*)(F.ws + OFF_SMALL);
    const int tid = F.tid, d = tid & 127, q = tid >> 7, t0 = c * 64;
    const size_t row0 = (size_t)b * S + t0;
    {
        const float lbv = raw.lbv;
        float qa[16], fa[16], vv[16];
#pragma unroll
        for (int i = 0; i < 16; ++i) { qa[i] = bf2f(raw.qa[i]); fa[i] = bf2f(raw.fa[i]); vv[i] = bf2f(raw.vv[i]); }
        float cs[16]; float run = 1.f;
#pragma unroll
        for (int i = 0; i < 16; ++i) { const float e_ = __expf(-fa[i]), sg = __builtin_amdgcn_rcpf(1.f + e_); run *= lbv + (1.f - lbv) * sg; cs[i] = run; fa[i] = (1.f - lbv) * e_ * sg; }
        CS[q * 128 + d] = run;
        WG_BAR();
        float off = 1.f, tot = 1.f;
#pragma unroll
        for (int qq = 0; qq < 4; ++qq) { const float v_ = CS[qq * 128 + d]; off *= (qq < q) ? v_ : 1.f; tot *= v_; }
        float kd[16];
        const float etot = tot;
#pragma unroll
        for (int i = 0; i < 16; ++i) { const float k = fa[i], eb_ = off * cs[i], ei_ = __builtin_amdgcn_rcpf(eb_), kei = k * ei_;
            QT[(16 * q + i) * QS + d] = (bf16_t)f2bf(siluf_(qa[i]) * eb_); KT[(16 * q + i) * QS + d] = (bf16_t)f2bf(kei); kd[i] = kei * etot; }
        const bf16x8_t k0 = pack_bf16x8(kd[0], kd[1], kd[2], kd[3], kd[4], kd[5], kd[6], kd[7]), k1 = pack_bf16x8(kd[8], kd[9], kd[10], kd[11], kd[12], kd[13], kd[14], kd[15]);
        const bf16x8_t v0 = pack_bf16x8(vv[0], vv[1], vv[2], vv[3], vv[4], vv[5], vv[6], vv[7]), v1 = pack_bf16x8(vv[8], vv[9], vv[10], vv[11], vv[12], vv[13], vv[14], vv[15]);
        *(LAS bf16x8_t*)(VT + d * VS + 16 * q) = v0; *(LAS bf16x8_t*)(VT + d * VS + 16 * q + 8) = v1;
        *(LAS bf16x8_t*)(KDT + d * VS + 16 * q) = k0; *(LAS bf16x8_t*)(KDT + d * VS + 16 * q + 8) = k1;
        WG_BAR();
#pragma unroll
        for (int j = 0; j < 2; ++j) { const int p = tid + 512 * j, dd = p >> 3, c8 = p & 7; bf16_t* tp = U + uidx(row0 + (dd >> 1), h * 128 + (dd & 1) * 64 + c8 * 8);
            const bf16x8_t k_ = *(const LAS bf16x8_t*)(KDT + dd * VS + c8 * 8), v_ = *(const LAS bf16x8_t*)(VT + dd * VS + c8 * 8);
            if (!dry) { *(bf16x8_t*)(tp + 4 * UT) = k_; *(bf16x8_t*)(tp + 8 * UT) = v_; } }
        if (q == 0 && !dry) decay[((size_t)((b * 32 + c) * 8 + h)) * 128 + d] = tot;
    }
    {
        const int w = F.wave, tb = w >> 1, r = F.lane & 15, g = F.lane >> 4;
#pragma unroll
        for (int k2 = 0; k2 < 2; ++k2) {
            const int sb = 2 * (w & 1) + k2;
            f32x4_t acc = {0.f, 0.f, 0.f, 0.f};
            if (sb <= tb) {
#pragma unroll
                for (int ks = 0; ks < 4; ++ks) {
                    const bf16x8_t a = *(const LAS bf16x8_t*)(QT + (16 * tb + r) * QS + 32 * ks + 8 * g), bb = *(const LAS bf16x8_t*)(KT + (16 * sb + r) * QS + 32 * ks + 8 * g);
                    acc = __builtin_amdgcn_mfma_f32_16x16x32_bf16(a, bb, acc, 0, 0, 0);
                }
            }
#pragma unroll
            for (int j = 0; j < 4; ++j) { const int t = 16 * tb + 4 * g + j, s = 16 * sb + r; AT[t * VS + s] = (bf16_t)f2bf(s <= t ? acc[j] : 0.f); }
        }
    }
    WG_BAR();
    {
        const int w = F.wave, th = w >> 2, eb = w & 3, l31 = F.lane & 31, hh = F.lane >> 5;
        f32x16 acc;
#pragma unroll
        for (int r = 0; r < 16; ++r) acc[r] = 0.f;
#pragma unroll
        for (int ks = 0; ks < 4; ++ks) {
            const bf16x8_t a = *(const LAS bf16x8_t*)(AT + (32 * th + l31) * VS + 16 * ks + 8 * hh), bb = *(const LAS bf16x8_t*)(VT + (32 * eb + l31) * VS + 16 * ks + 8 * hh);
            acc = __builtin_amdgcn_mfma_f32_32x32x16_bf16(a, bb, acc, 0, 0, 0);
        }
#pragma unroll
        for (int r = 0; r < 16; ++r) { const int t = 32 * th + (r & 3) + 8 * (r >> 2) + 4 * hh; OTL[t * 136 + 32 * eb + l31] = (bf16_t)f2bf(acc[r]); }
#pragma unroll
        for (int j = 0; j < 2; ++j) { const int p = tid + 512 * j, row = p >> 4, c16 = p & 15; const bf16x8_t qv_ = *(const LAS bf16x8_t*)(QT + row * QS + c16 * 8); if (!dry) *(bf16x8_t*)(U + uidx(row0 + row, h * 128 + c16 * 8)) = qv_; }
    }
    WG_BAR();
#pragma unroll
    for (int j = 0; j < 2; ++j) { const int p = tid + 512 * j, t_ = p >> 4, c16 = p & 15; const bf16x8_t o_ = *(const LAS bf16x8_t*)(OTL + t_ * 136 + c16 * 8);
        if (!dry) *(bf16x8_t*)(OI + (row0 + t_) * D + h * 128 + c16 * 8) = o_; }
    WG_BAR();
}

__device__ __forceinline__ void hgrn2_b_phase(const Frame& F, const int dry, int b, int h) {
    constexpr int QS = 132, VS = 72;
    LAS bf16_t* QB = (LAS bf16_t*)F.lds;
    LAS bf16_t* KB = QB + 64 * QS;
    LAS bf16_t* VB = KB + 128 * VS;
    LAS float* DEC = (LAS float*)(VB + 128 * VS);
    LAS float* OT = DEC + 128;
    bf16_t* U = (bf16_t*)(F.ws + OFF_U); const float* decay = (const float*)(F.ws + OFF_DECAY);
    const int tid = F.tid, w = F.wave, eb = w & 3, dh = w >> 2, l31 = F.lane & 31, hh = F.lane >> 5;
    f32x16 X[2];
#pragma unroll
    for (int xi = 0; xi < 2; ++xi)
#pragma unroll
        for (int r = 0; r < 16; ++r) X[xi][r] = 0.f;
    bf16x8_t pq[2], pk[2], pv[2]; float pdec = 0.f;
    {
        const size_t row0 = (size_t)b * S;
#pragma unroll
        for (int j = 0; j < 2; ++j) { const int p = tid + 512 * j; const bf16_t* up = U + uidx(row0 + (p >> 4), h * 128 + (p & 15) * 8);
            pq[j] = *(const bf16x8_t*)up; pk[j] = *(const bf16x8_t*)(up + 4 * UT); pv[j] = *(const bf16x8_t*)(up + 8 * UT); }
        if (tid < 128) pdec = decay[((size_t)((b * 32 + 0) * 8 + h)) * 128 + tid];
    }
    for (int c = 0; c < 32; ++c) {
        const size_t row0 = (size_t)b * S + c * 64;
#pragma unroll
        for (int j = 0; j < 2; ++j) { const int p = tid + 512 * j, ur = p >> 4, c16 = p & 15;
            { const v4u w4 = __builtin_bit_cast(v4u, pq[j]); v2u lo, hi; lo.x = w4.x; lo.y = w4.y; hi.x = w4.z; hi.y = w4.w; *(LAS v2u*)(QB + ur * QS + c16 * 8) = lo; *(LAS v2u*)(QB + ur * QS + c16 * 8 + 4) = hi; }
            *(LAS bf16x8_t*)(KB + (2 * ur + (c16 >> 3)) * VS + (c16 & 7) * 8) = pk[j];
            *(LAS bf16x8_t*)(VB + (2 * ur + (c16 >> 3)) * VS + (c16 & 7) * 8) = pv[j]; }
        if (tid < 128) DEC[tid] = pdec;
        WG_BAR();
        if (c + 1 < 32) {
            const size_t rn = row0 + 64;
#pragma unroll
            for (int j = 0; j < 2; ++j) { const int p = tid + 512 * j; const bf16_t* up = U + uidx(rn + (p >> 4), h * 128 + (p & 15) * 8);
                pq[j] = *(const bf16x8_t*)up; pk[j] = *(const bf16x8_t*)(up + 4 * UT); pv[j] = *(const bf16x8_t*)(up + 8 * UT); }
            if (tid < 128) pdec = decay[((size_t)((b * 32 + c + 1) * 8 + h)) * 128 + tid];
        }
        f32x16 accT[2];
#pragma unroll
        for (int tt = 0; tt < 2; ++tt)
#pragma unroll
            for (int r = 0; r < 16; ++r) accT[tt][r] = 0.f;
#pragma unroll
        for (int xi = 0; xi < 2; ++xi)
#pragma unroll
            for (int s = 0; s < 2; ++s) {
                const bf16x8_t a = pack_bf16x8(X[xi][8 * s + 0], X[xi][8 * s + 1], X[xi][8 * s + 2], X[xi][8 * s + 3], X[xi][8 * s + 4], X[xi][8 * s + 5], X[xi][8 * s + 6], X[xi][8 * s + 7]);
#pragma unroll
                for (int tt = 0; tt < 2; ++tt) {
                    const LAS bf16_t* qp = QB + (32 * tt + l31) * QS + 64 * dh + 32 * xi + 16 * s + 4 * hh;
                    const bf16x8_t bq = cat_bf16x4(*(const LAS v2u*)qp, *(const LAS v2u*)(qp + 8));
                    accT[tt] = __builtin_amdgcn_mfma_f32_32x32x16_bf16(a, bq, accT[tt], 0, 0, 0);
                }
            }
#pragma unroll
        for (int xi = 0; xi < 2; ++xi) {
#pragma unroll
            for (int g4 = 0; g4 < 4; ++g4) { const f32x4_t dv = *(const LAS f32x4_t*)(DEC + 64 * dh + 32 * xi + 8 * g4 + 4 * hh);
                X[xi][4 * g4 + 0] *= dv[0]; X[xi][4 * g4 + 1] *= dv[1]; X[xi][4 * g4 + 2] *= dv[2]; X[xi][4 * g4 + 3] *= dv[3]; }
#pragma unroll
            for (int ks = 0; ks < 4; ++ks) {
                const bf16x8_t a = *(const LAS bf16x8_t*)(KB + (64 * dh + 32 * xi + l31) * VS + 16 * ks + 8 * hh), bv = *(const LAS bf16x8_t*)(VB + (32 * eb + l31) * VS + 16 * ks + 8 * hh);
                X[xi] = __builtin_amdgcn_mfma_f32_32x32x16_bf16(a, bv, X[xi], 0, 0, 0);
            }
        }
#pragma unroll
        for (int tt = 0; tt < 2; ++tt)
#pragma unroll
            for (int g4 = 0; g4 < 4; ++g4) { const f32x4_t ov = {accT[tt][4 * g4 + 0], accT[tt][4 * g4 + 1], accT[tt][4 * g4 + 2], accT[tt][4 * g4 + 3]};
                *(LAS f32x4_t*)(OT + (dh * 64 + 32 * tt + l31) * 132 + 32 * eb + 8 * g4 + 4 * hh) = ov; }
        WG_BAR();
#pragma unroll
        for (int j = 0; j < 2; ++j) { const int p = tid + 512 * j, t_ = p >> 4, c16 = p & 15; const LAS float* o0 = OT + t_ * 132 + c16 * 8; const LAS float* o1 = o0 + 64 * 132;
            const f32x4_t a0 = *(const LAS f32x4_t*)o0 + *(const LAS f32x4_t*)o1, a1 = *(const LAS f32x4_t*)(o0 + 4) + *(const LAS f32x4_t*)(o1 + 4);
            const bf16x8_t o_ = pack_bf16x8(a0[0], a0[1], a0[2], a0[3], a1[0], a1[1], a1[2], a1[3]);
            if (!dry) *(bf16x8_t*)(U + uidx(row0 + t_, h * 128 + c16 * 8)) = o_; }
    }
}

__device__ __forceinline__ void hgrn2_c_item(const Frame& F, const int dry, int b, int c, int h) {
    const bf16_t* U = (const bf16_t*)(F.ws + OFF_U); bf16_t* Y = (bf16_t*)(F.ws + OFF_A); const float* a_norm = F.in[5];
    const int w = F.wave, l31 = F.lane & 31, hh = F.lane >> 5;
    const size_t row0 = (size_t)b * S + c * 64;
    const f32x4_t an = *(const f32x4_t*)(a_norm + h * 128 + 4 * l31);
    v2u oi[4], p0[4], zz[4];
#pragma unroll
    for (int i = 0; i < 4; ++i) { const size_t row = row0 + 8 * w + 2 * i + hh;
        oi[i] = __builtin_nontemporal_load((const v2u*)(Y + row * D + h * 128 + 4 * l31)); p0[i] = __builtin_nontemporal_load((const v2u*)(U + uidx(row, h * 128 + 4 * l31)));
        zz[i] = __builtin_nontemporal_load((const v2u*)(U + uidx(row, 3072 + h * 128 + 4 * l31))); }
#pragma unroll
    for (int i = 0; i < 4; ++i) { const size_t row = row0 + 8 * w + 2 * i + hh;
        const float o0 = pg8::bflo(oi[i].x) + pg8::bflo(p0[i].x), o1 = pg8::bfhi(oi[i].x) + pg8::bfhi(p0[i].x);
        const float o2 = pg8::bflo(oi[i].y) + pg8::bflo(p0[i].y), o3 = pg8::bfhi(oi[i].y) + pg8::bfhi(p0[i].y);
        float ss = (o0 * o0 + o1 * o1) + (o2 * o2 + o3 * o3);
        ss += __shfl_xor(ss, 1); ss += __shfl_xor(ss, 2); ss += __shfl_xor(ss, 4); ss += __shfl_xor(ss, 8); ss += __shfl_xor(ss, 16);
        const float rs = rsqrtf(ss * (1.f / 128.f) + EPS);
        v2u yw; yw.x = pg8::cvt_pk_bf16(o0 * rs * an[0] * siluf_(pg8::bflo(zz[i].x)), o1 * rs * an[1] * siluf_(pg8::bfhi(zz[i].x)));
        yw.y = pg8::cvt_pk_bf16(o2 * rs * an[2] * siluf_(pg8::bflo(zz[i].y)), o3 * rs * an[3] * siluf_(pg8::bfhi(zz[i].y)));
        if (!dry) *(v2u*)(Y + row * D + h * 128 + 4 * l31) = yw; }
}

constexpr size_t OFF_MS = OFF_PART;
constexpr size_t OFF_ITEM1 = OFF_PART + 1 * MiB;

struct MlRaw { unsigned short xq[19], xk[19], vv[32]; float gi, gf, cwq[4], cbq, cwk[4], cbk, bi, bf; };
__device__ __forceinline__ void mlstm_a_load(const Frame& F, int b, int c, int h, MlRaw& r) {
    const bf16_t* U = (const bf16_t*)(F.ws + OFF_U);
    const int tid = F.tid, d = tid & 127, qq = tid >> 7, t0 = c * 64;
#pragma unroll
    for (int i = 0; i < 19; ++i) { const int t = t0 + 16 * qq - 3 + i; const bool ok = t >= 0; const bf16_t* up = U + uidx((size_t)b * S + (ok ? t : 0), h * 128 + d);
        r.xq[i] = ok ? up[0] : (unsigned short)0; r.xk[i] = ok ? up[4 * UT] : (unsigned short)0; }
    const int e = tid & 255, hf = tid >> 8;
    const bf16_t* vp = U + uidx((size_t)b * S + t0 + 32 * hf, 2048 + h * 256 + e);
#pragma unroll
    for (int i = 0; i < 32; ++i) r.vv[i] = vp[(size_t)i * 256];
    const float* gates = (const float*)(F.ws + OFF_GATES1); const size_t grow = (size_t)b * S + t0 + F.lane;
    r.gi = gates[grow * 16 + h]; r.gf = gates[grow * 16 + 8 + h];
    const float* cw = F.in[16]; const float* cb = F.in[17]; const int cq = h * 128 + d, ck = 1024 + h * 128 + d;
#pragma unroll
    for (int k = 0; k < 4; ++k) { r.cwq[k] = cw[k * 2048 + cq]; r.cwk[k] = cw[k * 2048 + ck]; }
    r.cbq = cb[cq]; r.cbk = cb[ck]; r.bi = F.in[18][h]; r.bf = F.in[19][h];
}
__device__ __forceinline__ void mlstm_a_item(const Frame& F, const int dry, int b, int c, int h, const MlRaw& raw) {
    constexpr int QS = 136, VS = 72;
    LAS bf16_t* QT = (LAS bf16_t*)F.lds;
    LAS bf16_t* KT = QT + 64 * QS;
    LAS bf16_t* VT = KT + 64 * QS;
    LAS bf16_t* AT = VT + 256 * VS;
    LAS float* BCS = (LAS float*)(AT + 64 * VS);
    LAS float* A2 = BCS + 64; LAS float* PM = A2 + 64; LAS float* KWS = PM + 64;
    LAS float* NL = KWS + 64;
    LAS float* DL = NL + 512;
    LAS bf16_t* KWT = (LAS bf16_t*)(DL + 256);
    LAS bf16_t* NT = KWT + 128 * VS;
    bf16_t* U = (bf16_t*)(F.ws + OFF_U); bf16_t* QA = (bf16_t*)F.out;     bf16_t* NUM = (bf16_t*)(F.ws + OFF_B);
    const float* gates = (const float*)(F.ws + OFF_GATES1); float* MS = (float*)(F.ws + OFF_MS); float* ITEM = (float*)(F.ws + OFF_ITEM1) + (size_t)((b * 32 + c) * 8 + h) * 256;
    const float* cw = F.in[16]; const float* cb = F.in[17];
    const int tid = F.tid, w = F.wave, lane = F.lane, d = tid & 127, qq = tid >> 7, t0 = c * 64;
    const size_t row0 = (size_t)b * S + t0;
    if (w == 0) {
        const size_t row = row0 + lane;
        const float li = raw.gi + raw.bi, xf = raw.gf + raw.bf;
        const float lf = fminf(xf, 0.f) - __logf(1.f + __expf(-fabsf(xf)));
        float bc = lf;
#pragma unroll
        for (int o = 1; o < 64; o <<= 1) { const float v_ = __shfl_up(bc, o); bc += (lane >= o) ? v_ : 0.f; }
        const float a2 = li - bc; float pm = a2;
#pragma unroll
        for (int o = 1; o < 64; o <<= 1) { const float v_ = __shfl_up(pm, o); pm = (lane >= o) ? fmaxf(pm, v_) : pm; }
        const float pml = __shfl(pm, 63), bl = __shfl(bc, 63);
        BCS[lane] = bc; A2[lane] = a2; PM[lane] = pm; KWS[lane] = __expf(a2 - pml);
        if (!dry) { MS[(row * 8 + h) * 4 + 0] = bc; MS[(row * 8 + h) * 4 + 1] = bc + pm; }
        if (lane == 0 && !dry) { ITEM[128] = bl + pml; ITEM[129] = bl; }
    }
    float kp[16];
    {
        float xq[19], xk[19];
#pragma unroll
        for (int i = 0; i < 19; ++i) { xq[i] = bf2f(raw.xq[i]); xk[i] = bf2f(raw.xk[i]); }
        const float q0 = raw.cwq[0], q1 = raw.cwq[1], q2 = raw.cwq[2], q3 = raw.cwq[3], qb = raw.cbq;
        const float k0 = raw.cwk[0], k1 = raw.cwk[1], k2 = raw.cwk[2], k3 = raw.cwk[3], kb = raw.cbk;
#pragma unroll
        for (int i = 0; i < 16; ++i) {
            const float qv = siluf_(qb + q0 * xq[i] + q1 * xq[i + 1] + q2 * xq[i + 2] + q3 * xq[i + 3]) * 0.08838834764831845f;
            kp[i] = siluf_(kb + k0 * xk[i] + k1 * xk[i + 1] + k2 * xk[i + 2] + k3 * xk[i + 3]);
            QT[(16 * qq + i) * QS + d] = (bf16_t)f2bf(qv); KT[(16 * qq + i) * QS + d] = (bf16_t)f2bf(kp[i]);
        }
    }
    bf16x8_t vt[4];
    {
        const int e = tid & 255, hf = tid >> 8;
        unsigned short vv[32];
#pragma unroll
        for (int i = 0; i < 32; ++i) vv[i] = raw.vv[i];
#pragma unroll
        for (int j = 0; j < 4; ++j) { v4u w4; w4.x = vv[8 * j] | ((unsigned)vv[8 * j + 1] << 16); w4.y = vv[8 * j + 2] | ((unsigned)vv[8 * j + 3] << 16); w4.z = vv[8 * j + 4] | ((unsigned)vv[8 * j + 5] << 16); w4.w = vv[8 * j + 6] | ((unsigned)vv[8 * j + 7] << 16);
            vt[j] = __builtin_bit_cast(bf16x8_t, w4); *(LAS bf16x8_t*)(VT + e * VS + 32 * hf + 8 * j) = vt[j]; }
    }
    WG_BAR();
    {
        bf16_t* vg = U + uidx(row0, 2048 + h * 256);
#pragma unroll
        for (int j = 0; j < 4; ++j) { const int p = tid + 512 * j; const bf16x8_t v_ = *(const LAS bf16x8_t*)(VT + (p >> 3) * VS + (p & 7) * 8); if (!dry) *(bf16x8_t*)(vg + (size_t)p * 8) = v_; }
        float kw[16], ns = 0.f;
#pragma unroll
        for (int i = 0; i < 16; ++i) { kw[i] = kp[i] * KWS[16 * qq + i]; ns += kw[i]; }
        NL[qq * 128 + d] = ns;
        LAS bf16_t* kp_ = KWT + d * VS + 16 * qq;
        { const bf16x8_t ka_ = pack_bf16x8(kw[0], kw[1], kw[2], kw[3], kw[4], kw[5], kw[6], kw[7]), kb_ = pack_bf16x8(kw[8], kw[9], kw[10], kw[11], kw[12], kw[13], kw[14], kw[15]); *(LAS bf16x8_t*)kp_ = ka_; *(LAS bf16x8_t*)(kp_ + 8) = kb_; }
#pragma unroll
        for (int j = 0; j < 2; ++j) { const int p = tid + 512 * j, row = p >> 4, c16 = p & 15; const bf16x8_t qv_ = *(const LAS bf16x8_t*)(QT + row * QS + c16 * 8); if (!dry) *(bf16x8_t*)(QA + (row0 + row) * D + h * 128 + c16 * 8) = qv_; }
    }
    {
        const int tb = w >> 1, r = lane & 15, g = lane >> 4;
#pragma unroll
        for (int k2 = 0; k2 < 2; ++k2) {
            const int sb = 2 * (w & 1) + k2;
            f32x4_t acc = {0.f, 0.f, 0.f, 0.f};
            if (sb <= tb) {
#pragma unroll
                for (int ks = 0; ks < 4; ++ks) {
                    const bf16x8_t a = *(const LAS bf16x8_t*)(KT + (16 * sb + r) * QS + 32 * ks + 8 * g), bb = *(const LAS bf16x8_t*)(QT + (16 * tb + r) * QS + 32 * ks + 8 * g);
                    acc = __builtin_amdgcn_mfma_f32_16x16x32_bf16(a, bb, acc, 0, 0, 0);
                }
            }
            const int t = 16 * tb + r, s0 = 16 * sb + 4 * g; const float pmt = PM[t];
            float sc[4], ds = 0.f;
#pragma unroll
            for (int j = 0; j < 4; ++j) { sc[j] = (s0 + j <= t) ? acc[j] * __expf(A2[s0 + j] - pmt) : 0.f; ds += sc[j]; }
            v2u pw; pw.x = pg8::cvt_pk_bf16(sc[0], sc[1]); pw.y = pg8::cvt_pk_bf16(sc[2], sc[3]);
            *(LAS v2u*)(AT + t * VS + s0) = pw;
            ds += __shfl_xor(ds, 16); ds += __shfl_xor(ds, 32);
            if (g == 0) DL[sb * 64 + t] = ds;
        }
    }
    WG_BAR();
    {
        const int l31 = lane & 31, hh = lane >> 5;
#pragma unroll
        for (int th = 0; th < 2; ++th) {
            f32x16 acc;
#pragma unroll
            for (int r = 0; r < 16; ++r) acc[r] = 0.f;
#pragma unroll
            for (int ks = 0; ks < 4; ++ks) {
                const bf16x8_t a = *(const LAS bf16x8_t*)(AT + (32 * th + l31) * VS + 16 * ks + 8 * hh), bb = *(const LAS bf16x8_t*)(VT + (32 * w + l31) * VS + 16 * ks + 8 * hh);
                acc = __builtin_amdgcn_mfma_f32_32x32x16_bf16(a, bb, acc, 0, 0, 0);
            }
#pragma unroll
            for (int r = 0; r < 16; ++r) { const int t = 32 * th + (r & 3) + 8 * (r >> 2) + 4 * hh; NT[t * 264 + 32 * w + l31] = (bf16_t)f2bf(acc[r]); }
        }
#pragma unroll
        for (int j = 0; j < 2; ++j) { const int p = tid + 512 * j, dd = p >> 3, c8 = p & 7; const bf16x8_t k_ = *(const LAS bf16x8_t*)(KWT + dd * VS + c8 * 8);
            if (!dry) *(bf16x8_t*)(QA + (row0 + (dd >> 1)) * D + 1024 + h * 128 + (dd & 1) * 64 + c8 * 8) = k_; }
        if (tid < 64 && !dry) MS[((row0 + tid) * 8 + h) * 4 + 2] = (DL[tid] + DL[64 + tid]) + (DL[128 + tid] + DL[192 + tid]);
        if (tid >= 128 && tid < 256 && !dry) { const int dd = tid - 128; ITEM[dd] = (NL[dd] + NL[128 + dd]) + (NL[256 + dd] + NL[384 + dd]); }
    }
    WG_BAR();
#pragma unroll
    for (int j = 0; j < 4; ++j) { const int p = tid + 512 * j, t_ = p >> 5, c32 = p & 31; const bf16x8_t o_ = *(const LAS bf16x8_t*)(NT + t_ * 264 + c32 * 8);
        if (!dry) *(bf16x8_t*)(NUM + (row0 + t_) * D + h * 256 + c32 * 8) = o_; }
    WG_BAR();
}

__device__ __forceinline__ void mlstm_b_phase(const Frame& F, const int dry, int b, int h, int eq) {
    constexpr int QS = 132, VS = 72, OS = 72;
    constexpr int SET_B = (64 * QS + 128 * VS + 64 * VS) * 2;
    LAS unsigned char* L = F.lds;
    LAS bf16_t* OB0 = (LAS bf16_t*)(L + 2 * SET_B);
    LAS float* NS0 = (LAS float*)(L + 2 * SET_B + 2 * 64 * OS * 2);
    LAS float* DECC = NS0 + 256;
    LAS float* SLOC = DECC + 32;
    LAS float* NLB = SLOC + 32;
    bf16_t* U = (bf16_t*)(F.ws + OFF_U); const bf16_t* QA = (const bf16_t*)F.out;
    float* MS = (float*)(F.ws + OFF_MS); float* ITEM0 = (float*)(F.ws + OFF_ITEM1) + (size_t)((b * 32) * 8 + h) * 256;
    int tid = threadIdx.x; asm volatile("" : "+v"(tid));
    const int w = __builtin_amdgcn_readfirstlane(F.wave), lane = tid & 63, l31 = lane & 31, hh = lane >> 5;
    if (w == 0) {
        const float Mc_l = (lane < 32) ? ITEM0[(size_t)lane * 2048 + 128] : 0.f, bl_l = (lane < 32) ? ITEM0[(size_t)lane * 2048 + 129] : 0.f;
        float m = 0.f, mine_m = 0.f, mine_dec = 0.f, mine_sl = 0.f;
        for (int c = 0; c < 32; ++c) { const float Mc = __shfl(Mc_l, c), bl = __shfl(bl_l, c), mn = fmaxf(bl + m, Mc);
            if (lane == c) { mine_m = m; mine_dec = __expf(bl + m - mn); mine_sl = __expf(Mc - mn); }
            m = mn; }
        if (lane < 32) { DECC[lane] = mine_dec; SLOC[lane] = mine_sl; if (!dry && eq == 0) ITEM0[(size_t)lane * 2048 + 130] = mine_m; }
    }
    if (tid < 128) NS0[tid] = 0.f;
    if (w < 4) {
        const int eb = w & 1; const bool own = w < 2;
        f32x16 X[4];
#pragma unroll
        for (int xi = 0; xi < 4; ++xi)
#pragma unroll
            for (int r = 0; r < 16; ++r) X[xi][r] = 0.f;
        WG_BAR();
        WG_BAR();
        for (int c = 0; c < 32; ++c) {
            const int par = c & 1;
            const LAS bf16_t* QB = (const LAS bf16_t*)(L + par * SET_B); const LAS bf16_t* KB = QB + 64 * QS; const LAS bf16_t* VB = KB + 128 * VS;
            LAS bf16_t* OB = OB0 + par * 64 * OS;
            if (own) {
            const float dec = DECC[c];
            bf16x8_t bv[4];
#pragma unroll
            for (int ks = 0; ks < 4; ++ks) bv[ks] = *(const LAS bf16x8_t*)(VB + (32 * eb + l31) * VS + 16 * ks + 8 * hh);
            f32x16 accT[2];
#pragma unroll
            for (int tt = 0; tt < 2; ++tt)
#pragma unroll
                for (int r = 0; r < 16; ++r) accT[tt][r] = 0.f;
            bf16x8_t fq[3][2], fk[3][2], ax[2];
#define MLB_LDF(HQ) { const int xi_ = (HQ) >> 1, s_ = (HQ) & 1; \
                if (xi_ < 4) { _Pragma("unroll") for (int tt = 0; tt < 2; ++tt) { const LAS bf16_t* qp = QB + (32 * tt + l31) * QS + 32 * xi_ + 16 * s_ + 4 * hh; fq[(HQ) % 3][tt] = cat_bf16x4(*(const LAS v2u*)qp, *(const LAS v2u*)(qp + 8)); } } \
                if (xi_ >= 1) { _Pragma("unroll") for (int k2 = 0; k2 < 2; ++k2) fk[(HQ) % 3][k2] = *(const LAS bf16x8_t*)(KB + (32 * (xi_ - 1) + l31) * VS + 16 * (2 * s_ + k2) + 8 * hh); } }
            MLB_LDF(0) MLB_LDF(1)
            __builtin_amdgcn_s_setprio(1);
#pragma unroll
            for (int hq = 0; hq < 10; ++hq) {
                const int xi = hq >> 1, s_ = hq & 1;
                if (hq + 2 < 10) MLB_LDF(hq + 2)
                if (s_ == 0) {
                    if (xi < 4) {
#pragma unroll
                        for (int s2 = 0; s2 < 2; ++s2) ax[s2] = pack_bf16x8(X[xi][8 * s2 + 0], X[xi][8 * s2 + 1], X[xi][8 * s2 + 2], X[xi][8 * s2 + 3], X[xi][8 * s2 + 4], X[xi][8 * s2 + 5], X[xi][8 * s2 + 6], X[xi][8 * s2 + 7]);
                    }
                    if (xi >= 1) {
#pragma unroll
                        for (int r = 0; r < 16; ++r) X[xi - 1][r] *= dec;
                    }
                }
                __builtin_amdgcn_sched_barrier(0);
#pragma unroll
                for (int u = 0; u < 2; ++u) {
                    if (xi < 4) accT[u] = __builtin_amdgcn_mfma_f32_32x32x16_bf16(ax[s_], fq[hq % 3][u], accT[u], 0, 0, 0);
                    if (xi >= 1) X[xi - 1] = __builtin_amdgcn_mfma_f32_32x32x16_bf16(fk[hq % 3][u], bv[2 * s_ + u], X[xi - 1], 0, 0, 0);
                }
                __builtin_amdgcn_sched_barrier(0);
            }
#undef MLB_LDF
            __builtin_amdgcn_s_setprio(0);
#pragma unroll
            for (int tt = 0; tt < 2; ++tt)
#pragma unroll
                for (int g4 = 0; g4 < 4; ++g4) { v2u o_; o_.x = pg8::cvt_pk_bf16(accT[tt][4 * g4 + 0], accT[tt][4 * g4 + 1]); o_.y = pg8::cvt_pk_bf16(accT[tt][4 * g4 + 2], accT[tt][4 * g4 + 3]);
                    *(LAS v2u*)(OB + (32 * tt + l31) * OS + 32 * eb + 8 * g4 + 4 * hh) = o_; }
            }
            if (!own) {
                const int t2 = tid - 128;
                if (c >= 1) { const LAS bf16_t* OBp = OB0 + ((c - 1) & 1) * 64 * OS; bf16_t* og = U + uidx((size_t)b * S + (size_t)(c - 1) * 64, h * 256 + 64 * eq);
#pragma unroll
                    for (int j = 0; j < 4; ++j) { const int p = t2 + 128 * j, t_ = p >> 3, c8 = p & 7; const bf16x8_t o_ = *(const LAS bf16x8_t*)(OBp + t_ * OS + c8 * 8);
                        if (!dry) *(bf16x8_t*)(og + (size_t)t_ * 256 + c8 * 8) = o_; } }
                NS0[((c + 1) & 1) * 128 + t2] = DECC[c] * NS0[par * 128 + t2] + SLOC[c] * NLB[par * 128 + t2];
            }
            if (eq == 0 && !own) {
                const LAS float* NSc = NS0 + par * 128;
                const int t2 = tid - 128, tq = t2 >> 1, d0 = (t2 & 1) * 64; float sn = 0.f;
#pragma unroll
                for (int j = 0; j < 16; ++j) { const v2u qv = *(const LAS v2u*)(QB + tq * QS + d0 + 4 * j); const f32x4_t nv = *(const LAS f32x4_t*)(NSc + d0 + 4 * j);
                    sn += (pg8::bflo(qv.x) * nv[0] + pg8::bfhi(qv.x) * nv[1]) + (pg8::bflo(qv.y) * nv[2] + pg8::bfhi(qv.y) * nv[3]); }
                sn += __shfl_xor(sn, 1);
                if ((t2 & 1) == 0 && !dry) *(float*)((char*)(MS + (((size_t)b * S + (size_t)c * 64) * 8 + h) * 4 + 3) + (unsigned)(tq * 128)) = sn;
            }
            WG_BAR();
        }
        if (!own) { const int t2 = tid - 128; const LAS bf16_t* OBp = OB0 + (31 & 1) * 64 * OS; bf16_t* og = U + uidx((size_t)b * S + (size_t)31 * 64, h * 256 + 64 * eq);
#pragma unroll
            for (int j = 0; j < 4; ++j) { const int p = t2 + 128 * j, t_ = p >> 3, c8 = p & 7; const bf16x8_t o_ = *(const LAS bf16x8_t*)(OBp + t_ * OS + c8 * 8);
                if (!dry) *(bf16x8_t*)(og + (size_t)t_ * 256 + c8 * 8) = o_; } }
        WG_BAR();
    } else {
        const int ltid = tid - 256;
        bf16x8_t pq0[4], pk0[4], pv0[2], pq1[4], pk1[4], pv1[2], pq2[4], pk2[4], pv2[2]; float pn0 = 0.f, pn1 = 0.f, pn2 = 0.f;
        const unsigned qo_ = (unsigned)(((ltid >> 4) * D + (ltid & 15) * 8) * 2), vo_ = (unsigned)(((ltid >> 5) * 256 + (ltid & 31) * 8) * 2);
        const char* QAb = (const char*)(QA + (size_t)b * S * D + h * 128);
        const char* UVb = (const char*)(U + ((size_t)(8 + h) * 8192 + (size_t)b * S + 16 * eq) * 256);
#define ML_LOAD(CH, PQ, PK, PV, PNL) { \
_Pragma("unroll") \
            for (int j = 0; j < 4; ++j) { const char* ap = QAb + (size_t)(64 * (CH) + 16 * j) * (D * 2) + qo_; PQ[j] = *(const bf16x8_t*)ap; PK[j] = *(const bf16x8_t*)(ap + 2048); \
                if (j < 2) PV[j] = *(const bf16x8_t*)(UVb + (size_t)(64 * (CH) + 8 * j) * 512 + vo_); } \
            PNL = *(const float*)((const char*)(ITEM0 + (size_t)(CH) * 2048) + (unsigned)((ltid & 127) * 4)); }
#define ML_STAGE(CH, PQ, PK, PV, PNL) { const float sl_ = SLOC[(CH)]; if (ltid < 128) NLB[((CH) & 1) * 128 + ltid] = PNL; LAS bf16_t* QBs = (LAS bf16_t*)(L + ((CH) & 1) * SET_B); LAS bf16_t* KBs = QBs + 64 * QS; LAS bf16_t* VBs = KBs + 128 * VS; \
_Pragma("unroll") \
            for (int j = 0; j < 4; ++j) { const int p = ltid + 256 * j, ur = p >> 4, c16 = p & 15; \
                { const v4u w4 = __builtin_bit_cast(v4u, PQ[j]); v2u lo, hi; lo.x = w4.x; lo.y = w4.y; hi.x = w4.z; hi.y = w4.w; *(LAS v2u*)(QBs + ur * QS + c16 * 8) = lo; *(LAS v2u*)(QBs + ur * QS + c16 * 8 + 4) = hi; } \
                *(LAS bf16x8_t*)(KBs + (2 * ur + (c16 >> 3)) * VS + (c16 & 7) * 8) = PK[j]; \
                if (j < 2) { const int vr = p >> 5, c32 = p & 31; const v4u w4 = __builtin_bit_cast(v4u, PV[j]); \
                  const bf16x8_t vs_ = pack_bf16x8(pg8::bflo(w4.x) * sl_, pg8::bfhi(w4.x) * sl_, pg8::bflo(w4.y) * sl_, pg8::bfhi(w4.y) * sl_, pg8::bflo(w4.z) * sl_, pg8::bfhi(w4.z) * sl_, pg8::bflo(w4.w) * sl_, pg8::bfhi(w4.w) * sl_); \
                  *(LAS bf16x8_t*)(VBs + (4 * vr + (c32 >> 3)) * VS + (c32 & 7) * 8) = vs_; } \
                __builtin_amdgcn_sched_barrier(0); } }
        ML_LOAD(0, pq0, pk0, pv0, pn0) ML_LOAD(1, pq1, pk1, pv1, pn1) ML_LOAD(2, pq2, pk2, pv2, pn2)
        WG_BAR();
        ML_STAGE(0, pq0, pk0, pv0, pn0)
        ML_LOAD(3, pq0, pk0, pv0, pn0)
        WG_BAR();
#define ML_ITER(CIDX, PQ, PK, PV, PNL) { const int c = (CIDX); \
            if (c + 1 < 32) { ML_STAGE(c + 1, PQ, PK, PV, PNL) if (c + 4 < 32) ML_LOAD(c + 4, PQ, PK, PV, PNL) } \
            WG_BAR(); __builtin_amdgcn_sched_barrier(0); }
#pragma unroll 1
        for (int c0 = 0; c0 < 30; c0 += 6) { ML_ITER(c0, pq1, pk1, pv1, pn1) ML_ITER(c0 + 1, pq2, pk2, pv2, pn2) ML_ITER(c0 + 2, pq0, pk0, pv0, pn0)
                                            ML_ITER(c0 + 3, pq1, pk1, pv1, pn1) ML_ITER(c0 + 4, pq2, pk2, pv2, pn2) ML_ITER(c0 + 5, pq0, pk0, pv0, pn0) }
        ML_ITER(30, pq1, pk1, pv1, pn1) ML_ITER(31, pq2, pk2, pv2, pn2)
        WG_BAR();
#undef ML_ITER
#undef ML_STAGE
#undef ML_LOAD
    }
}

struct McRaw { v4u oi[4], nm[4], gg[4]; f32x4_t st[4]; float m_st; };
__device__ __forceinline__ void mlstm_c_load(const Frame& F, int b, int c, int h, McRaw& r) {
    const bf16_t* U = (const bf16_t*)(F.ws + OFF_U); const bf16_t* Y = (const bf16_t*)(F.ws + OFF_B);
    const float* MS = (const float*)(F.ws + OFF_MS); const float* ITEM = (const float*)(F.ws + OFF_ITEM1) + (size_t)((b * 32 + c) * 8 + h) * 256;
    const int w = F.wave, l32 = F.lane & 31, hf = F.lane >> 5; const size_t row0 = (size_t)b * S + c * 64;
    const char* ub = (const char*)(U + uidx(row0, h * 256)); const char* gb = (const char*)(U + uidx(row0, 4096 + h * 256)); const char* yb = (const char*)(Y + row0 * D + h * 256); const char* mb = (const char*)(MS + (row0 * 8 + h) * 4);
    const unsigned uo = (unsigned)(((8 * w + hf) * 256 + 8 * l32) * 2), yo = (unsigned)(((8 * w + hf) * D + 8 * l32) * 2), mo = (unsigned)((8 * w + hf) * 128);
#pragma unroll
    for (int i = 0; i < 4; ++i) {
        r.oi[i] = __builtin_nontemporal_load((const v4u*)(ub + uo + i * 1024)); r.nm[i] = __builtin_nontemporal_load((const v4u*)(yb + yo + i * (2 * D * 2))); r.gg[i] = __builtin_nontemporal_load((const v4u*)(gb + uo + i * 1024));
        r.st[i] = *(const f32x4_t*)(mb + mo + i * 256); }
    r.m_st = ITEM[130];
}
__device__ __forceinline__ void mlstm_c_item(const Frame& F, const int dry, int b, int c, int h, const McRaw& r) {
    bf16_t* Y = (bf16_t*)(F.ws + OFF_B);
    const int w = F.wave, l32 = F.lane & 31, hf = F.lane >> 5;
    const size_t row0 = (size_t)b * S + c * 64;
    const f32x4_t cn0 = *(const f32x4_t*)(F.in[20] + h * 256 + 8 * l32), cn1 = *(const f32x4_t*)(F.in[20] + h * 256 + 8 * l32 + 4);
    const float m_st = r.m_st;
#pragma unroll
    for (int i = 0; i < 4; ++i) { const size_t row = row0 + 8 * w + 2 * i + hf;
        const float bcs = r.st[i][0], mloc = r.st[i][1], dloc = r.st[i][2], di = r.st[i][3];
        const float mt = fmaxf(mloc, bcs + m_st), gi = __expf(bcs + m_st - mt), gl = __expf(mloc - mt);
        const float den = gi * di + gl * dloc, inv = 1.f / fmaxf(fabsf(den), __expf(-mt));
        const v4u o = r.oi[i], n_ = r.nm[i], g = r.gg[i];
        const float h0 = (gi * pg8::bflo(o.x) + gl * pg8::bflo(n_.x)) * inv, h1 = (gi * pg8::bfhi(o.x) + gl * pg8::bfhi(n_.x)) * inv;
        const float h2 = (gi * pg8::bflo(o.y) + gl * pg8::bflo(n_.y)) * inv, h3 = (gi * pg8::bfhi(o.y) + gl * pg8::bfhi(n_.y)) * inv;
        const float h4 = (gi * pg8::bflo(o.z) + gl * pg8::bflo(n_.z)) * inv, h5 = (gi * pg8::bfhi(o.z) + gl * pg8::bfhi(n_.z)) * inv;
        const float h6 = (gi * pg8::bflo(o.w) + gl * pg8::bflo(n_.w)) * inv, h7 = (gi * pg8::bfhi(o.w) + gl * pg8::bfhi(n_.w)) * inv;
        float ss = ((h0 * h0 + h1 * h1) + (h2 * h2 + h3 * h3)) + ((h4 * h4 + h5 * h5) + (h6 * h6 + h7 * h7));
        ss += __shfl_xor(ss, 1); ss += __shfl_xor(ss, 2); ss += __shfl_xor(ss, 4); ss += __shfl_xor(ss, 8); ss += __shfl_xor(ss, 16);
        const float rs = rsqrtf(ss * (1.f / 256.f) + EPS);
        v4u yw; yw.x = pg8::cvt_pk_bf16(h0 * rs * cn0[0] * pg8::bflo(g.x), h1 * rs * cn0[1] * pg8::bfhi(g.x)); yw.y = pg8::cvt_pk_bf16(h2 * rs * cn0[2] * pg8::bflo(g.y), h3 * rs * cn0[3] * pg8::bfhi(g.y));
        yw.z = pg8::cvt_pk_bf16(h4 * rs * cn1[0] * pg8::bflo(g.z), h5 * rs * cn1[1] * pg8::bfhi(g.z)); yw.w = pg8::cvt_pk_bf16(h6 * rs * cn1[2] * pg8::bflo(g.w), h7 * rs * cn1[3] * pg8::bfhi(g.w));
        if (!dry) *(v4u*)(Y + row * D + h * 256 + 8 * l32) = yw; }
}

#ifndef MK_DUP
#define MK_DUP -1
#endif
enum { PH_P0 = 0, PH_IN0, PH_MIX0A, PH_MIX0B, PH_MIX0C, PH_OUT0, PH_GATE0, PH_IN1, PH_MIX1A, PH_MIX1B, PH_MIX1C, PH_OUT1, PH_GATE1, PH_FINAL, PH_END };

__global__ void __launch_bounds__(NWAVES * 64, 2) mk_fwd(Ptrs args) {
    extern __shared__ __attribute__((aligned(16))) unsigned char lds_raw[];
    Frame F;
    F.lds = (LAS unsigned char*)lds_raw;
    F.tid = threadIdx.x; F.lane = F.tid & 63; F.wave = __builtin_amdgcn_readfirstlane(F.tid >> 6);
    F.G = gridDim.x; F.bid = blockIdx.x; F.in = args.in; F.out = args.out; F.ws = args.ws;
    volatile LAS unsigned* MISC = (volatile LAS unsigned*)(F.lds + MISC_OFF);
    if (F.tid < 32) MISC[F.tid] = 0u;
    __syncthreads();
    XcdBarrier bar = xcd_barrier_post((unsigned*)(F.ws + OFF_CTL) + CW_BAR + args.li * XCD_BAR_WORDS, MISC + 8);
    const int lo = args.ph_lo, hi = args.ph_hi, dryv = args.dup;
#define IN_(k) (lo <= (k) && (k) < hi)
#define RUN(k, BODY) do { if (IN_(k)) { { int t_ = threadIdx.x; asm volatile("" : "+v"(t_)); F.tid = t_; F.lane = t_ & 63; } if (MK_DUP == (k)) { BODY(dryv) xcd_barrier(bar); } BODY(0) } } while (0)
#ifndef MK_TSPROBE
#define MK_TSPROBE -1
#endif
    unsigned long long* const tsb = (unsigned long long*)(F.ws + OFF_CTL + 524288);
#define STAMP(k) do { if (MK_TSPROBE >= 0 && F.bid == 0 && F.tid == 0) __hip_atomic_store(tsb + (k), (unsigned long long)__builtin_amdgcn_s_memrealtime(), __ATOMIC_RELAXED, __HIP_MEMORY_SCOPE_AGENT); } while (0)
#define SEAM(k) do { if (IN_(k) && IN_((k) + 1)) xcd_barrier(bar); STAMP((k) + 1); } while (0)
    STAMP(0);
    unsigned char* ws = F.ws;
    bf16_t* A = (bf16_t*)(ws + OFF_A); bf16_t* B = (bf16_t*)(ws + OFF_B); bf16_t* U = (bf16_t*)(ws + OFF_U);
    float* plpart = (float*)(ws + OFF_PART); float* hpart = plpart + (size_t)M * 32;
    const bf16_t* P16 = (const bf16_t*)(ws + OFF_WIN0); bf16_t* PL = U;
    const bf16_t* PLEW = (const bf16_t*)(ws + OFF_PLEW); bf16_t* PL1 = (bf16_t*)(ws + OFF_WIN1);
    float* plpart1 = (float*)(ws + OFF_WIN0 + 8 * MiB);

#define BODY_PH_P0(DRY) { p0_prologue(F); }
#define BODY_PH_IN0(DRY) { pg8::Gemm g{(const bf16_t*)F.out, (const bf16_t*)(ws + OFF_WIN0), M, 6144, 2048}; pg8::StaticOrder So; So.init(M, 6144, F.G, F.bid); \
        pg8::EpiIn0 E{U, (const float*)(ws + OFF_SMALL) + 1024, DRY}; \
        pg8::gemm_phase<pg8::EpiIn0, pg8::StaticOrder, true, true>(F.lds, g, So, E); }
#define BODY_PH_MIX0A(DRY) { cvt_p_phase(F, DRY); \
        { H2Raw cur_, nxt_; if (F.bid < 1024) hgrn2_a_load(F, F.bid >> 8, (F.bid >> 3) & 31, F.bid & 7, cur_); \
          for (int it = F.bid; it < 1024; it += F.G) { const int in_ = it + F.G; if (in_ < 1024) hgrn2_a_load(F, in_ >> 8, (in_ >> 3) & 31, in_ & 7, nxt_); hgrn2_a_item(F, DRY, it >> 8, (it >> 3) & 31, it & 7, cur_); cur_ = nxt_; } } \
        { LruRaw cur_, nxt_; LruW wf_; rglru_a_weights(F, F.bid & 7, wf_); if (F.bid < 1024) rglru_a_load(F, F.bid >> 8, (F.bid >> 3) & 31, F.bid & 7, cur_); \
          for (int it = F.bid; it < 1024; it += F.G) { const int in_ = it + F.G; if (in_ < 1024) rglru_a_load(F, in_ >> 8, (in_ >> 3) & 31, in_ & 7, nxt_); rglru_a_item(F, DRY, it >> 8, (it >> 3) & 31, it & 7, cur_, wf_); cur_ = nxt_; } } }
#define BODY_PH_MIX0B(DRY) { if (F.bid < 32) hgrn2_b_phase(F, DRY, F.bid >> 3, F.bid & 7); else { for (int it = F.bid - 32; it < 1024; it += F.G - 32) rglru_b_item(F, DRY, it >> 8, (it >> 3) & 31, it & 7); \
        p0_layer1_weights(F, (F.bid - 32) * NWAVES + F.wave, (F.G - 32) * NWAVES); } }
#define BODY_PH_MIX0C(DRY) { for (int it = F.bid; it < 1024; it += F.G) hgrn2_c_item(F, DRY, it >> 8, (it >> 3) & 31, it & 7); }
#define BODY_PH_OUT0(DRY) { { pg8::Gemm g{A, (const bf16_t*)(ws + OFF_WOUT0), M, 2048, 2048}; pg8::StaticOrder So; So.init(M, 2048, F.G, F.bid); \
          pg8::EpiOut<false> E{(const bf16_t*)F.out, B, DRY}; \
          pg8::gemm_phase<pg8::EpiOut<false>, pg8::StaticOrder, true, true>(F.lds, g, So, E); } \
        { unsigned char* ws2 = ws; asm volatile("" : "+s"(ws2));     \
          pg8::Gemm g{(const bf16_t*)(ws2 + OFF_WIN0), (const bf16_t*)(ws2 + OFF_PLEW), M, 2048, 256}; pg8::StaticOrder So; So.init(M, 2048, F.G, F.bid); \
          pg8::EpiPle E{(bf16_t*)(ws2 + OFF_U), (float*)(ws2 + OFF_PART), DRY}; \
          pg8::gemm_phase<pg8::EpiPle, pg8::StaticOrder, true, true>(F.lds, g, So, E); } }
#define BODY_PH_GATE0(DRY) { pg8::Gemm g{B, (const bf16_t*)(ws + OFF_WG0), M, 2048, 2048}; pg8::StaticOrder So; So.init(M, 2048, F.G, F.bid); \
        pg8::EpiGate E{B, A, nullptr, PL, plpart, F.in[23], hpart, DRY}; \
        pg8::gemm_phase<pg8::EpiGate, pg8::StaticOrder, true, true>(F.lds, g, So, E); }
#define BODY_PH_IN1(DRY) { pg8::Gemm g{A, (const bf16_t*)(ws + OFF_WIN1), M, 8192, 2048}; pg8::StaticOrderMix32 So; So.init(M, 8192, F.G, F.bid); \
        pg8::EpiIn1 E{U, hpart, DRY}; \
        pg8::gemm_phase<pg8::EpiIn1, pg8::StaticOrderMix32, true, true>(F.lds, g, So, E); \
        gates1_phase(F, DRY); }
#define BODY_PH_MIX1A(DRY) { MlRaw cur_, nxt_; if (F.bid < 1024) mlstm_a_load(F, F.bid >> 8, (F.bid >> 3) & 31, F.bid & 7, cur_); \
        for (int it = F.bid; it < 1024; it += F.G) { const int in_ = it + F.G; if (in_ < 1024) mlstm_a_load(F, in_ >> 8, (in_ >> 3) & 31, in_ & 7, nxt_); mlstm_a_item(F, DRY, it >> 8, (it >> 3) & 31, it & 7, cur_); cur_ = nxt_; } }
#define BODY_PH_MIX1B(DRY) { if (F.bid < 128) mlstm_b_phase(F, DRY, F.bid >> 5, F.bid & 7, (F.bid >> 3) & 3);     \
    else { \
        pg8::Gemm g{P16 + (size_t)M * PLE, PLEW + (size_t)2048 * 256, M, 2048, 256}; pg8::StaticOrder So; So.init(M, 2048, F.G - 128, F.bid - 128); \
        pg8::EpiPle E{PL1, plpart1, DRY}; \
        pg8::gemm_phase<pg8::EpiPle, pg8::StaticOrder, true, true>(F.lds, g, So, E); } }
#define BODY_PH_MIX1C(DRY) { McRaw cur_, nxt_; if (F.bid < 1024) mlstm_c_load(F, F.bid >> 8, (F.bid >> 3) & 31, F.bid & 7, cur_); \
        for (int it = F.bid; it < 1024; it += F.G) { const int in_ = it + F.G; if (in_ < 1024) mlstm_c_load(F, in_ >> 8, (in_ >> 3) & 31, in_ & 7, nxt_); mlstm_c_item(F, DRY, it >> 8, (it >> 3) & 31, it & 7, cur_); cur_ = nxt_; } }
#define BODY_PH_OUT1(DRY) { pg8::Gemm g{B, (const bf16_t*)(ws + OFF_WOUT1), M, 2048, 2048}; pg8::StaticOrder So; So.init(M, 2048, F.G, F.bid); \
          pg8::EpiOut<false> E{A, A, DRY}; \
          pg8::gemm_phase<pg8::EpiOut<false>, pg8::StaticOrder, true, true>(F.lds, g, So, E); }
#define BODY_PH_GATE1(DRY) { pg8::Gemm g{A, (const bf16_t*)(ws + OFF_WG1), M, 2048, 2048}; pg8::StaticOrder So; So.init(M, 2048, F.G, F.bid); \
        float peps = 0.f; \
        if (MK_TSPROBE >= 0) { const unsigned long long t0_ = __hip_atomic_load(tsb + (MK_TSPROBE >= 0 ? MK_TSPROBE : 0), __ATOMIC_RELAXED, __HIP_MEMORY_SCOPE_AGENT), t1_ = __hip_atomic_load(tsb + (MK_TSPROBE >= 0 ? MK_TSPROBE : 0) + 1, __ATOMIC_RELAXED, __HIP_MEMORY_SCOPE_AGENT); \
            unsigned bk = (unsigned)((t1_ - t0_) / 500ull); if (bk > 95u) bk = 95u; peps = sqrtf((float)bk * 1e-6f); }     \
        pg8::EpiGateFinal E{A, F.out, PL1, plpart1, F.in[23] + D, F.in[25], (float*)(ws + OFF_GATES1), (unsigned*)(ws + OFF_CTL) + CW_FIN, peps, DRY}; \
        pg8::gemm_phase<pg8::EpiGateFinal, pg8::StaticOrder, false, true>(F.lds, g, So, E); }

    RUN(PH_P0, BODY_PH_P0);
    SEAM(PH_P0);
    RUN(PH_IN0, BODY_PH_IN0);
    SEAM(PH_IN0);
    RUN(PH_MIX0A, BODY_PH_MIX0A);
    SEAM(PH_MIX0A);
    RUN(PH_MIX0B, BODY_PH_MIX0B);
    SEAM(PH_MIX0B);
    RUN(PH_MIX0C, BODY_PH_MIX0C);
    SEAM(PH_MIX0C);
    RUN(PH_OUT0, BODY_PH_OUT0);
    SEAM(PH_OUT0);
    RUN(PH_GATE0, BODY_PH_GATE0);
    SEAM(PH_GATE0);
    RUN(PH_IN1, BODY_PH_IN1);
    SEAM(PH_IN1);
    RUN(PH_MIX1A, BODY_PH_MIX1A);
    SEAM(PH_MIX1A);
    RUN(PH_MIX1B, BODY_PH_MIX1B);
    SEAM(PH_MIX1B);
    RUN(PH_MIX1C, BODY_PH_MIX1C);
    SEAM(PH_MIX1C);
    RUN(PH_OUT1, BODY_PH_OUT1);
    SEAM(PH_OUT1);
    RUN(PH_GATE1, BODY_PH_GATE1);
#undef IN_
#undef SEAM
#undef RUN
}


extern "C" void kernel_launch(void* const* d_in, const int* in_sizes, int n_in, void* d_out, int out_size, void* d_ws, size_t ws_size, hipStream_t stream) {
    static int grid = 0;
    if (grid == 0) {
        if (n_in != 26 || ws_size < WS_END || out_size != M * D) { fprintf(stderr, "kernel_launch: unexpected problem (n_in %d, ws %zu, out %d)\n", n_in, ws_size, out_size); grid = -1; return; }
        int dev = 0, cus = 0, per_cu = 0;
        if (hipGetDevice(&dev) != hipSuccess || hipDeviceGetAttribute(&cus, hipDeviceAttributeMultiprocessorCount, dev) != hipSuccess) { grid = -1; return; }
        if (hipFuncSetAttribute((const void*)mk_fwd, hipFuncAttributeMaxDynamicSharedMemorySize, LDS_BYTES) != hipSuccess) { fprintf(stderr, "kernel_launch: hipFuncSetAttribute failed\n"); grid = -1; return; }
        if (hipOccupancyMaxActiveBlocksPerMultiprocessor(&per_cu, (const void*)mk_fwd, NWAVES * 64, LDS_BYTES) != hipSuccess || per_cu < 1) { fprintf(stderr, "kernel_launch: occupancy query says %d blocks per CU\n", per_cu); (void)hipGetLastError(); grid = -1; return; }
        grid = cus;
    }
    if (grid < 0) return;
    (void)hipMemsetAsync((char*)d_ws + OFF_CTL, 0, CTL_ZERO_BYTES, stream);
    Ptrs a{};
    for (int i = 0; i < 26; ++i) a.in[i] = (const float*)d_in[i];
    a.out = (float*)d_out; a.ws = (unsigned char*)d_ws; a.ph_lo = PH_P0; a.ph_hi = PH_END; a.li = 0; a.dup = 1;
    void* kargs[] = {&a};
    const hipError_t e = hipLaunchCooperativeKernel((const void*)mk_fwd, dim3(grid), dim3(NWAVES * 64), kargs, LDS_BYTES, stream);
    if (e != hipSuccess) fprintf(stderr, "kernel_launch: cooperative launch failed: %s (grid %d)\n", hipGetErrorString(e), grid);
}
```
